# Optimizing an MI355X kernel written in HIP

```python
import math
import jax, jax.numpy as jnp
from jax import lax
import numpy as np

D_MODEL = 1024
BATCH = 8
SEQ = 4096
DEPTH = 2

HEAD_DIM = 64
ATT_HEADS = 6
CONV_GROUPS = 4
RWKV_HEADS = 6
ATT_W = ATT_HEADS * HEAD_DIM
CONV_W = CONV_GROUPS * HEAD_DIM
RWKV_W = RWKV_HEADS * HEAD_DIM
D_MIX = ATT_W + CONV_W + RWKV_W
DIFF_HALF = HEAD_DIM // 2
CONV_K = 3
DECAY_LORA = 64
ICLR_LORA = 64
GATE_LORA = 128
RWKV_SPLITS = (RWKV_W, RWKV_W, RWKV_W, DECAY_LORA, ICLR_LORA, GATE_LORA)
RWKV_COLS = 3 * RWKV_W + DECAY_LORA + ICLR_LORA + GATE_LORA
N_IN = 3 * ATT_W + 3 * CONV_W + RWKV_COLS
D_FF = 4 * D_MODEL
Q_BLOCK = 128
NORM_EPS = 1e-6
GN_EPS = 64e-5

kernel_name = 'hymba_diffattn_shortconv_rwkv7'


def _split_points(sizes):
    return [int(s) for s in np.cumsum(sizes)[:-1]]


def rms_norm(x, g):
    xf = x.astype(jnp.float32)
    y = xf * lax.rsqrt(jnp.mean(xf * xf, axis=-1, keepdims=True) + NORM_EPS)
    return (y * g.astype(jnp.float32)).astype(x.dtype)


def diff_attention(q, k, v, lam, subln_g, lambda_init):
    bsz, seq, _ = q.shape
    nb = seq // Q_BLOCK
    q = q.astype(jnp.float32).reshape(bsz, seq, ATT_HEADS, 2, DIFF_HALF).transpose(3, 0, 2, 1, 4)
    k = k.astype(jnp.float32).reshape(bsz, seq, ATT_HEADS, 2, DIFF_HALF).transpose(3, 0, 2, 1, 4)
    v = v.astype(jnp.float32).reshape(bsz, seq, ATT_HEADS, HEAD_DIM).transpose(0, 2, 1, 3)
    q_blocks = q.reshape(2, bsz, ATT_HEADS, nb, Q_BLOCK, DIFF_HALF).transpose(3, 0, 1, 2, 4, 5)
    key_pos = jnp.arange(seq)
    lam = lam.astype(jnp.float32)
    scale = DIFF_HALF ** -0.5

    def one_block(args):
        q_blk, blk = args
        q_pos = blk * Q_BLOCK + jnp.arange(Q_BLOCK)
        causal = key_pos[None, :] <= q_pos[:, None]
        s = jnp.einsum('nbhqd,nbhkd->nbhqk', q_blk, k) * scale
        p = jax.nn.softmax(jnp.where(causal, s, -jnp.inf), axis=-1)
        return jnp.einsum('bhqk,bhkd->bhqd', p[0] - lam * p[1], v)

    o = lax.map(one_block, (q_blocks, jnp.arange(nb)))
    o = o.transpose(1, 0, 3, 2, 4).reshape(bsz, seq, ATT_HEADS, HEAD_DIM)
    o = o * lax.rsqrt(jnp.mean(o * o, axis=-1, keepdims=True) + NORM_EPS)
    o = o * subln_g.astype(jnp.float32) * (1.0 - lambda_init)
    return o.reshape(bsz, seq, ATT_W)


def short_conv(b, c, u, conv_w):
    seq = u.shape[1]
    z = c * u
    zp = jnp.pad(z, ((0, 0), (CONV_K - 1, 0), (0, 0)))
    y = sum(conv_w[j] * zp[:, j:j + seq] for j in range(CONV_K))
    return b * y


def rwkv7_time_mix(p, shift_mu, w0, w_up, a0, a_up, g_up, k_k, k_a, r_k, lnx_g, lnx_b):
    f32 = jnp.float32
    bsz, seq, _ = p.shape
    p = p.astype(f32)
    p_prev = jnp.pad(p, ((0, 0), (1, 0), (0, 0)))[:, :seq]
    z = p + shift_mu.astype(f32) * (p_prev - p)
    r, k, v, w_dn, a_dn, g_dn = jnp.split(z, _split_points(RWKV_SPLITS), axis=-1)
    w = w0.astype(f32) + jnp.tanh(w_dn) @ w_up.astype(f32)
    decay = jnp.exp(-jnp.exp(-jax.nn.softplus(-w) - 0.5))
    a = jax.nn.sigmoid(a0.astype(f32) + a_dn @ a_up.astype(f32))
    g = jax.nn.sigmoid(g_dn) @ g_up.astype(f32)
    kk = k * k_k.astype(f32)
    k = k * (1.0 + (a - 1.0) * k_a.astype(f32))
    heads = lambda t: t.reshape(bsz, seq, RWKV_HEADS, HEAD_DIM)
    r, decay, k, v, kk, a = [heads(t) for t in (r, decay, k, v, kk, a)]
    kk = kk / jnp.maximum(jnp.sqrt(jnp.sum(kk * kk, axis=-1, keepdims=True)), 1e-12)

    def step(state, inp):
        r_t, w_t, k_t, v_t, kk_t, a_t = inp
        sa = jnp.einsum('bhvk,bhk->bhv', state, -kk_t)
        state = (state * w_t[:, :, None, :]
                 + sa[..., None] * (kk_t * a_t)[:, :, None, :]
                 + v_t[..., None] * k_t[:, :, None, :])
        y_t = jnp.einsum('bhvk,bhk->bhv', state, r_t)
        return state, y_t

    xs = tuple(t.transpose(1, 0, 2, 3) for t in (r, decay, k, v, kk, a))
    state0 = jnp.zeros((bsz, RWKV_HEADS, HEAD_DIM, HEAD_DIM), f32)
    _, y = lax.scan(step, state0, xs)
    y = y.transpose(1, 0, 2, 3)
    mu = jnp.mean(y, axis=-1, keepdims=True)
    var = jnp.mean(jnp.square(y - mu), axis=-1, keepdims=True)
    yn = (y - mu) * lax.rsqrt(var + GN_EPS)
    yn = yn * lnx_g.astype(f32).reshape(RWKV_HEADS, HEAD_DIM) + lnx_b.astype(f32).reshape(RWKV_HEADS, HEAD_DIM)
    bonus = jnp.sum(r * k * r_k.astype(f32), axis=-1, keepdims=True) * v
    return (yn + bonus).reshape(bsz, seq, RWKV_W) * g


def setup_inputs(seed: int = 0) -> dict:
    key = jax.random.key(seed)
    ks = iter(jax.random.split(key, 32))
    f32 = jnp.float32
    nrm = lambda shape, scale: jax.random.normal(next(ks), shape, f32) * scale
    uni = lambda shape: jax.random.uniform(next(ks), shape, f32)
    L = DEPTH
    return {
        'x': nrm((BATCH, SEQ, D_MODEL), 1.0),
        'norm_mix_g': 1.0 + nrm((L, D_MODEL), 0.02),
        'w_in': nrm((L, D_MODEL, N_IN), D_MODEL ** -0.5),
        'lam_q1': nrm((L, DIFF_HALF), 0.1),
        'lam_k1': nrm((L, DIFF_HALF), 0.1),
        'lam_q2': nrm((L, DIFF_HALF), 0.1),
        'lam_k2': nrm((L, DIFF_HALF), 0.1),
        'subln_g': 1.0 + nrm((L, HEAD_DIM), 0.02),
        'conv_w': nrm((L, CONV_K, CONV_W), CONV_K ** -0.5),
        'shift_mu': uni((L, RWKV_COLS)),
        'rwkv_w0': -6.0 + 5.0 * uni((L, RWKV_W)),
        'rwkv_w_up': nrm((L, DECAY_LORA, RWKV_W), 0.1 * DECAY_LORA ** -0.5),
        'rwkv_a0': nrm((L, RWKV_W), 0.1),
        'rwkv_a_up': nrm((L, ICLR_LORA, RWKV_W), 0.5 * ICLR_LORA ** -0.5),
        'rwkv_g_up': nrm((L, GATE_LORA, RWKV_W), GATE_LORA ** -0.5),
        'rwkv_k_k': 0.85 + nrm((L, RWKV_W), 0.02),
        'rwkv_k_a': 1.0 + nrm((L, RWKV_W), 0.02),
        'rwkv_r_k': nrm((L, RWKV_HEADS, HEAD_DIM), 0.1),
        'lnx_g': 1.0 + nrm((L, RWKV_W), 0.02),
        'lnx_b': nrm((L, RWKV_W), 0.02),
        'w_out': nrm((L, D_MIX, D_MODEL), D_MIX ** -0.5),
        'norm_mlp_g': 1.0 + nrm((L, D_MODEL), 0.02),
        'w_mlp_up': nrm((L, D_MODEL, D_FF), D_MODEL ** -0.5),
        'w_mlp_down': nrm((L, D_FF, D_MODEL), D_FF ** -0.5),
        'final_norm_g': 1.0 + nrm((D_MODEL,), 0.02),
    }


def reference(x, norm_mix_g, w_in, lam_q1, lam_k1, lam_q2, lam_k2, subln_g, conv_w,
              shift_mu, rwkv_w0, rwkv_w_up, rwkv_a0, rwkv_a_up, rwkv_g_up, rwkv_k_k,
              rwkv_k_a, rwkv_r_k, lnx_g, lnx_b, w_out, norm_mlp_g, w_mlp_up, w_mlp_down,
              final_norm_g):
    f32 = jnp.float32
    for l in range(DEPTH):
        h = rms_norm(x, norm_mix_g[l])
        proj = h @ w_in[l]
        p_att, p_conv, p_rwkv = jnp.split(proj, [3 * ATT_W, 3 * ATT_W + 3 * CONV_W], axis=-1)

        q, k, v = jnp.split(p_att, 3, axis=-1)
        lambda_init = 0.8 - 0.6 * math.exp(-0.3 * l)
        lam = (jnp.exp(jnp.sum(lam_q1[l].astype(f32) * lam_k1[l].astype(f32)))
               - jnp.exp(jnp.sum(lam_q2[l].astype(f32) * lam_k2[l].astype(f32)))
               + lambda_init)
        o_att = diff_attention(q, k, v, lam, subln_g[l], lambda_init)

        b_gate, c_gate, u = jnp.split(p_conv, 3, axis=-1)
        o_conv = short_conv(b_gate, c_gate, u, conv_w[l])

        o_rwkv = rwkv7_time_mix(p_rwkv, shift_mu[l], rwkv_w0[l], rwkv_w_up[l], rwkv_a0[l],
                                rwkv_a_up[l], rwkv_g_up[l], rwkv_k_k[l], rwkv_k_a[l],
                                rwkv_r_k[l], lnx_g[l], lnx_b[l])

        mixed = jnp.concatenate([o_att.astype(x.dtype), o_conv.astype(x.dtype),
                                 o_rwkv.astype(x.dtype)], axis=-1)
        x = x + mixed @ w_out[l]

        h = rms_norm(x, norm_mlp_g[l])
        x = x + jnp.square(jax.nn.relu(h @ w_mlp_up[l])) @ w_mlp_down[l]
    return rms_norm(x, final_norm_g)
```

```cpp
#include <hip/hip_runtime.h>
#include <hip/hip_cooperative_groups.h>
#include <hip/hip_bf16.h>
#include <cstdio>
#include <cstdint>
#include <cmath>
namespace pg8 {
#define PG8_LAS __attribute__((address_space(3)))
typedef unsigned short bf16_t;
typedef short bf16x8 __attribute__((ext_vector_type(8)));
typedef float f32x4 __attribute__((ext_vector_type(4)));
typedef unsigned u32x4 __attribute__((ext_vector_type(4)));
constexpr int BM = 256, BK = 64, HALF = 128, HTB = HALF * BK * 2  , STAGE_BYTES = 8 * HTB, NXCD = 8, WGM = 8;

__host__ __device__ __forceinline__ int lds_byte(int r, int c) { const int st = (r >> 4) * 2 + (c >> 5), rr = r & 15, cc = c & 31, ob = rr * 64 + cc * 2; return st * 1024 + (ob ^ (((ob >> 9) & 1) << 5)); }
__host__ __device__ __forceinline__ void stage_rc(int b, int& R, int& C) { const int st = b / 1024, sb = b % 1024, swz = sb ^ (((sb >> 9) & 1) << 5); R = (st >> 1) * 16 + swz / 64; C = (st & 1) * 32 + (swz % 64) / 2; }
__host__ __device__ __forceinline__ int perm32(int rho) { const int n = rho >> 4, i = rho & 15; return 8 * (i >> 2) + 4 * n + (i & 3); }

struct Unit { int pm, pn; };
struct Gemm { const bf16_t* A; const bf16_t* Bt; int M, N, K; };

struct StaticOrder {
    int nM, nN, nwg, G, c;
    __host__ __device__ void init(int M, int N, int G_, int c_) { nM = M / BM; nN = N / BM; nwg = nM * nN; G = G_; c = c_; }
    __host__ __device__ bool next(int i, Unit& u) const {
        const long L = (long)i * G + c; if (L >= nwg) return false;
        int wgid = (int)L; { const int q = nwg / NXCD, r = nwg % NXCD, xcd = wgid % NXCD, off = wgid / NXCD; wgid = (xcd < r ? xcd * (q + 1) : r * (q + 1) + (xcd - r) * q) + off; }
        const int nig = WGM * nN, gid = wgid / nig, fm = gid * WGM, gsz = (nM - fm) < WGM ? (nM - fm) : WGM;
        u.pm = fm + ((wgid % nig) % gsz); u.pn = (wgid % nig) / gsz; return true;
    }
    __device__ __forceinline__ void a_ready(const Unit&) const {}
    __device__ __forceinline__ void done(const Unit&) const {}
};

__device__ __forceinline__ unsigned cvt_pk_bf16(float lo, float hi) { unsigned r; asm volatile("v_cvt_pk_bf16_f32 %0, %1, %2" : "=v"(r) : "v"(lo), "v"(hi)); return r; }
typedef float f32x2 __attribute__((ext_vector_type(2)));
template <int ACT  > struct EpiBf16S {
    static constexpr bool PERM = true, AFTER_DRAIN = false;
    bf16_t* O; int ldc;
    __device__ __forceinline__ void operator()(const f32x4 (&acc)[2][2][4][2], const Unit& u, int wr, int wc, int fr, int fq) const {
        const int row0 = u.pm * BM + wr * 64 + fr; const int col0 = u.pn * BM + wc * 32 + 8 * fq;
#pragma unroll
        for (int ai = 0; ai < 2; ++ai)
#pragma unroll
            for (int m = 0; m < 4; ++m) { bf16_t* rowp = O + (size_t)(row0 + ai * HALF + m * 16) * ldc + col0;
#pragma unroll
                for (int bj = 0; bj < 2; ++bj) { f32x4 v0 = acc[ai][bj][m][0], v1 = acc[ai][bj][m][1];
                    if (ACT == 2) {
#pragma unroll
                        for (int e = 0; e < 4; ++e) { float a = v0[e] > 0.f ? v0[e] : 0.f; v0[e] = a * a; float b = v1[e] > 0.f ? v1[e] : 0.f; v1[e] = b * b; } }
                    u32x4 w; w.x = cvt_pk_bf16(v0[0], v0[1]); w.y = cvt_pk_bf16(v0[2], v0[3]); w.z = cvt_pk_bf16(v1[0], v1[1]); w.w = cvt_pk_bf16(v1[2], v1[3]);
                    *(u32x4*)(rowp + bj * HALF) = w; } }
    }
};
struct EpiResF32 {
    static constexpr bool PERM = false, AFTER_DRAIN = false;
    const float* base; float* out; int ldc;
    __device__ __forceinline__ void operator()(const f32x4 (&acc)[2][2][4][2], const Unit& u, int wr, int wc, int fr, int fq) const {
        const int col0 = u.pn * BM + wc * 32 + 4 * fq;
#pragma unroll
        for (int ai = 0; ai < 2; ++ai)
#pragma unroll
            for (int m = 0; m < 4; ++m) { const int r = u.pm * BM + ai * HALF + wr * 64 + m * 16 + fr; const size_t off = (size_t)r * ldc + col0;
#pragma unroll
                for (int bj = 0; bj < 2; ++bj)
#pragma unroll
                    for (int n = 0; n < 2; ++n) { const size_t idx = off + bj * HALF + n * 16; const f32x4 bs = *(const f32x4*)(base + idx); *(f32x4*)(out + idx) = bs + acc[ai][bj][m][n]; }
                asm volatile("" ::: "memory"); }
    }
};
template <class Epi, class Sched, bool ALIGN_EPI = false, bool SP2 = false>
__device__ __forceinline__ void gemm_phase(PG8_LAS unsigned char* lds, const Gemm g, const Sched& S, const Epi& E) {
    int tid_ = threadIdx.x; asm volatile("" : "+v"(tid_)); const int tid = tid_, wid = __builtin_amdgcn_readfirstlane(tid >> 6), lane = tid & 63, wr = wid >> 2, wc = wid & 3, fr = lane & 15, fq = lane >> 4;
    const int K = g.K, nt = K / BK;
    unsigned voffA[2], voffB[2];
#pragma unroll
    for (int i = 0; i < 2; ++i) { int R, C; stage_rc(tid * 16 + i * 8192, R, C); const int Rb = Epi::PERM ? ((R & ~31) + perm32(R & 31)) : R;
        voffA[i] = (unsigned)(R * K + C) * 2u; voffB[i] = (unsigned)(Rb * K + C) * 2u; }
    const size_t kstep = (size_t)(BK * 2);
    const size_t hstep = (size_t)HALF * K * 2;
    const size_t tstep = 2 * hstep;
    const unsigned ldsw = (unsigned)wid * 1024u;
    const int aoff = lds_byte(wr * 64 + fr, fq * 8), boff = lds_byte(wc * 32 + fr, fq * 8);
#define PG8_SA(b, h) (((b) * 2 + (h)) * HTB)
#define PG8_SB(b, h) ((4 + (b) * 2 + (h)) * HTB)
#define PG8_STAGE(bufoff, gbase, voff) do { _Pragma("unroll") for (int _i = 0; _i < 2; ++_i) \
        __builtin_amdgcn_global_load_lds((const unsigned*)((const char*)(gbase) + (voff)[_i]), (PG8_LAS unsigned*)(lds + (bufoff) + ldsw + _i * 8192), 16, 0, 0); } while (0)
#define PG8_LDA(dst, b, h) do { _Pragma("unroll") for (int m = 0; m < 4; ++m) _Pragma("unroll") for (int k = 0; k < 2; ++k) dst[m][k] = *(const PG8_LAS bf16x8*)(lds + PG8_SA(b, h) + aoff + m * 2048 + k * 1024); } while (0)
#define PG8_LDB(dst, b, h) do { _Pragma("unroll") for (int n = 0; n < 2; ++n) _Pragma("unroll") for (int k = 0; k < 2; ++k) dst[n][k] = *(const PG8_LAS bf16x8*)(lds + PG8_SB(b, h) + boff + n * 2048 + k * 1024); } while (0)
#define PG8_MMA(ai, bj, At, Bt) do { __builtin_amdgcn_s_setprio(1); _Pragma("unroll") for (int m = 0; m < 4; ++m) _Pragma("unroll") for (int n = 0; n < 2; ++n) _Pragma("unroll") for (int k = 0; k < 2; ++k) \
        acc[ai][bj][m][n] = __builtin_amdgcn_mfma_f32_16x16x32_bf16(Bt[n][k], At[m][k], acc[ai][bj][m][n], 0, 0, 0); __builtin_amdgcn_s_setprio(0); } while (0)
#define PG8_WAIT_V(n) asm volatile("s_waitcnt vmcnt(" #n ")" ::: "memory")
#define PG8_WAIT_L(n) asm volatile("s_waitcnt lgkmcnt(" #n ")" ::: "memory")
#define PG8_BAR __builtin_amdgcn_s_barrier()
#define PG8_SCHED __builtin_amdgcn_sched_barrier(0)
    Unit cur, nxt; int ui = 0;
    if (!S.next(0, cur)) return;
    f32x4 acc[2][2][4][2];
#pragma unroll
    for (int a = 0; a < 2; ++a)
#pragma unroll
        for (int b = 0; b < 2; ++b)
#pragma unroll
            for (int m = 0; m < 4; ++m)
#pragma unroll
                for (int n = 0; n < 2; ++n) acc[a][b][m][n] = (f32x4){0.f, 0.f, 0.f, 0.f};
    bf16x8 At[4][2], B0[2][2], B1[2][2];
    const char* cA = (const char*)g.A + (size_t)cur.pm * tstep; const char* cB = (const char*)g.Bt + (size_t)cur.pn * tstep;
    S.a_ready(cur);
    if constexpr (SP2) {
        PG8_STAGE(PG8_SB(0, 0), cB, voffB); PG8_STAGE(PG8_SB(0, 1), cB + hstep, voffB); PG8_STAGE(PG8_SA(0, 0), cA, voffA); PG8_STAGE(PG8_SA(0, 1), cA + hstep, voffA);
        if (wr == 1) PG8_BAR;
        PG8_WAIT_V(2); PG8_BAR;
        PG8_STAGE(PG8_SB(1, 0), cB + kstep, voffB); PG8_STAGE(PG8_SA(1, 0), cA + kstep, voffA); PG8_STAGE(PG8_SB(1, 1), cB + hstep + kstep, voffB);
        PG8_WAIT_V(6); PG8_BAR;
    } else {
        PG8_STAGE(PG8_SB(0, 0), cB, voffB); PG8_STAGE(PG8_SA(0, 0), cA, voffA); PG8_STAGE(PG8_SB(0, 1), cB + hstep, voffB); PG8_STAGE(PG8_SA(0, 1), cA + hstep, voffA);
        if (wr == 1) PG8_BAR;
        PG8_WAIT_V(4); PG8_BAR;
        PG8_STAGE(PG8_SB(1, 0), cB + kstep, voffB); PG8_STAGE(PG8_SA(1, 0), cA + kstep, voffA); PG8_STAGE(PG8_SB(1, 1), cB + hstep + kstep, voffB);
        PG8_WAIT_V(6); PG8_BAR;
    }
    for (;;) {
        const bool has_next = S.next(ui + 1, nxt);
        const char* nA = has_next ? (const char*)g.A + (size_t)nxt.pm * tstep : cA; const char* nB = has_next ? (const char*)g.Bt + (size_t)nxt.pn * tstep : cB;
        for (int t = 0; t < nt; t += 2) {
            const bool last = (t == nt - 2);
            const char* a1 = cA + (size_t)(t + 1) * kstep;
            const char* a2 = last ? nA : cA + (size_t)(t + 2) * kstep; const char* b2 = last ? nB : cB + (size_t)(t + 2) * kstep;
            const char* a3 = a2 + kstep; const char* b3 = b2 + kstep;
            if (last && has_next) S.a_ready(nxt);
            if constexpr (SP2) {
            PG8_LDB(B0, 0, 0); PG8_LDB(B1, 0, 1); PG8_SCHED; PG8_LDA(At, 0, 0); PG8_STAGE(PG8_SA(1, 1), a1 + hstep, voffA);
            PG8_WAIT_V(8); PG8_WAIT_L(0); PG8_BAR; PG8_MMA(0, 0, At, B0); PG8_MMA(0, 1, At, B1); PG8_BAR; PG8_SCHED;
            PG8_LDA(At, 0, 1); PG8_STAGE(PG8_SB(0, 0), b2, voffB); PG8_STAGE(PG8_SB(0, 1), b2 + hstep, voffB); PG8_STAGE(PG8_SA(0, 0), a2, voffA);
            PG8_WAIT_V(8); PG8_WAIT_L(0); PG8_BAR; PG8_MMA(1, 0, At, B0); PG8_MMA(1, 1, At, B1); PG8_BAR; PG8_SCHED;
            PG8_LDB(B0, 1, 0); PG8_LDB(B1, 1, 1); PG8_SCHED; PG8_LDA(At, 1, 0); PG8_STAGE(PG8_SA(0, 1), a2 + hstep, voffA);
            PG8_WAIT_V(8); PG8_WAIT_L(0); PG8_BAR; PG8_MMA(0, 0, At, B0); PG8_MMA(0, 1, At, B1); PG8_BAR; PG8_SCHED;
            PG8_LDA(At, 1, 1); PG8_STAGE(PG8_SB(1, 0), b3, voffB); PG8_STAGE(PG8_SB(1, 1), b3 + hstep, voffB); PG8_STAGE(PG8_SA(1, 0), a3, voffA);
            PG8_WAIT_V(8); PG8_WAIT_L(0); PG8_BAR; PG8_MMA(1, 0, At, B0); PG8_MMA(1, 1, At, B1); PG8_BAR; PG8_SCHED;
            } else {
            PG8_LDB(B0, 0, 0); PG8_SCHED; PG8_LDA(At, 0, 0); PG8_STAGE(PG8_SA(1, 1), a1 + hstep, voffA);
            PG8_WAIT_L(8); PG8_BAR; PG8_WAIT_L(0); PG8_MMA(0, 0, At, B0); PG8_BAR; PG8_SCHED;
            PG8_LDB(B1, 0, 1); PG8_STAGE(PG8_SB(0, 0), b2, voffB);
            PG8_BAR; PG8_WAIT_L(0); PG8_MMA(0, 1, At, B1); PG8_BAR;
            PG8_LDA(At, 0, 1); PG8_STAGE(PG8_SA(0, 0), a2, voffA);
            PG8_BAR; PG8_WAIT_L(0); PG8_MMA(1, 0, At, B0); PG8_BAR; PG8_SCHED;
            PG8_STAGE(PG8_SB(0, 1), b2 + hstep, voffB);
            PG8_WAIT_V(6); PG8_BAR; PG8_MMA(1, 1, At, B1); PG8_BAR;
            PG8_LDB(B0, 1, 0); PG8_SCHED; PG8_LDA(At, 1, 0); PG8_STAGE(PG8_SA(0, 1), a2 + hstep, voffA);
            PG8_WAIT_L(8); PG8_BAR; PG8_WAIT_L(0); PG8_MMA(0, 0, At, B0); PG8_BAR; PG8_SCHED;
            PG8_LDB(B1, 1, 1); PG8_STAGE(PG8_SB(1, 0), b3, voffB);
            PG8_BAR; PG8_WAIT_L(0); PG8_MMA(0, 1, At, B1); PG8_BAR;
            PG8_LDA(At, 1, 1); PG8_STAGE(PG8_SA(1, 0), a3, voffA);
            PG8_BAR; PG8_WAIT_L(0); PG8_MMA(1, 0, At, B0); PG8_BAR; PG8_SCHED;
            PG8_STAGE(PG8_SB(1, 1), b3 + hstep, voffB);
            PG8_WAIT_V(6); PG8_BAR; PG8_MMA(1, 1, At, B1); PG8_BAR;
            }
        }
        if constexpr (ALIGN_EPI) { if (wr == 0) PG8_BAR; }
        if constexpr (!Epi::AFTER_DRAIN) { E(acc, cur, wr, wc, fr, fq); S.done(cur); }
        if (!has_next) break;
#pragma unroll
        for (int a = 0; a < 2; ++a)
#pragma unroll
            for (int b = 0; b < 2; ++b)
#pragma unroll
                for (int m = 0; m < 4; ++m)
#pragma unroll
                    for (int n = 0; n < 2; ++n) acc[a][b][m][n] = (f32x4){0.f, 0.f, 0.f, 0.f};
        cur = nxt; cA = nA; cB = nB; ++ui;
        if constexpr (ALIGN_EPI) { if (wr == 1) PG8_BAR; }
    }
    PG8_WAIT_V(0);
    if constexpr (!ALIGN_EPI) { if (wr == 0) PG8_BAR; }
    PG8_BAR;
    if constexpr (Epi::AFTER_DRAIN) { E.fused(acc, cur, wr, wc, fr, fq, lds, wid, lane); S.done(cur); }
#undef PG8_SA
#undef PG8_SB
#undef PG8_STAGE
#undef PG8_LDA
#undef PG8_LDB
#undef PG8_MMA
#undef PG8_WAIT_V
#undef PG8_WAIT_L
#undef PG8_BAR
#undef PG8_SCHED
}
}

#define PG8_SP2 true
#define PG8_ALIGN true
namespace attn_body {
using bf16=__hip_bfloat16;
using bf16x8=__attribute__((ext_vector_type(8)))short;
using s16x4=__attribute__((ext_vector_type(4)))short;
using f32x16=__attribute__((ext_vector_type(16)))float;
using u32x4=__attribute__((ext_vector_type(4)))unsigned;
constexpr int BATCH=8,NHEAD=6,SEQ=4096,D=64,DM=3328,OPITCH=1024;
constexpr int NW=8,QBLK=32,QB=QBLK*NW,KVBLK=64,NQB=SEQ/QB;
constexpr int ATTN_PITCH=DM, ATTN_UNIT_ROWS=QB;
__device__ __forceinline__ int crow(int r,int hi){return (r&3)+8*(r>>2)+4*hi;}
#define SBAR() __builtin_amdgcn_sched_barrier(0)
__device__ __forceinline__ void cmask(f32x16&p0,f32x16&p1,int jb,int qrel,int hi){
  const float NEG=-INFINITY; int kb=64*jb+4*hi;
  #pragma unroll
  for(int r=0;r<16;++r){int kv=kb+(r&3)+8*(r>>2); if(kv>qrel)p0[r]=NEG; if(kv+32>qrel)p1[r]=NEG;}
}

constexpr int NSLOT=3, SLOTB=8192;
constexpr int LDS_K=0, LDS_V=NSLOT*SLOTB, LDS_WS=2*NSLOT*SLOTB, LDS_OST=LDS_WS+NW*64*4, LDS_OST1=LDS_OST+NW*4096, LDS_BYTES=LDS_OST1+NW*4096;
constexpr float C2=0.17677669529663687f*1.4426950408889634f;
__device__ __forceinline__ void glds16(const void*gsrc,unsigned lds_dst){unsigned keep;
  asm volatile("s_mov_b32 %0, m0\n\ts_mov_b32 m0, %2\n\ts_nop 0\n\tglobal_load_lds_dwordx4 %1, off\n\ts_mov_b32 m0, %0":"=&s"(keep):"v"(gsrc),"s"(lds_dst):"memory");}
__device__ __forceinline__ float max3f(float a,float b,float c){float r;asm("v_max3_f32 %0, %1, %2, %3":"=v"(r):"v"(a),"v"(b),"v"(c));return r;}
__device__ __forceinline__ float max2f(float a,float b){float r;asm("v_max_f32_e32 %0, %1, %2":"=v"(r):"v"(a),"v"(b));return r;}
__device__ __forceinline__ float fadd_s(float a,float b){float r;asm("v_add_f32_e32 %0, %1, %2":"=v"(r):"v"(a),"v"(b));return r;}
__device__ __forceinline__ float fsub_s(float a,float b){float r;asm("v_sub_f32_e32 %0, %1, %2":"=v"(r):"v"(a),"v"(b));return r;}
typedef float f32x2_t __attribute__((ext_vector_type(2))); typedef __bf16 bf16x2_t __attribute__((ext_vector_type(2)));
__device__ __forceinline__ unsigned cvtpk_s(float lo,float hi){f32x2_t v={lo,hi};bf16x2_t b=__builtin_convertvector(v,bf16x2_t);return __builtin_bit_cast(unsigned,b);}
#define WAIT_BAR(N) asm volatile("s_waitcnt vmcnt(" #N ") lgkmcnt(0)\n\ts_barrier":::"memory")

__device__ __forceinline__ void qkt(f32x16&p0,f32x16&p1,const char*Kslot,const bf16x8*qr,const f32x16&negm,int r32,int hi){
  const char*kb=Kslot+hi*1024+r32*16;
  #pragma unroll
  for(int d0=0;d0<4;++d0){
    const bf16x8 b0=*reinterpret_cast<const bf16x8*>(kb+d0*2048);
    const bf16x8 b1=*reinterpret_cast<const bf16x8*>(kb+d0*2048+512);
    if(d0==0){p0=__builtin_amdgcn_mfma_f32_32x32x16_bf16(b0,qr[0],negm,0,0,0);p1=__builtin_amdgcn_mfma_f32_32x32x16_bf16(b1,qr[0],negm,0,0,0);}
    else{p0=__builtin_amdgcn_mfma_f32_32x32x16_bf16(b0,qr[d0],p0,0,0,0);p1=__builtin_amdgcn_mfma_f32_32x32x16_bf16(b1,qr[d0],p1,0,0,0);}}
}
typedef __attribute__((address_space(3))) const char* lds_cptr;
typedef short v4i16_t __attribute__((ext_vector_type(4)));
__device__ __forceinline__ void kload8(bf16x8*kf,lds_cptr kp){
  kf[0]=*(const __attribute__((address_space(3))) bf16x8*)(kp);      kf[1]=*(const __attribute__((address_space(3))) bf16x8*)(kp+512);
  kf[2]=*(const __attribute__((address_space(3))) bf16x8*)(kp+2048); kf[3]=*(const __attribute__((address_space(3))) bf16x8*)(kp+2560);
  kf[4]=*(const __attribute__((address_space(3))) bf16x8*)(kp+4096); kf[5]=*(const __attribute__((address_space(3))) bf16x8*)(kp+4608);
  kf[6]=*(const __attribute__((address_space(3))) bf16x8*)(kp+6144); kf[7]=*(const __attribute__((address_space(3))) bf16x8*)(kp+6656);
}
__device__ __forceinline__ void kload2(bf16x8*kf,lds_cptr kp,int j){ kf[2*j]=*(const __attribute__((address_space(3))) bf16x8*)(kp+j*2048); kf[2*j+1]=*(const __attribute__((address_space(3))) bf16x8*)(kp+j*2048+512); }
__device__ __forceinline__ s16x4 vtr(lds_cptr p){ return __builtin_bit_cast(s16x4,__builtin_amdgcn_ds_read_tr16_b64_v4i16((__attribute__((address_space(3))) v4i16_t*)p)); }
__device__ __forceinline__ float rowmax(const f32x16&p0,const f32x16&p1){
  float a=max3f(p0[0],p0[1],p1[0]),b=max3f(p0[2],p0[3],p1[1]);a=max3f(a,p1[2],p1[3]);
  #pragma unroll
  for(int r=4;r<16;r+=4){a=max3f(a,p0[r],p0[r+1]);b=max3f(b,p0[r+2],p0[r+3]);a=max3f(a,p1[r],p1[r+1]);b=max3f(b,p1[r+2],p1[r+3]);}
  const float m=max2f(a,b);
  auto rr=__builtin_amdgcn_permlane32_swap(__float_as_uint(m),__float_as_uint(m),false,false);
  return max2f(__uint_as_float(rr[0]),__uint_as_float(rr[1]));
}
__device__ __forceinline__ void pv(f32x16*o,int vb,bf16x8 pa0,bf16x8 pa1,bf16x8 pa2,bf16x8 pa3){
  #pragma unroll
  for(int d0=0;d0<2;++d0){s16x4 lo[4],hi[4];
    #pragma unroll
    for(int ks=0;ks<4;++ks){
      asm volatile("ds_read_b64_tr_b16 %0,%1 offset:%c2":"=&v"(lo[ks]):"v"(vb),"i"(d0*4096+ks*1024):"memory");
      asm volatile("ds_read_b64_tr_b16 %0,%1 offset:%c2":"=&v"(hi[ks]):"v"(vb),"i"(d0*4096+ks*1024+512):"memory");}
    asm volatile("s_waitcnt lgkmcnt(0)":::"memory");SBAR();
    #define PK(k) (bf16x8){lo[k][0],lo[k][1],lo[k][2],lo[k][3],hi[k][0],hi[k][1],hi[k][2],hi[k][3]}
    o[d0]=__builtin_amdgcn_mfma_f32_32x32x16_bf16(pa0,PK(0),o[d0],0,0,0);
    o[d0]=__builtin_amdgcn_mfma_f32_32x32x16_bf16(pa1,PK(1),o[d0],0,0,0);
    o[d0]=__builtin_amdgcn_mfma_f32_32x32x16_bf16(pa2,PK(2),o[d0],0,0,0);
    o[d0]=__builtin_amdgcn_mfma_f32_32x32x16_bf16(pa3,PK(3),o[d0],0,0,0);
    #undef PK
  }
}

#ifndef ATTN_STORE16
#define ATTN_STORE16(p,v) (*(u32x4*)(p)=(v))
#endif
template<int THRL> __device__ __forceinline__ void attn_unit(int b,int h,int qb,int nsel,float lam,const float*subg,float omli,const bf16*Q,const bf16*__restrict__ K,const bf16*__restrict__ V,bf16*O,char*shm){
  int tid_=threadIdx.x; asm volatile("":"+v"(tid_)); const int tid=tid_,lane=tid&63,r32=lane&31,hi=lane>>5; const int wid=__builtin_amdgcn_readfirstlane(tid>>6);
  const long rowbase=(long)b*SEQ; const int q0=qb*QB;
  const bf16*Qw=Q+(rowbase+q0+wid*QBLK)*DM+h*D;
  const bf16*Kh=K+rowbase*DM+h*D,*Vh=V+rowbase*DM+h*D;
  const unsigned lds0=(unsigned)(uintptr_t)shm;
  float*wsf=(float*)(shm+LDS_WS)+wid*64;
  const bf16*ksrc=Kh+(long)lane*DM+wid*8;
  const bf16*vsrc=Vh+(long)(16*(wid&3)+(lane>>2))*DM+(wid>>2)*32+(lane&3)*8;
  const unsigned kdst=lds0+LDS_K+wid*1024, vdst=lds0+LDS_V+wid*1024;
  #define DMA_K(t,slot) glds16(ksrc+(long)(t)*KVBLK*DM,(unsigned)__builtin_amdgcn_readfirstlane(kdst+(slot)))
  #define DMA_V(t,slot) glds16(vsrc+(long)(t)*KVBLK*DM,(unsigned)__builtin_amdgcn_readfirstlane(vdst+(slot)))
  const int vb0=(int)(lds0+LDS_V)+((lane>>4)&1)*32+(lane&3)*8+(4*hi+((lane&15)>>2))*64;
  const char*Kbase=shm+LDS_K; bf16x8 kf[8];
  const lds_cptr shm3=(lds_cptr)shm; const lds_cptr kp0=shm3+LDS_K+hi*1024+r32*16; const lds_cptr vp0=shm3+LDS_V+((lane>>4)&1)*32+(lane&3)*8+(4*hi+((lane&15)>>2))*64;
  const int NT=(q0+QB)/KVBLK;
  DMA_K(0,0);DMA_V(0,0);DMA_K(1,SLOTB);
  bf16x8 qr[4];
  #pragma unroll
  for(int d0=0;d0<4;++d0){qr[d0]=*reinterpret_cast<const bf16x8*>(&Qw[(long)r32*DM+d0*16+hi*8]); if((d0>>1)!=nsel)qr[d0]=bf16x8{0,0,0,0,0,0,0,0};}
  float mhat=0.f,l_reg=0.f;f32x16 o[2];o[0]=f32x16{};o[1]=f32x16{};f32x16 negm=f32x16{};asm volatile("":"+v"(negm));
  const int qrel=wid*QBLK+r32;
  #define CMASK(P0,P1,t) do{int jb_=(t)-(NT-4); if(jb_>=0)cmask(P0,P1,jb_,qrel,hi);}while(0)
  bool resc=false;
  #define START(P0,P1) do{ const float rm=rowmax(P0,P1); resc=false; \
    { const float dl=rm; mhat=fadd_s(mhat,dl); \
      _Pragma("unroll") for(int r=0;r<16;++r){P0[r]=fsub_s(P0[r],dl);P1[r]=fsub_s(P1[r],dl);} \
      _Pragma("unroll") for(int r=0;r<16;++r)negm[r]=-mhat; asm volatile("":"+v"(negm)); } \
    _Pragma("unroll") for(int r=0;r<16;++r)P0[r]=__builtin_amdgcn_exp2f(P0[r]); }while(0)
  #define RESC() do{ if(resc){ asm volatile("s_waitcnt lgkmcnt(0)":::"memory"); \
      _Pragma("unroll") for(int d_=0;d_<2;++d_) _Pragma("unroll") for(int r=0;r<16;++r)o[d_][r]*=wsf[crow(r,hi)]; } }while(0)
  f32x16 pA0,pA1,pB0,pB1;
  int sl_prev=0,sl_cur=0,sl_next=SLOTB;
  #define ROT() do{sl_prev=sl_cur;sl_cur=sl_next;sl_next=(sl_next==(NSLOT-1)*SLOTB)?0:sl_next+SLOTB;}while(0)
  DMA_K(2,2*SLOTB);
  WAIT_BAR(3);
  qkt(pA0,pA1,Kbase,qr,negm,r32,hi);asm volatile("s_nop 15\n\ts_nop 7":"+v"(pA0),"+v"(pA1));CMASK(pA0,pA1,0);
  START(pA0,pA1);
  _Pragma("unroll") for(int r=0;r<16;++r)pA1[r]=__builtin_amdgcn_exp2f(pA1[r]);
  WAIT_BAR(0);
  DMA_K(3,0);DMA_V(1,SLOTB);
  ROT();
  kload8(kf,kp0+sl_cur);
  WAIT_BAR(2);
  s16x4 vlo[8],vhi[8]; u32x4 pw0,pw1,pw2,pw3;
  #define PKW(P,B) cvtpk_s(P[B],P[B+1])
  #define PAF(k) __builtin_bit_cast(bf16x8,pw##k)
  #define VFR(i) (bf16x8){vlo[i][0],vlo[i][1],vlo[i][2],vlo[i][3],vhi[i][0],vhi[i][1],vhi[i][2],vhi[i][3]}
  #define PIN(x) asm volatile("":"+v"(x))
  #define MX3(a,b,c) __builtin_fmaxf(__builtin_fmaxf((a),(b)),(c))
  #define GAPA(MF,A0,A1,A2,A3,W0,W1,PW) do{ MF; sacc+=A0; sacc+=A1; sacc+=A2; sacc+=A3; PIN(sacc); W0; W1; PIN(PW); SBAR(); }while(0)
  #define EX(v) __builtin_amdgcn_exp2f(v)
  #define GAPB(MF,X,B) do{ MF; X[B]=EX(X[B]); X[B+1]=EX(X[B+1]); X[B+2]=EX(X[B+2]); X[B+3]=EX(X[B+3]); PIN(X); SBAR(); }while(0)
  #define VRD(i) do{ vlo[i]=vtr(vp_+(((i)>>2)*4096+((i)&3)*1024)); vhi[i]=vtr(vp_+(((i)>>2)*4096+((i)&3)*1024+512)); }while(0)
  #define KRD(G,j) do{ if(G){ kload2(kf,kp0+sl_next,j); SBAR(); } }while(0)
  #define STEP(C0,C1,P0,P1,t,GK,GV,GL) do{ SBAR(); \
    const lds_cptr vp_=vp0+sl_prev; \
    VRD(0); SBAR(); float sacc=(P0[0]+P0[1]); \
    GAPA(C0=__builtin_amdgcn_mfma_f32_32x32x16_bf16(kf[0],qr[0],negm,0,0,0), P0[2],P0[3],P0[4],P0[5],     pw0[0]=PKW(P0,0), pw0[1]=PKW(P0,2), pw0); \
    VRD(4); SBAR(); GAPA(C1=__builtin_amdgcn_mfma_f32_32x32x16_bf16(kf[1],qr[0],negm,0,0,0), P0[6],P0[7],P0[8],P0[9],     pw0[2]=PKW(P0,4), pw0[3]=PKW(P0,6), pw0); \
    VRD(1); SBAR(); GAPA(C0=__builtin_amdgcn_mfma_f32_32x32x16_bf16(kf[2],qr[1],C0,0,0,0),   P0[10],P0[11],P0[12],P0[13], pw1[0]=PKW(P0,8), pw1[1]=PKW(P0,10), pw1); \
    VRD(5); SBAR(); GAPA(C1=__builtin_amdgcn_mfma_f32_32x32x16_bf16(kf[3],qr[1],C1,0,0,0),   P0[14],P0[15],P1[0],P1[1],   pw1[2]=PKW(P0,12),pw1[3]=PKW(P0,14), pw1); \
    VRD(2); SBAR(); GAPA(C0=__builtin_amdgcn_mfma_f32_32x32x16_bf16(kf[4],qr[2],C0,0,0,0),   P1[2],P1[3],P1[4],P1[5],     pw2[0]=PKW(P1,0), pw2[1]=PKW(P1,2), pw2); \
    VRD(6); SBAR(); GAPA(C1=__builtin_amdgcn_mfma_f32_32x32x16_bf16(kf[5],qr[2],C1,0,0,0),   P1[6],P1[7],P1[8],P1[9],     pw2[2]=PKW(P1,4), pw2[3]=PKW(P1,6), pw2); \
    VRD(3); SBAR(); GAPA(C0=__builtin_amdgcn_mfma_f32_32x32x16_bf16(kf[6],qr[3],C0,0,0,0),   P1[10],P1[11],P1[12],P1[13], pw3[0]=PKW(P1,8), pw3[1]=PKW(P1,10), pw3); \
    VRD(7); SBAR(); GAPA(C1=__builtin_amdgcn_mfma_f32_32x32x16_bf16(kf[7],qr[3],C1,0,0,0),   P1[14],P1[15],0.f,0.f,       pw3[2]=PKW(P1,12),pw3[3]=PKW(P1,14), pw3); \
    l_reg+=sacc; \
    if(GK){DMA_K((t)+3,sl_cur);} if(GV){DMA_V((t)+1,sl_next);} \
    CMASK(C0,C1,t); \
    { float a=MX3(C0[0],C0[1],C1[0]),b=MX3(C0[2],C0[3],C1[1]); a=MX3(a,C1[2],C1[3]); \
      _Pragma("unroll") for(int r=4;r<16;r+=4){a=MX3(a,C0[r],C0[r+1]);b=MX3(b,C0[r+2],C0[r+3]);a=MX3(a,C1[r],C1[r+1]);b=MX3(b,C1[r+2],C1[r+3]);} \
      float rm=__builtin_fmaxf(a,b); { auto rr=__builtin_amdgcn_permlane32_swap(__float_as_uint(rm),__float_as_uint(rm),false,false); rm=__builtin_fmaxf(__uint_as_float(rr[0]),__uint_as_float(rr[1])); } \
      resc=false; \
      if(__builtin_expect(__any(rm>(float)THRL),0)){ const float dl=__builtin_fmaxf(rm,0.f); mhat+=dl; \
        _Pragma("unroll") for(int r=0;r<16;++r){C0[r]-=dl;C1[r]-=dl;} \
        _Pragma("unroll") for(int r=0;r<16;++r)negm[r]=-mhat; asm volatile("":"+v"(negm)); \
        const float f=__builtin_amdgcn_exp2f(-dl); l_reg*=f; if(hi==0)wsf[r32]=f; resc=true; } } \
    SBAR(); \
    GAPB(o[0]=__builtin_amdgcn_mfma_f32_32x32x16_bf16(PAF(0),VFR(0),o[0],0,0,0), C0,0); \
    GAPB(o[1]=__builtin_amdgcn_mfma_f32_32x32x16_bf16(PAF(0),VFR(4),o[1],0,0,0), C0,4); \
    KRD(GL,0); GAPB(o[0]=__builtin_amdgcn_mfma_f32_32x32x16_bf16(PAF(1),VFR(1),o[0],0,0,0), C0,8); \
    KRD(GL,1); GAPB(o[1]=__builtin_amdgcn_mfma_f32_32x32x16_bf16(PAF(1),VFR(5),o[1],0,0,0), C0,12); \
    KRD(GL,2); GAPB(o[0]=__builtin_amdgcn_mfma_f32_32x32x16_bf16(PAF(2),VFR(2),o[0],0,0,0), C1,0); \
    KRD(GL,3); GAPB(o[1]=__builtin_amdgcn_mfma_f32_32x32x16_bf16(PAF(2),VFR(6),o[1],0,0,0), C1,4); \
    GAPB(o[0]=__builtin_amdgcn_mfma_f32_32x32x16_bf16(PAF(3),VFR(3),o[0],0,0,0), C1,8); \
    GAPB(o[1]=__builtin_amdgcn_mfma_f32_32x32x16_bf16(PAF(3),VFR(7),o[1],0,0,0), C1,12); \
    }while(0)
  int t=1;
  #undef CMASK
  #define CMASK(P0,P1,t) do{}while(0)
  for(;t+5<NT;t+=2){
    STEP(pB0,pB1,pA0,pA1,t,true,true,true);     WAIT_BAR(2); RESC(); ROT();
    STEP(pA0,pA1,pB0,pB1,t+1,true,true,true);   WAIT_BAR(2); RESC(); ROT();
  }
  #undef CMASK
  #define CMASK(P0,P1,t) do{int jb_=(t)-(NT-4); if(jb_>=0)cmask(P0,P1,jb_,qrel,hi);}while(0)
  #define ENDW(tt) do{ if((tt)+3<NT){WAIT_BAR(2);} else if((tt)+2<NT){WAIT_BAR(1);} else {WAIT_BAR(0);} }while(0)
  for(;t+1<NT;t+=2){
    STEP(pB0,pB1,pA0,pA1,t,(t+3<NT),(t+1<NT),(t+1<NT));       ENDW(t);   RESC(); ROT();
    STEP(pA0,pA1,pB0,pB1,t+1,(t+4<NT),(t+2<NT),(t+2<NT));     ENDW(t+1); RESC(); ROT();
  }
  STEP(pB0,pB1,pA0,pA1,NT-1,false,false,false); RESC();
  { float sacc=pB0[0]+pB0[1]; _Pragma("unroll") for(int r=2;r<16;++r)sacc+=pB0[r]; _Pragma("unroll") for(int r=0;r<16;++r)sacc+=pB1[r]; l_reg+=sacc;
    pw0=(u32x4){PKW(pB0,0),PKW(pB0,2),PKW(pB0,4),PKW(pB0,6)};pw1=(u32x4){PKW(pB0,8),PKW(pB0,10),PKW(pB0,12),PKW(pB0,14)};pw2=(u32x4){PKW(pB1,0),PKW(pB1,2),PKW(pB1,4),PKW(pB1,6)};pw3=(u32x4){PKW(pB1,8),PKW(pB1,10),PKW(pB1,12),PKW(pB1,14)};
    SBAR(); pv(o,vb0+sl_cur,PAF(0),PAF(1),PAF(2),PAF(3)); }
  #undef PKW
  #undef PAF
  #undef VFR
  #undef PIN
  #undef MX3
  #undef GAPA
  #undef GAPB
  #undef EX
  #undef VRD
  #undef KRD
  #undef STEP
  #undef ENDW
  {auto rr=__builtin_amdgcn_permlane32_swap(__float_as_uint(l_reg),__float_as_uint(l_reg),false,false);l_reg=__uint_as_float(rr[0])+__uint_as_float(rr[1]);}
  if(hi==0)wsf[32+r32]=l_reg;asm volatile("s_waitcnt lgkmcnt(0)":::"memory");
  float rli[16];
  #pragma unroll
  for(int r=0;r<16;++r)rli[r]=__builtin_amdgcn_rcpf(wsf[32+crow(r,hi)]);
  bf16*Ow=O+(rowbase+q0+wid*QBLK)*OPITCH+h*D;
  { bf16*stg=(bf16*)(shm+(nsel==0?LDS_OST1:LDS_OST))+wid*2048;
    #pragma unroll
    for(int r=0;r<16;++r){const int orow=crow(r,hi);
      #pragma unroll
      for(int d0=0;d0<2;++d0)stg[orow*64+d0*32+r32]=__float2bfloat16(o[d0][r]*rli[r]);}
    asm volatile("s_waitcnt lgkmcnt(0)":::"memory");
    if(nsel==1){ const bf16*stg1=(const bf16*)(shm+LDS_OST1)+wid*2048;
      #pragma unroll
      for(int i=0;i<4;++i){const int row=i*8+(lane>>3),ch=lane&7; const u32x4 v2=*(const u32x4*)(stg+row*64+ch*8); const u32x4 v1=*(const u32x4*)(stg1+row*64+ch*8);
        float dd[8]; float ss=0.f;
        #pragma unroll
        for(int j=0;j<4;++j){ const float a0=__uint_as_float(v1[j]<<16),a1=__uint_as_float(v1[j]&0xffff0000u),b0=__uint_as_float(v2[j]<<16),b1=__uint_as_float(v2[j]&0xffff0000u);
          dd[2*j]=a0-lam*b0; dd[2*j+1]=a1-lam*b1; ss+=dd[2*j]*dd[2*j]+dd[2*j+1]*dd[2*j+1]; }
        ss+=__shfl_xor(ss,1); ss+=__shfl_xor(ss,2); ss+=__shfl_xor(ss,4);
        const float rs=omli/sqrtf(ss*(1.0f/64.0f)+1e-6f);
        u32x4 w;
        #pragma unroll
        for(int j=0;j<4;++j) w[j]=cvtpk_s(dd[2*j]*rs*subg[ch*8+2*j],dd[2*j+1]*rs*subg[ch*8+2*j+1]);
        ATTN_STORE16(Ow+(long)row*OPITCH+ch*8,w);} } }
  asm volatile("s_waitcnt lgkmcnt(0)\n\ts_barrier":::"memory");
  #undef DMA_K
  #undef DMA_V
  #undef CMASK
  #undef START
  #undef RESC
  #undef ROT

}
#undef SBAR
#undef WAIT_BAR
}
#ifndef GOFF
#define GOFF 0
#endif
#define GEMMCALL0 if (!((GOFF) & 1))
#define GEMMCALL1 if (!((GOFF) & 2))
#define GEMMCALL2 if (!((GOFF) & 4))
#define GEMMCALL3 if (!((GOFF) & 8))
namespace cg = cooperative_groups;
#define GAS __attribute__((address_space(1)))
#define LAS __attribute__((address_space(3)))
#define DI __device__ __forceinline__
typedef unsigned short bf16;
typedef unsigned v4u __attribute__((ext_vector_type(4)));
typedef unsigned v2u __attribute__((ext_vector_type(2)));
typedef float f32x4 __attribute__((ext_vector_type(4)));
typedef short bf16x8 __attribute__((ext_vector_type(8)));

constexpr int NWAVES = 8;
constexpr int DMODEL = 1024, SEQ = 4096, M = 32768, NIN = 3328, FF = 4096;
constexpr int RW = 384, RCOLS = 1408, ROFF = 1920, COFF = 1152;
constexpr float NORM_EPS = 1e-6f, GN_EPS = 64e-5f;
constexpr size_t MiB = 1u << 20;
constexpr size_t WS_CTL = 0, CTL_ZERO_BYTES = 4096;
constexpr size_t WS_WIN = 1 * MiB, WS_WOUT = 14 * MiB, WS_WUP = 18 * MiB, WS_WDN = 34 * MiB, WS_LORA = 50 * MiB;
constexpr size_t WS_XB = 51 * MiB, WS_PROJ = 115 * MiB, WS_MIX = 323 * MiB, WS_S = 387 * MiB, WS_END = 507 * MiB;
constexpr size_t WS_HID = 115 * MiB;
constexpr size_t SARR = (size_t)M * RW;
constexpr int LORA_L = 384 * 64 * 2 + 384 * 128;
constexpr int LDS_BYTES = 147456, MISC_OFF = 131072;
constexpr int SCAN_WGS = 96, ATT_ITEMS = 768;

struct Args { const float* in[25]; float* out; unsigned char* ws; int i0, i1; };

DI float wave_sum(float v) {
#pragma unroll
    for (int o = 1; o < 64; o <<= 1) v += __shfl_xor(v, o);
    return v;
}
DI unsigned f2bf(float f) { unsigned u = __builtin_bit_cast(unsigned, f); return (u + 0x7fffu + ((u >> 16) & 1u)) >> 16; }
DI unsigned pk2(float lo, float hi) { return f2bf(lo) | (f2bf(hi) << 16); }
DI float bflo(unsigned w) { return __uint_as_float(w << 16); }
DI float bfhi(unsigned w) { return __uint_as_float(w & 0xffff0000u); }
DI float bf1(const bf16* p) { return __uint_as_float(((unsigned)*p) << 16); }
DI void unpack8(v4u w, float* f) { f[0] = bflo(w.x); f[1] = bfhi(w.x); f[2] = bflo(w.y); f[3] = bfhi(w.y); f[4] = bflo(w.z); f[5] = bfhi(w.z); f[6] = bflo(w.w); f[7] = bfhi(w.w); }
DI v4u pack8(const float* f) { v4u o; o.x = pk2(f[0], f[1]); o.y = pk2(f[2], f[3]); o.z = pk2(f[4], f[5]); o.w = pk2(f[6], f[7]); return o; }
DI float sigmoidf_(float x) { return 1.f / (1.f + __expf(-x)); }
DI float tanhf_(float x) { const float e = __expf(2.f * x); return 1.f - 2.f / (e + 1.f); }
template <int CTRL> DI float dpp_add(float x) { return x + __int_as_float(__builtin_amdgcn_update_dpp(0, __float_as_int(x), CTRL, 0xf, 0xf, true)); }
DI float red16(float x) { x = dpp_add<0xB1>(x); x = dpp_add<0x4E>(x); x = dpp_add<0x141>(x); x = dpp_add<0x140>(x); return x; }

struct Frame {
    LAS unsigned char* lds;
    int tid, lane, wave, G, gw, NGW;
    const float* const* in;
    float* out; unsigned char* ws;
};
DI const float* INP(const Frame& F, int k) { asm volatile("" : "+s"(k)); return F.in[k]; }
#define F_WIN  ((bf16*)(F.ws + WS_WIN))
#define F_WOUT ((bf16*)(F.ws + WS_WOUT))
#define F_WUP  ((bf16*)(F.ws + WS_WUP))
#define F_WDN  ((bf16*)(F.ws + WS_WDN))
#define F_LORA ((bf16*)(F.ws + WS_LORA))
#define F_XB   ((bf16*)(F.ws + WS_XB))
#define F_PROJ ((bf16*)(F.ws + WS_PROJ))
#define F_MIX  ((bf16*)(F.ws + WS_MIX))
#define F_HID  ((bf16*)(F.ws + WS_HID))
#define F_S_r  ((bf16*)(F.ws + WS_XB))
#define F_S_ld ((bf16*)(F.ws + WS_XB) + SARR)
#define F_S_k  ((bf16*)(F.ws + WS_S))
#define F_S_v  ((bf16*)(F.ws + WS_S) + SARR)
#define F_S_n  ((bf16*)(F.ws + WS_S) + 2 * SARR)
#define F_S_b  ((bf16*)(F.ws + WS_S) + 3 * SARR)
#define F_S_g  ((bf16*)(F.ws + WS_S) + 4 * SARR)
#define F_ctl  ((unsigned*)(F.ws + WS_CTL))

DI void transpose_item(const float* W, int K, int N, bf16* WT, LAS float* scr, int item, int lane, const float* gk, float cs, int csn) {
    const int nblk = N / 32, kb = item / nblk, nb = item % nblk, k0 = 64 * kb, n0 = 32 * nb;
    const float colscale = (n0 + (lane & 31) < csn) ? cs : 1.f;
#pragma unroll 8
    for (int i = 0; i < 32; ++i) { const int kk = 2 * i + (lane >> 5); float v = W[(size_t)(k0 + kk) * N + n0 + (lane & 31)]; if (gk) v *= gk[k0 + kk]; scr[kk * 33 + (lane & 31)] = v * colscale; }
    asm volatile("s_waitcnt lgkmcnt(0)" ::: "memory");
    const int c = lane & 7;
#pragma unroll
    for (int j = 0; j < 4; ++j) { const int n = (lane >> 3) + 8 * j; const LAS float* s = scr + (8 * c) * 33 + n;
        v4u o; o.x = pk2(s[0 * 33], s[1 * 33]); o.y = pk2(s[2 * 33], s[3 * 33]); o.z = pk2(s[4 * 33], s[5 * 33]); o.w = pk2(s[6 * 33], s[7 * 33]);
        *(v4u*)(WT + (size_t)(n0 + n) * K + k0 + 8 * c) = o; }
    asm volatile("s_waitcnt lgkmcnt(0)" ::: "memory");
}
DI Frame refresh(const Frame& F0) { Frame F = F0; int t = threadIdx.x; asm volatile("" : "+v"(t)); int bxx = blockIdx.x; asm volatile("" : "+s"(bxx)); F.tid = t; F.lane = t & 63; F.wave = __builtin_amdgcn_readfirstlane(t >> 6); F.gw = bxx * NWAVES + F.wave; return F; }
DI void prologue(const Frame& F0) { Frame F = refresh(F0);
    LAS float* scr = (LAS float*)(F.lds + F.wave * 16384);
    constexpr int I_IN = 16 * 104, I_OUT = 16 * 32, I_UP = 16 * 128, I_DN = 64 * 32, I_LW = 12, I_LG = 24;
    constexpr int PER = I_IN + I_OUT + I_UP + I_DN + 2 * I_LW + I_LG;
    constexpr float C2 = 0.17677669529663687f * 1.4426950408889634f;
    for (int it = F.gw; it < 2 * PER; it += F.NGW) {
        const int l = it / PER; int r = it % PER;
        if (r < I_IN) { transpose_item(INP(F, 2) + (size_t)l * DMODEL * NIN, DMODEL, NIN, F_WIN + (size_t)l * NIN * DMODEL, scr, r, F.lane, INP(F, 1) + l * DMODEL, C2, 384); continue; } r -= I_IN;
        if (r < I_OUT) { transpose_item(INP(F, 20) + (size_t)l * DMODEL * DMODEL, DMODEL, DMODEL, F_WOUT + (size_t)l * DMODEL * DMODEL, scr, r, F.lane, nullptr, 1.f, 0); continue; } r -= I_OUT;
        if (r < I_UP) { transpose_item(INP(F, 22) + (size_t)l * DMODEL * FF, DMODEL, FF, F_WUP + (size_t)l * FF * DMODEL, scr, r, F.lane, INP(F, 21) + l * DMODEL, 1.f, 0); continue; } r -= I_UP;
        if (r < I_DN) { transpose_item(INP(F, 23) + (size_t)l * FF * DMODEL, FF, DMODEL, F_WDN + (size_t)l * DMODEL * FF, scr, r, F.lane, nullptr, 1.f, 0); continue; } r -= I_DN;
        bf16* L = F_LORA + (size_t)l * LORA_L;
        if (r < I_LW) { transpose_item(INP(F, 11) + (size_t)l * 64 * RW, 64, RW, L, scr, r, F.lane, nullptr, 1.f, 0); continue; } r -= I_LW;
        if (r < I_LW) { transpose_item(INP(F, 13) + (size_t)l * 64 * RW, 64, RW, L + RW * 64, scr, r, F.lane, nullptr, 1.f, 0); continue; } r -= I_LW;
        transpose_item(INP(F, 14) + (size_t)l * 128 * RW, 128, RW, L + 2 * RW * 64, scr, r, F.lane, nullptr, 1.f, 0);
    }
}
DI void rms_rows_bf16(const Frame& F0, const float* src, bf16* dst) { Frame F = refresh(F0);
    for (int m = F.gw; m < M; m += F.NGW) {
        const f32x4* xr = (const f32x4*)(src + (size_t)m * DMODEL) + F.lane;
        f32x4 v[4]; float s2 = 0.f;
#pragma unroll
        for (int j = 0; j < 4; ++j) { v[j] = xr[64 * j]; s2 += (v[j].x * v[j].x + v[j].y * v[j].y) + (v[j].z * v[j].z + v[j].w * v[j].w); }
        const float rstd = 1.f / sqrtf(wave_sum(s2) * (1.f / DMODEL) + NORM_EPS);
        v2u* o8 = (v2u*)(dst + (size_t)m * DMODEL) + F.lane;
#pragma unroll
        for (int j = 0; j < 4; ++j) { v2u w; w.x = pk2(v[j].x * rstd, v[j].y * rstd); w.y = pk2(v[j].z * rstd, v[j].w * rstd); o8[64 * j] = w; }
    }
}
DI void final_norm(const Frame& F0, float* x, const float* g) { Frame F = refresh(F0);
    for (int m = F.gw; m < M; m += F.NGW) {
        f32x4* xr = (f32x4*)(x + (size_t)m * DMODEL) + F.lane; const f32x4* gr = (const f32x4*)g + F.lane;
        f32x4 v[4]; float s2 = 0.f;
#pragma unroll
        for (int j = 0; j < 4; ++j) { v[j] = xr[64 * j]; s2 += (v[j].x * v[j].x + v[j].y * v[j].y) + (v[j].z * v[j].z + v[j].w * v[j].w); }
        const float rstd = 1.f / sqrtf(wave_sum(s2) * (1.f / DMODEL) + NORM_EPS);
#pragma unroll
        for (int j = 0; j < 4; ++j) xr[64 * j] = v[j] * rstd * gr[64 * j];
    }
}

DI void loadz8(const bf16* prow, bool first, const float* mu, int col, float* z) {
    const v4u p = *(const v4u*)(prow + col); v4u q = (v4u){0u, 0u, 0u, 0u}; if (!first) q = *(const v4u*)(prow - NIN + col);
    const f32x4 m0 = *(const f32x4*)(mu + col), m1 = *(const f32x4*)(mu + col + 4);
    float pf[8], qf[8]; unpack8(p, pf); unpack8(q, qf);
#pragma unroll
    for (int j = 0; j < 4; ++j) { z[j] = pf[j] + m0[j] * (qf[j] - pf[j]); z[4 + j] = pf[4 + j] + m1[j] * (qf[4 + j] - pf[4 + j]); }
}
DI float loadz1(const bf16* prow, bool first, float mu, int col) { const float p = bf1(prow + col); const float q = first ? 0.f : bf1(prow - NIN + col); return p + mu * (q - p); }

DI void prep_phase(const Frame& F0, int l) { Frame F = refresh(F0);
    const float* mu = INP(F, 9) + l * RCOLS;
    const float* w0 = INP(F, 10) + l * RW; const float* a0 = INP(F, 12) + l * RW; const float* kkw = INP(F, 15) + l * RW; const float* kaw = INP(F, 16) + l * RW;
    const bf16* WUT = F_LORA + (size_t)l * LORA_L; const bf16* AUT = WUT + RW * 64; const bf16* GUT = AUT + RW * 64;
    const int row = F.lane & 15, kq = F.lane >> 4;
    for (int tile = F.gw; tile < M / 16; tile += F.NGW) {
        const int t0 = tile * 16;
        bf16x8 Aw[2], Aa[2], Ag[4];
        { const int t = t0 + row; const bool first = (t % SEQ) == 0; const bf16* prow = F_PROJ + (size_t)t * NIN + ROFF; float z[8];
#pragma unroll
          for (int ks = 0; ks < 2; ++ks) { loadz8(prow, first, mu, 1152 + ks * 32 + kq * 8, z);
#pragma unroll
              for (int j = 0; j < 8; ++j) z[j] = tanhf_(z[j]);
              Aw[ks] = __builtin_bit_cast(bf16x8, pack8(z)); }
#pragma unroll
          for (int ks = 0; ks < 2; ++ks) { loadz8(prow, first, mu, 1216 + ks * 32 + kq * 8, z); Aa[ks] = __builtin_bit_cast(bf16x8, pack8(z)); }
#pragma unroll
          for (int ks = 0; ks < 4; ++ks) { loadz8(prow, first, mu, 1280 + ks * 32 + kq * 8, z);
#pragma unroll
              for (int j = 0; j < 8; ++j) z[j] = sigmoidf_(z[j]);
              Ag[ks] = __builtin_bit_cast(bf16x8, pack8(z)); } }
#pragma unroll 1
        for (int hd = 0; hd < 6; ++hd) {
            float kkv[4][4], av[4][4], ss[4] = {0.f, 0.f, 0.f, 0.f};
#pragma unroll
            for (int cgi = 0; cgi < 4; ++cgi) {
                const int ch = hd * 64 + cgi * 16 + row;
                f32x4 cw = (f32x4){0.f, 0.f, 0.f, 0.f}, ca = cw, cgt = cw;
#pragma unroll
                for (int ks = 0; ks < 2; ++ks) {
                    const bf16x8 bw = *(const bf16x8*)(WUT + (size_t)ch * 64 + ks * 32 + kq * 8); cw = __builtin_amdgcn_mfma_f32_16x16x32_bf16(Aw[ks], bw, cw, 0, 0, 0);
                    const bf16x8 ba = *(const bf16x8*)(AUT + (size_t)ch * 64 + ks * 32 + kq * 8); ca = __builtin_amdgcn_mfma_f32_16x16x32_bf16(Aa[ks], ba, ca, 0, 0, 0); }
#pragma unroll
                for (int ks = 0; ks < 4; ++ks) { const bf16x8 bg = *(const bf16x8*)(GUT + (size_t)ch * 128 + ks * 32 + kq * 8); cgt = __builtin_amdgcn_mfma_f32_16x16x32_bf16(Ag[ks], bg, cgt, 0, 0, 0); }
                const float w0c = w0[ch], a0c = a0[ch], kkc = kkw[ch], kac = kaw[ch], mur = mu[ch], muk = mu[RW + ch], muv = mu[2 * RW + ch];
#pragma unroll
                for (int j = 0; j < 4; ++j) {
                    const int tt = t0 + kq * 4 + j; const bool fj = (tt % SEQ) == 0; const bf16* pr = F_PROJ + (size_t)tt * NIN + ROFF;
                    const float zr = loadz1(pr, fj, mur, ch), zk = loadz1(pr, fj, muk, RW + ch), zv = loadz1(pr, fj, muv, 2 * RW + ch);
                    const float wl = w0c + cw[j];
                    const float xs = -wl; const float sp = fmaxf(xs, 0.f) + __logf(1.f + __expf(-fabsf(xs)));
                    const float ld = -__expf(-sp - 0.5f);
                    const float a = sigmoidf_(a0c + ca[j]);
                    const float kk = zk * kkc, kp = zk * (1.f + (a - 1.f) * kac);
                    kkv[cgi][j] = kk; av[cgi][j] = a; ss[j] += kk * kk;
                    const size_t idx = (size_t)tt * RW + ch;
                    F_S_r[idx] = (bf16)f2bf(zr); F_S_ld[idx] = (bf16)f2bf(ld); F_S_k[idx] = (bf16)f2bf(kp); F_S_v[idx] = (bf16)f2bf(zv); F_S_g[idx] = (bf16)f2bf(cgt[j]);
                }
            }
#pragma unroll
            for (int j = 0; j < 4; ++j) { float s = ss[j]; s += __shfl_xor(s, 1); s += __shfl_xor(s, 2); s += __shfl_xor(s, 4); s += __shfl_xor(s, 8); ss[j] = 1.f / fmaxf(sqrtf(s), 1e-12f); }
#pragma unroll
            for (int cgi = 0; cgi < 4; ++cgi)
#pragma unroll
                for (int j = 0; j < 4; ++j) { const int tt = t0 + kq * 4 + j; const size_t idx = (size_t)tt * RW + hd * 64 + cgi * 16 + row; const float kn = kkv[cgi][j] * ss[j];
                    F_S_n[idx] = (bf16)f2bf(-kn); F_S_b[idx] = (bf16)f2bf(kn * av[cgi][j]); }
        }
    }
    const float* cw_ = INP(F, 8) + l * 3 * 256;
    for (int it = F.gw; it < M / 2; it += F.NGW) {
        const int t = it * 2 + (F.lane >> 5), c8 = (F.lane & 31) * 8, pos = t % SEQ;
        const bf16* base = F_PROJ + (size_t)t * NIN + COFF + c8;
        float b8[8], g8[8], u8[8], acc[8], w8[8];
        unpack8(*(const v4u*)base, b8);
#pragma unroll
        for (int j = 0; j < 8; ++j) acc[j] = 0.f;
#pragma unroll
        for (int d = 0; d < 3; ++d) {
            const int back = 2 - d;
            if (pos >= back) {
                const bf16* pb = base - (size_t)back * NIN;
                unpack8(*(const v4u*)(pb + 256), g8); unpack8(*(const v4u*)(pb + 512), u8);
                const f32x4 wa = *(const f32x4*)(cw_ + d * 256 + c8), wb = *(const f32x4*)(cw_ + d * 256 + c8 + 4);
                w8[0] = wa.x; w8[1] = wa.y; w8[2] = wa.z; w8[3] = wa.w; w8[4] = wb.x; w8[5] = wb.y; w8[6] = wb.z; w8[7] = wb.w;
#pragma unroll
                for (int j = 0; j < 8; ++j) acc[j] += w8[j] * (g8[j] * u8[j]);
            }
        }
#pragma unroll
        for (int j = 0; j < 8; ++j) acc[j] *= b8[j];
        *(v4u*)(F_MIX + (size_t)t * DMODEL + 384 + c8) = pack8(acc);
    }
}

DI void post_phase(const Frame& F0, int l) { Frame F = refresh(F0);
    const float* rk = INP(F, 17) + l * RW; const float* lg = INP(F, 18) + l * RW; const float* lb = INP(F, 19) + l * RW;
    for (int it = F.gw; it < M * 6 / 8; it += F.NGW) {
        const int pair = it * 8 + (F.lane >> 3), t = pair / 6, hd = pair % 6, ch = hd * 64 + (F.lane & 7) * 8;
        bf16* yp = F_MIX + (size_t)t * DMODEL + 640 + ch; const size_t idx = (size_t)t * RW + ch;
        float y[8], r[8], k[8], v[8], g[8], o[8];
        unpack8(*(const v4u*)yp, y); unpack8(*(const v4u*)(F_S_r + idx), r); unpack8(*(const v4u*)(F_S_k + idx), k); unpack8(*(const v4u*)(F_S_v + idx), v); unpack8(*(const v4u*)(F_S_g + idx), g);
        float s = 0.f, dot = 0.f;
#pragma unroll
        for (int j = 0; j < 8; ++j) { s += y[j]; dot += r[j] * k[j] * rk[ch + j]; }
        s += __shfl_xor(s, 1); s += __shfl_xor(s, 2); s += __shfl_xor(s, 4);
        dot += __shfl_xor(dot, 1); dot += __shfl_xor(dot, 2); dot += __shfl_xor(dot, 4);
        const float mean = s * (1.f / 64.f); float q = 0.f;
#pragma unroll
        for (int j = 0; j < 8; ++j) { const float d = y[j] - mean; q += d * d; }
        q += __shfl_xor(q, 1); q += __shfl_xor(q, 2); q += __shfl_xor(q, 4);
        const float rstd = 1.f / sqrtf(q * (1.f / 64.f) + GN_EPS);
#pragma unroll
        for (int j = 0; j < 8; ++j) o[j] = ((y[j] - mean) * rstd * lg[ch + j] + lb[ch + j] + dot * v[j]) * g[j];
        *(v4u*)yp = pack8(o);
    }
}

DI void scan_wg(const Frame& F0, int sw) { Frame F = refresh(F0);
    const int bh = sw >> 1, half = sw & 1, b = bh / 6, hd = bh % 6;
    const int rloc = F.wave * 4 + (F.lane >> 4), kp = F.lane & 15;
    const size_t tb = (size_t)b * SEQ; const int cb = hd * 64;
    LAS unsigned char* const lds = F.lds;
    constexpr int BUFB = 6 * 8192, YOFF = 2 * BUFB;
    v4u st[3];
#define SCAN_LOAD(c) do { _Pragma("unroll") for (int i = 0; i < 3; ++i) { const int p = F.tid + 512 * i, a = p >> 8, tt = (p & 255) >> 3, c8 = (p & 7) * 8; \
        const bf16* src = (a == 0 ? F_S_r : a == 1 ? F_S_ld : a == 2 ? F_S_k : a == 3 ? F_S_v : a == 4 ? F_S_n : F_S_b); \
        st[i] = *(const v4u*)(src + (tb + (size_t)(c) * 32 + tt) * RW + cb + c8); } } while (0)
#define SCAN_STORE(bufsel) do { _Pragma("unroll") for (int i = 0; i < 3; ++i) { const int p = F.tid + 512 * i, a = p >> 8, tt = (p & 255) >> 3, c8 = (p & 7) * 8; \
        float f[8]; unpack8(st[i], f); if (a == 1) { _Pragma("unroll") for (int j = 0; j < 8; ++j) f[j] = __expf(f[j]); } \
        LAS f32x4* d = (LAS f32x4*)(lds + (bufsel) * BUFB + a * 8192 + tt * 256 + c8 * 4); d[0] = (f32x4){f[0], f[1], f[2], f[3]}; d[1] = (f32x4){f[4], f[5], f[6], f[7]}; } } while (0)
    SCAN_LOAD(0); SCAN_STORE(0);
    __syncthreads();
    f32x4 s = (f32x4){0.f, 0.f, 0.f, 0.f};
#pragma unroll 1
    for (int c = 0; c < SEQ / 32; ++c) {
        const int cur = c & 1;
        if (c + 1 < SEQ / 32) SCAN_LOAD(c + 1);
        const LAS unsigned char* bb = lds + cur * BUFB + kp * 16;
        const LAS unsigned char* vb = lds + cur * BUFB + 3 * 8192 + (half * 32 + rloc) * 4;
        LAS float* yb = (LAS float*)(lds + YOFF + cur * 4096) + rloc;
#pragma unroll 4
        for (int tt = 0; tt < 32; ++tt) {
            const f32x4 rv = *(const LAS f32x4*)(bb + 0 * 8192 + tt * 256), wv = *(const LAS f32x4*)(bb + 1 * 8192 + tt * 256), kv = *(const LAS f32x4*)(bb + 2 * 8192 + tt * 256);
            const f32x4 nv = *(const LAS f32x4*)(bb + 4 * 8192 + tt * 256), bv = *(const LAS f32x4*)(bb + 5 * 8192 + tt * 256);
            const float vv = *(const LAS float*)(vb + tt * 256);
            float sa = (s.x * nv.x + s.y * nv.y) + (s.z * nv.z + s.w * nv.w);
            sa = red16(sa);
            const f32x4 tmp = bv * sa + kv * vv;
            s = s * wv + tmp;
            float y = (s.x * rv.x + s.y * rv.y) + (s.z * rv.z + s.w * rv.w);
            y = red16(y);
            if (kp == 0) yb[tt * 32] = y;
        }
        if (c + 1 < SEQ / 32) SCAN_STORE(cur ^ 1);
        __syncthreads();
        {
            const int tt = F.tid >> 4, r2 = (F.tid & 15) * 2;
            const LAS float* ys = (const LAS float*)(lds + YOFF + cur * 4096) + tt * 32 + r2;
            *(unsigned*)(F_MIX + (tb + (size_t)c * 32 + tt) * DMODEL + 640 + cb + half * 32 + r2) = pk2(ys[0], ys[1]);
        }
    }
#undef SCAN_LOAD
#undef SCAN_STORE
    __syncthreads();
}

DI void mix_phase(const Frame& F0, int l, char* ldsg) { Frame F = refresh(F0);
#ifndef SKIP_SCAN
    if ((int)blockIdx.x < SCAN_WGS) scan_wg(F, (int)blockIdx.x);
#endif
    const float* lq1 = INP(F, 3) + l * 32; const float* lk1 = INP(F, 4) + l * 32; const float* lq2 = INP(F, 5) + l * 32; const float* lk2 = INP(F, 6) + l * 32;
    float d1 = 0.f, d2 = 0.f;
    for (int i = 0; i < 32; ++i) { d1 += lq1[i] * lk1[i]; d2 += lq2[i] * lk2[i]; }
    const float lambda_init = (l == 0) ? 0.2f : 0.35550906759f;
    const float lam = __expf(d1) - __expf(d2) + lambda_init;
    const float* sg = INP(F, 7) + l * 64;
    volatile LAS unsigned* qslot = (volatile LAS unsigned*)(F.lds + MISC_OFF + 64);
    for (;;) {
        if (F.tid == 0) *qslot = atomicAdd(F_ctl + 64 * (1 + l), 1u);
        __syncthreads();
        const unsigned idx = (unsigned)__builtin_amdgcn_readfirstlane((int)*qslot);
        __syncthreads();
        if (idx >= (unsigned)ATT_ITEMS) break;
        const int qb = 15 - (int)(idx / 48u), bh = (int)(idx % 48u), b = bh / 6, h = bh % 6;
        const attn_body::bf16* P = (const attn_body::bf16*)F_PROJ;
#ifndef SKIP_ATT
#pragma unroll 1
        for (int ns = 0; ns < 2; ++ns)
            attn_body::attn_unit<8>(b, h, qb, ns, lam, sg, 1.f - lambda_init, P, P + 384, P + 768, (attn_body::bf16*)F_MIX, ldsg);
#endif
    }
}

__global__ void __launch_bounds__(NWAVES * 64, 2) mega_fwd(Args args) {
    extern __shared__ __attribute__((aligned(16))) unsigned char lds[];
    cg::grid_group grid = cg::this_grid();
    Frame F;
    F.lds = (LAS unsigned char*)lds;
    F.tid = threadIdx.x; F.lane = F.tid & 63; F.wave = __builtin_amdgcn_readfirstlane(F.tid >> 6);
    F.G = gridDim.x; F.gw = (int)blockIdx.x * NWAVES + F.wave; F.NGW = F.G * NWAVES;
    F.in = args.in; F.out = args.out; F.ws = args.ws;
    const int G = F.G;

    prologue(F);
    rms_rows_bf16(F, INP(F, 0), F_XB);
    grid.sync();
#pragma unroll 1
    for (int l = 0; l < 2; ++l) {
        {
            pg8::Gemm g{F_XB, F_WIN + (size_t)l * NIN * DMODEL, M, NIN, DMODEL}; pg8::StaticOrder S; int bx = blockIdx.x; asm volatile("" : "+s"(bx)); S.init(M, NIN, G, bx);
            pg8::EpiBf16S<0> E{F_PROJ, NIN};
            GEMMCALL0 pg8::gemm_phase<pg8::EpiBf16S<0>, pg8::StaticOrder, true, true>(F.lds, g, S, E);
        }
        grid.sync();
#ifndef SKIP_PREP
        prep_phase(F, l);
#endif
        grid.sync();
        mix_phase(F, l, (char*)lds);
        grid.sync();
#ifndef SKIP_POST
        post_phase(F, l);
#endif
        grid.sync();
        {
            pg8::Gemm g{F_MIX, F_WOUT + (size_t)l * DMODEL * DMODEL, M, DMODEL, DMODEL}; pg8::StaticOrder S; int bx = blockIdx.x; asm volatile("" : "+s"(bx)); S.init(M, DMODEL, G, bx);
            pg8::EpiResF32 E{l == 0 ? INP(F, 0) : (const float*)F.out, F.out, DMODEL};
            GEMMCALL1 pg8::gemm_phase<pg8::EpiResF32, pg8::StaticOrder, true, true>(F.lds, g, S, E);
        }
        grid.sync();
        rms_rows_bf16(F, F.out, F_XB);
        grid.sync();
        {
            pg8::Gemm g{F_XB, F_WUP + (size_t)l * FF * DMODEL, M, FF, DMODEL}; pg8::StaticOrder S; int bx = blockIdx.x; asm volatile("" : "+s"(bx)); S.init(M, FF, G, bx);
            pg8::EpiBf16S<2> E{F_HID, FF};
            GEMMCALL2 pg8::gemm_phase<pg8::EpiBf16S<2>, pg8::StaticOrder, true, true>(F.lds, g, S, E);
        }
        grid.sync();
        {
            pg8::Gemm g{F_HID, F_WDN + (size_t)l * DMODEL * FF, M, DMODEL, FF}; pg8::StaticOrder S; int bx = blockIdx.x; asm volatile("" : "+s"(bx)); S.init(M, DMODEL, G, bx);
            pg8::EpiResF32 E{(const float*)F.out, F.out, DMODEL};
            GEMMCALL3 pg8::gemm_phase<pg8::EpiResF32, pg8::StaticOrder, true, true>(F.lds, g, S, E);
        }
        grid.sync();
        if (l == 0) { rms_rows_bf16(F, F.out, F_XB); grid.sync(); }
    }
    final_norm(F, F.out, INP(F, 24));
}

extern "C" void kernel_launch(void* const* d_in, const int* in_sizes, int n_in, void* d_out, int out_size, void* d_ws, size_t ws_size, hipStream_t stream) {
    static int grid = 0;
    if (grid == 0) {
        if (n_in != 25 || in_sizes[0] != M * DMODEL || out_size != M * DMODEL || ws_size < WS_END) {
            fprintf(stderr, "kernel_launch: unexpected problem geometry (n_in %d, in0 %d, out %d, ws %zu)\n", n_in, n_in > 0 ? in_sizes[0] : -1, out_size, ws_size); grid = -1; return; }
        int dev = 0, cus = 0, per_cu = 0;
        if (hipGetDevice(&dev) != hipSuccess || hipDeviceGetAttribute(&cus, hipDeviceAttributeMultiprocessorCount, dev) != hipSuccess) { grid = -1; return; }
        if (hipFuncSetAttribute((const void*)mega_fwd, hipFuncAttributeMaxDynamicSharedMemorySize, LDS_BYTES) != hipSuccess) { fprintf(stderr, "kernel_launch: hipFuncSetAttribute failed\n"); grid = -1; return; }
        if (hipOccupancyMaxActiveBlocksPerMultiprocessor(&per_cu, (const void*)mega_fwd, NWAVES * 64, LDS_BYTES) != hipSuccess || per_cu < 1) { fprintf(stderr, "kernel_launch: occupancy query gave %d\n", per_cu); (void)hipGetLastError(); per_cu = 1; }
        grid = cus * per_cu;
    }
    if (grid < 0) return;
    (void)hipMemsetAsync((char*)d_ws + WS_CTL, 0, CTL_ZERO_BYTES, stream);
    Args a{};
    for (int i = 0; i < 25; ++i) a.in[i] = (const float*)d_in[i];
    a.out = (float*)d_out; a.ws = (unsigned char*)d_ws; a.i0 = 0; a.i1 = 0;
    void* kargs[] = {&a};
    const hipError_t e = hipLaunchCooperativeKernel((const void*)mega_fwd, dim3(grid), dim3(NWAVES * 64), kargs, LDS_BYTES, stream);
    if (e != hipSuccess) fprintf(stderr, "kernel_launch: cooperative launch failed: %s (grid %d)\n", hipGetErrorString(e), grid);
}
```

```cpp
#include <hip/hip_runtime.h>
#include <hip/hip_cooperative_groups.h>
#include <hip/hip_bf16.h>
#include <cstdio>
#include <cstdint>
#include <cmath>
namespace pg8 {
#define PG8_LAS __attribute__((address_space(3)))
typedef unsigned short bf16_t;
typedef short bf16x8 __attribute__((ext_vector_type(8)));
typedef float f32x4 __attribute__((ext_vector_type(4)));
typedef unsigned u32x4 __attribute__((ext_vector_type(4)));
constexpr int BM = 256, BK = 64, HALF = 128, HTB = HALF * BK * 2  , STAGE_BYTES = 8 * HTB, NXCD = 8, WGM = 8;

__host__ __device__ __forceinline__ int lds_byte(int r, int c) { const int st = (r >> 4) * 2 + (c >> 5), rr = r & 15, cc = c & 31, ob = rr * 64 + cc * 2; return st * 1024 + (ob ^ (((ob >> 9) & 1) << 5)); }
__host__ __device__ __forceinline__ void stage_rc(int b, int& R, int& C) { const int st = b / 1024, sb = b % 1024, swz = sb ^ (((sb >> 9) & 1) << 5); R = (st >> 1) * 16 + swz / 64; C = (st & 1) * 32 + (swz % 64) / 2; }
__host__ __device__ __forceinline__ int perm32(int rho) { const int n = rho >> 4, i = rho & 15; return 8 * (i >> 2) + 4 * n + (i & 3); }

struct Unit { int pm, pn; };
struct Gemm { const bf16_t* A; const bf16_t* Bt; int M, N, K; };

struct StaticOrder {
    int nM, nN, nwg, G, c;
    __host__ __device__ void init(int M, int N, int G_, int c_) { nM = M / BM; nN = N / BM; nwg = nM * nN; G = G_; c = c_; }
    __host__ __device__ bool next(int i, Unit& u) const {
        const long L = (long)i * G + c; if (L >= nwg) return false;
        int wgid = (int)L; { const int q = nwg / NXCD, r = nwg % NXCD, xcd = wgid % NXCD, off = wgid / NXCD; wgid = (xcd < r ? xcd * (q + 1) : r * (q + 1) + (xcd - r) * q) + off; }
        const int nig = WGM * nN, gid = wgid / nig, fm = gid * WGM, gsz = (nM - fm) < WGM ? (nM - fm) : WGM;
        u.pm = fm + ((wgid % nig) % gsz); u.pn = (wgid % nig) / gsz; return true;
    }
    __device__ __forceinline__ void a_ready(const Unit&) const {}
    __device__ __forceinline__ void done(const Unit&) const {}
};

__device__ __forceinline__ unsigned cvt_pk_bf16(float lo, float hi) { unsigned r; asm volatile("v_cvt_pk_bf16_f32 %0, %1, %2" : "=v"(r) : "v"(lo), "v"(hi)); return r; }
typedef float f32x2 __attribute__((ext_vector_type(2)));
template <int ACT  > struct EpiBf16S {
    static constexpr bool PERM = true, AFTER_DRAIN = false;
    bf16_t* O; int ldc;
    __device__ __forceinline__ void operator()(const f32x4 (&acc)[2][2][4][2], const Unit& u, int wr, int wc, int fr, int fq) const {
        const int row0 = u.pm * BM + wr * 64 + fr; const int col0 = u.pn * BM + wc * 32 + 8 * fq;
#pragma unroll
        for (int ai = 0; ai < 2; ++ai)
#pragma unroll
            for (int m = 0; m < 4; ++m) { bf16_t* rowp = O + (size_t)(row0 + ai * HALF + m * 16) * ldc + col0;
#pragma unroll
                for (int bj = 0; bj < 2; ++bj) { f32x4 v0 = acc[ai][bj][m][0], v1 = acc[ai][bj][m][1];
                    if (ACT == 2) {
#pragma unroll
                        for (int e = 0; e < 4; ++e) { float a = v0[e] > 0.f ? v0[e] : 0.f; v0[e] = a * a; float b = v1[e] > 0.f ? v1[e] : 0.f; v1[e] = b * b; } }
                    u32x4 w; w.x = cvt_pk_bf16(v0[0], v0[1]); w.y = cvt_pk_bf16(v0[2], v0[3]); w.z = cvt_pk_bf16(v1[0], v1[1]); w.w = cvt_pk_bf16(v1[2], v1[3]);
                    *(u32x4*)(rowp + bj * HALF) = w; } }
    }
};
struct EpiResF32 {
    static constexpr bool PERM = false, AFTER_DRAIN = false;
    const float* base; float* out; int ldc;
    __device__ __forceinline__ void operator()(const f32x4 (&acc)[2][2][4][2], const Unit& u, int wr, int wc, int fr, int fq) const {
        const int col0 = u.pn * BM + wc * 32 + 4 * fq;
#pragma unroll
        for (int ai = 0; ai < 2; ++ai)
#pragma unroll
            for (int m = 0; m < 4; ++m) { const int r = u.pm * BM + ai * HALF + wr * 64 + m * 16 + fr; const size_t off = (size_t)r * ldc + col0;
#pragma unroll
                for (int bj = 0; bj < 2; ++bj)
#pragma unroll
                    for (int n = 0; n < 2; ++n) { const size_t idx = off + bj * HALF + n * 16; const f32x4 bs = *(const f32x4*)(base + idx); *(f32x4*)(out + idx) = bs + acc[ai][bj][m][n]; }
                asm volatile("" ::: "memory"); }
    }
};
template <class Epi, class Sched, bool ALIGN_EPI = false, bool SP2 = false>
__device__ __forceinline__ void gemm_phase(PG8_LAS unsigned char* lds, const Gemm g, const Sched& S, const Epi& E) {
    int tid_ = threadIdx.x; asm volatile("" : "+v"(tid_)); const int tid = tid_, wid = __builtin_amdgcn_readfirstlane(tid >> 6), lane = tid & 63, wr = wid >> 2, wc = wid & 3, fr = lane & 15, fq = lane >> 4;
    const int K = g.K, nt = K / BK;
    unsigned voffA[2], voffB[2];
#pragma unroll
    for (int i = 0; i < 2; ++i) { int R, C; stage_rc(tid * 16 + i * 8192, R, C); const int Rb = Epi::PERM ? ((R & ~31) + perm32(R & 31)) : R;
        voffA[i] = (unsigned)(R * K + C) * 2u; voffB[i] = (unsigned)(Rb * K + C) * 2u; }
    const size_t kstep = (size_t)(BK * 2);
    const size_t hstep = (size_t)HALF * K * 2;
    const size_t tstep = 2 * hstep;
    const unsigned ldsw = (unsigned)wid * 1024u;
    const int aoff = lds_byte(wr * 64 + fr, fq * 8), boff = lds_byte(wc * 32 + fr, fq * 8);
#define PG8_SA(b, h) (((b) * 2 + (h)) * HTB)
#define PG8_SB(b, h) ((4 + (b) * 2 + (h)) * HTB)
#define PG8_STAGE(bufoff, gbase, voff) do { _Pragma("unroll") for (int _i = 0; _i < 2; ++_i) \
        __builtin_amdgcn_global_load_lds((const unsigned*)((const char*)(gbase) + (voff)[_i]), (PG8_LAS unsigned*)(lds + (bufoff) + ldsw + _i * 8192), 16, 0, 0); } while (0)
#define PG8_LDA(dst, b, h) do { _Pragma("unroll") for (int m = 0; m < 4; ++m) _Pragma("unroll") for (int k = 0; k < 2; ++k) dst[m][k] = *(const PG8_LAS bf16x8*)(lds + PG8_SA(b, h) + aoff + m * 2048 + k * 1024); } while (0)
#define PG8_LDB(dst, b, h) do { _Pragma("unroll") for (int n = 0; n < 2; ++n) _Pragma("unroll") for (int k = 0; k < 2; ++k) dst[n][k] = *(const PG8_LAS bf16x8*)(lds + PG8_SB(b, h) + boff + n * 2048 + k * 1024); } while (0)
#define PG8_MMA(ai, bj, At, Bt) do { __builtin_amdgcn_s_setprio(1); _Pragma("unroll") for (int m = 0; m < 4; ++m) _Pragma("unroll") for (int n = 0; n < 2; ++n) _Pragma("unroll") for (int k = 0; k < 2; ++k) \
        acc[ai][bj][m][n] = __builtin_amdgcn_mfma_f32_16x16x32_bf16(Bt[n][k], At[m][k], acc[ai][bj][m][n], 0, 0, 0); __builtin_amdgcn_s_setprio(0); } while (0)
#define PG8_WAIT_V(n) asm volatile("s_waitcnt vmcnt(" #n ")" ::: "memory")
#define PG8_WAIT_L(n) asm volatile("s_waitcnt lgkmcnt(" #n ")" ::: "memory")
#define PG8_BAR __builtin_amdgcn_s_barrier()
#define PG8_SCHED __builtin_amdgcn_sched_barrier(0)
    Unit cur, nxt; int ui = 0;
    if (!S.next(0, cur)) return;
    f32x4 acc[2][2][4][2];
#pragma unroll
    for (int a = 0; a < 2; ++a)
#pragma unroll
        for (int b = 0; b < 2; ++b)
#pragma unroll
            for (int m = 0; m < 4; ++m)
#pragma unroll
                for (int n = 0; n < 2; ++n) acc[a][b][m][n] = (f32x4){0.f, 0.f, 0.f, 0.f};
    bf16x8 At[4][2], B0[2][2], B1[2][2];
    const char* cA = (const char*)g.A + (size_t)cur.pm * tstep; const char* cB = (const char*)g.Bt + (size_t)cur.pn * tstep;
    S.a_ready(cur);
    if constexpr (SP2) {
        PG8_STAGE(PG8_SB(0, 0), cB, voffB); PG8_STAGE(PG8_SB(0, 1), cB + hstep, voffB); PG8_STAGE(PG8_SA(0, 0), cA, voffA); PG8_STAGE(PG8_SA(0, 1), cA + hstep, voffA);
        if (wr == 1) PG8_BAR;
        PG8_WAIT_V(2); PG8_BAR;
        PG8_STAGE(PG8_SB(1, 0), cB + kstep, voffB); PG8_STAGE(PG8_SA(1, 0), cA + kstep, voffA); PG8_STAGE(PG8_SB(1, 1), cB + hstep + kstep, voffB);
        PG8_WAIT_V(6); PG8_BAR;
    } else {
        PG8_STAGE(PG8_SB(0, 0), cB, voffB); PG8_STAGE(PG8_SA(0, 0), cA, voffA); PG8_STAGE(PG8_SB(0, 1), cB + hstep, voffB); PG8_STAGE(PG8_SA(0, 1), cA + hstep, voffA);
        if (wr == 1) PG8_BAR;
        PG8_WAIT_V(4); PG8_BAR;
        PG8_STAGE(PG8_SB(1, 0), cB + kstep, voffB); PG8_STAGE(PG8_SA(1, 0), cA + kstep, voffA); PG8_STAGE(PG8_SB(1, 1), cB + hstep + kstep, voffB);
        PG8_WAIT_V(6); PG8_BAR;
    }
    for (;;) {
        const bool has_next = S.next(ui + 1, nxt);
        const char* nA = has_next ? (const char*)g.A + (size_t)nxt.pm * tstep : cA; const char* nB = has_next ? (const char*)g.Bt + (size_t)nxt.pn * tstep : cB;
        for (int t = 0; t < nt; t += 2) {
            const bool last = (t == nt - 2);
            const char* a1 = cA + (size_t)(t + 1) * kstep;
            const char* a2 = last ? nA : cA + (size_t)(t + 2) * kstep; const char* b2 = last ? nB : cB + (size_t)(t + 2) * kstep;
            const char* a3 = a2 + kstep; const char* b3 = b2 + kstep;
            if (last && has_next) S.a_ready(nxt);
            if constexpr (SP2) {
            PG8_LDB(B0, 0, 0); PG8_LDB(B1, 0, 1); PG8_SCHED; PG8_LDA(At, 0, 0); PG8_STAGE(PG8_SA(1, 1), a1 + hstep, voffA);
            PG8_WAIT_V(8); PG8_WAIT_L(0); PG8_BAR; PG8_MMA(0, 0, At, B0); PG8_MMA(0, 1, At, B1); PG8_BAR; PG8_SCHED;
            PG8_LDA(At, 0, 1); PG8_STAGE(PG8_SB(0, 0), b2, voffB); PG8_STAGE(PG8_SB(0, 1), b2 + hstep, voffB); PG8_STAGE(PG8_SA(0, 0), a2, voffA);
            PG8_WAIT_V(8); PG8_WAIT_L(0); PG8_BAR; PG8_MMA(1, 0, At, B0); PG8_MMA(1, 1, At, B1); PG8_BAR; PG8_SCHED;
            PG8_LDB(B0, 1, 0); PG8_LDB(B1, 1, 1); PG8_SCHED; PG8_LDA(At, 1, 0); PG8_STAGE(PG8_SA(0, 1), a2 + hstep, voffA);
            PG8_WAIT_V(8); PG8_WAIT_L(0); PG8_BAR; PG8_MMA(0, 0, At, B0); PG8_MMA(0, 1, At, B1); PG8_BAR; PG8_SCHED;
            PG8_LDA(At, 1, 1); PG8_STAGE(PG8_SB(1, 0), b3, voffB); PG8_STAGE(PG8_SB(1, 1), b3 + hstep, voffB); PG8_STAGE(PG8_SA(1, 0), a3, voffA);
            PG8_WAIT_V(8); PG8_WAIT_L(0); PG8_BAR; PG8_MMA(1, 0, At, B0); PG8_MMA(1, 1, At, B1); PG8_BAR; PG8_SCHED;
            } else {
            PG8_LDB(B0, 0, 0); PG8_SCHED; PG8_LDA(At, 0, 0); PG8_STAGE(PG8_SA(1, 1), a1 + hstep, voffA);
            PG8_WAIT_L(8); PG8_BAR; PG8_WAIT_L(0); PG8_MMA(0, 0, At, B0); PG8_BAR; PG8_SCHED;
            PG8_LDB(B1, 0, 1); PG8_STAGE(PG8_SB(0, 0), b2, voffB);
            PG8_BAR; PG8_WAIT_L(0); PG8_MMA(0, 1, At, B1); PG8_BAR;
            PG8_LDA(At, 0, 1); PG8_STAGE(PG8_SA(0, 0), a2, voffA);
            PG8_BAR; PG8_WAIT_L(0); PG8_MMA(1, 0, At, B0); PG8_BAR; PG8_SCHED;
            PG8_STAGE(PG8_SB(0, 1), b2 + hstep, voffB);
            PG8_WAIT_V(6); PG8_BAR; PG8_MMA(1, 1, At, B1); PG8_BAR;
            PG8_LDB(B0, 1, 0); PG8_SCHED; PG8_LDA(At, 1, 0); PG8_STAGE(PG8_SA(0, 1), a2 + hstep, voffA);
            PG8_WAIT_L(8); PG8_BAR; PG8_WAIT_L(0); PG8_MMA(0, 0, At, B0); PG8_BAR; PG8_SCHED;
            PG8_LDB(B1, 1, 1); PG8_STAGE(PG8_SB(1, 0), b3, voffB);
            PG8_BAR; PG8_WAIT_L(0); PG8_MMA(0, 1, At, B1); PG8_BAR;
            PG8_LDA(At, 1, 1); PG8_STAGE(PG8_SA(1, 0), a3, voffA);
            PG8_BAR; PG8_WAIT_L(0); PG8_MMA(1, 0, At, B0); PG8_BAR; PG8_SCHED;
            PG8_STAGE(PG8_SB(1, 1), b3 + hstep, voffB);
            PG8_WAIT_V(6); PG8_BAR; PG8_MMA(1, 1, At, B1); PG8_BAR;
            }
        }
        if constexpr (ALIGN_EPI) { if (wr == 0) PG8_BAR; }
        if constexpr (!Epi::AFTER_DRAIN) { E(acc, cur, wr, wc, fr, fq); S.done(cur); }
        if (!has_next) break;
#pragma unroll
        for (int a = 0; a < 2; ++a)
#pragma unroll
            for (int b = 0; b < 2; ++b)
#pragma unroll
                for (int m = 0; m < 4; ++m)
#pragma unroll
                    for (int n = 0; n < 2; ++n) acc[a][b][m][n] = (f32x4){0.f, 0.f, 0.f, 0.f};
        cur = nxt; cA = nA; cB = nB; ++ui;
        if constexpr (ALIGN_EPI) { if (wr == 1) PG8_BAR; }
    }
    PG8_WAIT_V(0);
    if constexpr (!ALIGN_EPI) { if (wr == 0) PG8_BAR; }
    PG8_BAR;
    if constexpr (Epi::AFTER_DRAIN) { E.fused(acc, cur, wr, wc, fr, fq, lds, wid, lane); S.done(cur); }
#undef PG8_SA
#undef PG8_SB
#undef PG8_STAGE
#undef PG8_LDA
#undef PG8_LDB
#undef PG8_MMA
#undef PG8_WAIT_V
#undef PG8_WAIT_L
#undef PG8_BAR
#undef PG8_SCHED
}
}

#define PG8_SP2 true
#define PG8_ALIGN true
namespace attn_body {
using bf16=__hip_bfloat16;
using bf16x8=__attribute__((ext_vector_type(8)))short;
using s16x4=__attribute__((ext_vector_type(4)))short;
using f32x16=__attribute__((ext_vector_type(16)))float;
using u32x4=__attribute__((ext_vector_type(4)))unsigned;
constexpr int BATCH=8,NHEAD=6,SEQ=4096,D=64,DM=3328,OPITCH=1024;
constexpr int NW=8,QBLK=32,QB=QBLK*NW,KVBLK=64,NQB=SEQ/QB;
constexpr int ATTN_PITCH=DM, ATTN_UNIT_ROWS=QB;
__device__ __forceinline__ int crow(int r,int hi){return (r&3)+8*(r>>2)+4*hi;}
#define SBAR() __builtin_amdgcn_sched_barrier(0)
__device__ __forceinline__ void cmask(f32x16&p0,f32x16&p1,int jb,int qrel,int hi){
  const float NEG=-INFINITY; int kb=64*jb+4*hi;
  #pragma unroll
  for(int r=0;r<16;++r){int kv=kb+(r&3)+8*(r>>2); if(kv>qrel)p0[r]=NEG; if(kv+32>qrel)p1[r]=NEG;}
}

constexpr int NSLOT=3, SLOTB=8192;
constexpr int LDS_K=0, LDS_V=NSLOT*SLOTB, LDS_WS=2*NSLOT*SLOTB, LDS_OST=LDS_WS+NW*64*4, LDS_OST1=LDS_OST+NW*4096, LDS_BYTES=LDS_OST1+NW*4096;
constexpr float C2=0.17677669529663687f*1.4426950408889634f;
__device__ __forceinline__ void glds16(const void*gsrc,unsigned lds_dst){unsigned keep;
  asm volatile("s_mov_b32 %0, m0\n\ts_mov_b32 m0, %2\n\ts_nop 0\n\tglobal_load_lds_dwordx4 %1, off\n\ts_mov_b32 m0, %0":"=&s"(keep):"v"(gsrc),"s"(lds_dst):"memory");}
__device__ __forceinline__ float max3f(float a,float b,float c){float r;asm("v_max3_f32 %0, %1, %2, %3":"=v"(r):"v"(a),"v"(b),"v"(c));return r;}
__device__ __forceinline__ float max2f(float a,float b){float r;asm("v_max_f32_e32 %0, %1, %2":"=v"(r):"v"(a),"v"(b));return r;}
__device__ __forceinline__ float fadd_s(float a,float b){float r;asm("v_add_f32_e32 %0, %1, %2":"=v"(r):"v"(a),"v"(b));return r;}
__device__ __forceinline__ float fsub_s(float a,float b){float r;asm("v_sub_f32_e32 %0, %1, %2":"=v"(r):"v"(a),"v"(b));return r;}
typedef float f32x2_t __attribute__((ext_vector_type(2))); typedef __bf16 bf16x2_t __attribute__((ext_vector_type(2)));
__device__ __forceinline__ unsigned cvtpk_s(float lo,float hi){f32x2_t v={lo,hi};bf16x2_t b=__builtin_convertvector(v,bf16x2_t);return __builtin_bit_cast(unsigned,b);}
#define WAIT_BAR(N) asm volatile("s_waitcnt vmcnt(" #N ") lgkmcnt(0)\n\ts_barrier":::"memory")

__device__ __forceinline__ void qkt(f32x16&p0,f32x16&p1,const char*Kslot,const bf16x8*qr,const f32x16&negm,int r32,int hi){
  const char*kb=Kslot+hi*1024+r32*16;
  #pragma unroll
  for(int d0=0;d0<4;++d0){
    const bf16x8 b0=*reinterpret_cast<const bf16x8*>(kb+d0*2048);
    const bf16x8 b1=*reinterpret_cast<const bf16x8*>(kb+d0*2048+512);
    if(d0==0){p0=__builtin_amdgcn_mfma_f32_32x32x16_bf16(b0,qr[0],negm,0,0,0);p1=__builtin_amdgcn_mfma_f32_32x32x16_bf16(b1,qr[0],negm,0,0,0);}
    else{p0=__builtin_amdgcn_mfma_f32_32x32x16_bf16(b0,qr[d0],p0,0,0,0);p1=__builtin_amdgcn_mfma_f32_32x32x16_bf16(b1,qr[d0],p1,0,0,0);}}
}
typedef __attribute__((address_space(3))) const char* lds_cptr;
typedef short v4i16_t __attribute__((ext_vector_type(4)));
__device__ __forceinline__ void kload8(bf16x8*kf,lds_cptr kp){
  kf[0]=*(const __attribute__((address_space(3))) bf16x8*)(kp);      kf[1]=*(const __attribute__((address_space(3))) bf16x8*)(kp+512);
  kf[2]=*(const __attribute__((address_space(3))) bf16x8*)(kp+2048); kf[3]=*(const __attribute__((address_space(3))) bf16x8*)(kp+2560);
  kf[4]=*(const __attribute__((address_space(3))) bf16x8*)(kp+4096); kf[5]=*(const __attribute__((address_space(3))) bf16x8*)(kp+4608);
  kf[6]=*(const __attribute__((address_space(3))) bf16x8*)(kp+6144); kf[7]=*(const __attribute__((address_space(3))) bf16x8*)(kp+6656);
}
__device__ __forceinline__ void kload2(bf16x8*kf,lds_cptr kp,int j){ kf[2*j]=*(const __attribute__((address_space(3))) bf16x8*)(kp+j*2048); kf[2*j+1]=*(const __attribute__((address_space(3))) bf16x8*)(kp+j*2048+512); }
__device__ __forceinline__ s16x4 vtr(lds_cptr p){ return __builtin_bit_cast(s16x4,__builtin_amdgcn_ds_read_tr16_b64_v4i16((__attribute__((address_space(3))) v4i16_t*)p)); }
__device__ __forceinline__ float rowmax(const f32x16&p0,const f32x16&p1){
  float a=max3f(p0[0],p0[1],p1[0]),b=max3f(p0[2],p0[3],p1[1]);a=max3f(a,p1[2],p1[3]);
  #pragma unroll
  for(int r=4;r<16;r+=4){a=max3f(a,p0[r],p0[r+1]);b=max3f(b,p0[r+2],p0[r+3]);a=max3f(a,p1[r],p1[r+1]);b=max3f(b,p1[r+2],p1[r+3]);}
  const float m=max2f(a,b);
  auto rr=__builtin_amdgcn_permlane32_swap(__float_as_uint(m),__float_as_uint(m),false,false);
  return max2f(__uint_as_float(rr[0]),__uint_as_float(rr[1]));
}
__device__ __forceinline__ void pv(f32x16*o,int vb,bf16x8 pa0,bf16x8 pa1,bf16x8 pa2,bf16x8 pa3){
  #pragma unroll
  for(int d0=0;d0<2;++d0){s16x4 lo[4],hi[4];
    #pragma unroll
    for(int ks=0;ks<4;++ks){
      asm volatile("ds_read_b64_tr_b16 %0,%1 offset:%c2":"=&v"(lo[ks]):"v"(vb),"i"(d0*4096+ks*1024):"memory");
      asm volatile("ds_read_b64_tr_b16 %0,%1 offset:%c2":"=&v"(hi[ks]):"v"(vb),"i"(d0*4096+ks*1024+512):"memory");}
    asm volatile("s_waitcnt lgkmcnt(0)":::"memory");SBAR();
    #define PK(k) (bf16x8){lo[k][0],lo[k][1],lo[k][2],lo[k][3],hi[k][0],hi[k][1],hi[k][2],hi[k][3]}
    o[d0]=__builtin_amdgcn_mfma_f32_32x32x16_bf16(pa0,PK(0),o[d0],0,0,0);
    o[d0]=__builtin_amdgcn_mfma_f32_32x32x16_bf16(pa1,PK(1),o[d0],0,0,0);
    o[d0]=__builtin_amdgcn_mfma_f32_32x32x16_bf16(pa2,PK(2),o[d0],0,0,0);
    o[d0]=__builtin_amdgcn_mfma_f32_32x32x16_bf16(pa3,PK(3),o[d0],0,0,0);
    #undef PK
  }
}

#ifndef ATTN_STORE16
#define ATTN_STORE16(p,v) (*(u32x4*)(p)=(v))
#endif
template<int THRL> __device__ __forceinline__ void attn_unit(int b,int h,int qb,int nsel,float lam,const float*subg,float omli,const bf16*Q,const bf16*__restrict__ K,const bf16*__restrict__ V,bf16*O,char*shm){
  int tid_=threadIdx.x; asm volatile("":"+v"(tid_)); const int tid=tid_,lane=tid&63,r32=lane&31,hi=lane>>5; const int wid=__builtin_amdgcn_readfirstlane(tid>>6);
  const long rowbase=(long)b*SEQ; const int q0=qb*QB;
  const bf16*Qw=Q+(rowbase+q0+wid*QBLK)*DM+h*D;
  const bf16*Kh=K+rowbase*DM+h*D,*Vh=V+rowbase*DM+h*D;
  const unsigned lds0=(unsigned)(uintptr_t)shm;
  float*wsf=(float*)(shm+LDS_WS)+wid*64;
  const bf16*ksrc=Kh+(long)lane*DM+wid*8;
  const bf16*vsrc=Vh+(long)(16*(wid&3)+(lane>>2))*DM+(wid>>2)*32+(lane&3)*8;
  const unsigned kdst=lds0+LDS_K+wid*1024, vdst=lds0+LDS_V+wid*1024;
  #define DMA_K(t,slot) glds16(ksrc+(long)(t)*KVBLK*DM,(unsigned)__builtin_amdgcn_readfirstlane(kdst+(slot)))
  #define DMA_V(t,slot) glds16(vsrc+(long)(t)*KVBLK*DM,(unsigned)__builtin_amdgcn_readfirstlane(vdst+(slot)))
  const int vb0=(int)(lds0+LDS_V)+((lane>>4)&1)*32+(lane&3)*8+(4*hi+((lane&15)>>2))*64;
  const char*Kbase=shm+LDS_K; bf16x8 kf[8];
  const lds_cptr shm3=(lds_cptr)shm; const lds_cptr kp0=shm3+LDS_K+hi*1024+r32*16; const lds_cptr vp0=shm3+LDS_V+((lane>>4)&1)*32+(lane&3)*8+(4*hi+((lane&15)>>2))*64;
  const int NT=(q0+QB)/KVBLK;
  DMA_K(0,0);DMA_V(0,0);DMA_K(1,SLOTB);
  bf16x8 qr[4];
  #pragma unroll
  for(int d0=0;d0<4;++d0){qr[d0]=*reinterpret_cast<const bf16x8*>(&Qw[(long)r32*DM+d0*16+hi*8]); if((d0>>1)!=nsel)qr[d0]=bf16x8{0,0,0,0,0,0,0,0};}
  float mhat=0.f,l_reg=0.f;f32x16 o[2];o[0]=f32x16{};o[1]=f32x16{};f32x16 negm=f32x16{};asm volatile("":"+v"(negm));
  const int qrel=wid*QBLK+r32;
  #define CMASK(P0,P1,t) do{int jb_=(t)-(NT-4); if(jb_>=0)cmask(P0,P1,jb_,qrel,hi);}while(0)
  bool resc=false;
  #define START(P0,P1) do{ const float rm=rowmax(P0,P1); resc=false; \
    { const float dl=rm; mhat=fadd_s(mhat,dl); \
      _Pragma("unroll") for(int r=0;r<16;++r){P0[r]=fsub_s(P0[r],dl);P1[r]=fsub_s(P1[r],dl);} \
      _Pragma("unroll") for(int r=0;r<16;++r)negm[r]=-mhat; asm volatile("":"+v"(negm)); } \
    _Pragma("unroll") for(int r=0;r<16;++r)P0[r]=__builtin_amdgcn_exp2f(P0[r]); }while(0)
  #define RESC() do{ if(resc){ asm volatile("s_waitcnt lgkmcnt(0)":::"memory"); \
      _Pragma("unroll") for(int d_=0;d_<2;++d_) _Pragma("unroll") for(int r=0;r<16;++r)o[d_][r]*=wsf[crow(r,hi)]; } }while(0)
  f32x16 pA0,pA1,pB0,pB1;
  int sl_prev=0,sl_cur=0,sl_next=SLOTB;
  #define ROT() do{sl_prev=sl_cur;sl_cur=sl_next;sl_next=(sl_next==(NSLOT-1)*SLOTB)?0:sl_next+SLOTB;}while(0)
  DMA_K(2,2*SLOTB);
  WAIT_BAR(3);
  qkt(pA0,pA1,Kbase,qr,negm,r32,hi);asm volatile("s_nop 15\n\ts_nop 7":"+v"(pA0),"+v"(pA1));CMASK(pA0,pA1,0);
  START(pA0,pA1);
  _Pragma("unroll") for(int r=0;r<16;++r)pA1[r]=__builtin_amdgcn_exp2f(pA1[r]);
  WAIT_BAR(0);
  DMA_K(3,0);DMA_V(1,SLOTB);
  ROT();
  kload8(kf,kp0+sl_cur);
  WAIT_BAR(2);
  s16x4 vlo[8],vhi[8]; u32x4 pw0,pw1,pw2,pw3;
  #define PKW(P,B) cvtpk_s(P[B],P[B+1])
  #define PAF(k) __builtin_bit_cast(bf16x8,pw##k)
  #define VFR(i) (bf16x8){vlo[i][0],vlo[i][1],vlo[i][2],vlo[i][3],vhi[i][0],vhi[i][1],vhi[i][2],vhi[i][3]}
  #define PIN(x) asm volatile("":"+v"(x))
  #define MX3(a,b,c) __builtin_fmaxf(__builtin_fmaxf((a),(b)),(c))
  #define GAPA(MF,A0,A1,A2,A3,W0,W1,PW) do{ MF; sacc+=A0; sacc+=A1; sacc+=A2; sacc+=A3; PIN(sacc); W0; W1; PIN(PW); SBAR(); }while(0)
  #define EX(v) __builtin_amdgcn_exp2f(v)
  #define GAPB(MF,X,B) do{ MF; X[B]=EX(X[B]); X[B+1]=EX(X[B+1]); X[B+2]=EX(X[B+2]); X[B+3]=EX(X[B+3]); PIN(X); SBAR(); }while(0)
  #define VRD(i) do{ vlo[i]=vtr(vp_+(((i)>>2)*4096+((i)&3)*1024)); vhi[i]=vtr(vp_+(((i)>>2)*4096+((i)&3)*1024+512)); }while(0)
  #define KRD(G,j) do{ if(G){ kload2(kf,kp0+sl_next,j); SBAR(); } }while(0)
  #define STEP(C0,C1,P0,P1,t,GK,GV,GL) do{ SBAR(); \
    const lds_cptr vp_=vp0+sl_prev; \
    VRD(0); SBAR(); float sacc=(P0[0]+P0[1]); \
    GAPA(C0=__builtin_amdgcn_mfma_f32_32x32x16_bf16(kf[0],qr[0],negm,0,0,0), P0[2],P0[3],P0[4],P0[5],     pw0[0]=PKW(P0,0), pw0[1]=PKW(P0,2), pw0); \
    VRD(4); SBAR(); GAPA(C1=__builtin_amdgcn_mfma_f32_32x32x16_bf16(kf[1],qr[0],negm,0,0,0), P0[6],P0[7],P0[8],P0[9],     pw0[2]=PKW(P0,4), pw0[3]=PKW(P0,6), pw0); \
    VRD(1); SBAR(); GAPA(C0=__builtin_amdgcn_mfma_f32_32x32x16_bf16(kf[2],qr[1],C0,0,0,0),   P0[10],P0[11],P0[12],P0[13], pw1[0]=PKW(P0,8), pw1[1]=PKW(P0,10), pw1); \
    VRD(5); SBAR(); GAPA(C1=__builtin_amdgcn_mfma_f32_32x32x16_bf16(kf[3],qr[1],C1,0,0,0),   P0[14],P0[15],P1[0],P1[1],   pw1[2]=PKW(P0,12),pw1[3]=PKW(P0,14), pw1); \
    VRD(2); SBAR(); GAPA(C0=__builtin_amdgcn_mfma_f32_32x32x16_bf16(kf[4],qr[2],C0,0,0,0),   P1[2],P1[3],P1[4],P1[5],     pw2[0]=PKW(P1,0), pw2[1]=PKW(P1,2), pw2); \
    VRD(6); SBAR(); GAPA(C1=__builtin_amdgcn_mfma_f32_32x32x16_bf16(kf[5],qr[2],C1,0,0,0),   P1[6],P1[7],P1[8],P1[9],     pw2[2]=PKW(P1,4), pw2[3]=PKW(P1,6), pw2); \
    VRD(3); SBAR(); GAPA(C0=__builtin_amdgcn_mfma_f32_32x32x16_bf16(kf[6],qr[3],C0,0,0,0),   P1[10],P1[11],P1[12],P1[13], pw3[0]=PKW(P1,8), pw3[1]=PKW(P1,10), pw3); \
    VRD(7); SBAR(); GAPA(C1=__builtin_amdgcn_mfma_f32_32x32x16_bf16(kf[7],qr[3],C1,0,0,0),   P1[14],P1[15],0.f,0.f,       pw3[2]=PKW(P1,12),pw3[3]=PKW(P1,14), pw3); \
    l_reg+=sacc; \
    if(GK){DMA_K((t)+3,sl_cur);} if(GV){DMA_V((t)+1,sl_next);} \
    CMASK(C0,C1,t); \
    { float a=MX3(C0[0],C0[1],C1[0]),b=MX3(C0[2],C0[3],C1[1]); a=MX3(a,C1[2],C1[3]); \
      _Pragma("unroll") for(int r=4;r<16;r+=4){a=MX3(a,C0[r],C0[r+1]);b=MX3(b,C0[r+2],C0[r+3]);a=MX3(a,C1[r],C1[r+1]);b=MX3(b,C1[r+2],C1[r+3]);} \
      float rm=__builtin_fmaxf(a,b); { auto rr=__builtin_amdgcn_permlane32_swap(__float_as_uint(rm),__float_as_uint(rm),false,false); rm=__builtin_fmaxf(__uint_as_float(rr[0]),__uint_as_float(rr[1])); } \
      resc=false; \
      if(__builtin_expect(__any(rm>(float)THRL),0)){ const float dl=__builtin_fmaxf(rm,0.f); mhat+=dl; \
        _Pragma("unroll") for(int r=0;r<16;++r){C0[r]-=dl;C1[r]-=dl;} \
        _Pragma("unroll") for(int r=0;r<16;++r)negm[r]=-mhat; asm volatile("":"+v"(negm)); \
        const float f=__builtin_amdgcn_exp2f(-dl); l_reg*=f; if(hi==0)wsf[r32]=f; resc=true; } } \
    SBAR(); \
    GAPB(o[0]=__builtin_amdgcn_mfma_f32_32x32x16_bf16(PAF(0),VFR(0),o[0],0,0,0), C0,0); \
    GAPB(o[1]=__builtin_amdgcn_mfma_f32_32x32x16_bf16(PAF(0),VFR(4),o[1],0,0,0), C0,4); \
    KRD(GL,0); GAPB(o[0]=__builtin_amdgcn_mfma_f32_32x32x16_bf16(PAF(1),VFR(1),o[0],0,0,0), C0,8); \
    KRD(GL,1); GAPB(o[1]=__builtin_amdgcn_mfma_f32_32x32x16_bf16(PAF(1),VFR(5),o[1],0,0,0), C0,12); \
    KRD(GL,2); GAPB(o[0]=__builtin_amdgcn_mfma_f32_32x32x16_bf16(PAF(2),VFR(2),o[0],0,0,0), C1,0); \
    KRD(GL,3); GAPB(o[1]=__builtin_amdgcn_mfma_f32_32x32x16_bf16(PAF(2),VFR(6),o[1],0,0,0), C1,4); \
    GAPB(o[0]=__builtin_amdgcn_mfma_f32_32x32x16_bf16(PAF(3),VFR(3),o[0],0,0,0), C1,8); \
    GAPB(o[1]=__builtin_amdgcn_mfma_f32_32x32x16_bf16(PAF(3),VFR(7),o[1],0,0,0), C1,12); \
    }while(0)
  int t=1;
  #undef CMASK
  #define CMASK(P0,P1,t) do{}while(0)
  for(;t+5<NT;t+=2){
    STEP(pB0,pB1,pA0,pA1,t,true,true,true);     WAIT_BAR(2); RESC(); ROT();
    STEP(pA0,pA1,pB0,pB1,t+1,true,true,true);   WAIT_BAR(2); RESC(); ROT();
  }
  #undef CMASK
  #define CMASK(P0,P1,t) do{int jb_=(t)-(NT-4); if(jb_>=0)cmask(P0,P1,jb_,qrel,hi);}while(0)
  #define ENDW(tt) do{ if((tt)+3<NT){WAIT_BAR(2);} else if((tt)+2<NT){WAIT_BAR(1);} else {WAIT_BAR(0);} }while(0)
  for(;t+1<NT;t+=2){
    STEP(pB0,pB1,pA0,pA1,t,(t+3<NT),(t+1<NT),(t+1<NT));       ENDW(t);   RESC(); ROT();
    STEP(pA0,pA1,pB0,pB1,t+1,(t+4<NT),(t+2<NT),(t+2<NT));     ENDW(t+1); RESC(); ROT();
  }
  STEP(pB0,pB1,pA0,pA1,NT-1,false,false,false); RESC();
  { float sacc=pB0[0]+pB0[1]; _Pragma("unroll") for(int r=2;r<16;++r)sacc+=pB0[r]; _Pragma("unroll") for(int r=0;r<16;++r)sacc+=pB1[r]; l_reg+=sacc;
    pw0=(u32x4){PKW(pB0,0),PKW(pB0,2),PKW(pB0,4),PKW(pB0,6)};pw1=(u32x4){PKW(pB0,8),PKW(pB0,10),PKW(pB0,12),PKW(pB0,14)};pw2=(u32x4){PKW(pB1,0),PKW(pB1,2),PKW(pB1,4),PKW(pB1,6)};pw3=(u32x4){PKW(pB1,8),PKW(pB1,10),PKW(pB1,12),PKW(pB1,14)};
    SBAR(); pv(o,vb0+sl_cur,PAF(0),PAF(1),PAF(2),PAF(3)); }
  #undef PKW
  #undef PAF
  #undef VFR
  #undef PIN
  #undef MX3
  #undef GAPA
  #undef GAPB
  #undef EX
  #undef VRD
  #undef KRD
  #undef STEP
  #undef ENDW
  {auto rr=__builtin_amdgcn_permlane32_swap(__float_as_uint(l_reg),__float_as_uint(l_reg),false,false);l_reg=__uint_as_float(rr[0])+__uint_as_float(rr[1]);}
  if(hi==0)wsf[32+r32]=l_reg;asm volatile("s_waitcnt lgkmcnt(0)":::"memory");
  float rli[16];
  #pragma unroll
  for(int r=0;r<16;++r)rli[r]=__builtin_amdgcn_rcpf(wsf[32+crow(r,hi)]);
  bf16*Ow=O+(rowbase+q0+wid*QBLK)*OPITCH+h*D;
  { bf16*stg=(bf16*)(shm+(nsel==0?LDS_OST1:LDS_OST))+wid*2048;
    #pragma unroll
    for(int r=0;r<16;++r){const int orow=crow(r,hi);
      #pragma unroll
      for(int d0=0;d0<2;++d0)stg[orow*64+d0*32+r32]=__float2bfloat16(o[d0][r]*rli[r]);}
    asm volatile("s_waitcnt lgkmcnt(0)":::"memory");
    if(nsel==1){ const bf16*stg1=(const bf16*)(shm+LDS_OST1)+wid*2048;
      #pragma unroll
      for(int i=0;i<4;++i){const int row=i*8+(lane>>3),ch=lane&7; const u32x4 v2=*(const u32x4*)(stg+row*64+ch*8); const u32x4 v1=*(const u32x4*)(stg1+row*64+ch*8);
        float dd[8]; float ss=0.f;
        #pragma unroll
        for(int j=0;j<4;++j){ const float a0=__uint_as_float(v1[j]<<16),a1=__uint_as_float(v1[j]&0xffff0000u),b0=__uint_as_float(v2[j]<<16),b1=__uint_as_float(v2[j]&0xffff0000u);
          dd[2*j]=a0-lam*b0; dd[2*j+1]=a1-lam*b1; ss+=dd[2*j]*dd[2*j]+dd[2*j+1]*dd[2*j+1]; }
        ss+=__shfl_xor(ss,1); ss+=__shfl_xor(ss,2); ss+=__shfl_xor(ss,4);
        const float rs=omli/sqrtf(ss*(1.0f/64.0f)+1e-6f);
        u32x4 w;
        #pragma unroll
        for(int j=0;j<4;++j) w[j]=cvtpk_s(dd[2*j]*rs*subg[ch*8+2*j],dd[2*j+1]*rs*subg[ch*8+2*j+1]);
        ATTN_STORE16(Ow+(long)row*OPITCH+ch*8,w);} } }
  asm volatile("s_waitcnt lgkmcnt(0)\n\ts_barrier":::"memory");
  #undef DMA_K
  #undef DMA_V
  #undef CMASK
  #undef START
  #undef RESC
  #undef ROT

}
#undef SBAR
#undef WAIT_BAR
}
#ifndef GOFF
#define GOFF 0
#endif
#define GEMMCALL0 if (!((GOFF) & 1))
#define GEMMCALL1 if (!((GOFF) & 2))
#define GEMMCALL2 if (!((GOFF) & 4))
#define GEMMCALL3 if (!((GOFF) & 8))
namespace cg = cooperative_groups;
#define GAS __attribute__((address_space(1)))
#define LAS __attribute__((address_space(3)))
#define DI __device__ __forceinline__
typedef unsigned short bf16;
typedef unsigned v4u __attribute__((ext_vector_type(4)));
typedef unsigned v2u __attribute__((ext_vector_type(2)));
typedef float f32x4 __attribute__((ext_vector_type(4)));
typedef short bf16x8 __attribute__((ext_vector_type(8)));

constexpr int NWAVES = 8;
constexpr int DMODEL = 1024, SEQ = 4096, M = 32768, NIN = 3328, FF = 4096;
constexpr int RW = 384, RCOLS = 1408, ROFF = 1920, COFF = 1152;
constexpr float NORM_EPS = 1e-6f, GN_EPS = 64e-5f;
constexpr size_t MiB = 1u << 20;
constexpr size_t WS_CTL = 0, CTL_ZERO_BYTES = 65536;
constexpr int CW_BAR = 4096;
constexpr size_t WS_WIN = 1 * MiB, WS_WOUT = 14 * MiB, WS_WUP = 18 * MiB, WS_WDN = 34 * MiB, WS_LORA = 50 * MiB;
constexpr size_t WS_XB = 51 * MiB, WS_PROJ = 115 * MiB, WS_MIX = 323 * MiB, WS_S = 387 * MiB, WS_END = 507 * MiB;
constexpr size_t WS_HID = 115 * MiB;
constexpr size_t SARR = (size_t)M * RW;
constexpr int LORA_L = 384 * 64 * 2 + 384 * 128;
constexpr int LDS_BYTES = 147456, MISC_OFF = 131072;
constexpr int SCAN_WGS = 96, ATT_ITEMS = 768;

#ifndef PROBE
#define PROBE 0
#endif
struct Args { const float* in[25]; float* out; unsigned char* ws; int i0, i1; };

DI float wave_sum(float v) {
#pragma unroll
    for (int o = 1; o < 64; o <<= 1) v += __shfl_xor(v, o);
    return v;
}
DI unsigned f2bf(float f) { unsigned u = __builtin_bit_cast(unsigned, f); return (u + 0x7fffu + ((u >> 16) & 1u)) >> 16; }
DI unsigned pk2(float lo, float hi) { return f2bf(lo) | (f2bf(hi) << 16); }
DI float bflo(unsigned w) { return __uint_as_float(w << 16); }
DI float bfhi(unsigned w) { return __uint_as_float(w & 0xffff0000u); }
DI float bf1(const bf16* p) { return __uint_as_float(((unsigned)*p) << 16); }
DI void unpack8(v4u w, float* f) { f[0] = bflo(w.x); f[1] = bfhi(w.x); f[2] = bflo(w.y); f[3] = bfhi(w.y); f[4] = bflo(w.z); f[5] = bfhi(w.z); f[6] = bflo(w.w); f[7] = bfhi(w.w); }
DI v4u pack8(const float* f) { v4u o; o.x = pk2(f[0], f[1]); o.y = pk2(f[2], f[3]); o.z = pk2(f[4], f[5]); o.w = pk2(f[6], f[7]); return o; }
DI float sigmoidf_(float x) { return 1.f / (1.f + __expf(-x)); }
DI float tanhf_(float x) { const float e = __expf(2.f * x); return 1.f - 2.f / (e + 1.f); }
template <int CTRL> DI float dpp_add(float x) { return x + __int_as_float(__builtin_amdgcn_update_dpp(0, __float_as_int(x), CTRL, 0xf, 0xf, true)); }
DI float red16(float x) { x = dpp_add<0xB1>(x); x = dpp_add<0x4E>(x); x = dpp_add<0x141>(x); x = dpp_add<0x140>(x); return x; }

#define XB_TMO      128
#define XB_XCNT(j)  (256  + 64 * (j))
#define XB_XSUB(j)  (1280 + 64 * (j))
#define XB_XGEN(j)  (2304 + 64 * (j))
#define XB_TOP      3328
#define XB_TOPGEN   3392
#define XCD_BAR_WORDS 3456
#define XB_SPIN_CAP (1u << 18)

__device__ __forceinline__ unsigned xb_ld(unsigned* p)              { return __hip_atomic_load(p, __ATOMIC_RELAXED, __HIP_MEMORY_SCOPE_AGENT); }
__device__ __forceinline__ unsigned xb_add(unsigned* p, unsigned v) { return __hip_atomic_fetch_add(p, v, __ATOMIC_RELAXED, __HIP_MEMORY_SCOPE_AGENT); }
__device__ __forceinline__ unsigned xb_xcc_id() { return (unsigned)__builtin_amdgcn_s_getreg((3 << 11) | 20) & 0xFu; }
#define XB_SPIN(cond, bar) do { unsigned _sp = 0; while (cond) { __builtin_amdgcn_s_sleep(1); \
    if ((++_sp & 255u) == 0u) { if (xb_ld(&(bar)[XB_TMO])) break; if (_sp > XB_SPIN_CAP) { atomicAdd(&(bar)[XB_TMO], 1u); break; } } } } while (0)

struct XcdBarrier {
    unsigned* bar; unsigned x;
    volatile LAS unsigned* st;
};

__device__ __forceinline__ XcdBarrier xcd_barrier_post(unsigned* bar, volatile LAS unsigned* st) {
    XcdBarrier b; b.bar = bar; b.x = xb_xcc_id(); b.st = st;
    if (threadIdx.x == 0) (void)xb_add(&bar[XB_XCNT(b.x)], 1u);
    return b;
}
__device__ __forceinline__ void xcd_barrier_complete(unsigned* bar, unsigned x, unsigned& nloc, unsigned& nx) {
    const unsigned G = gridDim.x * gridDim.y * gridDim.z;
    unsigned sum, cnt, mine, sp = 0u;
    for (;;) {
        sum = 0u; cnt = 0u; mine = 0u;
#pragma unroll
        for (unsigned j = 0; j < 16; ++j) { const unsigned c = xb_ld(&bar[XB_XCNT(j)]); sum += c; cnt += (c > 0u) ? 1u : 0u; mine = (j == x) ? c : mine; }
        if (sum == G) break;
        __builtin_amdgcn_s_sleep(1);
        if ((++sp & 255u) == 0u) { if (xb_ld(&bar[XB_TMO])) break; if (sp > XB_SPIN_CAP) { atomicAdd(&bar[XB_TMO], 1u); break; } }
    }
    nloc = mine > 0u ? mine : 1u; nx = cnt > 0u ? cnt : 1u;
}

__device__ __forceinline__ void xcd_barrier(const XcdBarrier& b) {
    asm volatile("s_waitcnt vmcnt(0)" ::: "memory");
    __syncthreads();
    if (threadIdx.x == 0) {
        unsigned* bar = b.bar;
        __builtin_amdgcn_s_waitcnt(0);
        unsigned nloc = b.st[0], nx = b.st[1];
        if (nloc == 0u) { xcd_barrier_complete(bar, b.x, nloc, nx); b.st[0] = nloc; b.st[1] = nx; }
        const unsigned old = xb_add(&bar[XB_XSUB(b.x)], 1u);
        const unsigned gen = old / nloc;
        if (old + 1u == (gen + 1u) * nloc) {
            __builtin_amdgcn_fence(__ATOMIC_RELEASE, "agent");
            asm volatile("s_waitcnt vmcnt(0)" ::: "memory");
            const unsigned og = xb_add(&bar[XB_TOP], 1u);
            const unsigned tg = og / nx;
            if (og + 1u == (tg + 1u) * nx) xb_add(&bar[XB_TOPGEN], 1u);
            else XB_SPIN(xb_ld(&bar[XB_TOPGEN]) == tg, bar);
            __builtin_amdgcn_fence(__ATOMIC_ACQUIRE, "agent");
            xb_add(&bar[XB_XGEN(b.x)], 1u);
            asm volatile("s_waitcnt vmcnt(0)" ::: "memory");
        } else {
            XB_SPIN(xb_ld(&bar[XB_XGEN(b.x)]) == gen, bar);
            __builtin_amdgcn_fence(__ATOMIC_ACQUIRE, "agent");
            asm volatile("s_waitcnt vmcnt(0)" ::: "memory");
        }
    }
    __syncthreads();
}


struct Frame {
    LAS unsigned char* lds;
    int tid, lane, wave, G, gw, NGW;
    const float* const* in;
    float* out; unsigned char* ws;
};
DI const float* INP(const Frame& F, int k) { asm volatile("" : "+s"(k)); return F.in[k]; }
#define F_WIN  ((bf16*)(F.ws + WS_WIN))
#define F_WOUT ((bf16*)(F.ws + WS_WOUT))
#define F_WUP  ((bf16*)(F.ws + WS_WUP))
#define F_WDN  ((bf16*)(F.ws + WS_WDN))
#define F_LORA ((bf16*)(F.ws + WS_LORA))
#define F_XB   ((bf16*)(F.ws + WS_XB))
#define F_PROJ ((bf16*)(F.ws + WS_PROJ))
#define F_MIX  ((bf16*)(F.ws + WS_MIX))
#define F_HID  ((bf16*)(F.ws + WS_HID))
#define F_S_r  ((bf16*)(F.ws + WS_XB))
#define F_S_ld ((bf16*)(F.ws + WS_XB) + SARR)
#define F_S_k  ((bf16*)(F.ws + WS_S))
#define F_S_v  ((bf16*)(F.ws + WS_S) + SARR)
#define F_S_n  ((bf16*)(F.ws + WS_S) + 2 * SARR)
#define F_S_b  ((bf16*)(F.ws + WS_S) + 3 * SARR)
#define F_S_g  ((bf16*)(F.ws + WS_S) + 4 * SARR)
#define F_ctl  ((unsigned*)(F.ws + WS_CTL))

DI void transpose_item(const float* W, int K, int N, bf16* WT, LAS float* scr, int item, int lane, const float* gk, float cs, int csn) {
    const int nblk = N / 32, kb = item / nblk, nb = item % nblk, k0 = 64 * kb, n0 = 32 * nb;
    const float colscale = (n0 + (lane & 31) < csn) ? cs : 1.f;
#pragma unroll 8
    for (int i = 0; i < 32; ++i) { const int kk = 2 * i + (lane >> 5); float v = W[(size_t)(k0 + kk) * N + n0 + (lane & 31)]; if (gk) v *= gk[k0 + kk]; scr[kk * 33 + (lane & 31)] = v * colscale; }
    asm volatile("s_waitcnt lgkmcnt(0)" ::: "memory");
    const int c = lane & 7;
#pragma unroll
    for (int j = 0; j < 4; ++j) { const int n = (lane >> 3) + 8 * j; const LAS float* s = scr + (8 * c) * 33 + n;
        v4u o; o.x = pk2(s[0 * 33], s[1 * 33]); o.y = pk2(s[2 * 33], s[3 * 33]); o.z = pk2(s[4 * 33], s[5 * 33]); o.w = pk2(s[6 * 33], s[7 * 33]);
        *(v4u*)(WT + (size_t)(n0 + n) * K + k0 + 8 * c) = o; }
    asm volatile("s_waitcnt lgkmcnt(0)" ::: "memory");
}
DI Frame refresh(const Frame& F0) { Frame F = F0; int t = threadIdx.x; asm volatile("" : "+v"(t)); int bxx = blockIdx.x; asm volatile("" : "+s"(bxx)); F.tid = t; F.lane = t & 63; F.wave = __builtin_amdgcn_readfirstlane(t >> 6); F.gw = bxx * NWAVES + F.wave; return F; }
DI void prologue(const Frame& F0) { Frame F = refresh(F0);
    LAS float* scr = (LAS float*)(F.lds + F.wave * 16384);
    constexpr int I_IN = 16 * 104, I_OUT = 16 * 32, I_UP = 16 * 128, I_DN = 64 * 32, I_LW = 12, I_LG = 24;
    constexpr int PER = I_IN + I_OUT + I_UP + I_DN + 2 * I_LW + I_LG;
    constexpr float C2 = 0.17677669529663687f * 1.4426950408889634f;
    for (int it = F.gw; it < 2 * PER; it += F.NGW) {
        const int l = it / PER; int r = it % PER;
        if (r < I_IN) { transpose_item(INP(F, 2) + (size_t)l * DMODEL * NIN, DMODEL, NIN, F_WIN + (size_t)l * NIN * DMODEL, scr, r, F.lane, INP(F, 1) + l * DMODEL, C2, 384); continue; } r -= I_IN;
        if (r < I_OUT) { transpose_item(INP(F, 20) + (size_t)l * DMODEL * DMODEL, DMODEL, DMODEL, F_WOUT + (size_t)l * DMODEL * DMODEL, scr, r, F.lane, nullptr, 1.f, 0); continue; } r -= I_OUT;
        if (r < I_UP) { transpose_item(INP(F, 22) + (size_t)l * DMODEL * FF, DMODEL, FF, F_WUP + (size_t)l * FF * DMODEL, scr, r, F.lane, INP(F, 21) + l * DMODEL, 1.f, 0); continue; } r -= I_UP;
        if (r < I_DN) { transpose_item(INP(F, 23) + (size_t)l * FF * DMODEL, FF, DMODEL, F_WDN + (size_t)l * DMODEL * FF, scr, r, F.lane, nullptr, 1.f, 0); continue; } r -= I_DN;
        bf16* L = F_LORA + (size_t)l * LORA_L;
        if (r < I_LW) { transpose_item(INP(F, 11) + (size_t)l * 64 * RW, 64, RW, L, scr, r, F.lane, nullptr, 1.f, 0); continue; } r -= I_LW;
        if (r < I_LW) { transpose_item(INP(F, 13) + (size_t)l * 64 * RW, 64, RW, L + RW * 64, scr, r, F.lane, nullptr, 1.f, 0); continue; } r -= I_LW;
        transpose_item(INP(F, 14) + (size_t)l * 128 * RW, 128, RW, L + 2 * RW * 64, scr, r, F.lane, nullptr, 1.f, 0);
    }
}
DI void rms_rows_bf16(const Frame& F0, const float* src, bf16* dst) { Frame F = refresh(F0);
    for (int m = F.gw; m < M; m += F.NGW) {
        const f32x4* xr = (const f32x4*)(src + (size_t)m * DMODEL) + F.lane;
        f32x4 v[4]; float s2 = 0.f;
#pragma unroll
        for (int j = 0; j < 4; ++j) { v[j] = xr[64 * j]; s2 += (v[j].x * v[j].x + v[j].y * v[j].y) + (v[j].z * v[j].z + v[j].w * v[j].w); }
        const float rstd = 1.f / sqrtf(wave_sum(s2) * (1.f / DMODEL) + NORM_EPS);
        v2u* o8 = (v2u*)(dst + (size_t)m * DMODEL) + F.lane;
#pragma unroll
        for (int j = 0; j < 4; ++j) { v2u w; w.x = pk2(v[j].x * rstd, v[j].y * rstd); w.y = pk2(v[j].z * rstd, v[j].w * rstd); o8[64 * j] = w; }
    }
}
DI void final_norm(const Frame& F0, float* x, const float* g) { Frame F = refresh(F0);
    for (int m = F.gw; m < M; m += F.NGW) {
        f32x4* xr = (f32x4*)(x + (size_t)m * DMODEL) + F.lane; const f32x4* gr = (const f32x4*)g + F.lane;
        f32x4 v[4]; float s2 = 0.f;
#pragma unroll
        for (int j = 0; j < 4; ++j) { v[j] = xr[64 * j]; s2 += (v[j].x * v[j].x + v[j].y * v[j].y) + (v[j].z * v[j].z + v[j].w * v[j].w); }
        const float rstd = 1.f / sqrtf(wave_sum(s2) * (1.f / DMODEL) + NORM_EPS);
#pragma unroll
        for (int j = 0; j < 4; ++j) xr[64 * j] = v[j] * rstd * gr[64 * j];
    }
}

DI void loadz8(const bf16* prow, bool first, const float* mu, int col, float* z) {
    const v4u p = *(const v4u*)(prow + col); v4u q = (v4u){0u, 0u, 0u, 0u}; if (!first) q = *(const v4u*)(prow - NIN + col);
    const f32x4 m0 = *(const f32x4*)(mu + col), m1 = *(const f32x4*)(mu + col + 4);
    float pf[8], qf[8]; unpack8(p, pf); unpack8(q, qf);
#pragma unroll
    for (int j = 0; j < 4; ++j) { z[j] = pf[j] + m0[j] * (qf[j] - pf[j]); z[4 + j] = pf[4 + j] + m1[j] * (qf[4 + j] - pf[4 + j]); }
}
DI float loadz1(const bf16* prow, bool first, float mu, int col) { const float p = bf1(prow + col); const float q = first ? 0.f : bf1(prow - NIN + col); return p + mu * (q - p); }

DI void prep_phase(const Frame& F0, int l) { Frame F = refresh(F0);
    const float* mu = INP(F, 9) + l * RCOLS;
    const float* w0 = INP(F, 10) + l * RW; const float* a0 = INP(F, 12) + l * RW; const float* kkw = INP(F, 15) + l * RW; const float* kaw = INP(F, 16) + l * RW;
    const bf16* WUT = F_LORA + (size_t)l * LORA_L; const bf16* AUT = WUT + RW * 64; const bf16* GUT = AUT + RW * 64;
    const int row = F.lane & 15, kq = F.lane >> 4;
    for (int tile = F.gw; tile < M / 16; tile += F.NGW) {
        const int t0 = tile * 16;
        bf16x8 Aw[2], Aa[2], Ag[4];
        { const int t = t0 + row; const bool first = (t % SEQ) == 0; const bf16* prow = F_PROJ + (size_t)t * NIN + ROFF; float z[8];
#pragma unroll
          for (int ks = 0; ks < 2; ++ks) { loadz8(prow, first, mu, 1152 + ks * 32 + kq * 8, z);
#pragma unroll
              for (int j = 0; j < 8; ++j) z[j] = tanhf_(z[j]);
              Aw[ks] = __builtin_bit_cast(bf16x8, pack8(z)); }
#pragma unroll
          for (int ks = 0; ks < 2; ++ks) { loadz8(prow, first, mu, 1216 + ks * 32 + kq * 8, z); Aa[ks] = __builtin_bit_cast(bf16x8, pack8(z)); }
#pragma unroll
          for (int ks = 0; ks < 4; ++ks) { loadz8(prow, first, mu, 1280 + ks * 32 + kq * 8, z);
#pragma unroll
              for (int j = 0; j < 8; ++j) z[j] = sigmoidf_(z[j]);
              Ag[ks] = __builtin_bit_cast(bf16x8, pack8(z)); } }
#pragma unroll 1
        for (int hd = 0; hd < 6; ++hd) {
            float kkv[4][4], av[4][4], ss[4] = {0.f, 0.f, 0.f, 0.f};
#pragma unroll
            for (int cgi = 0; cgi < 4; ++cgi) {
                const int ch = hd * 64 + cgi * 16 + row;
                f32x4 cw = (f32x4){0.f, 0.f, 0.f, 0.f}, ca = cw, cgt = cw;
#pragma unroll
                for (int ks = 0; ks < 2; ++ks) {
                    const bf16x8 bw = *(const bf16x8*)(WUT + (size_t)ch * 64 + ks * 32 + kq * 8); cw = __builtin_amdgcn_mfma_f32_16x16x32_bf16(Aw[ks], bw, cw, 0, 0, 0);
                    const bf16x8 ba = *(const bf16x8*)(AUT + (size_t)ch * 64 + ks * 32 + kq * 8); ca = __builtin_amdgcn_mfma_f32_16x16x32_bf16(Aa[ks], ba, ca, 0, 0, 0); }
#pragma unroll
                for (int ks = 0; ks < 4; ++ks) { const bf16x8 bg = *(const bf16x8*)(GUT + (size_t)ch * 128 + ks * 32 + kq * 8); cgt = __builtin_amdgcn_mfma_f32_16x16x32_bf16(Ag[ks], bg, cgt, 0, 0, 0); }
                const float w0c = w0[ch], a0c = a0[ch], kkc = kkw[ch], kac = kaw[ch], mur = mu[ch], muk = mu[RW + ch], muv = mu[2 * RW + ch];
#pragma unroll
                for (int j = 0; j < 4; ++j) {
                    const int tt = t0 + kq * 4 + j; const bool fj = (tt % SEQ) == 0; const bf16* pr = F_PROJ + (size_t)tt * NIN + ROFF;
                    const float zr = loadz1(pr, fj, mur, ch), zk = loadz1(pr, fj, muk, RW + ch), zv = loadz1(pr, fj, muv, 2 * RW + ch);
                    const float wl = w0c + cw[j];
                    const float xs = -wl; const float sp = fmaxf(xs, 0.f) + __logf(1.f + __expf(-fabsf(xs)));
                    const float ld = -__expf(-sp - 0.5f);
                    const float a = sigmoidf_(a0c + ca[j]);
                    const float kk = zk * kkc, kp = zk * (1.f + (a - 1.f) * kac);
                    kkv[cgi][j] = kk; av[cgi][j] = a; ss[j] += kk * kk;
                    const size_t idx = (size_t)tt * RW + ch;
                    F_S_r[idx] = (bf16)f2bf(zr); F_S_ld[idx] = (bf16)f2bf(ld); F_S_k[idx] = (bf16)f2bf(kp); F_S_v[idx] = (bf16)f2bf(zv); F_S_g[idx] = (bf16)f2bf(cgt[j]);
                }
            }
#pragma unroll
            for (int j = 0; j < 4; ++j) { float s = ss[j]; s += __shfl_xor(s, 1); s += __shfl_xor(s, 2); s += __shfl_xor(s, 4); s += __shfl_xor(s, 8); ss[j] = 1.f / fmaxf(sqrtf(s), 1e-12f); }
#pragma unroll
            for (int cgi = 0; cgi < 4; ++cgi)
#pragma unroll
                for (int j = 0; j < 4; ++j) { const int tt = t0 + kq * 4 + j; const size_t idx = (size_t)tt * RW + hd * 64 + cgi * 16 + row; const float kn = kkv[cgi][j] * ss[j];
                    F_S_n[idx] = (bf16)f2bf(-kn); F_S_b[idx] = (bf16)f2bf(kn * av[cgi][j]); }
        }
    }
    const float* cw_ = INP(F, 8) + l * 3 * 256;
    for (int it = F.gw; it < M / 2; it += F.NGW) {
        const int t = it * 2 + (F.lane >> 5), c8 = (F.lane & 31) * 8, pos = t % SEQ;
        const bf16* base = F_PROJ + (size_t)t * NIN + COFF + c8;
        float b8[8], g8[8], u8[8], acc[8], w8[8];
        unpack8(*(const v4u*)base, b8);
#pragma unroll
        for (int j = 0; j < 8; ++j) acc[j] = 0.f;
#pragma unroll
        for (int d = 0; d < 3; ++d) {
            const int back = 2 - d;
            if (pos >= back) {
                const bf16* pb = base - (size_t)back * NIN;
                unpack8(*(const v4u*)(pb + 256), g8); unpack8(*(const v4u*)(pb + 512), u8);
                const f32x4 wa = *(const f32x4*)(cw_ + d * 256 + c8), wb = *(const f32x4*)(cw_ + d * 256 + c8 + 4);
                w8[0] = wa.x; w8[1] = wa.y; w8[2] = wa.z; w8[3] = wa.w; w8[4] = wb.x; w8[5] = wb.y; w8[6] = wb.z; w8[7] = wb.w;
#pragma unroll
                for (int j = 0; j < 8; ++j) acc[j] += w8[j] * (g8[j] * u8[j]);
            }
        }
#pragma unroll
        for (int j = 0; j < 8; ++j) acc[j] *= b8[j];
        *(v4u*)(F_MIX + (size_t)t * DMODEL + 384 + c8) = pack8(acc);
    }
}

DI void post_phase(const Frame& F0, int l) { Frame F = refresh(F0);
    const float* rk = INP(F, 17) + l * RW; const float* lg = INP(F, 18) + l * RW; const float* lb = INP(F, 19) + l * RW;
    for (int it = F.gw; it < M * 6 / 8; it += F.NGW) {
        const int pair = it * 8 + (F.lane >> 3), t = pair / 6, hd = pair % 6, ch = hd * 64 + (F.lane & 7) * 8;
        bf16* yp = F_MIX + (size_t)t * DMODEL + 640 + ch; const size_t idx = (size_t)t * RW + ch;
        float y[8], r[8], k[8], v[8], g[8], o[8];
        unpack8(*(const v4u*)yp, y); unpack8(*(const v4u*)(F_S_r + idx), r); unpack8(*(const v4u*)(F_S_k + idx), k); unpack8(*(const v4u*)(F_S_v + idx), v); unpack8(*(const v4u*)(F_S_g + idx), g);
        float s = 0.f, dot = 0.f;
#pragma unroll
        for (int j = 0; j < 8; ++j) { s += y[j]; dot += r[j] * k[j] * rk[ch + j]; }
        s += __shfl_xor(s, 1); s += __shfl_xor(s, 2); s += __shfl_xor(s, 4);
        dot += __shfl_xor(dot, 1); dot += __shfl_xor(dot, 2); dot += __shfl_xor(dot, 4);
        const float mean = s * (1.f / 64.f); float q = 0.f;
#pragma unroll
        for (int j = 0; j < 8; ++j) { const float d = y[j] - mean; q += d * d; }
        q += __shfl_xor(q, 1); q += __shfl_xor(q, 2); q += __shfl_xor(q, 4);
        const float rstd = 1.f / sqrtf(q * (1.f / 64.f) + GN_EPS);
#pragma unroll
        for (int j = 0; j < 8; ++j) o[j] = ((y[j] - mean) * rstd * lg[ch + j] + lb[ch + j] + dot * v[j]) * g[j];
        *(v4u*)yp = pack8(o);
    }
}

DI void scan_wg(const Frame& F0, int sw) { Frame F = refresh(F0);
    const int bh = sw >> 1, half = sw & 1, b = bh / 6, hd = bh % 6;
    const int rloc = F.wave * 4 + (F.lane >> 4), kp = F.lane & 15;
    const size_t tb = (size_t)b * SEQ; const int cb = hd * 64;
    LAS unsigned char* const lds = F.lds;
    constexpr int BUFB = 6 * 8192, YOFF = 2 * BUFB;
    v4u st[3];
#define SCAN_LOAD(c) do { _Pragma("unroll") for (int i = 0; i < 3; ++i) { const int p = F.tid + 512 * i, a = p >> 8, tt = (p & 255) >> 3, c8 = (p & 7) * 8; \
        const bf16* src = (a == 0 ? F_S_r : a == 1 ? F_S_ld : a == 2 ? F_S_k : a == 3 ? F_S_v : a == 4 ? F_S_n : F_S_b); \
        st[i] = *(const v4u*)(src + (tb + (size_t)(c) * 32 + tt) * RW + cb + c8); } } while (0)
#define SCAN_STORE(bufsel) do { _Pragma("unroll") for (int i = 0; i < 3; ++i) { const int p = F.tid + 512 * i, a = p >> 8, tt = (p & 255) >> 3, c8 = (p & 7) * 8; \
        float f[8]; unpack8(st[i], f); if (a == 1) { _Pragma("unroll") for (int j = 0; j < 8; ++j) f[j] = __expf(f[j]); } \
        LAS f32x4* d = (LAS f32x4*)(lds + (bufsel) * BUFB + a * 8192 + tt * 256 + c8 * 4); d[0] = (f32x4){f[0], f[1], f[2], f[3]}; d[1] = (f32x4){f[4], f[5], f[6], f[7]}; } } while (0)
    SCAN_LOAD(0); SCAN_STORE(0);
    __syncthreads();
    f32x4 s = (f32x4){0.f, 0.f, 0.f, 0.f};
#pragma unroll 1
    for (int c = 0; c < SEQ / 32; ++c) {
        const int cur = c & 1;
        if (c + 1 < SEQ / 32) SCAN_LOAD(c + 1);
        const LAS unsigned char* bb = lds + cur * BUFB + kp * 16;
        const LAS unsigned char* vb = lds + cur * BUFB + 3 * 8192 + (half * 32 + rloc) * 4;
        LAS float* yb = (LAS float*)(lds + YOFF + cur * 4096) + rloc;
#pragma unroll 4
        for (int tt = 0; tt < 32; ++tt) {
            const f32x4 rv = *(const LAS f32x4*)(bb + 0 * 8192 + tt * 256), wv = *(const LAS f32x4*)(bb + 1 * 8192 + tt * 256), kv = *(const LAS f32x4*)(bb + 2 * 8192 + tt * 256);
            const f32x4 nv = *(const LAS f32x4*)(bb + 4 * 8192 + tt * 256), bv = *(const LAS f32x4*)(bb + 5 * 8192 + tt * 256);
            const float vv = *(const LAS float*)(vb + tt * 256);
            float sa = (s.x * nv.x + s.y * nv.y) + (s.z * nv.z + s.w * nv.w);
            sa = red16(sa);
            const f32x4 tmp = bv * sa + kv * vv;
            s = s * wv + tmp;
            float y = (s.x * rv.x + s.y * rv.y) + (s.z * rv.z + s.w * rv.w);
            y = red16(y);
            if (kp == 0) yb[tt * 32] = y;
        }
        if (c + 1 < SEQ / 32) SCAN_STORE(cur ^ 1);
        __syncthreads();
        {
            const int tt = F.tid >> 4, r2 = (F.tid & 15) * 2;
            const LAS float* ys = (const LAS float*)(lds + YOFF + cur * 4096) + tt * 32 + r2;
            *(unsigned*)(F_MIX + (tb + (size_t)c * 32 + tt) * DMODEL + 640 + cb + half * 32 + r2) = pk2(ys[0], ys[1]);
        }
    }
#undef SCAN_LOAD
#undef SCAN_STORE
    __syncthreads();
}

DI void mix_phase(const Frame& F0, int l, char* ldsg) { Frame F = refresh(F0);
#ifndef SKIP_SCAN
    if ((int)blockIdx.x < SCAN_WGS) { scan_wg(F, (int)blockIdx.x); if (PROBE & 2) scan_wg(F, (int)blockIdx.x); }
#endif
    const float* lq1 = INP(F, 3) + l * 32; const float* lk1 = INP(F, 4) + l * 32; const float* lq2 = INP(F, 5) + l * 32; const float* lk2 = INP(F, 6) + l * 32;
    float d1 = 0.f, d2 = 0.f;
    for (int i = 0; i < 32; ++i) { d1 += lq1[i] * lk1[i]; d2 += lq2[i] * lk2[i]; }
    const float lambda_init = (l == 0) ? 0.2f : 0.35550906759f;
    const float lam = __expf(d1) - __expf(d2) + lambda_init;
    const float* sg = INP(F, 7) + l * 64;
    volatile LAS unsigned* qslot = (volatile LAS unsigned*)(F.lds + MISC_OFF + 64);
    for (int rep = 0; rep < ((PROBE & 4) ? 2 : 1); ++rep)
    for (;;) {
        if (F.tid == 0) *qslot = atomicAdd(F_ctl + 64 * (1 + l + 2 * rep), 1u);
        __syncthreads();
        const unsigned idx = (unsigned)__builtin_amdgcn_readfirstlane((int)*qslot);
        __syncthreads();
        if (idx >= (unsigned)ATT_ITEMS) break;
        const int qb = 15 - (int)(idx / 48u), bh = (int)(idx % 48u), b = bh / 6, h = bh % 6;
        const attn_body::bf16* P = (const attn_body::bf16*)F_PROJ;
#ifndef SKIP_ATT
#pragma unroll 1
        for (int ns = 0; ns < 2; ++ns)
            attn_body::attn_unit<8>(b, h, qb, ns, lam, sg, 1.f - lambda_init, P, P + 384, P + 768, (attn_body::bf16*)F_MIX, ldsg);
#endif
    }
}

__global__ void __launch_bounds__(NWAVES * 64, 2) mega_fwd(Args args) {
    extern __shared__ __attribute__((aligned(16))) unsigned char lds[];
    cg::grid_group grid = cg::this_grid();
    Frame F;
    F.lds = (LAS unsigned char*)lds;
    F.tid = threadIdx.x; F.lane = F.tid & 63; F.wave = __builtin_amdgcn_readfirstlane(F.tid >> 6);
    F.G = gridDim.x; F.gw = (int)blockIdx.x * NWAVES + F.wave; F.NGW = F.G * NWAVES;
    F.in = args.in; F.out = args.out; F.ws = args.ws;
    const int G = F.G;
    if (F.tid < 32) ((LAS unsigned*)(F.lds + MISC_OFF))[F.tid] = 0u;
    __syncthreads();
    XcdBarrier bar = xcd_barrier_post((unsigned*)(args.ws + WS_CTL) + CW_BAR, (volatile LAS unsigned*)(F.lds + MISC_OFF) + 8);

    prologue(F);
    rms_rows_bf16(F, INP(F, 0), F_XB);
    grid.sync();
#pragma unroll 1
    for (int l = 0; l < 2; ++l) {
        {
            pg8::Gemm g{F_XB, F_WIN + (size_t)l * NIN * DMODEL, M, NIN, DMODEL}; pg8::StaticOrder S; int bx = blockIdx.x; asm volatile("" : "+s"(bx)); S.init(M, NIN, G, bx);
            pg8::EpiBf16S<0> E{F_PROJ, NIN};
            GEMMCALL0 pg8::gemm_phase<pg8::EpiBf16S<0>, pg8::StaticOrder, true, true>(F.lds, g, S, E);
            if (PROBE & 1) { __syncthreads(); pg8::gemm_phase<pg8::EpiBf16S<0>, pg8::StaticOrder, true, true>(F.lds, g, S, E); }
        }
        xcd_barrier(bar);
#ifndef SKIP_PREP
        prep_phase(F, l);
        if (PROBE & 8) { __syncthreads(); prep_phase(F, l); }
#endif
        xcd_barrier(bar);
        mix_phase(F, l, (char*)lds);
        xcd_barrier(bar);
#ifndef SKIP_POST
        post_phase(F, l);
#endif
        xcd_barrier(bar);
        {
            pg8::Gemm g{F_MIX, F_WOUT + (size_t)l * DMODEL * DMODEL, M, DMODEL, DMODEL}; pg8::StaticOrder S; int bx = blockIdx.x; asm volatile("" : "+s"(bx)); S.init(M, DMODEL, G, bx);
            pg8::EpiResF32 E{l == 0 ? INP(F, 0) : (const float*)F.out, F.out, DMODEL};
            GEMMCALL1 pg8::gemm_phase<pg8::EpiResF32, pg8::StaticOrder, true, true>(F.lds, g, S, E);
        }
        xcd_barrier(bar);
        rms_rows_bf16(F, F.out, F_XB);
        if (PROBE & 16) { xcd_barrier(bar); rms_rows_bf16(F, F.out, F_XB); xcd_barrier(bar); rms_rows_bf16(F, F.out, F_XB); }
        if (PROBE & 32) { for (int q = 0; q < 10; ++q) xcd_barrier(bar); }
        xcd_barrier(bar);
        {
            pg8::Gemm g{F_XB, F_WUP + (size_t)l * FF * DMODEL, M, FF, DMODEL}; pg8::StaticOrder S; int bx = blockIdx.x; asm volatile("" : "+s"(bx)); S.init(M, FF, G, bx);
            pg8::EpiBf16S<2> E{F_HID, FF};
            GEMMCALL2 pg8::gemm_phase<pg8::EpiBf16S<2>, pg8::StaticOrder, true, true>(F.lds, g, S, E);
            if (PROBE & 1) { __syncthreads(); pg8::gemm_phase<pg8::EpiBf16S<2>, pg8::StaticOrder, true, true>(F.lds, g, S, E); }
        }
        xcd_barrier(bar);
        {
            pg8::Gemm g{F_HID, F_WDN + (size_t)l * DMODEL * FF, M, DMODEL, FF}; pg8::StaticOrder S; int bx = blockIdx.x; asm volatile("" : "+s"(bx)); S.init(M, DMODEL, G, bx);
            pg8::EpiResF32 E{(const float*)F.out, F.out, DMODEL};
            GEMMCALL3 pg8::gemm_phase<pg8::EpiResF32, pg8::StaticOrder, true, true>(F.lds, g, S, E);
        }
        xcd_barrier(bar);
        if (l == 0) { rms_rows_bf16(F, F.out, F_XB); xcd_barrier(bar); }
    }
    final_norm(F, F.out, INP(F, 24));
}

extern "C" void kernel_launch(void* const* d_in, const int* in_sizes, int n_in, void* d_out, int out_size, void* d_ws, size_t ws_size, hipStream_t stream) {
    static int grid = 0;
    if (grid == 0) {
        if (n_in != 25 || in_sizes[0] != M * DMODEL || out_size != M * DMODEL || ws_size < WS_END) {
            fprintf(stderr, "kernel_launch: unexpected problem geometry (n_in %d, in0 %d, out %d, ws %zu)\n", n_in, n_in > 0 ? in_sizes[0] : -1, out_size, ws_size); grid = -1; return; }
        int dev = 0, cus = 0, per_cu = 0;
        if (hipGetDevice(&dev) != hipSuccess || hipDeviceGetAttribute(&cus, hipDeviceAttributeMultiprocessorCount, dev) != hipSuccess) { grid = -1; return; }
        if (hipFuncSetAttribute((const void*)mega_fwd, hipFuncAttributeMaxDynamicSharedMemorySize, LDS_BYTES) != hipSuccess) { fprintf(stderr, "kernel_launch: hipFuncSetAttribute failed\n"); grid = -1; return; }
        if (hipOccupancyMaxActiveBlocksPerMultiprocessor(&per_cu, (const void*)mega_fwd, NWAVES * 64, LDS_BYTES) != hipSuccess || per_cu < 1) { fprintf(stderr, "kernel_launch: occupancy query gave %d\n", per_cu); (void)hipGetLastError(); per_cu = 1; }
        grid = cus * per_cu;
    }
    if (grid < 0) return;
    (void)hipMemsetAsync((char*)d_ws + WS_CTL, 0, CTL_ZERO_BYTES, stream);
    Args a{};
    for (int i = 0; i < 25; ++i) a.in[i] = (const float*)d_in[i];
    a.out = (float*)d_out; a.ws = (unsigned char*)d_ws; a.i0 = 0; a.i1 = 0;
    void* kargs[] = {&a};
    const hipError_t e = hipLaunchCooperativeKernel((const void*)mega_fwd, dim3(grid), dim3(NWAVES * 64), kargs, LDS_BYTES, stream);
    if (e != hipSuccess) fprintf(stderr, "kernel_launch: cooperative launch failed: %s (grid %d)\n", hipGetErrorString(e), grid);
}
```

```cpp
#include <hip/hip_runtime.h>
#include <hip/hip_cooperative_groups.h>
#include <hip/hip_bf16.h>
#include <cstdio>
#include <cstdint>
#include <cmath>
namespace pg8 {
#define PG8_LAS __attribute__((address_space(3)))
typedef unsigned short bf16_t;
typedef short bf16x8 __attribute__((ext_vector_type(8)));
typedef float f32x4 __attribute__((ext_vector_type(4)));
typedef unsigned u32x4 __attribute__((ext_vector_type(4)));
constexpr int BM = 256, BK = 64, HALF = 128, HTB = HALF * BK * 2  , STAGE_BYTES = 8 * HTB, NXCD = 8, WGM = 8;

__host__ __device__ __forceinline__ int lds_byte(int r, int c) { const int st = (r >> 4) * 2 + (c >> 5), rr = r & 15, cc = c & 31, ob = rr * 64 + cc * 2; return st * 1024 + (ob ^ (((ob >> 9) & 1) << 5)); }
__host__ __device__ __forceinline__ void stage_rc(int b, int& R, int& C) { const int st = b / 1024, sb = b % 1024, swz = sb ^ (((sb >> 9) & 1) << 5); R = (st >> 1) * 16 + swz / 64; C = (st & 1) * 32 + (swz % 64) / 2; }
__host__ __device__ __forceinline__ int perm32(int rho) { const int n = rho >> 4, i = rho & 15; return 8 * (i >> 2) + 4 * n + (i & 3); }

struct Unit { int pm, pn; };
struct Gemm { const bf16_t* A; const bf16_t* Bt; int M, N, K; };

struct StaticOrder {
    int nM, nN, nwg, G, c;
    __host__ __device__ void init(int M, int N, int G_, int c_) { nM = M / BM; nN = N / BM; nwg = nM * nN; G = G_; c = c_; }
    __host__ __device__ bool next(int i, Unit& u) const {
        const long L = (long)i * G + c; if (L >= nwg) return false;
        int wgid = (int)L; { const int q = nwg / NXCD, r = nwg % NXCD, xcd = wgid % NXCD, off = wgid / NXCD; wgid = (xcd < r ? xcd * (q + 1) : r * (q + 1) + (xcd - r) * q) + off; }
        const int nig = WGM * nN, gid = wgid / nig, fm = gid * WGM, gsz = (nM - fm) < WGM ? (nM - fm) : WGM;
        u.pm = fm + ((wgid % nig) % gsz); u.pn = (wgid % nig) / gsz; return true;
    }
    __device__ __forceinline__ void a_ready(const Unit&) const {}
    __device__ __forceinline__ void done(const Unit&) const {}
};

__device__ __forceinline__ unsigned cvt_pk_bf16(float lo, float hi) { unsigned r; asm volatile("v_cvt_pk_bf16_f32 %0, %1, %2" : "=v"(r) : "v"(lo), "v"(hi)); return r; }
typedef float f32x2 __attribute__((ext_vector_type(2)));
template <int ACT  > struct EpiBf16S {
    static constexpr bool PERM = true, AFTER_DRAIN = false;
    bf16_t* O; int ldc;
    __device__ __forceinline__ void operator()(const f32x4 (&acc)[2][2][4][2], const Unit& u, int wr, int wc, int fr, int fq) const {
        const int row0 = u.pm * BM + wr * 64 + fr; const int col0 = u.pn * BM + wc * 32 + 8 * fq;
#pragma unroll
        for (int ai = 0; ai < 2; ++ai)
#pragma unroll
            for (int m = 0; m < 4; ++m) { bf16_t* rowp = O + (size_t)(row0 + ai * HALF + m * 16) * ldc + col0;
#pragma unroll
                for (int bj = 0; bj < 2; ++bj) { f32x4 v0 = acc[ai][bj][m][0], v1 = acc[ai][bj][m][1];
                    if (ACT == 2) {
#pragma unroll
                        for (int e = 0; e < 4; ++e) { float a = v0[e] > 0.f ? v0[e] : 0.f; v0[e] = a * a; float b = v1[e] > 0.f ? v1[e] : 0.f; v1[e] = b * b; } }
                    u32x4 w; w.x = cvt_pk_bf16(v0[0], v0[1]); w.y = cvt_pk_bf16(v0[2], v0[3]); w.z = cvt_pk_bf16(v1[0], v1[1]); w.w = cvt_pk_bf16(v1[2], v1[3]);
                    *(u32x4*)(rowp + bj * HALF) = w; } }
    }
};
struct EpiResF32 {
    static constexpr bool PERM = false, AFTER_DRAIN = false;
    const float* base; float* out; int ldc;
    __device__ __forceinline__ void operator()(const f32x4 (&acc)[2][2][4][2], const Unit& u, int wr, int wc, int fr, int fq) const {
        const int col0 = u.pn * BM + wc * 32 + 4 * fq;
#pragma unroll
        for (int ai = 0; ai < 2; ++ai)
#pragma unroll
            for (int m = 0; m < 4; ++m) { const int r = u.pm * BM + ai * HALF + wr * 64 + m * 16 + fr; const size_t off = (size_t)r * ldc + col0;
#pragma unroll
                for (int bj = 0; bj < 2; ++bj)
#pragma unroll
                    for (int n = 0; n < 2; ++n) { const size_t idx = off + bj * HALF + n * 16; const f32x4 bs = *(const f32x4*)(base + idx); *(f32x4*)(out + idx) = bs + acc[ai][bj][m][n]; }
                asm volatile("" ::: "memory"); }
    }
};
template <class Epi, class Sched, bool ALIGN_EPI = false, bool SP2 = false>
__device__ __forceinline__ void gemm_phase(PG8_LAS unsigned char* lds, const Gemm g, const Sched& S, const Epi& E) {
    int tid_ = threadIdx.x; asm volatile("" : "+v"(tid_)); const int tid = tid_, wid = __builtin_amdgcn_readfirstlane(tid >> 6), lane = tid & 63, wr = wid >> 2, wc = wid & 3, fr = lane & 15, fq = lane >> 4;
    const int K = g.K, nt = K / BK;
    unsigned voffA[2], voffB[2];
#pragma unroll
    for (int i = 0; i < 2; ++i) { int R, C; stage_rc(tid * 16 + i * 8192, R, C); const int Rb = Epi::PERM ? ((R & ~31) + perm32(R & 31)) : R;
        voffA[i] = (unsigned)(R * K + C) * 2u; voffB[i] = (unsigned)(Rb * K + C) * 2u; }
    const size_t kstep = (size_t)(BK * 2);
    const size_t hstep = (size_t)HALF * K * 2;
    const size_t tstep = 2 * hstep;
    const unsigned ldsw = (unsigned)wid * 1024u;
    const int aoff = lds_byte(wr * 64 + fr, fq * 8), boff = lds_byte(wc * 32 + fr, fq * 8);
#define PG8_SA(b, h) (((b) * 2 + (h)) * HTB)
#define PG8_SB(b, h) ((4 + (b) * 2 + (h)) * HTB)
#define PG8_STAGE(bufoff, gbase, voff) do { _Pragma("unroll") for (int _i = 0; _i < 2; ++_i) \
        __builtin_amdgcn_global_load_lds((const unsigned*)((const char*)(gbase) + (voff)[_i]), (PG8_LAS unsigned*)(lds + (bufoff) + ldsw + _i * 8192), 16, 0, 0); } while (0)
#define PG8_LDA(dst, b, h) do { _Pragma("unroll") for (int m = 0; m < 4; ++m) _Pragma("unroll") for (int k = 0; k < 2; ++k) dst[m][k] = *(const PG8_LAS bf16x8*)(lds + PG8_SA(b, h) + aoff + m * 2048 + k * 1024); } while (0)
#define PG8_LDB(dst, b, h) do { _Pragma("unroll") for (int n = 0; n < 2; ++n) _Pragma("unroll") for (int k = 0; k < 2; ++k) dst[n][k] = *(const PG8_LAS bf16x8*)(lds + PG8_SB(b, h) + boff + n * 2048 + k * 1024); } while (0)
#define PG8_MMA(ai, bj, At, Bt) do { __builtin_amdgcn_s_setprio(1); _Pragma("unroll") for (int m = 0; m < 4; ++m) _Pragma("unroll") for (int n = 0; n < 2; ++n) _Pragma("unroll") for (int k = 0; k < 2; ++k) \
        acc[ai][bj][m][n] = __builtin_amdgcn_mfma_f32_16x16x32_bf16(Bt[n][k], At[m][k], acc[ai][bj][m][n], 0, 0, 0); __builtin_amdgcn_s_setprio(0); } while (0)
#define PG8_WAIT_V(n) asm volatile("s_waitcnt vmcnt(" #n ")" ::: "memory")
#define PG8_WAIT_L(n) asm volatile("s_waitcnt lgkmcnt(" #n ")" ::: "memory")
#define PG8_BAR __builtin_amdgcn_s_barrier()
#define PG8_SCHED __builtin_amdgcn_sched_barrier(0)
    Unit cur, nxt; int ui = 0;
    if (!S.next(0, cur)) return;
    f32x4 acc[2][2][4][2];
#pragma unroll
    for (int a = 0; a < 2; ++a)
#pragma unroll
        for (int b = 0; b < 2; ++b)
#pragma unroll
            for (int m = 0; m < 4; ++m)
#pragma unroll
                for (int n = 0; n < 2; ++n) acc[a][b][m][n] = (f32x4){0.f, 0.f, 0.f, 0.f};
    bf16x8 At[4][2], B0[2][2], B1[2][2];
    const char* cA = (const char*)g.A + (size_t)cur.pm * tstep; const char* cB = (const char*)g.Bt + (size_t)cur.pn * tstep;
    S.a_ready(cur);
    if constexpr (SP2) {
        PG8_STAGE(PG8_SB(0, 0), cB, voffB); PG8_STAGE(PG8_SB(0, 1), cB + hstep, voffB); PG8_STAGE(PG8_SA(0, 0), cA, voffA); PG8_STAGE(PG8_SA(0, 1), cA + hstep, voffA);
        if (wr == 1) PG8_BAR;
        PG8_WAIT_V(2); PG8_BAR;
        PG8_STAGE(PG8_SB(1, 0), cB + kstep, voffB); PG8_STAGE(PG8_SA(1, 0), cA + kstep, voffA); PG8_STAGE(PG8_SB(1, 1), cB + hstep + kstep, voffB);
        PG8_WAIT_V(6); PG8_BAR;
    } else {
        PG8_STAGE(PG8_SB(0, 0), cB, voffB); PG8_STAGE(PG8_SA(0, 0), cA, voffA); PG8_STAGE(PG8_SB(0, 1), cB + hstep, voffB); PG8_STAGE(PG8_SA(0, 1), cA + hstep, voffA);
        if (wr == 1) PG8_BAR;
        PG8_WAIT_V(4); PG8_BAR;
        PG8_STAGE(PG8_SB(1, 0), cB + kstep, voffB); PG8_STAGE(PG8_SA(1, 0), cA + kstep, voffA); PG8_STAGE(PG8_SB(1, 1), cB + hstep + kstep, voffB);
        PG8_WAIT_V(6); PG8_BAR;
    }
    for (;;) {
        const bool has_next = S.next(ui + 1, nxt);
        const char* nA = has_next ? (const char*)g.A + (size_t)nxt.pm * tstep : cA; const char* nB = has_next ? (const char*)g.Bt + (size_t)nxt.pn * tstep : cB;
        for (int t = 0; t < nt; t += 2) {
            const bool last = (t == nt - 2);
            const char* a1 = cA + (size_t)(t + 1) * kstep;
            const char* a2 = last ? nA : cA + (size_t)(t + 2) * kstep; const char* b2 = last ? nB : cB + (size_t)(t + 2) * kstep;
            const char* a3 = a2 + kstep; const char* b3 = b2 + kstep;
            if (last && has_next) S.a_ready(nxt);
            if constexpr (SP2) {
            PG8_LDB(B0, 0, 0); PG8_LDB(B1, 0, 1); PG8_SCHED; PG8_LDA(At, 0, 0); PG8_STAGE(PG8_SA(1, 1), a1 + hstep, voffA);
            PG8_WAIT_V(8); PG8_WAIT_L(0); PG8_BAR; PG8_MMA(0, 0, At, B0); PG8_MMA(0, 1, At, B1); PG8_BAR; PG8_SCHED;
            PG8_LDA(At, 0, 1); PG8_STAGE(PG8_SB(0, 0), b2, voffB); PG8_STAGE(PG8_SB(0, 1), b2 + hstep, voffB); PG8_STAGE(PG8_SA(0, 0), a2, voffA);
            PG8_WAIT_V(8); PG8_WAIT_L(0); PG8_BAR; PG8_MMA(1, 0, At, B0); PG8_MMA(1, 1, At, B1); PG8_BAR; PG8_SCHED;
            PG8_LDB(B0, 1, 0); PG8_LDB(B1, 1, 1); PG8_SCHED; PG8_LDA(At, 1, 0); PG8_STAGE(PG8_SA(0, 1), a2 + hstep, voffA);
            PG8_WAIT_V(8); PG8_WAIT_L(0); PG8_BAR; PG8_MMA(0, 0, At, B0); PG8_MMA(0, 1, At, B1); PG8_BAR; PG8_SCHED;
            PG8_LDA(At, 1, 1); PG8_STAGE(PG8_SB(1, 0), b3, voffB); PG8_STAGE(PG8_SB(1, 1), b3 + hstep, voffB); PG8_STAGE(PG8_SA(1, 0), a3, voffA);
            PG8_WAIT_V(8); PG8_WAIT_L(0); PG8_BAR; PG8_MMA(1, 0, At, B0); PG8_MMA(1, 1, At, B1); PG8_BAR; PG8_SCHED;
            } else {
            PG8_LDB(B0, 0, 0); PG8_SCHED; PG8_LDA(At, 0, 0); PG8_STAGE(PG8_SA(1, 1), a1 + hstep, voffA);
            PG8_WAIT_L(8); PG8_BAR; PG8_WAIT_L(0); PG8_MMA(0, 0, At, B0); PG8_BAR; PG8_SCHED;
            PG8_LDB(B1, 0, 1); PG8_STAGE(PG8_SB(0, 0), b2, voffB);
            PG8_BAR; PG8_WAIT_L(0); PG8_MMA(0, 1, At, B1); PG8_BAR;
            PG8_LDA(At, 0, 1); PG8_STAGE(PG8_SA(0, 0), a2, voffA);
            PG8_BAR; PG8_WAIT_L(0); PG8_MMA(1, 0, At, B0); PG8_BAR; PG8_SCHED;
            PG8_STAGE(PG8_SB(0, 1), b2 + hstep, voffB);
            PG8_WAIT_V(6); PG8_BAR; PG8_MMA(1, 1, At, B1); PG8_BAR;
            PG8_LDB(B0, 1, 0); PG8_SCHED; PG8_LDA(At, 1, 0); PG8_STAGE(PG8_SA(0, 1), a2 + hstep, voffA);
            PG8_WAIT_L(8); PG8_BAR; PG8_WAIT_L(0); PG8_MMA(0, 0, At, B0); PG8_BAR; PG8_SCHED;
            PG8_LDB(B1, 1, 1); PG8_STAGE(PG8_SB(1, 0), b3, voffB);
            PG8_BAR; PG8_WAIT_L(0); PG8_MMA(0, 1, At, B1); PG8_BAR;
            PG8_LDA(At, 1, 1); PG8_STAGE(PG8_SA(1, 0), a3, voffA);
            PG8_BAR; PG8_WAIT_L(0); PG8_MMA(1, 0, At, B0); PG8_BAR; PG8_SCHED;
            PG8_STAGE(PG8_SB(1, 1), b3 + hstep, voffB);
            PG8_WAIT_V(6); PG8_BAR; PG8_MMA(1, 1, At, B1); PG8_BAR;
            }
        }
        if constexpr (ALIGN_EPI) { if (wr == 0) PG8_BAR; }
        if constexpr (!Epi::AFTER_DRAIN) { E(acc, cur, wr, wc, fr, fq); S.done(cur); }
        if (!has_next) break;
#pragma unroll
        for (int a = 0; a < 2; ++a)
#pragma unroll
            for (int b = 0; b < 2; ++b)
#pragma unroll
                for (int m = 0; m < 4; ++m)
#pragma unroll
                    for (int n = 0; n < 2; ++n) acc[a][b][m][n] = (f32x4){0.f, 0.f, 0.f, 0.f};
        cur = nxt; cA = nA; cB = nB; ++ui;
        if constexpr (ALIGN_EPI) { if (wr == 1) PG8_BAR; }
    }
    PG8_WAIT_V(0);
    if constexpr (!ALIGN_EPI) { if (wr == 0) PG8_BAR; }
    PG8_BAR;
    if constexpr (Epi::AFTER_DRAIN) { E.fused(acc, cur, wr, wc, fr, fq, lds, wid, lane); S.done(cur); }
#undef PG8_SA
#undef PG8_SB
#undef PG8_STAGE
#undef PG8_LDA
#undef PG8_LDB
#undef PG8_MMA
#undef PG8_WAIT_V
#undef PG8_WAIT_L
#undef PG8_BAR
#undef PG8_SCHED
}
}

#define PG8_SP2 true
#define PG8_ALIGN true
namespace attn_body {
using bf16=__hip_bfloat16;
using bf16x8=__attribute__((ext_vector_type(8)))short;
using s16x4=__attribute__((ext_vector_type(4)))short;
using f32x16=__attribute__((ext_vector_type(16)))float;
using u32x4=__attribute__((ext_vector_type(4)))unsigned;
constexpr int BATCH=8,NHEAD=6,SEQ=4096,D=64,DM=3328,OPITCH=1024;
constexpr int NW=8,QBLK=32,QB=QBLK*NW,KVBLK=64,NQB=SEQ/QB;
constexpr int ATTN_PITCH=DM, ATTN_UNIT_ROWS=QB;
__device__ __forceinline__ int crow(int r,int hi){return (r&3)+8*(r>>2)+4*hi;}
#define SBAR() __builtin_amdgcn_sched_barrier(0)
__device__ __forceinline__ void cmask(f32x16&p0,f32x16&p1,int jb,int qrel,int hi){
  const float NEG=-INFINITY; int kb=64*jb+4*hi;
  #pragma unroll
  for(int r=0;r<16;++r){int kv=kb+(r&3)+8*(r>>2); if(kv>qrel)p0[r]=NEG; if(kv+32>qrel)p1[r]=NEG;}
}

constexpr int NSLOT=3, SLOTB=8192;
constexpr int LDS_K=0, LDS_V=NSLOT*SLOTB, LDS_WS=2*NSLOT*SLOTB, LDS_OST=LDS_WS+NW*64*4, LDS_OST1=LDS_OST+NW*4096, LDS_BYTES=LDS_OST1+NW*4096;
constexpr float C2=0.17677669529663687f*1.4426950408889634f;
__device__ __forceinline__ void glds16(const void*gsrc,unsigned lds_dst){unsigned keep;
  asm volatile("s_mov_b32 %0, m0\n\ts_mov_b32 m0, %2\n\ts_nop 0\n\tglobal_load_lds_dwordx4 %1, off\n\ts_mov_b32 m0, %0":"=&s"(keep):"v"(gsrc),"s"(lds_dst):"memory");}
__device__ __forceinline__ float max3f(float a,float b,float c){float r;asm("v_max3_f32 %0, %1, %2, %3":"=v"(r):"v"(a),"v"(b),"v"(c));return r;}
__device__ __forceinline__ float max2f(float a,float b){float r;asm("v_max_f32_e32 %0, %1, %2":"=v"(r):"v"(a),"v"(b));return r;}
__device__ __forceinline__ float fadd_s(float a,float b){float r;asm("v_add_f32_e32 %0, %1, %2":"=v"(r):"v"(a),"v"(b));return r;}
__device__ __forceinline__ float fsub_s(float a,float b){float r;asm("v_sub_f32_e32 %0, %1, %2":"=v"(r):"v"(a),"v"(b));return r;}
typedef float f32x2_t __attribute__((ext_vector_type(2))); typedef __bf16 bf16x2_t __attribute__((ext_vector_type(2)));
__device__ __forceinline__ unsigned cvtpk_s(float lo,float hi){f32x2_t v={lo,hi};bf16x2_t b=__builtin_convertvector(v,bf16x2_t);return __builtin_bit_cast(unsigned,b);}
#define WAIT_BAR(N) asm volatile("s_waitcnt vmcnt(" #N ") lgkmcnt(0)\n\ts_barrier":::"memory")

__device__ __forceinline__ void qkt(f32x16&p0,f32x16&p1,const char*Kslot,const bf16x8*qr,const f32x16&negm,int r32,int hi){
  const char*kb=Kslot+hi*1024+r32*16;
  #pragma unroll
  for(int d0=0;d0<4;++d0){
    const bf16x8 b0=*reinterpret_cast<const bf16x8*>(kb+d0*2048);
    const bf16x8 b1=*reinterpret_cast<const bf16x8*>(kb+d0*2048+512);
    if(d0==0){p0=__builtin_amdgcn_mfma_f32_32x32x16_bf16(b0,qr[0],negm,0,0,0);p1=__builtin_amdgcn_mfma_f32_32x32x16_bf16(b1,qr[0],negm,0,0,0);}
    else{p0=__builtin_amdgcn_mfma_f32_32x32x16_bf16(b0,qr[d0],p0,0,0,0);p1=__builtin_amdgcn_mfma_f32_32x32x16_bf16(b1,qr[d0],p1,0,0,0);}}
}
typedef __attribute__((address_space(3))) const char* lds_cptr;
typedef short v4i16_t __attribute__((ext_vector_type(4)));
__device__ __forceinline__ void kload8(bf16x8*kf,lds_cptr kp){
  kf[0]=*(const __attribute__((address_space(3))) bf16x8*)(kp);      kf[1]=*(const __attribute__((address_space(3))) bf16x8*)(kp+512);
  kf[2]=*(const __attribute__((address_space(3))) bf16x8*)(kp+2048); kf[3]=*(const __attribute__((address_space(3))) bf16x8*)(kp+2560);
  kf[4]=*(const __attribute__((address_space(3))) bf16x8*)(kp+4096); kf[5]=*(const __attribute__((address_space(3))) bf16x8*)(kp+4608);
  kf[6]=*(const __attribute__((address_space(3))) bf16x8*)(kp+6144); kf[7]=*(const __attribute__((address_space(3))) bf16x8*)(kp+6656);
}
__device__ __forceinline__ void kload2(bf16x8*kf,lds_cptr kp,int j){ kf[2*j]=*(const __attribute__((address_space(3))) bf16x8*)(kp+j*2048); kf[2*j+1]=*(const __attribute__((address_space(3))) bf16x8*)(kp+j*2048+512); }
__device__ __forceinline__ s16x4 vtr(lds_cptr p){ return __builtin_bit_cast(s16x4,__builtin_amdgcn_ds_read_tr16_b64_v4i16((__attribute__((address_space(3))) v4i16_t*)p)); }
__device__ __forceinline__ float rowmax(const f32x16&p0,const f32x16&p1){
  float a=max3f(p0[0],p0[1],p1[0]),b=max3f(p0[2],p0[3],p1[1]);a=max3f(a,p1[2],p1[3]);
  #pragma unroll
  for(int r=4;r<16;r+=4){a=max3f(a,p0[r],p0[r+1]);b=max3f(b,p0[r+2],p0[r+3]);a=max3f(a,p1[r],p1[r+1]);b=max3f(b,p1[r+2],p1[r+3]);}
  const float m=max2f(a,b);
  auto rr=__builtin_amdgcn_permlane32_swap(__float_as_uint(m),__float_as_uint(m),false,false);
  return max2f(__uint_as_float(rr[0]),__uint_as_float(rr[1]));
}
__device__ __forceinline__ void pv(f32x16*o,int vb,bf16x8 pa0,bf16x8 pa1,bf16x8 pa2,bf16x8 pa3){
  #pragma unroll
  for(int d0=0;d0<2;++d0){s16x4 lo[4],hi[4];
    #pragma unroll
    for(int ks=0;ks<4;++ks){
      asm volatile("ds_read_b64_tr_b16 %0,%1 offset:%c2":"=&v"(lo[ks]):"v"(vb),"i"(d0*4096+ks*1024):"memory");
      asm volatile("ds_read_b64_tr_b16 %0,%1 offset:%c2":"=&v"(hi[ks]):"v"(vb),"i"(d0*4096+ks*1024+512):"memory");}
    asm volatile("s_waitcnt lgkmcnt(0)":::"memory");SBAR();
    #define PK(k) (bf16x8){lo[k][0],lo[k][1],lo[k][2],lo[k][3],hi[k][0],hi[k][1],hi[k][2],hi[k][3]}
    o[d0]=__builtin_amdgcn_mfma_f32_32x32x16_bf16(pa0,PK(0),o[d0],0,0,0);
    o[d0]=__builtin_amdgcn_mfma_f32_32x32x16_bf16(pa1,PK(1),o[d0],0,0,0);
    o[d0]=__builtin_amdgcn_mfma_f32_32x32x16_bf16(pa2,PK(2),o[d0],0,0,0);
    o[d0]=__builtin_amdgcn_mfma_f32_32x32x16_bf16(pa3,PK(3),o[d0],0,0,0);
    #undef PK
  }
}

#ifndef ATTN_STORE16
#define ATTN_STORE16(p,v) (*(u32x4*)(p)=(v))
#endif
template<int THRL> __device__ __forceinline__ void attn_unit(int b,int h,int qb,int nsel,float lam,const float*subg,float omli,const bf16*Q,const bf16*__restrict__ K,const bf16*__restrict__ V,bf16*O,char*shm){
  int tid_=threadIdx.x; asm volatile("":"+v"(tid_)); const int tid=tid_,lane=tid&63,r32=lane&31,hi=lane>>5; const int wid=__builtin_amdgcn_readfirstlane(tid>>6);
  const long rowbase=(long)b*SEQ; const int q0=qb*QB;
  const bf16*Qw=Q+(rowbase+q0+wid*QBLK)*DM+h*D;
  const bf16*Kh=K+rowbase*DM+h*D,*Vh=V+rowbase*DM+h*D;
  const unsigned lds0=(unsigned)(uintptr_t)shm;
  float*wsf=(float*)(shm+LDS_WS)+wid*64;
  const bf16*ksrc=Kh+(long)lane*DM+wid*8;
  const bf16*vsrc=Vh+(long)(16*(wid&3)+(lane>>2))*DM+(wid>>2)*32+(lane&3)*8;
  const unsigned kdst=lds0+LDS_K+wid*1024, vdst=lds0+LDS_V+wid*1024;
  #define DMA_K(t,slot) glds16(ksrc+(long)(t)*KVBLK*DM,(unsigned)__builtin_amdgcn_readfirstlane(kdst+(slot)))
  #define DMA_V(t,slot) glds16(vsrc+(long)(t)*KVBLK*DM,(unsigned)__builtin_amdgcn_readfirstlane(vdst+(slot)))
  const int vb0=(int)(lds0+LDS_V)+((lane>>4)&1)*32+(lane&3)*8+(4*hi+((lane&15)>>2))*64;
  const char*Kbase=shm+LDS_K; bf16x8 kf[8];
  const lds_cptr shm3=(lds_cptr)shm; const lds_cptr kp0=shm3+LDS_K+hi*1024+r32*16; const lds_cptr vp0=shm3+LDS_V+((lane>>4)&1)*32+(lane&3)*8+(4*hi+((lane&15)>>2))*64;
  const int NT=(q0+QB)/KVBLK;
  DMA_K(0,0);DMA_V(0,0);DMA_K(1,SLOTB);
  bf16x8 qr[4];
  #pragma unroll
  for(int d0=0;d0<4;++d0){qr[d0]=*reinterpret_cast<const bf16x8*>(&Qw[(long)r32*DM+d0*16+hi*8]); if((d0>>1)!=nsel)qr[d0]=bf16x8{0,0,0,0,0,0,0,0};}
  float mhat=0.f,l_reg=0.f;f32x16 o[2];o[0]=f32x16{};o[1]=f32x16{};f32x16 negm=f32x16{};asm volatile("":"+v"(negm));
  const int qrel=wid*QBLK+r32;
  #define CMASK(P0,P1,t) do{int jb_=(t)-(NT-4); if(jb_>=0)cmask(P0,P1,jb_,qrel,hi);}while(0)
  bool resc=false;
  #define START(P0,P1) do{ const float rm=rowmax(P0,P1); resc=false; \
    { const float dl=rm; mhat=fadd_s(mhat,dl); \
      _Pragma("unroll") for(int r=0;r<16;++r){P0[r]=fsub_s(P0[r],dl);P1[r]=fsub_s(P1[r],dl);} \
      _Pragma("unroll") for(int r=0;r<16;++r)negm[r]=-mhat; asm volatile("":"+v"(negm)); } \
    _Pragma("unroll") for(int r=0;r<16;++r)P0[r]=__builtin_amdgcn_exp2f(P0[r]); }while(0)
  #define RESC() do{ if(resc){ asm volatile("s_waitcnt lgkmcnt(0)":::"memory"); \
      _Pragma("unroll") for(int d_=0;d_<2;++d_) _Pragma("unroll") for(int r=0;r<16;++r)o[d_][r]*=wsf[crow(r,hi)]; } }while(0)
  f32x16 pA0,pA1,pB0,pB1;
  int sl_prev=0,sl_cur=0,sl_next=SLOTB;
  #define ROT() do{sl_prev=sl_cur;sl_cur=sl_next;sl_next=(sl_next==(NSLOT-1)*SLOTB)?0:sl_next+SLOTB;}while(0)
  DMA_K(2,2*SLOTB);
  WAIT_BAR(3);
  qkt(pA0,pA1,Kbase,qr,negm,r32,hi);asm volatile("s_nop 15\n\ts_nop 7":"+v"(pA0),"+v"(pA1));CMASK(pA0,pA1,0);
  START(pA0,pA1);
  _Pragma("unroll") for(int r=0;r<16;++r)pA1[r]=__builtin_amdgcn_exp2f(pA1[r]);
  WAIT_BAR(0);
  DMA_K(3,0);DMA_V(1,SLOTB);
  ROT();
  kload8(kf,kp0+sl_cur);
  WAIT_BAR(2);
  s16x4 vlo[8],vhi[8]; u32x4 pw0,pw1,pw2,pw3;
  #define PKW(P,B) cvtpk_s(P[B],P[B+1])
  #define PAF(k) __builtin_bit_cast(bf16x8,pw##k)
  #define VFR(i) (bf16x8){vlo[i][0],vlo[i][1],vlo[i][2],vlo[i][3],vhi[i][0],vhi[i][1],vhi[i][2],vhi[i][3]}
  #define PIN(x) asm volatile("":"+v"(x))
  #define MX3(a,b,c) __builtin_fmaxf(__builtin_fmaxf((a),(b)),(c))
  #define GAPA(MF,A0,A1,A2,A3,W0,W1,PW) do{ MF; sacc+=A0; sacc+=A1; sacc+=A2; sacc+=A3; PIN(sacc); W0; W1; PIN(PW); SBAR(); }while(0)
  #define EX(v) __builtin_amdgcn_exp2f(v)
  #define GAPB(MF,X,B) do{ MF; X[B]=EX(X[B]); X[B+1]=EX(X[B+1]); X[B+2]=EX(X[B+2]); X[B+3]=EX(X[B+3]); PIN(X); SBAR(); }while(0)
  #define VRD(i) do{ vlo[i]=vtr(vp_+(((i)>>2)*4096+((i)&3)*1024)); vhi[i]=vtr(vp_+(((i)>>2)*4096+((i)&3)*1024+512)); }while(0)
  #define KRD(G,j) do{ if(G){ kload2(kf,kp0+sl_next,j); SBAR(); } }while(0)
  #define STEP(C0,C1,P0,P1,t,GK,GV,GL) do{ SBAR(); \
    const lds_cptr vp_=vp0+sl_prev; \
    VRD(0); SBAR(); float sacc=(P0[0]+P0[1]); \
    GAPA(C0=__builtin_amdgcn_mfma_f32_32x32x16_bf16(kf[0],qr[0],negm,0,0,0), P0[2],P0[3],P0[4],P0[5],     pw0[0]=PKW(P0,0), pw0[1]=PKW(P0,2), pw0); \
    VRD(4); SBAR(); GAPA(C1=__builtin_amdgcn_mfma_f32_32x32x16_bf16(kf[1],qr[0],negm,0,0,0), P0[6],P0[7],P0[8],P0[9],     pw0[2]=PKW(P0,4), pw0[3]=PKW(P0,6), pw0); \
    VRD(1); SBAR(); GAPA(C0=__builtin_amdgcn_mfma_f32_32x32x16_bf16(kf[2],qr[1],C0,0,0,0),   P0[10],P0[11],P0[12],P0[13], pw1[0]=PKW(P0,8), pw1[1]=PKW(P0,10), pw1); \
    VRD(5); SBAR(); GAPA(C1=__builtin_amdgcn_mfma_f32_32x32x16_bf16(kf[3],qr[1],C1,0,0,0),   P0[14],P0[15],P1[0],P1[1],   pw1[2]=PKW(P0,12),pw1[3]=PKW(P0,14), pw1); \
    VRD(2); SBAR(); GAPA(C0=__builtin_amdgcn_mfma_f32_32x32x16_bf16(kf[4],qr[2],C0,0,0,0),   P1[2],P1[3],P1[4],P1[5],     pw2[0]=PKW(P1,0), pw2[1]=PKW(P1,2), pw2); \
    VRD(6); SBAR(); GAPA(C1=__builtin_amdgcn_mfma_f32_32x32x16_bf16(kf[5],qr[2],C1,0,0,0),   P1[6],P1[7],P1[8],P1[9],     pw2[2]=PKW(P1,4), pw2[3]=PKW(P1,6), pw2); \
    VRD(3); SBAR(); GAPA(C0=__builtin_amdgcn_mfma_f32_32x32x16_bf16(kf[6],qr[3],C0,0,0,0),   P1[10],P1[11],P1[12],P1[13], pw3[0]=PKW(P1,8), pw3[1]=PKW(P1,10), pw3); \
    VRD(7); SBAR(); GAPA(C1=__builtin_amdgcn_mfma_f32_32x32x16_bf16(kf[7],qr[3],C1,0,0,0),   P1[14],P1[15],0.f,0.f,       pw3[2]=PKW(P1,12),pw3[3]=PKW(P1,14), pw3); \
    l_reg+=sacc; \
    if(GK){DMA_K((t)+3,sl_cur);} if(GV){DMA_V((t)+1,sl_next);} \
    CMASK(C0,C1,t); \
    { float a=MX3(C0[0],C0[1],C1[0]),b=MX3(C0[2],C0[3],C1[1]); a=MX3(a,C1[2],C1[3]); \
      _Pragma("unroll") for(int r=4;r<16;r+=4){a=MX3(a,C0[r],C0[r+1]);b=MX3(b,C0[r+2],C0[r+3]);a=MX3(a,C1[r],C1[r+1]);b=MX3(b,C1[r+2],C1[r+3]);} \
      float rm=__builtin_fmaxf(a,b); { auto rr=__builtin_amdgcn_permlane32_swap(__float_as_uint(rm),__float_as_uint(rm),false,false); rm=__builtin_fmaxf(__uint_as_float(rr[0]),__uint_as_float(rr[1])); } \
      resc=false; \
      if(__builtin_expect(__any(rm>(float)THRL),0)){ const float dl=__builtin_fmaxf(rm,0.f); mhat+=dl; \
        _Pragma("unroll") for(int r=0;r<16;++r){C0[r]-=dl;C1[r]-=dl;} \
        _Pragma("unroll") for(int r=0;r<16;++r)negm[r]=-mhat; asm volatile("":"+v"(negm)); \
        const float f=__builtin_amdgcn_exp2f(-dl); l_reg*=f; if(hi==0)wsf[r32]=f; resc=true; } } \
    SBAR(); \
    GAPB(o[0]=__builtin_amdgcn_mfma_f32_32x32x16_bf16(PAF(0),VFR(0),o[0],0,0,0), C0,0); \
    GAPB(o[1]=__builtin_amdgcn_mfma_f32_32x32x16_bf16(PAF(0),VFR(4),o[1],0,0,0), C0,4); \
    KRD(GL,0); GAPB(o[0]=__builtin_amdgcn_mfma_f32_32x32x16_bf16(PAF(1),VFR(1),o[0],0,0,0), C0,8); \
    KRD(GL,1); GAPB(o[1]=__builtin_amdgcn_mfma_f32_32x32x16_bf16(PAF(1),VFR(5),o[1],0,0,0), C0,12); \
    KRD(GL,2); GAPB(o[0]=__builtin_amdgcn_mfma_f32_32x32x16_bf16(PAF(2),VFR(2),o[0],0,0,0), C1,0); \
    KRD(GL,3); GAPB(o[1]=__builtin_amdgcn_mfma_f32_32x32x16_bf16(PAF(2),VFR(6),o[1],0,0,0), C1,4); \
    GAPB(o[0]=__builtin_amdgcn_mfma_f32_32x32x16_bf16(PAF(3),VFR(3),o[0],0,0,0), C1,8); \
    GAPB(o[1]=__builtin_amdgcn_mfma_f32_32x32x16_bf16(PAF(3),VFR(7),o[1],0,0,0), C1,12); \
    }while(0)
  int t=1;
  #undef CMASK
  #define CMASK(P0,P1,t) do{}while(0)
  for(;t+5<NT;t+=2){
    STEP(pB0,pB1,pA0,pA1,t,true,true,true);     WAIT_BAR(2); RESC(); ROT();
    STEP(pA0,pA1,pB0,pB1,t+1,true,true,true);   WAIT_BAR(2); RESC(); ROT();
  }
  #undef CMASK
  #define CMASK(P0,P1,t) do{int jb_=(t)-(NT-4); if(jb_>=0)cmask(P0,P1,jb_,qrel,hi);}while(0)
  #define ENDW(tt) do{ if((tt)+3<NT){WAIT_BAR(2);} else if((tt)+2<NT){WAIT_BAR(1);} else {WAIT_BAR(0);} }while(0)
  for(;t+1<NT;t+=2){
    STEP(pB0,pB1,pA0,pA1,t,(t+3<NT),(t+1<NT),(t+1<NT));       ENDW(t);   RESC(); ROT();
    STEP(pA0,pA1,pB0,pB1,t+1,(t+4<NT),(t+2<NT),(t+2<NT));     ENDW(t+1); RESC(); ROT();
  }
  STEP(pB0,pB1,pA0,pA1,NT-1,false,false,false); RESC();
  { float sacc=pB0[0]+pB0[1]; _Pragma("unroll") for(int r=2;r<16;++r)sacc+=pB0[r]; _Pragma("unroll") for(int r=0;r<16;++r)sacc+=pB1[r]; l_reg+=sacc;
    pw0=(u32x4){PKW(pB0,0),PKW(pB0,2),PKW(pB0,4),PKW(pB0,6)};pw1=(u32x4){PKW(pB0,8),PKW(pB0,10),PKW(pB0,12),PKW(pB0,14)};pw2=(u32x4){PKW(pB1,0),PKW(pB1,2),PKW(pB1,4),PKW(pB1,6)};pw3=(u32x4){PKW(pB1,8),PKW(pB1,10),PKW(pB1,12),PKW(pB1,14)};
    SBAR(); pv(o,vb0+sl_cur,PAF(0),PAF(1),PAF(2),PAF(3)); }
  #undef PKW
  #undef PAF
  #undef VFR
  #undef PIN
  #undef MX3
  #undef GAPA
  #undef GAPB
  #undef EX
  #undef VRD
  #undef KRD
  #undef STEP
  #undef ENDW
  {auto rr=__builtin_amdgcn_permlane32_swap(__float_as_uint(l_reg),__float_as_uint(l_reg),false,false);l_reg=__uint_as_float(rr[0])+__uint_as_float(rr[1]);}
  if(hi==0)wsf[32+r32]=l_reg;asm volatile("s_waitcnt lgkmcnt(0)":::"memory");
  float rli[16];
  #pragma unroll
  for(int r=0;r<16;++r)rli[r]=__builtin_amdgcn_rcpf(wsf[32+crow(r,hi)]);
  bf16*Ow=O+(rowbase+q0+wid*QBLK)*OPITCH+h*D;
  { bf16*stg=(bf16*)(shm+(nsel==0?LDS_OST1:LDS_OST))+wid*2048;
    #pragma unroll
    for(int r=0;r<16;++r){const int orow=crow(r,hi);
      #pragma unroll
      for(int d0=0;d0<2;++d0)stg[orow*64+d0*32+r32]=__float2bfloat16(o[d0][r]*rli[r]);}
    asm volatile("s_waitcnt lgkmcnt(0)":::"memory");
    if(nsel==1){ const bf16*stg1=(const bf16*)(shm+LDS_OST1)+wid*2048;
      #pragma unroll
      for(int i=0;i<4;++i){const int row=i*8+(lane>>3),ch=lane&7; const u32x4 v2=*(const u32x4*)(stg+row*64+ch*8); const u32x4 v1=*(const u32x4*)(stg1+row*64+ch*8);
        float dd[8]; float ss=0.f;
        #pragma unroll
        for(int j=0;j<4;++j){ const float a0=__uint_as_float(v1[j]<<16),a1=__uint_as_float(v1[j]&0xffff0000u),b0=__uint_as_float(v2[j]<<16),b1=__uint_as_float(v2[j]&0xffff0000u);
          dd[2*j]=a0-lam*b0; dd[2*j+1]=a1-lam*b1; ss+=dd[2*j]*dd[2*j]+dd[2*j+1]*dd[2*j+1]; }
        ss+=__shfl_xor(ss,1); ss+=__shfl_xor(ss,2); ss+=__shfl_xor(ss,4);
        const float rs=omli/sqrtf(ss*(1.0f/64.0f)+1e-6f);
        u32x4 w;
        #pragma unroll
        for(int j=0;j<4;++j) w[j]=cvtpk_s(dd[2*j]*rs*subg[ch*8+2*j],dd[2*j+1]*rs*subg[ch*8+2*j+1]);
        ATTN_STORE16(Ow+(long)row*OPITCH+ch*8,w);} } }
  asm volatile("s_waitcnt lgkmcnt(0)\n\ts_barrier":::"memory");
  #undef DMA_K
  #undef DMA_V
  #undef CMASK
  #undef START
  #undef RESC
  #undef ROT

}
#undef SBAR
#undef WAIT_BAR
}
#ifndef GOFF
#define GOFF 0
#endif
#define GEMMCALL0 if (!((GOFF) & 1))
#define GEMMCALL1 if (!((GOFF) & 2))
#define GEMMCALL2 if (!((GOFF) & 4))
#define GEMMCALL3 if (!((GOFF) & 8))
namespace cg = cooperative_groups;
#define GAS __attribute__((address_space(1)))
#define LAS __attribute__((address_space(3)))
#define DI __device__ __forceinline__
typedef unsigned short bf16;
typedef unsigned v4u __attribute__((ext_vector_type(4)));
typedef unsigned v2u __attribute__((ext_vector_type(2)));
typedef float f32x4 __attribute__((ext_vector_type(4)));
typedef short bf16x8 __attribute__((ext_vector_type(8)));

constexpr int NWAVES = 8;
constexpr int DMODEL = 1024, SEQ = 4096, M = 32768, NIN = 3328, FF = 4096;
constexpr int RW = 384, RCOLS = 1408, ROFF = 1920, COFF = 1152;
constexpr float NORM_EPS = 1e-6f, GN_EPS = 64e-5f;
constexpr size_t MiB = 1u << 20;
constexpr size_t WS_CTL = 0, CTL_ZERO_BYTES = 65536;
constexpr int CW_BAR = 4096;
constexpr size_t WS_WIN = 1 * MiB, WS_WOUT = 14 * MiB, WS_WUP = 18 * MiB, WS_WDN = 34 * MiB, WS_LORA = 50 * MiB;
constexpr size_t WS_XB = 51 * MiB, WS_PROJ = 115 * MiB, WS_MIX = 323 * MiB, WS_S = 387 * MiB, WS_END = 507 * MiB;
constexpr size_t WS_HID = 115 * MiB;
constexpr size_t SARR = (size_t)M * RW;
constexpr int LORA_L = 384 * 64 * 2 + 384 * 128;
constexpr int LDS_BYTES = 147456, MISC_OFF = 131072;
constexpr int SCAN_WGS = 96, ATT_ITEMS = 768;

#ifndef PROBE
#define PROBE 0
#endif
struct Args { const float* in[25]; float* out; unsigned char* ws; int i0, i1; };

DI float wave_sum(float v) {
#pragma unroll
    for (int o = 1; o < 64; o <<= 1) v += __shfl_xor(v, o);
    return v;
}
DI unsigned f2bf(float f) { unsigned u = __builtin_bit_cast(unsigned, f); return (u + 0x7fffu + ((u >> 16) & 1u)) >> 16; }
DI unsigned pk2(float lo, float hi) { return f2bf(lo) | (f2bf(hi) << 16); }
DI float bflo(unsigned w) { return __uint_as_float(w << 16); }
DI float bfhi(unsigned w) { return __uint_as_float(w & 0xffff0000u); }
DI float bf1(const bf16* p) { return __uint_as_float(((unsigned)*p) << 16); }
DI void unpack8(v4u w, float* f) { f[0] = bflo(w.x); f[1] = bfhi(w.x); f[2] = bflo(w.y); f[3] = bfhi(w.y); f[4] = bflo(w.z); f[5] = bfhi(w.z); f[6] = bflo(w.w); f[7] = bfhi(w.w); }
DI v4u pack8(const float* f) { v4u o; o.x = pk2(f[0], f[1]); o.y = pk2(f[2], f[3]); o.z = pk2(f[4], f[5]); o.w = pk2(f[6], f[7]); return o; }
DI float sigmoidf_(float x) { return 1.f / (1.f + __expf(-x)); }
DI float tanhf_(float x) { const float e = __expf(2.f * x); return 1.f - 2.f / (e + 1.f); }
template <int CTRL> DI float dpp_add(float x) { return x + __int_as_float(__builtin_amdgcn_update_dpp(0, __float_as_int(x), CTRL, 0xf, 0xf, true)); }
DI float red16(float x) { x = dpp_add<0xB1>(x); x = dpp_add<0x4E>(x); x = dpp_add<0x141>(x); x = dpp_add<0x140>(x); return x; }

#define XB_TMO      128
#define XB_XCNT(j)  (256  + 64 * (j))
#define XB_XSUB(j)  (1280 + 64 * (j))
#define XB_XGEN(j)  (2304 + 64 * (j))
#define XB_TOP      3328
#define XB_TOPGEN   3392
#define XCD_BAR_WORDS 3456
#define XB_SPIN_CAP (1u << 18)

__device__ __forceinline__ unsigned xb_ld(unsigned* p)              { return __hip_atomic_load(p, __ATOMIC_RELAXED, __HIP_MEMORY_SCOPE_AGENT); }
__device__ __forceinline__ unsigned xb_add(unsigned* p, unsigned v) { return __hip_atomic_fetch_add(p, v, __ATOMIC_RELAXED, __HIP_MEMORY_SCOPE_AGENT); }
__device__ __forceinline__ unsigned xb_xcc_id() { return (unsigned)__builtin_amdgcn_s_getreg((3 << 11) | 20) & 0xFu; }
#define XB_SPIN(cond, bar) do { unsigned _sp = 0; while (cond) { __builtin_amdgcn_s_sleep(1); \
    if ((++_sp & 255u) == 0u) { if (xb_ld(&(bar)[XB_TMO])) break; if (_sp > XB_SPIN_CAP) { atomicAdd(&(bar)[XB_TMO], 1u); break; } } } } while (0)

struct XcdBarrier {
    unsigned* bar; unsigned x;
    volatile LAS unsigned* st;
};

__device__ __forceinline__ XcdBarrier xcd_barrier_post(unsigned* bar, volatile LAS unsigned* st) {
    XcdBarrier b; b.bar = bar; b.x = xb_xcc_id(); b.st = st;
    if (threadIdx.x == 0) (void)xb_add(&bar[XB_XCNT(b.x)], 1u);
    return b;
}
__device__ __forceinline__ void xcd_barrier_complete(unsigned* bar, unsigned x, unsigned& nloc, unsigned& nx) {
    const unsigned G = gridDim.x * gridDim.y * gridDim.z;
    unsigned sum, cnt, mine, sp = 0u;
    for (;;) {
        sum = 0u; cnt = 0u; mine = 0u;
#pragma unroll
        for (unsigned j = 0; j < 16; ++j) { const unsigned c = xb_ld(&bar[XB_XCNT(j)]); sum += c; cnt += (c > 0u) ? 1u : 0u; mine = (j == x) ? c : mine; }
        if (sum == G) break;
        __builtin_amdgcn_s_sleep(1);
        if ((++sp & 255u) == 0u) { if (xb_ld(&bar[XB_TMO])) break; if (sp > XB_SPIN_CAP) { atomicAdd(&bar[XB_TMO], 1u); break; } }
    }
    nloc = mine > 0u ? mine : 1u; nx = cnt > 0u ? cnt : 1u;
}

__device__ __forceinline__ void xcd_barrier(const XcdBarrier& b) {
    asm volatile("s_waitcnt vmcnt(0)" ::: "memory");
    __syncthreads();
    if (threadIdx.x == 0) {
        unsigned* bar = b.bar;
        __builtin_amdgcn_s_waitcnt(0);
        unsigned nloc = b.st[0], nx = b.st[1];
        if (nloc == 0u) { xcd_barrier_complete(bar, b.x, nloc, nx); b.st[0] = nloc; b.st[1] = nx; }
        const unsigned old = xb_add(&bar[XB_XSUB(b.x)], 1u);
        const unsigned gen = old / nloc;
        if (old + 1u == (gen + 1u) * nloc) {
            __builtin_amdgcn_fence(__ATOMIC_RELEASE, "agent");
            asm volatile("s_waitcnt vmcnt(0)" ::: "memory");
            const unsigned og = xb_add(&bar[XB_TOP], 1u);
            const unsigned tg = og / nx;
            if (og + 1u == (tg + 1u) * nx) xb_add(&bar[XB_TOPGEN], 1u);
            else XB_SPIN(xb_ld(&bar[XB_TOPGEN]) == tg, bar);
            __builtin_amdgcn_fence(__ATOMIC_ACQUIRE, "agent");
            xb_add(&bar[XB_XGEN(b.x)], 1u);
            asm volatile("s_waitcnt vmcnt(0)" ::: "memory");
        } else {
            XB_SPIN(xb_ld(&bar[XB_XGEN(b.x)]) == gen, bar);
            __builtin_amdgcn_fence(__ATOMIC_ACQUIRE, "agent");
            asm volatile("s_waitcnt vmcnt(0)" ::: "memory");
        }
    }
    __syncthreads();
}


struct Frame {
    LAS unsigned char* lds;
    int tid, lane, wave, G, gw, NGW;
    const float* const* in;
    float* out; unsigned char* ws;
};
DI const float* INP(const Frame& F, int k) { asm volatile("" : "+s"(k)); return F.in[k]; }
#define F_WIN  ((bf16*)(F.ws + WS_WIN))
#define F_WOUT ((bf16*)(F.ws + WS_WOUT))
#define F_WUP  ((bf16*)(F.ws + WS_WUP))
#define F_WDN  ((bf16*)(F.ws + WS_WDN))
#define F_LORA ((bf16*)(F.ws + WS_LORA))
#define F_XB   ((bf16*)(F.ws + WS_XB))
#define F_PROJ ((bf16*)(F.ws + WS_PROJ))
#define F_MIX  ((bf16*)(F.ws + WS_MIX))
#define F_HID  ((bf16*)(F.ws + WS_HID))
#define F_S_r  ((bf16*)(F.ws + WS_XB))
#define F_S_ld ((bf16*)(F.ws + WS_XB) + SARR)
#define F_S_k  ((bf16*)(F.ws + WS_S))
#define F_S_v  ((bf16*)(F.ws + WS_S) + SARR)
#define F_S_n  ((bf16*)(F.ws + WS_S) + 2 * SARR)
#define F_S_b  ((bf16*)(F.ws + WS_S) + 3 * SARR)
#define F_S_g  ((bf16*)(F.ws + WS_S) + 4 * SARR)
#define F_ctl  ((unsigned*)(F.ws + WS_CTL))

DI void transpose_item(const float* W, int K, int N, bf16* WT, LAS float* scr, int item, int lane, const float* gk, float cs, int csn) {
    const int nblk = N / 32, kb = item / nblk, nb = item % nblk, k0 = 64 * kb, n0 = 32 * nb;
    const float colscale = (n0 + (lane & 31) < csn) ? cs : 1.f;
#pragma unroll 8
    for (int i = 0; i < 32; ++i) { const int kk = 2 * i + (lane >> 5); float v = W[(size_t)(k0 + kk) * N + n0 + (lane & 31)]; if (gk) v *= gk[k0 + kk]; scr[kk * 33 + (lane & 31)] = v * colscale; }
    asm volatile("s_waitcnt lgkmcnt(0)" ::: "memory");
    const int c = lane & 7;
#pragma unroll
    for (int j = 0; j < 4; ++j) { const int n = (lane >> 3) + 8 * j; const LAS float* s = scr + (8 * c) * 33 + n;
        v4u o; o.x = pk2(s[0 * 33], s[1 * 33]); o.y = pk2(s[2 * 33], s[3 * 33]); o.z = pk2(s[4 * 33], s[5 * 33]); o.w = pk2(s[6 * 33], s[7 * 33]);
        *(v4u*)(WT + (size_t)(n0 + n) * K + k0 + 8 * c) = o; }
    asm volatile("s_waitcnt lgkmcnt(0)" ::: "memory");
}
DI Frame refresh(const Frame& F0) { Frame F = F0; int t = threadIdx.x; asm volatile("" : "+v"(t)); int bxx = blockIdx.x; asm volatile("" : "+s"(bxx)); F.tid = t; F.lane = t & 63; F.wave = __builtin_amdgcn_readfirstlane(t >> 6); F.gw = bxx * NWAVES + F.wave; return F; }
DI void prologue(const Frame& F0) { Frame F = refresh(F0);
    LAS float* scr = (LAS float*)(F.lds + F.wave * 16384);
    constexpr int I_IN = 16 * 104, I_OUT = 16 * 32, I_UP = 16 * 128, I_DN = 64 * 32, I_LW = 12, I_LG = 24;
    constexpr int PER = I_IN + I_OUT + I_UP + I_DN + 2 * I_LW + I_LG;
    constexpr float C2 = 0.17677669529663687f * 1.4426950408889634f;
    for (int it = F.gw; it < 2 * PER; it += F.NGW) {
        const int l = it / PER; int r = it % PER;
        if (r < I_IN) { transpose_item(INP(F, 2) + (size_t)l * DMODEL * NIN, DMODEL, NIN, F_WIN + (size_t)l * NIN * DMODEL, scr, r, F.lane, INP(F, 1) + l * DMODEL, C2, 384); continue; } r -= I_IN;
        if (r < I_OUT) { transpose_item(INP(F, 20) + (size_t)l * DMODEL * DMODEL, DMODEL, DMODEL, F_WOUT + (size_t)l * DMODEL * DMODEL, scr, r, F.lane, nullptr, 1.f, 0); continue; } r -= I_OUT;
        if (r < I_UP) { transpose_item(INP(F, 22) + (size_t)l * DMODEL * FF, DMODEL, FF, F_WUP + (size_t)l * FF * DMODEL, scr, r, F.lane, INP(F, 21) + l * DMODEL, 1.f, 0); continue; } r -= I_UP;
        if (r < I_DN) { transpose_item(INP(F, 23) + (size_t)l * FF * DMODEL, FF, DMODEL, F_WDN + (size_t)l * DMODEL * FF, scr, r, F.lane, nullptr, 1.f, 0); continue; } r -= I_DN;
        bf16* L = F_LORA + (size_t)l * LORA_L;
        if (r < I_LW) { transpose_item(INP(F, 11) + (size_t)l * 64 * RW, 64, RW, L, scr, r, F.lane, nullptr, 1.f, 0); continue; } r -= I_LW;
        if (r < I_LW) { transpose_item(INP(F, 13) + (size_t)l * 64 * RW, 64, RW, L + RW * 64, scr, r, F.lane, nullptr, 1.f, 0); continue; } r -= I_LW;
        transpose_item(INP(F, 14) + (size_t)l * 128 * RW, 128, RW, L + 2 * RW * 64, scr, r, F.lane, nullptr, 1.f, 0);
    }
}
DI void rms_rows_bf16(const Frame& F0, const float* src, bf16* dst) { Frame F = refresh(F0);
    for (int m = F.gw; m < M; m += F.NGW) {
        const f32x4* xr = (const f32x4*)(src + (size_t)m * DMODEL) + F.lane;
        f32x4 v[4]; float s2 = 0.f;
#pragma unroll
        for (int j = 0; j < 4; ++j) { v[j] = xr[64 * j]; s2 += (v[j].x * v[j].x + v[j].y * v[j].y) + (v[j].z * v[j].z + v[j].w * v[j].w); }
        const float rstd = 1.f / sqrtf(wave_sum(s2) * (1.f / DMODEL) + NORM_EPS);
        v2u* o8 = (v2u*)(dst + (size_t)m * DMODEL) + F.lane;
#pragma unroll
        for (int j = 0; j < 4; ++j) { v2u w; w.x = pk2(v[j].x * rstd, v[j].y * rstd); w.y = pk2(v[j].z * rstd, v[j].w * rstd); o8[64 * j] = w; }
    }
}
DI void final_norm(const Frame& F0, float* x, const float* g) { Frame F = refresh(F0);
    for (int m = F.gw; m < M; m += F.NGW) {
        f32x4* xr = (f32x4*)(x + (size_t)m * DMODEL) + F.lane; const f32x4* gr = (const f32x4*)g + F.lane;
        f32x4 v[4]; float s2 = 0.f;
#pragma unroll
        for (int j = 0; j < 4; ++j) { v[j] = xr[64 * j]; s2 += (v[j].x * v[j].x + v[j].y * v[j].y) + (v[j].z * v[j].z + v[j].w * v[j].w); }
        const float rstd = 1.f / sqrtf(wave_sum(s2) * (1.f / DMODEL) + NORM_EPS);
#pragma unroll
        for (int j = 0; j < 4; ++j) xr[64 * j] = v[j] * rstd * gr[64 * j];
    }
}

DI void loadz8(const bf16* prow, bool first, const float* mu, int col, float* z) {
    const v4u p = *(const v4u*)(prow + col); v4u q = (v4u){0u, 0u, 0u, 0u}; if (!first) q = *(const v4u*)(prow - NIN + col);
    const f32x4 m0 = *(const f32x4*)(mu + col), m1 = *(const f32x4*)(mu + col + 4);
    float pf[8], qf[8]; unpack8(p, pf); unpack8(q, qf);
#pragma unroll
    for (int j = 0; j < 4; ++j) { z[j] = pf[j] + m0[j] * (qf[j] - pf[j]); z[4 + j] = pf[4 + j] + m1[j] * (qf[4 + j] - pf[4 + j]); }
}
DI float loadz1(const bf16* prow, bool first, float mu, int col) { const float p = bf1(prow + col); const float q = first ? 0.f : bf1(prow - NIN + col); return p + mu * (q - p); }

DI void prep_phase(const Frame& F0, int l) { Frame F = refresh(F0);
    const float* mu = INP(F, 9) + l * RCOLS;
    const float* w0 = INP(F, 10) + l * RW; const float* a0 = INP(F, 12) + l * RW; const float* kkw = INP(F, 15) + l * RW; const float* kaw = INP(F, 16) + l * RW;
    const bf16* WUT = F_LORA + (size_t)l * LORA_L; const bf16* AUT = WUT + RW * 64; const bf16* GUT = AUT + RW * 64;
    const int row = F.lane & 15, kq = F.lane >> 4;
    for (int tile = F.gw; tile < M / 16; tile += F.NGW) {
        const int t0 = tile * 16;
        bf16x8 Aw[2], Aa[2], Ag[4];
        { const int t = t0 + row; const bool first = (t % SEQ) == 0; const bf16* prow = F_PROJ + (size_t)t * NIN + ROFF; float z[8];
#pragma unroll
          for (int ks = 0; ks < 2; ++ks) { loadz8(prow, first, mu, 1152 + ks * 32 + kq * 8, z);
#pragma unroll
              for (int j = 0; j < 8; ++j) z[j] = tanhf_(z[j]);
              Aw[ks] = __builtin_bit_cast(bf16x8, pack8(z)); }
#pragma unroll
          for (int ks = 0; ks < 2; ++ks) { loadz8(prow, first, mu, 1216 + ks * 32 + kq * 8, z); Aa[ks] = __builtin_bit_cast(bf16x8, pack8(z)); }
#pragma unroll
          for (int ks = 0; ks < 4; ++ks) { loadz8(prow, first, mu, 1280 + ks * 32 + kq * 8, z);
#pragma unroll
              for (int j = 0; j < 8; ++j) z[j] = sigmoidf_(z[j]);
              Ag[ks] = __builtin_bit_cast(bf16x8, pack8(z)); } }
#pragma unroll 1
        for (int hd = 0; hd < 6; ++hd) {
            float kkv[4][4], av[4][4], ss[4] = {0.f, 0.f, 0.f, 0.f};
#pragma unroll
            for (int cgi = 0; cgi < 4; ++cgi) {
                const int ch = hd * 64 + cgi * 16 + row;
                f32x4 cw = (f32x4){0.f, 0.f, 0.f, 0.f}, ca = cw, cgt = cw;
#pragma unroll
                for (int ks = 0; ks < 2; ++ks) {
                    const bf16x8 bw = *(const bf16x8*)(WUT + (size_t)ch * 64 + ks * 32 + kq * 8); cw = __builtin_amdgcn_mfma_f32_16x16x32_bf16(Aw[ks], bw, cw, 0, 0, 0);
                    const bf16x8 ba = *(const bf16x8*)(AUT + (size_t)ch * 64 + ks * 32 + kq * 8); ca = __builtin_amdgcn_mfma_f32_16x16x32_bf16(Aa[ks], ba, ca, 0, 0, 0); }
#pragma unroll
                for (int ks = 0; ks < 4; ++ks) { const bf16x8 bg = *(const bf16x8*)(GUT + (size_t)ch * 128 + ks * 32 + kq * 8); cgt = __builtin_amdgcn_mfma_f32_16x16x32_bf16(Ag[ks], bg, cgt, 0, 0, 0); }
                const float w0c = w0[ch], a0c = a0[ch], kkc = kkw[ch], kac = kaw[ch], mur = mu[ch], muk = mu[RW + ch], muv = mu[2 * RW + ch];
#pragma unroll
                for (int j = 0; j < 4; ++j) {
                    const int tt = t0 + kq * 4 + j; const bool fj = (tt % SEQ) == 0; const bf16* pr = F_PROJ + (size_t)tt * NIN + ROFF;
                    const float zr = loadz1(pr, fj, mur, ch), zk = loadz1(pr, fj, muk, RW + ch), zv = loadz1(pr, fj, muv, 2 * RW + ch);
                    const float wl = w0c + cw[j];
                    const float xs = -wl; const float sp = fmaxf(xs, 0.f) + __logf(1.f + __expf(-fabsf(xs)));
                    const float ld = -__expf(-sp - 0.5f);
                    const float a = sigmoidf_(a0c + ca[j]);
                    const float kk = zk * kkc, kp = zk * (1.f + (a - 1.f) * kac);
                    kkv[cgi][j] = kk; av[cgi][j] = a; ss[j] += kk * kk;
                    const size_t idx = (size_t)tt * RW + ch;
                    F_S_r[idx] = (bf16)f2bf(zr); F_S_ld[idx] = (bf16)f2bf(ld); F_S_k[idx] = (bf16)f2bf(kp); F_S_v[idx] = (bf16)f2bf(zv); F_S_g[idx] = (bf16)f2bf(cgt[j]);
                }
            }
#pragma unroll
            for (int j = 0; j < 4; ++j) { float s = ss[j]; s += __shfl_xor(s, 1); s += __shfl_xor(s, 2); s += __shfl_xor(s, 4); s += __shfl_xor(s, 8); ss[j] = 1.f / fmaxf(sqrtf(s), 1e-12f); }
#pragma unroll
            for (int cgi = 0; cgi < 4; ++cgi)
#pragma unroll
                for (int j = 0; j < 4; ++j) { const int tt = t0 + kq * 4 + j; const size_t idx = (size_t)tt * RW + hd * 64 + cgi * 16 + row; const float kn = kkv[cgi][j] * ss[j];
                    F_S_n[idx] = (bf16)f2bf(-kn); F_S_b[idx] = (bf16)f2bf(kn * av[cgi][j]); }
        }
    }
    const float* cw_ = INP(F, 8) + l * 3 * 256;
    for (int it = F.gw; it < M / 2; it += F.NGW) {
        const int t = it * 2 + (F.lane >> 5), c8 = (F.lane & 31) * 8, pos = t % SEQ;
        const bf16* base = F_PROJ + (size_t)t * NIN + COFF + c8;
        float b8[8], g8[8], u8[8], acc[8], w8[8];
        unpack8(*(const v4u*)base, b8);
#pragma unroll
        for (int j = 0; j < 8; ++j) acc[j] = 0.f;
#pragma unroll
        for (int d = 0; d < 3; ++d) {
            const int back = 2 - d;
            if (pos >= back) {
                const bf16* pb = base - (size_t)back * NIN;
                unpack8(*(const v4u*)(pb + 256), g8); unpack8(*(const v4u*)(pb + 512), u8);
                const f32x4 wa = *(const f32x4*)(cw_ + d * 256 + c8), wb = *(const f32x4*)(cw_ + d * 256 + c8 + 4);
                w8[0] = wa.x; w8[1] = wa.y; w8[2] = wa.z; w8[3] = wa.w; w8[4] = wb.x; w8[5] = wb.y; w8[6] = wb.z; w8[7] = wb.w;
#pragma unroll
                for (int j = 0; j < 8; ++j) acc[j] += w8[j] * (g8[j] * u8[j]);
            }
        }
#pragma unroll
        for (int j = 0; j < 8; ++j) acc[j] *= b8[j];
        *(v4u*)(F_MIX + (size_t)t * DMODEL + 384 + c8) = pack8(acc);
    }
}

DI void post_phase(const Frame& F0, int l) { Frame F = refresh(F0);
    const float* rk = INP(F, 17) + l * RW; const float* lg = INP(F, 18) + l * RW; const float* lb = INP(F, 19) + l * RW;
    for (int it = F.gw; it < M * 6 / 8; it += F.NGW) {
        const int pair = it * 8 + (F.lane >> 3), t = pair / 6, hd = pair % 6, ch = hd * 64 + (F.lane & 7) * 8;
        bf16* yp = F_MIX + (size_t)t * DMODEL + 640 + ch; const size_t idx = (size_t)t * RW + ch;
        float y[8], r[8], k[8], v[8], g[8], o[8];
        unpack8(*(const v4u*)yp, y); unpack8(*(const v4u*)(F_S_r + idx), r); unpack8(*(const v4u*)(F_S_k + idx), k); unpack8(*(const v4u*)(F_S_v + idx), v); unpack8(*(const v4u*)(F_S_g + idx), g);
        float s = 0.f, dot = 0.f;
#pragma unroll
        for (int j = 0; j < 8; ++j) { s += y[j]; dot += r[j] * k[j] * rk[ch + j]; }
        s += __shfl_xor(s, 1); s += __shfl_xor(s, 2); s += __shfl_xor(s, 4);
        dot += __shfl_xor(dot, 1); dot += __shfl_xor(dot, 2); dot += __shfl_xor(dot, 4);
        const float mean = s * (1.f / 64.f); float q = 0.f;
#pragma unroll
        for (int j = 0; j < 8; ++j) { const float d = y[j] - mean; q += d * d; }
        q += __shfl_xor(q, 1); q += __shfl_xor(q, 2); q += __shfl_xor(q, 4);
        const float rstd = 1.f / sqrtf(q * (1.f / 64.f) + GN_EPS);
#pragma unroll
        for (int j = 0; j < 8; ++j) o[j] = ((y[j] - mean) * rstd * lg[ch + j] + lb[ch + j] + dot * v[j]) * g[j];
        *(v4u*)yp = pack8(o);
    }
}

DI void scan_wg(const Frame& F0, int sw) { Frame F = refresh(F0);
    const int bh = sw >> 1, half = sw & 1, b = bh / 6, hd = bh % 6;
    const int rloc = F.wave * 4 + (F.lane >> 4), kp = F.lane & 15;
    const size_t tb = (size_t)b * SEQ; const int cb = hd * 64;
    LAS unsigned char* const lds = F.lds;
    constexpr int BUFB = 6 * 8192, YOFF = 2 * BUFB;
    v4u st[3];
#define SCAN_LOAD(c) do { _Pragma("unroll") for (int i = 0; i < 3; ++i) { const int p = F.tid + 512 * i, a = p >> 8, tt = (p & 255) >> 3, c8 = (p & 7) * 8; \
        const bf16* src = (a == 0 ? F_S_r : a == 1 ? F_S_ld : a == 2 ? F_S_k : a == 3 ? F_S_v : a == 4 ? F_S_n : F_S_b); \
        st[i] = *(const v4u*)(src + (tb + (size_t)(c) * 32 + tt) * RW + cb + c8); } } while (0)
#define SCAN_STORE(bufsel) do { _Pragma("unroll") for (int i = 0; i < 3; ++i) { const int p = F.tid + 512 * i, a = p >> 8, tt = (p & 255) >> 3, c8 = (p & 7) * 8; \
        float f[8]; unpack8(st[i], f); if (a == 1) { _Pragma("unroll") for (int j = 0; j < 8; ++j) f[j] = __expf(f[j]); } \
        LAS f32x4* d = (LAS f32x4*)(lds + (bufsel) * BUFB + a * 8192 + tt * 256 + c8 * 4); d[0] = (f32x4){f[0], f[1], f[2], f[3]}; d[1] = (f32x4){f[4], f[5], f[6], f[7]}; } } while (0)
    SCAN_LOAD(0); SCAN_STORE(0);
    __syncthreads();
    f32x4 s = (f32x4){0.f, 0.f, 0.f, 0.f};
#pragma unroll 1
    for (int c = 0; c < SEQ / 32; ++c) {
        const int cur = c & 1;
        if (c + 1 < SEQ / 32) SCAN_LOAD(c + 1);
        const LAS unsigned char* bb = lds + cur * BUFB + kp * 16;
        const LAS unsigned char* vb = lds + cur * BUFB + 3 * 8192 + (half * 32 + rloc) * 4;
        LAS float* yb = (LAS float*)(lds + YOFF + cur * 4096) + rloc;
        typedef float f32x2v __attribute__((ext_vector_type(2)));
        f32x4 rv = *(const LAS f32x4*)(bb + 0 * 8192), wv = *(const LAS f32x4*)(bb + 1 * 8192), kv = *(const LAS f32x4*)(bb + 2 * 8192);
        f32x4 nv = *(const LAS f32x4*)(bb + 4 * 8192), bv = *(const LAS f32x4*)(bb + 5 * 8192);
        float vv = *(const LAS float*)(vb);
#pragma unroll 8
        for (int tt = 0; tt < 32; ++tt) {
            const int tn = (tt + 1) & 31;
            const f32x4 rv2 = *(const LAS f32x4*)(bb + 0 * 8192 + tn * 256), wv2 = *(const LAS f32x4*)(bb + 1 * 8192 + tn * 256), kv2 = *(const LAS f32x4*)(bb + 2 * 8192 + tn * 256);
            const f32x4 nv2 = *(const LAS f32x4*)(bb + 4 * 8192 + tn * 256), bv2 = *(const LAS f32x4*)(bb + 5 * 8192 + tn * 256);
            const float vv2 = *(const LAS float*)(vb + tn * 256);
            f32x2v d2 = (f32x2v){s.x, s.y} * (f32x2v){nv.x, nv.y}; d2 = (f32x2v){s.z, s.w} * (f32x2v){nv.z, nv.w} + d2;
            float sa = red16(d2.x + d2.y);
            const f32x4 q = s * wv + kv * vv;
            s = bv * sa + q;
            f32x2v y2 = (f32x2v){s.x, s.y} * (f32x2v){rv.x, rv.y}; y2 = (f32x2v){s.z, s.w} * (f32x2v){rv.z, rv.w} + y2;
            const float y = red16(y2.x + y2.y);
            yb[tt * 32] = y;
            rv = rv2; wv = wv2; kv = kv2; nv = nv2; bv = bv2; vv = vv2;
        }
        if (c + 1 < SEQ / 32) SCAN_STORE(cur ^ 1);
        __syncthreads();
        {
            const int tt = F.tid >> 4, r2 = (F.tid & 15) * 2;
            const LAS float* ys = (const LAS float*)(lds + YOFF + cur * 4096) + tt * 32 + r2;
            *(unsigned*)(F_MIX + (tb + (size_t)c * 32 + tt) * DMODEL + 640 + cb + half * 32 + r2) = pk2(ys[0], ys[1]);
        }
    }
#undef SCAN_LOAD
#undef SCAN_STORE
    __syncthreads();
}

DI void mix_phase(const Frame& F0, int l, char* ldsg) { Frame F = refresh(F0);
#ifndef SKIP_SCAN
    if ((int)blockIdx.x < SCAN_WGS) { scan_wg(F, (int)blockIdx.x); if (PROBE & 2) scan_wg(F, (int)blockIdx.x); }
#endif
    const float* lq1 = INP(F, 3) + l * 32; const float* lk1 = INP(F, 4) + l * 32; const float* lq2 = INP(F, 5) + l * 32; const float* lk2 = INP(F, 6) + l * 32;
    float d1 = 0.f, d2 = 0.f;
    for (int i = 0; i < 32; ++i) { d1 += lq1[i] * lk1[i]; d2 += lq2[i] * lk2[i]; }
    const float lambda_init = (l == 0) ? 0.2f : 0.35550906759f;
    const float lam = __expf(d1) - __expf(d2) + lambda_init;
    const float* sg = INP(F, 7) + l * 64;
    volatile LAS unsigned* qslot = (volatile LAS unsigned*)(F.lds + MISC_OFF + 64);
    for (int rep = 0; rep < ((PROBE & 4) ? 2 : 1); ++rep)
    for (;;) {
        if (F.tid == 0) *qslot = atomicAdd(F_ctl + 64 * (1 + l + 2 * rep), 1u);
        __syncthreads();
        const unsigned idx = (unsigned)__builtin_amdgcn_readfirstlane((int)*qslot);
        __syncthreads();
        if (idx >= (unsigned)ATT_ITEMS) break;
        const int qb = 15 - (int)(idx / 48u), bh = (int)(idx % 48u), b = bh / 6, h = bh % 6;
        const attn_body::bf16* P = (const attn_body::bf16*)F_PROJ;
#ifndef SKIP_ATT
#pragma unroll 1
        for (int ns = 0; ns < 2; ++ns)
            attn_body::attn_unit<8>(b, h, qb, ns, lam, sg, 1.f - lambda_init, P, P + 384, P + 768, (attn_body::bf16*)F_MIX, ldsg);
#endif
    }
}

__global__ void __launch_bounds__(NWAVES * 64, 2) mega_fwd(Args args) {
    extern __shared__ __attribute__((aligned(16))) unsigned char lds[];
    cg::grid_group grid = cg::this_grid();
    Frame F;
    F.lds = (LAS unsigned char*)lds;
    F.tid = threadIdx.x; F.lane = F.tid & 63; F.wave = __builtin_amdgcn_readfirstlane(F.tid >> 6);
    F.G = gridDim.x; F.gw = (int)blockIdx.x * NWAVES + F.wave; F.NGW = F.G * NWAVES;
    F.in = args.in; F.out = args.out; F.ws = args.ws;
    const int G = F.G;
    if (F.tid < 32) ((LAS unsigned*)(F.lds + MISC_OFF))[F.tid] = 0u;
    __syncthreads();
    XcdBarrier bar = xcd_barrier_post((unsigned*)(args.ws + WS_CTL) + CW_BAR, (volatile LAS unsigned*)(F.lds + MISC_OFF) + 8);

    prologue(F);
    rms_rows_bf16(F, INP(F, 0), F_XB);
    grid.sync();
#pragma unroll 1
    for (int l = 0; l < 2; ++l) {
        {
            pg8::Gemm g{F_XB, F_WIN + (size_t)l * NIN * DMODEL, M, NIN, DMODEL}; pg8::StaticOrder S; int bx = blockIdx.x; asm volatile("" : "+s"(bx)); S.init(M, NIN, G, bx);
            pg8::EpiBf16S<0> E{F_PROJ, NIN};
            GEMMCALL0 pg8::gemm_phase<pg8::EpiBf16S<0>, pg8::StaticOrder, true, true>(F.lds, g, S, E);
            if (PROBE & 1) { __syncthreads(); pg8::gemm_phase<pg8::EpiBf16S<0>, pg8::StaticOrder, true, true>(F.lds, g, S, E); }
        }
        xcd_barrier(bar);
#ifndef SKIP_PREP
        prep_phase(F, l);
        if (PROBE & 8) { __syncthreads(); prep_phase(F, l); }
#endif
        xcd_barrier(bar);
        mix_phase(F, l, (char*)lds);
        xcd_barrier(bar);
#ifndef SKIP_POST
        post_phase(F, l);
#endif
        xcd_barrier(bar);
        {
            pg8::Gemm g{F_MIX, F_WOUT + (size_t)l * DMODEL * DMODEL, M, DMODEL, DMODEL}; pg8::StaticOrder S; int bx = blockIdx.x; asm volatile("" : "+s"(bx)); S.init(M, DMODEL, G, bx);
            pg8::EpiResF32 E{l == 0 ? INP(F, 0) : (const float*)F.out, F.out, DMODEL};
            GEMMCALL1 pg8::gemm_phase<pg8::EpiResF32, pg8::StaticOrder, true, true>(F.lds, g, S, E);
        }
        xcd_barrier(bar);
        rms_rows_bf16(F, F.out, F_XB);
        if (PROBE & 16) { xcd_barrier(bar); rms_rows_bf16(F, F.out, F_XB); xcd_barrier(bar); rms_rows_bf16(F, F.out, F_XB); }
        if (PROBE & 32) { for (int q = 0; q < 10; ++q) xcd_barrier(bar); }
        xcd_barrier(bar);
        {
            pg8::Gemm g{F_XB, F_WUP + (size_t)l * FF * DMODEL, M, FF, DMODEL}; pg8::StaticOrder S; int bx = blockIdx.x; asm volatile("" : "+s"(bx)); S.init(M, FF, G, bx);
            pg8::EpiBf16S<2> E{F_HID, FF};
            GEMMCALL2 pg8::gemm_phase<pg8::EpiBf16S<2>, pg8::StaticOrder, true, true>(F.lds, g, S, E);
            if (PROBE & 1) { __syncthreads(); pg8::gemm_phase<pg8::EpiBf16S<2>, pg8::StaticOrder, true, true>(F.lds, g, S, E); }
        }
        xcd_barrier(bar);
        {
            pg8::Gemm g{F_HID, F_WDN + (size_t)l * DMODEL * FF, M, DMODEL, FF}; pg8::StaticOrder S; int bx = blockIdx.x; asm volatile("" : "+s"(bx)); S.init(M, DMODEL, G, bx);
            pg8::EpiResF32 E{(const float*)F.out, F.out, DMODEL};
            GEMMCALL3 pg8::gemm_phase<pg8::EpiResF32, pg8::StaticOrder, true, true>(F.lds, g, S, E);
        }
        xcd_barrier(bar);
        if (l == 0) { rms_rows_bf16(F, F.out, F_XB); xcd_barrier(bar); }
    }
    final_norm(F, F.out, INP(F, 24));
}

extern "C" void kernel_launch(void* const* d_in, const int* in_sizes, int n_in, void* d_out, int out_size, void* d_ws, size_t ws_size, hipStream_t stream) {
    static int grid = 0;
    if (grid == 0) {
        if (n_in != 25 || in_sizes[0] != M * DMODEL || out_size != M * DMODEL || ws_size < WS_END) {
            fprintf(stderr, "kernel_launch: unexpected problem geometry (n_in %d, in0 %d, out %d, ws %zu)\n", n_in, n_in > 0 ? in_sizes[0] : -1, out_size, ws_size); grid = -1; return; }
        int dev = 0, cus = 0, per_cu = 0;
        if (hipGetDevice(&dev) != hipSuccess || hipDeviceGetAttribute(&cus, hipDeviceAttributeMultiprocessorCount, dev) != hipSuccess) { grid = -1; return; }
        if (hipFuncSetAttribute((const void*)mega_fwd, hipFuncAttributeMaxDynamicSharedMemorySize, LDS_BYTES) != hipSuccess) { fprintf(stderr, "kernel_launch: hipFuncSetAttribute failed\n"); grid = -1; return; }
        if (hipOccupancyMaxActiveBlocksPerMultiprocessor(&per_cu, (const void*)mega_fwd, NWAVES * 64, LDS_BYTES) != hipSuccess || per_cu < 1) { fprintf(stderr, "kernel_launch: occupancy query gave %d\n", per_cu); (void)hipGetLastError(); per_cu = 1; }
        grid = cus * per_cu;
    }
    if (grid < 0) return;
    (void)hipMemsetAsync((char*)d_ws + WS_CTL, 0, CTL_ZERO_BYTES, stream);
    Args a{};
    for (int i = 0; i < 25; ++i) a.in[i] = (const float*)d_in[i];
    a.out = (float*)d_out; a.ws = (unsigned char*)d_ws; a.i0 = 0; a.i1 = 0;
    void* kargs[] = {&a};
    const hipError_t e = hipLaunchCooperativeKernel((const void*)mega_fwd, dim3(grid), dim3(NWAVES * 64), kargs, LDS_BYTES, stream);
    if (e != hipSuccess) fprintf(stderr, "kernel_launch: cooperative launch failed: %s (grid %d)\n", hipGetErrorString(e), grid);
}
```

```cpp
#include <hip/hip_runtime.h>
#include <hip/hip_cooperative_groups.h>
#include <hip/hip_bf16.h>
#include <cstdio>
#include <cstdint>
#include <cmath>
namespace pg8 {
#define PG8_LAS __attribute__((address_space(3)))
typedef unsigned short bf16_t;
typedef short bf16x8 __attribute__((ext_vector_type(8)));
typedef float f32x4 __attribute__((ext_vector_type(4)));
typedef unsigned u32x4 __attribute__((ext_vector_type(4)));
constexpr int BM = 256, BK = 64, HALF = 128, HTB = HALF * BK * 2  , STAGE_BYTES = 8 * HTB, NXCD = 8, WGM = 8;

__host__ __device__ __forceinline__ int lds_byte(int r, int c) { const int st = (r >> 4) * 2 + (c >> 5), rr = r & 15, cc = c & 31, ob = rr * 64 + cc * 2; return st * 1024 + (ob ^ (((ob >> 9) & 1) << 5)); }
__host__ __device__ __forceinline__ void stage_rc(int b, int& R, int& C) { const int st = b / 1024, sb = b % 1024, swz = sb ^ (((sb >> 9) & 1) << 5); R = (st >> 1) * 16 + swz / 64; C = (st & 1) * 32 + (swz % 64) / 2; }
__host__ __device__ __forceinline__ int perm32(int rho) { const int n = rho >> 4, i = rho & 15; return 8 * (i >> 2) + 4 * n + (i & 3); }

struct Unit { int pm, pn; };
struct Gemm { const bf16_t* A; const bf16_t* Bt; int M, N, K; };

struct StaticOrder {
    int nM, nN, nwg, G, c;
    __host__ __device__ void init(int M, int N, int G_, int c_) { nM = M / BM; nN = N / BM; nwg = nM * nN; G = G_; c = c_; }
    __host__ __device__ bool next(int i, Unit& u) const {
        const long L = (long)i * G + c; if (L >= nwg) return false;
        int wgid = (int)L; { const int q = nwg / NXCD, r = nwg % NXCD, xcd = wgid % NXCD, off = wgid / NXCD; wgid = (xcd < r ? xcd * (q + 1) : r * (q + 1) + (xcd - r) * q) + off; }
        const int nig = WGM * nN, gid = wgid / nig, fm = gid * WGM, gsz = (nM - fm) < WGM ? (nM - fm) : WGM;
        u.pm = fm + ((wgid % nig) % gsz); u.pn = (wgid % nig) / gsz; return true;
    }
    __device__ __forceinline__ void a_ready(const Unit&) const {}
    __device__ __forceinline__ void done(const Unit&) const {}
};

__device__ __forceinline__ unsigned cvt_pk_bf16(float lo, float hi) { unsigned r; asm volatile("v_cvt_pk_bf16_f32 %0, %1, %2" : "=v"(r) : "v"(lo), "v"(hi)); return r; }
typedef float f32x2 __attribute__((ext_vector_type(2)));
template <int ACT  > struct EpiBf16S {
    static constexpr bool PERM = true, AFTER_DRAIN = false;
    bf16_t* O; int ldc;
    __device__ __forceinline__ void operator()(const f32x4 (&acc)[2][2][4][2], const Unit& u, int wr, int wc, int fr, int fq) const {
        const int row0 = u.pm * BM + wr * 64 + fr; const int col0 = u.pn * BM + wc * 32 + 8 * fq;
#pragma unroll
        for (int ai = 0; ai < 2; ++ai)
#pragma unroll
            for (int m = 0; m < 4; ++m) { bf16_t* rowp = O + (size_t)(row0 + ai * HALF + m * 16) * ldc + col0;
#pragma unroll
                for (int bj = 0; bj < 2; ++bj) { f32x4 v0 = acc[ai][bj][m][0], v1 = acc[ai][bj][m][1];
                    if (ACT == 2) {
#pragma unroll
                        for (int e = 0; e < 4; ++e) { float a = v0[e] > 0.f ? v0[e] : 0.f; v0[e] = a * a; float b = v1[e] > 0.f ? v1[e] : 0.f; v1[e] = b * b; } }
                    u32x4 w; w.x = cvt_pk_bf16(v0[0], v0[1]); w.y = cvt_pk_bf16(v0[2], v0[3]); w.z = cvt_pk_bf16(v1[0], v1[1]); w.w = cvt_pk_bf16(v1[2], v1[3]);
                    *(u32x4*)(rowp + bj * HALF) = w; } }
    }
};
struct EpiResF32 {
    static constexpr bool PERM = false, AFTER_DRAIN = false;
    const float* base; float* out; int ldc;
    __device__ __forceinline__ void operator()(const f32x4 (&acc)[2][2][4][2], const Unit& u, int wr, int wc, int fr, int fq) const {
        const int col0 = u.pn * BM + wc * 32 + 4 * fq;
#pragma unroll
        for (int ai = 0; ai < 2; ++ai)
#pragma unroll
            for (int m = 0; m < 4; ++m) { const int r = u.pm * BM + ai * HALF + wr * 64 + m * 16 + fr; const size_t off = (size_t)r * ldc + col0;
#pragma unroll
                for (int bj = 0; bj < 2; ++bj)
#pragma unroll
                    for (int n = 0; n < 2; ++n) { const size_t idx = off + bj * HALF + n * 16; const f32x4 bs = *(const f32x4*)(base + idx); *(f32x4*)(out + idx) = bs + acc[ai][bj][m][n]; }
                asm volatile("" ::: "memory"); }
    }
};
template <class Epi, class Sched, bool ALIGN_EPI = false, bool SP2 = false>
__device__ __forceinline__ void gemm_phase(PG8_LAS unsigned char* lds, const Gemm g, const Sched& S, const Epi& E) {
    int tid_ = threadIdx.x; asm volatile("" : "+v"(tid_)); const int tid = tid_, wid = __builtin_amdgcn_readfirstlane(tid >> 6), lane = tid & 63, wr = wid >> 2, wc = wid & 3, fr = lane & 15, fq = lane >> 4;
    const int K = g.K, nt = K / BK;
    unsigned voffA[2], voffB[2];
#pragma unroll
    for (int i = 0; i < 2; ++i) { int R, C; stage_rc(tid * 16 + i * 8192, R, C); const int Rb = Epi::PERM ? ((R & ~31) + perm32(R & 31)) : R;
        voffA[i] = (unsigned)(R * K + C) * 2u; voffB[i] = (unsigned)(Rb * K + C) * 2u; }
    const size_t kstep = (size_t)(BK * 2);
    const size_t hstep = (size_t)HALF * K * 2;
    const size_t tstep = 2 * hstep;
    const unsigned ldsw = (unsigned)wid * 1024u;
    const int aoff = lds_byte(wr * 64 + fr, fq * 8), boff = lds_byte(wc * 32 + fr, fq * 8);
#define PG8_SA(b, h) (((b) * 2 + (h)) * HTB)
#define PG8_SB(b, h) ((4 + (b) * 2 + (h)) * HTB)
#define PG8_STAGE(bufoff, gbase, voff) do { _Pragma("unroll") for (int _i = 0; _i < 2; ++_i) \
        __builtin_amdgcn_global_load_lds((const unsigned*)((const char*)(gbase) + (voff)[_i]), (PG8_LAS unsigned*)(lds + (bufoff) + ldsw + _i * 8192), 16, 0, 0); } while (0)
#define PG8_LDA(dst, b, h) do { _Pragma("unroll") for (int m = 0; m < 4; ++m) _Pragma("unroll") for (int k = 0; k < 2; ++k) dst[m][k] = *(const PG8_LAS bf16x8*)(lds + PG8_SA(b, h) + aoff + m * 2048 + k * 1024); } while (0)
#define PG8_LDB(dst, b, h) do { _Pragma("unroll") for (int n = 0; n < 2; ++n) _Pragma("unroll") for (int k = 0; k < 2; ++k) dst[n][k] = *(const PG8_LAS bf16x8*)(lds + PG8_SB(b, h) + boff + n * 2048 + k * 1024); } while (0)
#define PG8_MMA(ai, bj, At, Bt) do { __builtin_amdgcn_s_setprio(1); _Pragma("unroll") for (int m = 0; m < 4; ++m) _Pragma("unroll") for (int n = 0; n < 2; ++n) _Pragma("unroll") for (int k = 0; k < 2; ++k) \
        acc[ai][bj][m][n] = __builtin_amdgcn_mfma_f32_16x16x32_bf16(Bt[n][k], At[m][k], acc[ai][bj][m][n], 0, 0, 0); __builtin_amdgcn_s_setprio(0); } while (0)
#define PG8_WAIT_V(n) asm volatile("s_waitcnt vmcnt(" #n ")" ::: "memory")
#define PG8_WAIT_L(n) asm volatile("s_waitcnt lgkmcnt(" #n ")" ::: "memory")
#define PG8_BAR __builtin_amdgcn_s_barrier()
#define PG8_SCHED __builtin_amdgcn_sched_barrier(0)
    Unit cur, nxt; int ui = 0;
    if (!S.next(0, cur)) return;
    f32x4 acc[2][2][4][2];
#pragma unroll
    for (int a = 0; a < 2; ++a)
#pragma unroll
        for (int b = 0; b < 2; ++b)
#pragma unroll
            for (int m = 0; m < 4; ++m)
#pragma unroll
                for (int n = 0; n < 2; ++n) acc[a][b][m][n] = (f32x4){0.f, 0.f, 0.f, 0.f};
    bf16x8 At[4][2], B0[2][2], B1[2][2];
    const char* cA = (const char*)g.A + (size_t)cur.pm * tstep; const char* cB = (const char*)g.Bt + (size_t)cur.pn * tstep;
    S.a_ready(cur);
    if constexpr (SP2) {
        PG8_STAGE(PG8_SB(0, 0), cB, voffB); PG8_STAGE(PG8_SB(0, 1), cB + hstep, voffB); PG8_STAGE(PG8_SA(0, 0), cA, voffA); PG8_STAGE(PG8_SA(0, 1), cA + hstep, voffA);
        if (wr == 1) PG8_BAR;
        PG8_WAIT_V(2); PG8_BAR;
        PG8_STAGE(PG8_SB(1, 0), cB + kstep, voffB); PG8_STAGE(PG8_SA(1, 0), cA + kstep, voffA); PG8_STAGE(PG8_SB(1, 1), cB + hstep + kstep, voffB);
        PG8_WAIT_V(6); PG8_BAR;
    } else {
        PG8_STAGE(PG8_SB(0, 0), cB, voffB); PG8_STAGE(PG8_SA(0, 0), cA, voffA); PG8_STAGE(PG8_SB(0, 1), cB + hstep, voffB); PG8_STAGE(PG8_SA(0, 1), cA + hstep, voffA);
        if (wr == 1) PG8_BAR;
        PG8_WAIT_V(4); PG8_BAR;
        PG8_STAGE(PG8_SB(1, 0), cB + kstep, voffB); PG8_STAGE(PG8_SA(1, 0), cA + kstep, voffA); PG8_STAGE(PG8_SB(1, 1), cB + hstep + kstep, voffB);
        PG8_WAIT_V(6); PG8_BAR;
    }
    for (;;) {
        const bool has_next = S.next(ui + 1, nxt);
        const char* nA = has_next ? (const char*)g.A + (size_t)nxt.pm * tstep : cA; const char* nB = has_next ? (const char*)g.Bt + (size_t)nxt.pn * tstep : cB;
        for (int t = 0; t < nt; t += 2) {
            const bool last = (t == nt - 2);
            const char* a1 = cA + (size_t)(t + 1) * kstep;
            const char* a2 = last ? nA : cA + (size_t)(t + 2) * kstep; const char* b2 = last ? nB : cB + (size_t)(t + 2) * kstep;
            const char* a3 = a2 + kstep; const char* b3 = b2 + kstep;
            if (last && has_next) S.a_ready(nxt);
            if constexpr (SP2) {
            PG8_LDB(B0, 0, 0); PG8_LDB(B1, 0, 1); PG8_SCHED; PG8_LDA(At, 0, 0); PG8_STAGE(PG8_SA(1, 1), a1 + hstep, voffA);
            PG8_WAIT_V(8); PG8_WAIT_L(0); PG8_BAR; PG8_MMA(0, 0, At, B0); PG8_MMA(0, 1, At, B1); PG8_BAR; PG8_SCHED;
            PG8_LDA(At, 0, 1); PG8_STAGE(PG8_SB(0, 0), b2, voffB); PG8_STAGE(PG8_SB(0, 1), b2 + hstep, voffB); PG8_STAGE(PG8_SA(0, 0), a2, voffA);
            PG8_WAIT_V(8); PG8_WAIT_L(0); PG8_BAR; PG8_MMA(1, 0, At, B0); PG8_MMA(1, 1, At, B1); PG8_BAR; PG8_SCHED;
            PG8_LDB(B0, 1, 0); PG8_LDB(B1, 1, 1); PG8_SCHED; PG8_LDA(At, 1, 0); PG8_STAGE(PG8_SA(0, 1), a2 + hstep, voffA);
            PG8_WAIT_V(8); PG8_WAIT_L(0); PG8_BAR; PG8_MMA(0, 0, At, B0); PG8_MMA(0, 1, At, B1); PG8_BAR; PG8_SCHED;
            PG8_LDA(At, 1, 1); PG8_STAGE(PG8_SB(1, 0), b3, voffB); PG8_STAGE(PG8_SB(1, 1), b3 + hstep, voffB); PG8_STAGE(PG8_SA(1, 0), a3, voffA);
            PG8_WAIT_V(8); PG8_WAIT_L(0); PG8_BAR; PG8_MMA(1, 0, At, B0); PG8_MMA(1, 1, At, B1); PG8_BAR; PG8_SCHED;
            } else {
            PG8_LDB(B0, 0, 0); PG8_SCHED; PG8_LDA(At, 0, 0); PG8_STAGE(PG8_SA(1, 1), a1 + hstep, voffA);
            PG8_WAIT_L(8); PG8_BAR; PG8_WAIT_L(0); PG8_MMA(0, 0, At, B0); PG8_BAR; PG8_SCHED;
            PG8_LDB(B1, 0, 1); PG8_STAGE(PG8_SB(0, 0), b2, voffB);
            PG8_BAR; PG8_WAIT_L(0); PG8_MMA(0, 1, At, B1); PG8_BAR;
            PG8_LDA(At, 0, 1); PG8_STAGE(PG8_SA(0, 0), a2, voffA);
            PG8_BAR; PG8_WAIT_L(0); PG8_MMA(1, 0, At, B0); PG8_BAR; PG8_SCHED;
            PG8_STAGE(PG8_SB(0, 1), b2 + hstep, voffB);
            PG8_WAIT_V(6); PG8_BAR; PG8_MMA(1, 1, At, B1); PG8_BAR;
            PG8_LDB(B0, 1, 0); PG8_SCHED; PG8_LDA(At, 1, 0); PG8_STAGE(PG8_SA(0, 1), a2 + hstep, voffA);
            PG8_WAIT_L(8); PG8_BAR; PG8_WAIT_L(0); PG8_MMA(0, 0, At, B0); PG8_BAR; PG8_SCHED;
            PG8_LDB(B1, 1, 1); PG8_STAGE(PG8_SB(1, 0), b3, voffB);
            PG8_BAR; PG8_WAIT_L(0); PG8_MMA(0, 1, At, B1); PG8_BAR;
            PG8_LDA(At, 1, 1); PG8_STAGE(PG8_SA(1, 0), a3, voffA);
            PG8_BAR; PG8_WAIT_L(0); PG8_MMA(1, 0, At, B0); PG8_BAR; PG8_SCHED;
            PG8_STAGE(PG8_SB(1, 1), b3 + hstep, voffB);
            PG8_WAIT_V(6); PG8_BAR; PG8_MMA(1, 1, At, B1); PG8_BAR;
            }
        }
        if constexpr (ALIGN_EPI) { if (wr == 0) PG8_BAR; }
        if constexpr (!Epi::AFTER_DRAIN) { E(acc, cur, wr, wc, fr, fq); S.done(cur); }
        if (!has_next) break;
#pragma unroll
        for (int a = 0; a < 2; ++a)
#pragma unroll
            for (int b = 0; b < 2; ++b)
#pragma unroll
                for (int m = 0; m < 4; ++m)
#pragma unroll
                    for (int n = 0; n < 2; ++n) acc[a][b][m][n] = (f32x4){0.f, 0.f, 0.f, 0.f};
        cur = nxt; cA = nA; cB = nB; ++ui;
        if constexpr (ALIGN_EPI) { if (wr == 1) PG8_BAR; }
    }
    PG8_WAIT_V(0);
    if constexpr (!ALIGN_EPI) { if (wr == 0) PG8_BAR; }
    PG8_BAR;
    if constexpr (Epi::AFTER_DRAIN) { E.fused(acc, cur, wr, wc, fr, fq, lds, wid, lane); S.done(cur); }
#undef PG8_SA
#undef PG8_SB
#undef PG8_STAGE
#undef PG8_LDA
#undef PG8_LDB
#undef PG8_MMA
#undef PG8_WAIT_V
#undef PG8_WAIT_L
#undef PG8_BAR
#undef PG8_SCHED
}
}

#define PG8_SP2 true
#define PG8_ALIGN true
namespace attn_body {
using bf16=__hip_bfloat16;
using bf16x8=__attribute__((ext_vector_type(8)))short;
using s16x4=__attribute__((ext_vector_type(4)))short;
using f32x16=__attribute__((ext_vector_type(16)))float;
using u32x4=__attribute__((ext_vector_type(4)))unsigned;
constexpr int BATCH=8,NHEAD=6,SEQ=4096,D=64,DM=3328,OPITCH=1024;
constexpr int NW=8,QBLK=32,QB=QBLK*NW,KVBLK=64,NQB=SEQ/QB;
constexpr int ATTN_PITCH=DM, ATTN_UNIT_ROWS=QB;
__device__ __forceinline__ int crow(int r,int hi){return (r&3)+8*(r>>2)+4*hi;}
#define SBAR() __builtin_amdgcn_sched_barrier(0)
__device__ __forceinline__ void cmask(f32x16&p0,f32x16&p1,int jb,int qrel,int hi){
  const float NEG=-INFINITY; int kb=64*jb+4*hi;
  #pragma unroll
  for(int r=0;r<16;++r){int kv=kb+(r&3)+8*(r>>2); if(kv>qrel)p0[r]=NEG; if(kv+32>qrel)p1[r]=NEG;}
}

constexpr int NSLOT=3, SLOTB=8192;
constexpr int LDS_K=0, LDS_V=NSLOT*SLOTB, LDS_WS=2*NSLOT*SLOTB, LDS_OST=LDS_WS+NW*64*4, LDS_OST1=LDS_OST+NW*4096, LDS_BYTES=LDS_OST1+NW*4096;
constexpr float C2=0.17677669529663687f*1.4426950408889634f;
__device__ __forceinline__ void glds16(const void*gsrc,unsigned lds_dst){unsigned keep;
  asm volatile("s_mov_b32 %0, m0\n\ts_mov_b32 m0, %2\n\ts_nop 0\n\tglobal_load_lds_dwordx4 %1, off\n\ts_mov_b32 m0, %0":"=&s"(keep):"v"(gsrc),"s"(lds_dst):"memory");}
__device__ __forceinline__ float max3f(float a,float b,float c){float r;asm("v_max3_f32 %0, %1, %2, %3":"=v"(r):"v"(a),"v"(b),"v"(c));return r;}
__device__ __forceinline__ float max2f(float a,float b){float r;asm("v_max_f32_e32 %0, %1, %2":"=v"(r):"v"(a),"v"(b));return r;}
__device__ __forceinline__ float fadd_s(float a,float b){float r;asm("v_add_f32_e32 %0, %1, %2":"=v"(r):"v"(a),"v"(b));return r;}
__device__ __forceinline__ float fsub_s(float a,float b){float r;asm("v_sub_f32_e32 %0, %1, %2":"=v"(r):"v"(a),"v"(b));return r;}
typedef float f32x2_t __attribute__((ext_vector_type(2))); typedef __bf16 bf16x2_t __attribute__((ext_vector_type(2)));
__device__ __forceinline__ unsigned cvtpk_s(float lo,float hi){f32x2_t v={lo,hi};bf16x2_t b=__builtin_convertvector(v,bf16x2_t);return __builtin_bit_cast(unsigned,b);}
#define WAIT_BAR(N) asm volatile("s_waitcnt vmcnt(" #N ") lgkmcnt(0)\n\ts_barrier":::"memory")

__device__ __forceinline__ void qkt(f32x16&p0,f32x16&p1,const char*Kslot,const bf16x8*qr,const f32x16&negm,int r32,int hi){
  const char*kb=Kslot+hi*1024+r32*16;
  #pragma unroll
  for(int d0=0;d0<4;++d0){
    const bf16x8 b0=*reinterpret_cast<const bf16x8*>(kb+d0*2048);
    const bf16x8 b1=*reinterpret_cast<const bf16x8*>(kb+d0*2048+512);
    if(d0==0){p0=__builtin_amdgcn_mfma_f32_32x32x16_bf16(b0,qr[0],negm,0,0,0);p1=__builtin_amdgcn_mfma_f32_32x32x16_bf16(b1,qr[0],negm,0,0,0);}
    else{p0=__builtin_amdgcn_mfma_f32_32x32x16_bf16(b0,qr[d0],p0,0,0,0);p1=__builtin_amdgcn_mfma_f32_32x32x16_bf16(b1,qr[d0],p1,0,0,0);}}
}
typedef __attribute__((address_space(3))) const char* lds_cptr;
typedef short v4i16_t __attribute__((ext_vector_type(4)));
__device__ __forceinline__ void kload8(bf16x8*kf,lds_cptr kp){
  kf[0]=*(const __attribute__((address_space(3))) bf16x8*)(kp);      kf[1]=*(const __attribute__((address_space(3))) bf16x8*)(kp+512);
  kf[2]=*(const __attribute__((address_space(3))) bf16x8*)(kp+2048); kf[3]=*(const __attribute__((address_space(3))) bf16x8*)(kp+2560);
  kf[4]=*(const __attribute__((address_space(3))) bf16x8*)(kp+4096); kf[5]=*(const __attribute__((address_space(3))) bf16x8*)(kp+4608);
  kf[6]=*(const __attribute__((address_space(3))) bf16x8*)(kp+6144); kf[7]=*(const __attribute__((address_space(3))) bf16x8*)(kp+6656);
}
__device__ __forceinline__ void kload2(bf16x8*kf,lds_cptr kp,int j){ kf[2*j]=*(const __attribute__((address_space(3))) bf16x8*)(kp+j*2048); kf[2*j+1]=*(const __attribute__((address_space(3))) bf16x8*)(kp+j*2048+512); }
__device__ __forceinline__ s16x4 vtr(lds_cptr p){ return __builtin_bit_cast(s16x4,__builtin_amdgcn_ds_read_tr16_b64_v4i16((__attribute__((address_space(3))) v4i16_t*)p)); }
__device__ __forceinline__ float rowmax(const f32x16&p0,const f32x16&p1){
  float a=max3f(p0[0],p0[1],p1[0]),b=max3f(p0[2],p0[3],p1[1]);a=max3f(a,p1[2],p1[3]);
  #pragma unroll
  for(int r=4;r<16;r+=4){a=max3f(a,p0[r],p0[r+1]);b=max3f(b,p0[r+2],p0[r+3]);a=max3f(a,p1[r],p1[r+1]);b=max3f(b,p1[r+2],p1[r+3]);}
  const float m=max2f(a,b);
  auto rr=__builtin_amdgcn_permlane32_swap(__float_as_uint(m),__float_as_uint(m),false,false);
  return max2f(__uint_as_float(rr[0]),__uint_as_float(rr[1]));
}
__device__ __forceinline__ void pv(f32x16*o,int vb,bf16x8 pa0,bf16x8 pa1,bf16x8 pa2,bf16x8 pa3){
  #pragma unroll
  for(int d0=0;d0<2;++d0){s16x4 lo[4],hi[4];
    #pragma unroll
    for(int ks=0;ks<4;++ks){
      asm volatile("ds_read_b64_tr_b16 %0,%1 offset:%c2":"=&v"(lo[ks]):"v"(vb),"i"(d0*4096+ks*1024):"memory");
      asm volatile("ds_read_b64_tr_b16 %0,%1 offset:%c2":"=&v"(hi[ks]):"v"(vb),"i"(d0*4096+ks*1024+512):"memory");}
    asm volatile("s_waitcnt lgkmcnt(0)":::"memory");SBAR();
    #define PK(k) (bf16x8){lo[k][0],lo[k][1],lo[k][2],lo[k][3],hi[k][0],hi[k][1],hi[k][2],hi[k][3]}
    o[d0]=__builtin_amdgcn_mfma_f32_32x32x16_bf16(pa0,PK(0),o[d0],0,0,0);
    o[d0]=__builtin_amdgcn_mfma_f32_32x32x16_bf16(pa1,PK(1),o[d0],0,0,0);
    o[d0]=__builtin_amdgcn_mfma_f32_32x32x16_bf16(pa2,PK(2),o[d0],0,0,0);
    o[d0]=__builtin_amdgcn_mfma_f32_32x32x16_bf16(pa3,PK(3),o[d0],0,0,0);
    #undef PK
  }
}

#ifndef ATTN_STORE16
#define ATTN_STORE16(p,v) (*(u32x4*)(p)=(v))
#endif
template<int THRL> __device__ __forceinline__ void attn_unit(int b,int h,int qb,int nsel,float lam,const float*subg,float omli,const bf16*Q,const bf16*__restrict__ K,const bf16*__restrict__ V,bf16*O,char*shm){
  int tid_=threadIdx.x; asm volatile("":"+v"(tid_)); const int tid=tid_,lane=tid&63,r32=lane&31,hi=lane>>5; const int wid=__builtin_amdgcn_readfirstlane(tid>>6);
  const long rowbase=(long)b*SEQ; const int q0=qb*QB;
  const bf16*Qw=Q+(rowbase+q0+wid*QBLK)*DM+h*D;
  const bf16*Kh=K+rowbase*DM+h*D,*Vh=V+rowbase*DM+h*D;
  const unsigned lds0=(unsigned)(uintptr_t)shm;
  float*wsf=(float*)(shm+LDS_WS)+wid*64;
  const bf16*ksrc=Kh+(long)lane*DM+wid*8;
  const bf16*vsrc=Vh+(long)(16*(wid&3)+(lane>>2))*DM+(wid>>2)*32+(lane&3)*8;
  const unsigned kdst=lds0+LDS_K+wid*1024, vdst=lds0+LDS_V+wid*1024;
  #define DMA_K(t,slot) glds16(ksrc+(long)(t)*KVBLK*DM,(unsigned)__builtin_amdgcn_readfirstlane(kdst+(slot)))
  #define DMA_V(t,slot) glds16(vsrc+(long)(t)*KVBLK*DM,(unsigned)__builtin_amdgcn_readfirstlane(vdst+(slot)))
  const int vb0=(int)(lds0+LDS_V)+((lane>>4)&1)*32+(lane&3)*8+(4*hi+((lane&15)>>2))*64;
  const char*Kbase=shm+LDS_K; bf16x8 kf[8];
  const lds_cptr shm3=(lds_cptr)shm; const lds_cptr kp0=shm3+LDS_K+hi*1024+r32*16; const lds_cptr vp0=shm3+LDS_V+((lane>>4)&1)*32+(lane&3)*8+(4*hi+((lane&15)>>2))*64;
  const int NT=(q0+QB)/KVBLK;
  DMA_K(0,0);DMA_V(0,0);DMA_K(1,SLOTB);
  bf16x8 qr[4];
  #pragma unroll
  for(int d0=0;d0<4;++d0){qr[d0]=*reinterpret_cast<const bf16x8*>(&Qw[(long)r32*DM+d0*16+hi*8]); if((d0>>1)!=nsel)qr[d0]=bf16x8{0,0,0,0,0,0,0,0};}
  float mhat=0.f,l_reg=0.f;f32x16 o[2];o[0]=f32x16{};o[1]=f32x16{};f32x16 negm=f32x16{};asm volatile("":"+v"(negm));
  const int qrel=wid*QBLK+r32;
  #define CMASK(P0,P1,t) do{int jb_=(t)-(NT-4); if(jb_>=0)cmask(P0,P1,jb_,qrel,hi);}while(0)
  bool resc=false;
  #define START(P0,P1) do{ const float rm=rowmax(P0,P1); resc=false; \
    { const float dl=rm; mhat=fadd_s(mhat,dl); \
      _Pragma("unroll") for(int r=0;r<16;++r){P0[r]=fsub_s(P0[r],dl);P1[r]=fsub_s(P1[r],dl);} \
      _Pragma("unroll") for(int r=0;r<16;++r)negm[r]=-mhat; asm volatile("":"+v"(negm)); } \
    _Pragma("unroll") for(int r=0;r<16;++r)P0[r]=__builtin_amdgcn_exp2f(P0[r]); }while(0)
  #define RESC() do{ if(resc){ asm volatile("s_waitcnt lgkmcnt(0)":::"memory"); \
      _Pragma("unroll") for(int d_=0;d_<2;++d_) _Pragma("unroll") for(int r=0;r<16;++r)o[d_][r]*=wsf[crow(r,hi)]; } }while(0)
  f32x16 pA0,pA1,pB0,pB1;
  int sl_prev=0,sl_cur=0,sl_next=SLOTB;
  #define ROT() do{sl_prev=sl_cur;sl_cur=sl_next;sl_next=(sl_next==(NSLOT-1)*SLOTB)?0:sl_next+SLOTB;}while(0)
  DMA_K(2,2*SLOTB);
  WAIT_BAR(3);
  qkt(pA0,pA1,Kbase,qr,negm,r32,hi);asm volatile("s_nop 15\n\ts_nop 7":"+v"(pA0),"+v"(pA1));CMASK(pA0,pA1,0);
  START(pA0,pA1);
  _Pragma("unroll") for(int r=0;r<16;++r)pA1[r]=__builtin_amdgcn_exp2f(pA1[r]);
  WAIT_BAR(0);
  DMA_K(3,0);DMA_V(1,SLOTB);
  ROT();
  kload8(kf,kp0+sl_cur);
  WAIT_BAR(2);
  s16x4 vlo[8],vhi[8]; u32x4 pw0,pw1,pw2,pw3;
  #define PKW(P,B) cvtpk_s(P[B],P[B+1])
  #define PAF(k) __builtin_bit_cast(bf16x8,pw##k)
  #define VFR(i) (bf16x8){vlo[i][0],vlo[i][1],vlo[i][2],vlo[i][3],vhi[i][0],vhi[i][1],vhi[i][2],vhi[i][3]}
  #define PIN(x) asm volatile("":"+v"(x))
  #define MX3(a,b,c) __builtin_fmaxf(__builtin_fmaxf((a),(b)),(c))
  #define GAPA(MF,A0,A1,A2,A3,W0,W1,PW) do{ MF; sacc+=A0; sacc+=A1; sacc+=A2; sacc+=A3; PIN(sacc); W0; W1; PIN(PW); SBAR(); }while(0)
  #define EX(v) __builtin_amdgcn_exp2f(v)
  #define GAPB(MF,X,B) do{ MF; X[B]=EX(X[B]); X[B+1]=EX(X[B+1]); X[B+2]=EX(X[B+2]); X[B+3]=EX(X[B+3]); PIN(X); SBAR(); }while(0)
  #define VRD(i) do{ vlo[i]=vtr(vp_+(((i)>>2)*4096+((i)&3)*1024)); vhi[i]=vtr(vp_+(((i)>>2)*4096+((i)&3)*1024+512)); }while(0)
  #define KRD(G,j) do{ if(G){ kload2(kf,kp0+sl_next,j); SBAR(); } }while(0)
  #define STEP(C0,C1,P0,P1,t,GK,GV,GL) do{ SBAR(); \
    const lds_cptr vp_=vp0+sl_prev; \
    VRD(0); SBAR(); float sacc=(P0[0]+P0[1]); \
    GAPA(C0=__builtin_amdgcn_mfma_f32_32x32x16_bf16(kf[0],qr[0],negm,0,0,0), P0[2],P0[3],P0[4],P0[5],     pw0[0]=PKW(P0,0), pw0[1]=PKW(P0,2), pw0); \
    VRD(4); SBAR(); GAPA(C1=__builtin_amdgcn_mfma_f32_32x32x16_bf16(kf[1],qr[0],negm,0,0,0), P0[6],P0[7],P0[8],P0[9],     pw0[2]=PKW(P0,4), pw0[3]=PKW(P0,6), pw0); \
    VRD(1); SBAR(); GAPA(C0=__builtin_amdgcn_mfma_f32_32x32x16_bf16(kf[2],qr[1],C0,0,0,0),   P0[10],P0[11],P0[12],P0[13], pw1[0]=PKW(P0,8), pw1[1]=PKW(P0,10), pw1); \
    VRD(5); SBAR(); GAPA(C1=__builtin_amdgcn_mfma_f32_32x32x16_bf16(kf[3],qr[1],C1,0,0,0),   P0[14],P0[15],P1[0],P1[1],   pw1[2]=PKW(P0,12),pw1[3]=PKW(P0,14), pw1); \
    VRD(2); SBAR(); GAPA(C0=__builtin_amdgcn_mfma_f32_32x32x16_bf16(kf[4],qr[2],C0,0,0,0),   P1[2],P1[3],P1[4],P1[5],     pw2[0]=PKW(P1,0), pw2[1]=PKW(P1,2), pw2); \
    VRD(6); SBAR(); GAPA(C1=__builtin_amdgcn_mfma_f32_32x32x16_bf16(kf[5],qr[2],C1,0,0,0),   P1[6],P1[7],P1[8],P1[9],     pw2[2]=PKW(P1,4), pw2[3]=PKW(P1,6), pw2); \
    VRD(3); SBAR(); GAPA(C0=__builtin_amdgcn_mfma_f32_32x32x16_bf16(kf[6],qr[3],C0,0,0,0),   P1[10],P1[11],P1[12],P1[13], pw3[0]=PKW(P1,8), pw3[1]=PKW(P1,10), pw3); \
    VRD(7); SBAR(); GAPA(C1=__builtin_amdgcn_mfma_f32_32x32x16_bf16(kf[7],qr[3],C1,0,0,0),   P1[14],P1[15],0.f,0.f,       pw3[2]=PKW(P1,12),pw3[3]=PKW(P1,14), pw3); \
    l_reg+=sacc; \
    if(GK){DMA_K((t)+3,sl_cur);} if(GV){DMA_V((t)+1,sl_next);} \
    CMASK(C0,C1,t); \
    { float a=MX3(C0[0],C0[1],C1[0]),b=MX3(C0[2],C0[3],C1[1]); a=MX3(a,C1[2],C1[3]); \
      _Pragma("unroll") for(int r=4;r<16;r+=4){a=MX3(a,C0[r],C0[r+1]);b=MX3(b,C0[r+2],C0[r+3]);a=MX3(a,C1[r],C1[r+1]);b=MX3(b,C1[r+2],C1[r+3]);} \
      float rm=__builtin_fmaxf(a,b); { auto rr=__builtin_amdgcn_permlane32_swap(__float_as_uint(rm),__float_as_uint(rm),false,false); rm=__builtin_fmaxf(__uint_as_float(rr[0]),__uint_as_float(rr[1])); } \
      resc=false; \
      if(__builtin_expect(__any(rm>(float)THRL),0)){ const float dl=__builtin_fmaxf(rm,0.f); mhat+=dl; \
        _Pragma("unroll") for(int r=0;r<16;++r){C0[r]-=dl;C1[r]-=dl;} \
        _Pragma("unroll") for(int r=0;r<16;++r)negm[r]=-mhat; asm volatile("":"+v"(negm)); \
        const float f=__builtin_amdgcn_exp2f(-dl); l_reg*=f; if(hi==0)wsf[r32]=f; resc=true; } } \
    SBAR(); \
    GAPB(o[0]=__builtin_amdgcn_mfma_f32_32x32x16_bf16(PAF(0),VFR(0),o[0],0,0,0), C0,0); \
    GAPB(o[1]=__builtin_amdgcn_mfma_f32_32x32x16_bf16(PAF(0),VFR(4),o[1],0,0,0), C0,4); \
    KRD(GL,0); GAPB(o[0]=__builtin_amdgcn_mfma_f32_32x32x16_bf16(PAF(1),VFR(1),o[0],0,0,0), C0,8); \
    KRD(GL,1); GAPB(o[1]=__builtin_amdgcn_mfma_f32_32x32x16_bf16(PAF(1),VFR(5),o[1],0,0,0), C0,12); \
    KRD(GL,2); GAPB(o[0]=__builtin_amdgcn_mfma_f32_32x32x16_bf16(PAF(2),VFR(2),o[0],0,0,0), C1,0); \
    KRD(GL,3); GAPB(o[1]=__builtin_amdgcn_mfma_f32_32x32x16_bf16(PAF(2),VFR(6),o[1],0,0,0), C1,4); \
    GAPB(o[0]=__builtin_amdgcn_mfma_f32_32x32x16_bf16(PAF(3),VFR(3),o[0],0,0,0), C1,8); \
    GAPB(o[1]=__builtin_amdgcn_mfma_f32_32x32x16_bf16(PAF(3),VFR(7),o[1],0,0,0), C1,12); \
    }while(0)
  int t=1;
  #undef CMASK
  #define CMASK(P0,P1,t) do{}while(0)
  for(;t+5<NT;t+=2){
    STEP(pB0,pB1,pA0,pA1,t,true,true,true);     WAIT_BAR(2); RESC(); ROT();
    STEP(pA0,pA1,pB0,pB1,t+1,true,true,true);   WAIT_BAR(2); RESC(); ROT();
  }
  #undef CMASK
  #define CMASK(P0,P1,t) do{int jb_=(t)-(NT-4); if(jb_>=0)cmask(P0,P1,jb_,qrel,hi);}while(0)
  #define ENDW(tt) do{ if((tt)+3<NT){WAIT_BAR(2);} else if((tt)+2<NT){WAIT_BAR(1);} else {WAIT_BAR(0);} }while(0)
  for(;t+1<NT;t+=2){
    STEP(pB0,pB1,pA0,pA1,t,(t+3<NT),(t+1<NT),(t+1<NT));       ENDW(t);   RESC(); ROT();
    STEP(pA0,pA1,pB0,pB1,t+1,(t+4<NT),(t+2<NT),(t+2<NT));     ENDW(t+1); RESC(); ROT();
  }
  STEP(pB0,pB1,pA0,pA1,NT-1,false,false,false); RESC();
  { float sacc=pB0[0]+pB0[1]; _Pragma("unroll") for(int r=2;r<16;++r)sacc+=pB0[r]; _Pragma("unroll") for(int r=0;r<16;++r)sacc+=pB1[r]; l_reg+=sacc;
    pw0=(u32x4){PKW(pB0,0),PKW(pB0,2),PKW(pB0,4),PKW(pB0,6)};pw1=(u32x4){PKW(pB0,8),PKW(pB0,10),PKW(pB0,12),PKW(pB0,14)};pw2=(u32x4){PKW(pB1,0),PKW(pB1,2),PKW(pB1,4),PKW(pB1,6)};pw3=(u32x4){PKW(pB1,8),PKW(pB1,10),PKW(pB1,12),PKW(pB1,14)};
    SBAR(); pv(o,vb0+sl_cur,PAF(0),PAF(1),PAF(2),PAF(3)); }
  #undef PKW
  #undef PAF
  #undef VFR
  #undef PIN
  #undef MX3
  #undef GAPA
  #undef GAPB
  #undef EX
  #undef VRD
  #undef KRD
  #undef STEP
  #undef ENDW
  {auto rr=__builtin_amdgcn_permlane32_swap(__float_as_uint(l_reg),__float_as_uint(l_reg),false,false);l_reg=__uint_as_float(rr[0])+__uint_as_float(rr[1]);}
  if(hi==0)wsf[32+r32]=l_reg;asm volatile("s_waitcnt lgkmcnt(0)":::"memory");
  float rli[16];
  #pragma unroll
  for(int r=0;r<16;++r)rli[r]=__builtin_amdgcn_rcpf(wsf[32+crow(r,hi)]);
  bf16*Ow=O+(rowbase+q0+wid*QBLK)*OPITCH+h*D;
  { bf16*stg=(bf16*)(shm+(nsel==0?LDS_OST1:LDS_OST))+wid*2048;
    #pragma unroll
    for(int r=0;r<16;++r){const int orow=crow(r,hi);
      #pragma unroll
      for(int d0=0;d0<2;++d0)stg[orow*64+d0*32+r32]=__float2bfloat16(o[d0][r]*rli[r]);}
    asm volatile("s_waitcnt lgkmcnt(0)":::"memory");
    if(nsel==1){ const bf16*stg1=(const bf16*)(shm+LDS_OST1)+wid*2048;
      #pragma unroll
      for(int i=0;i<4;++i){const int row=i*8+(lane>>3),ch=lane&7; const u32x4 v2=*(const u32x4*)(stg+row*64+ch*8); const u32x4 v1=*(const u32x4*)(stg1+row*64+ch*8);
        float dd[8]; float ss=0.f;
        #pragma unroll
        for(int j=0;j<4;++j){ const float a0=__uint_as_float(v1[j]<<16),a1=__uint_as_float(v1[j]&0xffff0000u),b0=__uint_as_float(v2[j]<<16),b1=__uint_as_float(v2[j]&0xffff0000u);
          dd[2*j]=a0-lam*b0; dd[2*j+1]=a1-lam*b1; ss+=dd[2*j]*dd[2*j]+dd[2*j+1]*dd[2*j+1]; }
        ss+=__shfl_xor(ss,1); ss+=__shfl_xor(ss,2); ss+=__shfl_xor(ss,4);
        const float rs=omli/sqrtf(ss*(1.0f/64.0f)+1e-6f);
        u32x4 w;
        #pragma unroll
        for(int j=0;j<4;++j) w[j]=cvtpk_s(dd[2*j]*rs*subg[ch*8+2*j],dd[2*j+1]*rs*subg[ch*8+2*j+1]);
        ATTN_STORE16(Ow+(long)row*OPITCH+ch*8,w);} } }
  asm volatile("s_waitcnt lgkmcnt(0)\n\ts_barrier":::"memory");
  #undef DMA_K
  #undef DMA_V
  #undef CMASK
  #undef START
  #undef RESC
  #undef ROT

}
#undef SBAR
#undef WAIT_BAR
}
#ifndef GOFF
#define GOFF 0
#endif
#define GEMMCALL0 if (!((GOFF) & 1))
#define GEMMCALL1 if (!((GOFF) & 2))
#define GEMMCALL2 if (!((GOFF) & 4))
#define GEMMCALL3 if (!((GOFF) & 8))
namespace cg = cooperative_groups;
#define GAS __attribute__((address_space(1)))
#define LAS __attribute__((address_space(3)))
#define DI __device__ __forceinline__
typedef unsigned short bf16;
typedef unsigned v4u __attribute__((ext_vector_type(4)));
typedef unsigned v2u __attribute__((ext_vector_type(2)));
typedef float f32x4 __attribute__((ext_vector_type(4)));
typedef short bf16x8 __attribute__((ext_vector_type(8)));

constexpr int NWAVES = 8;
constexpr int DMODEL = 1024, SEQ = 4096, M = 32768, NIN = 3328, FF = 4096;
constexpr int RW = 384, RCOLS = 1408, ROFF = 1920, COFF = 1152;
constexpr float NORM_EPS = 1e-6f, GN_EPS = 64e-5f;
constexpr size_t MiB = 1u << 20;
constexpr size_t WS_CTL = 0, CTL_ZERO_BYTES = 65536;
constexpr int CW_BAR = 4096;
constexpr size_t WS_WIN = 1 * MiB, WS_WOUT = 14 * MiB, WS_WUP = 18 * MiB, WS_WDN = 34 * MiB, WS_LORA = 50 * MiB;
constexpr size_t WS_XB = 51 * MiB, WS_PROJ = 115 * MiB, WS_MIX = 323 * MiB, WS_S = 387 * MiB, WS_END = 507 * MiB;
constexpr size_t WS_HID = 115 * MiB;
constexpr size_t SARR = (size_t)M * RW;
constexpr int LORA_L = 384 * 64 * 2 + 384 * 128;
constexpr int LDS_BYTES = 147456, MISC_OFF = 131072;
constexpr int SCAN_WGS = 96, ATT_ITEMS = 768;

#ifndef PROBE
#define PROBE 0
#endif
struct Args { const float* in[25]; float* out; unsigned char* ws; int i0, i1; };

DI float wave_sum(float v) {
#pragma unroll
    for (int o = 1; o < 64; o <<= 1) v += __shfl_xor(v, o);
    return v;
}
DI unsigned f2bf(float f) { unsigned u = __builtin_bit_cast(unsigned, f); return (u + 0x7fffu + ((u >> 16) & 1u)) >> 16; }
DI unsigned pk2(float lo, float hi) { return f2bf(lo) | (f2bf(hi) << 16); }
DI float bflo(unsigned w) { return __uint_as_float(w << 16); }
DI float bfhi(unsigned w) { return __uint_as_float(w & 0xffff0000u); }
DI float bf1(const bf16* p) { return __uint_as_float(((unsigned)*p) << 16); }
DI void unpack8(v4u w, float* f) { f[0] = bflo(w.x); f[1] = bfhi(w.x); f[2] = bflo(w.y); f[3] = bfhi(w.y); f[4] = bflo(w.z); f[5] = bfhi(w.z); f[6] = bflo(w.w); f[7] = bfhi(w.w); }
DI v4u pack8(const float* f) { v4u o; o.x = pk2(f[0], f[1]); o.y = pk2(f[2], f[3]); o.z = pk2(f[4], f[5]); o.w = pk2(f[6], f[7]); return o; }
DI float sigmoidf_(float x) { return 1.f / (1.f + __expf(-x)); }
DI float tanhf_(float x) { const float e = __expf(2.f * x); return 1.f - 2.f / (e + 1.f); }
template <int CTRL> DI float dpp_add(float x) { return x + __int_as_float(__builtin_amdgcn_update_dpp(0, __float_as_int(x), CTRL, 0xf, 0xf, true)); }
DI float red16(float x) { x = dpp_add<0xB1>(x); x = dpp_add<0x4E>(x); x = dpp_add<0x141>(x); x = dpp_add<0x140>(x); return x; }

#define XB_TMO      128
#define XB_XCNT(j)  (256  + 64 * (j))
#define XB_XSUB(j)  (1280 + 64 * (j))
#define XB_XGEN(j)  (2304 + 64 * (j))
#define XB_TOP      3328
#define XB_TOPGEN   3392
#define XCD_BAR_WORDS 3456
#define XB_SPIN_CAP (1u << 18)

__device__ __forceinline__ unsigned xb_ld(unsigned* p)              { return __hip_atomic_load(p, __ATOMIC_RELAXED, __HIP_MEMORY_SCOPE_AGENT); }
__device__ __forceinline__ unsigned xb_add(unsigned* p, unsigned v) { return __hip_atomic_fetch_add(p, v, __ATOMIC_RELAXED, __HIP_MEMORY_SCOPE_AGENT); }
__device__ __forceinline__ unsigned xb_xcc_id() { return (unsigned)__builtin_amdgcn_s_getreg((3 << 11) | 20) & 0xFu; }
#define XB_SPIN(cond, bar) do { unsigned _sp = 0; while (cond) { __builtin_amdgcn_s_sleep(1); \
    if ((++_sp & 255u) == 0u) { if (xb_ld(&(bar)[XB_TMO])) break; if (_sp > XB_SPIN_CAP) { atomicAdd(&(bar)[XB_TMO], 1u); break; } } } } while (0)

struct XcdBarrier {
    unsigned* bar; unsigned x;
    volatile LAS unsigned* st;
};

__device__ __forceinline__ XcdBarrier xcd_barrier_post(unsigned* bar, volatile LAS unsigned* st) {
    XcdBarrier b; b.bar = bar; b.x = xb_xcc_id(); b.st = st;
    if (threadIdx.x == 0) (void)xb_add(&bar[XB_XCNT(b.x)], 1u);
    return b;
}
__device__ __forceinline__ void xcd_barrier_complete(unsigned* bar, unsigned x, unsigned& nloc, unsigned& nx) {
    const unsigned G = gridDim.x * gridDim.y * gridDim.z;
    unsigned sum, cnt, mine, sp = 0u;
    for (;;) {
        sum = 0u; cnt = 0u; mine = 0u;
#pragma unroll
        for (unsigned j = 0; j < 16; ++j) { const unsigned c = xb_ld(&bar[XB_XCNT(j)]); sum += c; cnt += (c > 0u) ? 1u : 0u; mine = (j == x) ? c : mine; }
        if (sum == G) break;
        __builtin_amdgcn_s_sleep(1);
        if ((++sp & 255u) == 0u) { if (xb_ld(&bar[XB_TMO])) break; if (sp > XB_SPIN_CAP) { atomicAdd(&bar[XB_TMO], 1u); break; } }
    }
    nloc = mine > 0u ? mine : 1u; nx = cnt > 0u ? cnt : 1u;
}

__device__ __forceinline__ void xcd_barrier(const XcdBarrier& b) {
    asm volatile("s_waitcnt vmcnt(0)" ::: "memory");
    __syncthreads();
    if (threadIdx.x == 0) {
        unsigned* bar = b.bar;
        __builtin_amdgcn_s_waitcnt(0);
        unsigned nloc = b.st[0], nx = b.st[1];
        if (nloc == 0u) { xcd_barrier_complete(bar, b.x, nloc, nx); b.st[0] = nloc; b.st[1] = nx; }
        const unsigned old = xb_add(&bar[XB_XSUB(b.x)], 1u);
        const unsigned gen = old / nloc;
        if (old + 1u == (gen + 1u) * nloc) {
            __builtin_amdgcn_fence(__ATOMIC_RELEASE, "agent");
            asm volatile("s_waitcnt vmcnt(0)" ::: "memory");
            const unsigned og = xb_add(&bar[XB_TOP], 1u);
            const unsigned tg = og / nx;
            if (og + 1u == (tg + 1u) * nx) xb_add(&bar[XB_TOPGEN], 1u);
            else XB_SPIN(xb_ld(&bar[XB_TOPGEN]) == tg, bar);
            __builtin_amdgcn_fence(__ATOMIC_ACQUIRE, "agent");
            xb_add(&bar[XB_XGEN(b.x)], 1u);
            asm volatile("s_waitcnt vmcnt(0)" ::: "memory");
        } else {
            XB_SPIN(xb_ld(&bar[XB_XGEN(b.x)]) == gen, bar);
            __builtin_amdgcn_fence(__ATOMIC_ACQUIRE, "agent");
            asm volatile("s_waitcnt vmcnt(0)" ::: "memory");
        }
    }
    __syncthreads();
}


struct Frame {
    LAS unsigned char* lds;
    int tid, lane, wave, G, gw, NGW;
    const float* const* in;
    float* out; unsigned char* ws;
};
DI const float* INP(const Frame& F, int k) { asm volatile("" : "+s"(k)); return F.in[k]; }
#define F_WIN  ((bf16*)(F.ws + WS_WIN))
#define F_WOUT ((bf16*)(F.ws + WS_WOUT))
#define F_WUP  ((bf16*)(F.ws + WS_WUP))
#define F_WDN  ((bf16*)(F.ws + WS_WDN))
#define F_LORA ((bf16*)(F.ws + WS_LORA))
#define F_XB   ((bf16*)(F.ws + WS_XB))
#define F_PROJ ((bf16*)(F.ws + WS_PROJ))
#define F_MIX  ((bf16*)(F.ws + WS_MIX))
#define F_HID  ((bf16*)(F.ws + WS_HID))
#define F_S_r  ((bf16*)(F.ws + WS_XB))
#define F_S_ld ((bf16*)(F.ws + WS_XB) + SARR)
#define F_S_k  ((bf16*)(F.ws + WS_S))
#define F_S_v  ((bf16*)(F.ws + WS_S) + SARR)
#define F_S_n  ((bf16*)(F.ws + WS_S) + 2 * SARR)
#define F_S_b  ((bf16*)(F.ws + WS_S) + 3 * SARR)
#define F_S_g  ((bf16*)(F.ws + WS_S) + 4 * SARR)
#define F_ctl  ((unsigned*)(F.ws + WS_CTL))

DI void transpose_item(const float* W, int K, int N, bf16* WT, LAS float* scr, int item, int lane, const float* gk, float cs, int csn) {
    const int nblk = N / 32, kb = item / nblk, nb = item % nblk, k0 = 64 * kb, n0 = 32 * nb;
    const float colscale = (n0 + (lane & 31) < csn) ? cs : 1.f;
#pragma unroll 8
    for (int i = 0; i < 32; ++i) { const int kk = 2 * i + (lane >> 5); float v = W[(size_t)(k0 + kk) * N + n0 + (lane & 31)]; if (gk) v *= gk[k0 + kk]; scr[kk * 33 + (lane & 31)] = v * colscale; }
    asm volatile("s_waitcnt lgkmcnt(0)" ::: "memory");
    const int c = lane & 7;
#pragma unroll
    for (int j = 0; j < 4; ++j) { const int n = (lane >> 3) + 8 * j; const LAS float* s = scr + (8 * c) * 33 + n;
        v4u o; o.x = pk2(s[0 * 33], s[1 * 33]); o.y = pk2(s[2 * 33], s[3 * 33]); o.z = pk2(s[4 * 33], s[5 * 33]); o.w = pk2(s[6 * 33], s[7 * 33]);
        *(v4u*)(WT + (size_t)(n0 + n) * K + k0 + 8 * c) = o; }
    asm volatile("s_waitcnt lgkmcnt(0)" ::: "memory");
}
DI Frame refresh(const Frame& F0) { Frame F = F0; int t = threadIdx.x; asm volatile("" : "+v"(t)); int bxx = blockIdx.x; asm volatile("" : "+s"(bxx)); F.tid = t; F.lane = t & 63; F.wave = __builtin_amdgcn_readfirstlane(t >> 6); F.gw = bxx * NWAVES + F.wave; return F; }
DI void prologue(const Frame& F0) { Frame F = refresh(F0);
    LAS float* scr = (LAS float*)(F.lds + F.wave * 16384);
    constexpr int I_IN = 16 * 104, I_OUT = 16 * 32, I_UP = 16 * 128, I_DN = 64 * 32, I_LW = 12, I_LG = 24;
    constexpr int PER = I_IN + I_OUT + I_UP + I_DN + 2 * I_LW + I_LG;
    constexpr float C2 = 0.17677669529663687f * 1.4426950408889634f;
    for (int it = F.gw; it < 2 * PER; it += F.NGW) {
        const int l = it / PER; int r = it % PER;
        if (r < I_IN) { transpose_item(INP(F, 2) + (size_t)l * DMODEL * NIN, DMODEL, NIN, F_WIN + (size_t)l * NIN * DMODEL, scr, r, F.lane, INP(F, 1) + l * DMODEL, C2, 384); continue; } r -= I_IN;
        if (r < I_OUT) { transpose_item(INP(F, 20) + (size_t)l * DMODEL * DMODEL, DMODEL, DMODEL, F_WOUT + (size_t)l * DMODEL * DMODEL, scr, r, F.lane, nullptr, 1.f, 0); continue; } r -= I_OUT;
        if (r < I_UP) { transpose_item(INP(F, 22) + (size_t)l * DMODEL * FF, DMODEL, FF, F_WUP + (size_t)l * FF * DMODEL, scr, r, F.lane, INP(F, 21) + l * DMODEL, 1.f, 0); continue; } r -= I_UP;
        if (r < I_DN) { transpose_item(INP(F, 23) + (size_t)l * FF * DMODEL, FF, DMODEL, F_WDN + (size_t)l * DMODEL * FF, scr, r, F.lane, nullptr, 1.f, 0); continue; } r -= I_DN;
        bf16* L = F_LORA + (size_t)l * LORA_L;
        if (r < I_LW) { transpose_item(INP(F, 11) + (size_t)l * 64 * RW, 64, RW, L, scr, r, F.lane, nullptr, 1.f, 0); continue; } r -= I_LW;
        if (r < I_LW) { transpose_item(INP(F, 13) + (size_t)l * 64 * RW, 64, RW, L + RW * 64, scr, r, F.lane, nullptr, 1.f, 0); continue; } r -= I_LW;
        transpose_item(INP(F, 14) + (size_t)l * 128 * RW, 128, RW, L + 2 * RW * 64, scr, r, F.lane, nullptr, 1.f, 0);
    }
}
DI void rms_rows_bf16(const Frame& F0, const float* src, bf16* dst) { Frame F = refresh(F0);
    for (int m = F.gw; m < M; m += F.NGW) {
        const f32x4* xr = (const f32x4*)(src + (size_t)m * DMODEL) + F.lane;
        f32x4 v[4]; float s2 = 0.f;
#pragma unroll
        for (int j = 0; j < 4; ++j) { v[j] = xr[64 * j]; s2 += (v[j].x * v[j].x + v[j].y * v[j].y) + (v[j].z * v[j].z + v[j].w * v[j].w); }
        const float rstd = 1.f / sqrtf(wave_sum(s2) * (1.f / DMODEL) + NORM_EPS);
        v2u* o8 = (v2u*)(dst + (size_t)m * DMODEL) + F.lane;
#pragma unroll
        for (int j = 0; j < 4; ++j) { v2u w; w.x = pk2(v[j].x * rstd, v[j].y * rstd); w.y = pk2(v[j].z * rstd, v[j].w * rstd); o8[64 * j] = w; }
    }
}
DI void final_norm(const Frame& F0, float* x, const float* g) { Frame F = refresh(F0);
    for (int m = F.gw; m < M; m += F.NGW) {
        f32x4* xr = (f32x4*)(x + (size_t)m * DMODEL) + F.lane; const f32x4* gr = (const f32x4*)g + F.lane;
        f32x4 v[4]; float s2 = 0.f;
#pragma unroll
        for (int j = 0; j < 4; ++j) { v[j] = xr[64 * j]; s2 += (v[j].x * v[j].x + v[j].y * v[j].y) + (v[j].z * v[j].z + v[j].w * v[j].w); }
        const float rstd = 1.f / sqrtf(wave_sum(s2) * (1.f / DMODEL) + NORM_EPS);
#pragma unroll
        for (int j = 0; j < 4; ++j) xr[64 * j] = v[j] * rstd * gr[64 * j];
    }
}

DI void loadz8(const bf16* prow, bool first, const float* mu, int col, float* z) {
    const v4u p = *(const v4u*)(prow + col); v4u q = (v4u){0u, 0u, 0u, 0u}; if (!first) q = *(const v4u*)(prow - NIN + col);
    const f32x4 m0 = *(const f32x4*)(mu + col), m1 = *(const f32x4*)(mu + col + 4);
    float pf[8], qf[8]; unpack8(p, pf); unpack8(q, qf);
#pragma unroll
    for (int j = 0; j < 4; ++j) { z[j] = pf[j] + m0[j] * (qf[j] - pf[j]); z[4 + j] = pf[4 + j] + m1[j] * (qf[4 + j] - pf[4 + j]); }
}
DI float loadz1(const bf16* prow, bool first, float mu, int col) { const float p = bf1(prow + col); const float q = first ? 0.f : bf1(prow - NIN + col); return p + mu * (q - p); }

DI void prep_phase(const Frame& F0, int l) { Frame F = refresh(F0);
    const float* mu = INP(F, 9) + l * RCOLS;
    const float* w0 = INP(F, 10) + l * RW; const float* a0 = INP(F, 12) + l * RW; const float* kkw = INP(F, 15) + l * RW; const float* kaw = INP(F, 16) + l * RW;
    const bf16* WUT = F_LORA + (size_t)l * LORA_L; const bf16* AUT = WUT + RW * 64; const bf16* GUT = AUT + RW * 64;
    const int row = F.lane & 15, kq = F.lane >> 4;
    for (int tile = F.gw; tile < M / 16; tile += F.NGW) {
        const int t0 = tile * 16;
        bf16x8 Aw[2], Aa[2], Ag[4];
        { const int t = t0 + row; const bool first = (t % SEQ) == 0; const bf16* prow = F_PROJ + (size_t)t * NIN + ROFF; float z[8];
#pragma unroll
          for (int ks = 0; ks < 2; ++ks) { loadz8(prow, first, mu, 1152 + ks * 32 + kq * 8, z);
#pragma unroll
              for (int j = 0; j < 8; ++j) z[j] = tanhf_(z[j]);
              Aw[ks] = __builtin_bit_cast(bf16x8, pack8(z)); }
#pragma unroll
          for (int ks = 0; ks < 2; ++ks) { loadz8(prow, first, mu, 1216 + ks * 32 + kq * 8, z); Aa[ks] = __builtin_bit_cast(bf16x8, pack8(z)); }
#pragma unroll
          for (int ks = 0; ks < 4; ++ks) { loadz8(prow, first, mu, 1280 + ks * 32 + kq * 8, z);
#pragma unroll
              for (int j = 0; j < 8; ++j) z[j] = sigmoidf_(z[j]);
              Ag[ks] = __builtin_bit_cast(bf16x8, pack8(z)); } }
#pragma unroll 1
        for (int hd = 0; hd < 6; ++hd) {
            float kkv[4][4], av[4][4], ss[4] = {0.f, 0.f, 0.f, 0.f};
#pragma unroll
            for (int cgi = 0; cgi < 4; ++cgi) {
                const int ch = hd * 64 + cgi * 16 + row;
                f32x4 cw = (f32x4){0.f, 0.f, 0.f, 0.f}, ca = cw, cgt = cw;
#pragma unroll
                for (int ks = 0; ks < 2; ++ks) {
                    const bf16x8 bw = *(const bf16x8*)(WUT + (size_t)ch * 64 + ks * 32 + kq * 8); cw = __builtin_amdgcn_mfma_f32_16x16x32_bf16(Aw[ks], bw, cw, 0, 0, 0);
                    const bf16x8 ba = *(const bf16x8*)(AUT + (size_t)ch * 64 + ks * 32 + kq * 8); ca = __builtin_amdgcn_mfma_f32_16x16x32_bf16(Aa[ks], ba, ca, 0, 0, 0); }
#pragma unroll
                for (int ks = 0; ks < 4; ++ks) { const bf16x8 bg = *(const bf16x8*)(GUT + (size_t)ch * 128 + ks * 32 + kq * 8); cgt = __builtin_amdgcn_mfma_f32_16x16x32_bf16(Ag[ks], bg, cgt, 0, 0, 0); }
                const float w0c = w0[ch], a0c = a0[ch], kkc = kkw[ch], kac = kaw[ch], mur = mu[ch], muk = mu[RW + ch], muv = mu[2 * RW + ch];
#pragma unroll
                for (int j = 0; j < 4; ++j) {
                    const int tt = t0 + kq * 4 + j; const bool fj = (tt % SEQ) == 0; const bf16* pr = F_PROJ + (size_t)tt * NIN + ROFF;
                    const float zr = loadz1(pr, fj, mur, ch), zk = loadz1(pr, fj, muk, RW + ch), zv = loadz1(pr, fj, muv, 2 * RW + ch);
                    const float wl = w0c + cw[j];
                    const float xs = -wl; const float sp = fmaxf(xs, 0.f) + __logf(1.f + __expf(-fabsf(xs)));
                    const float ld = -__expf(-sp - 0.5f);
                    const float a = sigmoidf_(a0c + ca[j]);
                    const float kk = zk * kkc, kp = zk * (1.f + (a - 1.f) * kac);
                    kkv[cgi][j] = kk; av[cgi][j] = a; ss[j] += kk * kk;
                    const size_t idx = (size_t)tt * RW + ch;
                    F_S_r[idx] = (bf16)f2bf(zr); F_S_ld[idx] = (bf16)f2bf(ld); F_S_k[idx] = (bf16)f2bf(kp); F_S_v[idx] = (bf16)f2bf(zv); F_S_g[idx] = (bf16)f2bf(cgt[j]);
                }
            }
#pragma unroll
            for (int j = 0; j < 4; ++j) { float s = ss[j]; s += __shfl_xor(s, 1); s += __shfl_xor(s, 2); s += __shfl_xor(s, 4); s += __shfl_xor(s, 8); ss[j] = 1.f / fmaxf(sqrtf(s), 1e-12f); }
#pragma unroll
            for (int cgi = 0; cgi < 4; ++cgi)
#pragma unroll
                for (int j = 0; j < 4; ++j) { const int tt = t0 + kq * 4 + j; const size_t idx = (size_t)tt * RW + hd * 64 + cgi * 16 + row; const float kn = kkv[cgi][j] * ss[j];
                    F_S_n[idx] = (bf16)f2bf(-kn); F_S_b[idx] = (bf16)f2bf(kn * av[cgi][j]); }
        }
    }
    const float* cw_ = INP(F, 8) + l * 3 * 256;
    for (int it = F.gw; it < M / 2; it += F.NGW) {
        const int t = it * 2 + (F.lane >> 5), c8 = (F.lane & 31) * 8, pos = t % SEQ;
        const bf16* base = F_PROJ + (size_t)t * NIN + COFF + c8;
        float b8[8], g8[8], u8[8], acc[8], w8[8];
        unpack8(*(const v4u*)base, b8);
#pragma unroll
        for (int j = 0; j < 8; ++j) acc[j] = 0.f;
#pragma unroll
        for (int d = 0; d < 3; ++d) {
            const int back = 2 - d;
            if (pos >= back) {
                const bf16* pb = base - (size_t)back * NIN;
                unpack8(*(const v4u*)(pb + 256), g8); unpack8(*(const v4u*)(pb + 512), u8);
                const f32x4 wa = *(const f32x4*)(cw_ + d * 256 + c8), wb = *(const f32x4*)(cw_ + d * 256 + c8 + 4);
                w8[0] = wa.x; w8[1] = wa.y; w8[2] = wa.z; w8[3] = wa.w; w8[4] = wb.x; w8[5] = wb.y; w8[6] = wb.z; w8[7] = wb.w;
#pragma unroll
                for (int j = 0; j < 8; ++j) acc[j] += w8[j] * (g8[j] * u8[j]);
            }
        }
#pragma unroll
        for (int j = 0; j < 8; ++j) acc[j] *= b8[j];
        *(v4u*)(F_MIX + (size_t)t * DMODEL + 384 + c8) = pack8(acc);
    }
}

DI void post_phase(const Frame& F0, int l) { Frame F = refresh(F0);
    const float* rk = INP(F, 17) + l * RW; const float* lg = INP(F, 18) + l * RW; const float* lb = INP(F, 19) + l * RW;
    for (int it = F.gw; it < M * 6 / 8; it += F.NGW) {
        const int pair = it * 8 + (F.lane >> 3), t = pair / 6, hd = pair % 6, ch = hd * 64 + (F.lane & 7) * 8;
        bf16* yp = F_MIX + (size_t)t * DMODEL + 640 + ch; const size_t idx = (size_t)t * RW + ch;
        float y[8], r[8], k[8], v[8], g[8], o[8];
        unpack8(*(const v4u*)yp, y); unpack8(*(const v4u*)(F_S_r + idx), r); unpack8(*(const v4u*)(F_S_k + idx), k); unpack8(*(const v4u*)(F_S_v + idx), v); unpack8(*(const v4u*)(F_S_g + idx), g);
        float s = 0.f, dot = 0.f;
#pragma unroll
        for (int j = 0; j < 8; ++j) { s += y[j]; dot += r[j] * k[j] * rk[ch + j]; }
        s += __shfl_xor(s, 1); s += __shfl_xor(s, 2); s += __shfl_xor(s, 4);
        dot += __shfl_xor(dot, 1); dot += __shfl_xor(dot, 2); dot += __shfl_xor(dot, 4);
        const float mean = s * (1.f / 64.f); float q = 0.f;
#pragma unroll
        for (int j = 0; j < 8; ++j) { const float d = y[j] - mean; q += d * d; }
        q += __shfl_xor(q, 1); q += __shfl_xor(q, 2); q += __shfl_xor(q, 4);
        const float rstd = 1.f / sqrtf(q * (1.f / 64.f) + GN_EPS);
#pragma unroll
        for (int j = 0; j < 8; ++j) o[j] = ((y[j] - mean) * rstd * lg[ch + j] + lb[ch + j] + dot * v[j]) * g[j];
        *(v4u*)yp = pack8(o);
    }
}

DI void scan_wg(const Frame& F0, int sw) { Frame F = refresh(F0);
    const int bh = sw >> 1, half = sw & 1, b = bh / 6, hd = bh % 6;
    const size_t tb = (size_t)b * SEQ; const int cb = hd * 64;
    LAS unsigned char* const lds = F.lds;
    constexpr int BUFB = 6 * 8192, YOFF = 2 * BUFB;
    const bool loader = F.wave >= 4; const int ltid = F.tid - 256;
#define SCAN_STAGE(c, bufsel, P0, NP, STRIDE) do { _Pragma("unroll") for (int i = 0; i < (NP); ++i) { const int p = (P0) + (STRIDE) * i, a = p >> 8, tt = (p & 255) >> 3, c8 = (p & 7) * 8; \
        const bf16* src = (a == 0 ? F_S_r : a == 1 ? F_S_ld : a == 2 ? F_S_k : a == 3 ? F_S_v : a == 4 ? F_S_n : F_S_b); \
        const v4u raw = *(const v4u*)(src + (tb + (size_t)(c) * 32 + tt) * RW + cb + c8); \
        float f[8]; unpack8(raw, f); if (a == 1) { _Pragma("unroll") for (int j = 0; j < 8; ++j) f[j] = __expf(f[j]); } \
        LAS f32x4* d = (LAS f32x4*)(lds + (bufsel) * BUFB + a * 8192 + tt * 256 + c8 * 4); d[0] = (f32x4){f[0], f[1], f[2], f[3]}; d[1] = (f32x4){f[4], f[5], f[6], f[7]}; } } while (0)
#define SCAN_YOUT(c, bufsel) do { _Pragma("unroll") for (int i = 0; i < 2; ++i) { const int e = ltid + 256 * i, tt = e >> 4, r2 = (e & 15) * 2; \
        const LAS float* ys = (const LAS float*)(lds + YOFF + (bufsel) * 4096) + tt * 32 + r2; \
        *(unsigned*)(F_MIX + (tb + (size_t)(c) * 32 + tt) * DMODEL + 640 + cb + half * 32 + r2) = pk2(ys[0], ys[1]); } } while (0)
    SCAN_STAGE(0, 0, F.tid, 3, 512);
    __syncthreads();
    typedef float f32x2v __attribute__((ext_vector_type(2)));
    const int rp = F.wave * 8 + (F.lane >> 4) * 2, kp = F.lane & 15;
    f32x4 s0 = (f32x4){0.f, 0.f, 0.f, 0.f}, s1 = s0;
#pragma unroll 1
    for (int c = 0; c < SEQ / 32; ++c) {
        const int cur = c & 1;
        if (loader) {
            if (c + 1 < SEQ / 32) SCAN_STAGE(c + 1, cur ^ 1, ltid, 6, 256);
            if (c > 0) SCAN_YOUT(c - 1, cur ^ 1);
        } else {
            const LAS unsigned char* bb = lds + cur * BUFB + kp * 16;
            const LAS unsigned char* vb = lds + cur * BUFB + 3 * 8192 + (half * 32 + rp) * 4;
            LAS f32x2v* yb = (LAS f32x2v*)(lds + YOFF + cur * 4096 + rp * 4);
            f32x4 rv = *(const LAS f32x4*)(bb + 0 * 8192), wv = *(const LAS f32x4*)(bb + 1 * 8192), kv = *(const LAS f32x4*)(bb + 2 * 8192);
            f32x4 nv = *(const LAS f32x4*)(bb + 4 * 8192), bv = *(const LAS f32x4*)(bb + 5 * 8192);
            f32x2v vv = *(const LAS f32x2v*)(vb);
#pragma unroll 8
            for (int tt = 0; tt < 32; ++tt) {
                const int tn = (tt + 1) & 31;
                const f32x4 rv2 = *(const LAS f32x4*)(bb + 0 * 8192 + tn * 256), wv2 = *(const LAS f32x4*)(bb + 1 * 8192 + tn * 256), kv2 = *(const LAS f32x4*)(bb + 2 * 8192 + tn * 256);
                const f32x4 nv2 = *(const LAS f32x4*)(bb + 4 * 8192 + tn * 256), bv2 = *(const LAS f32x4*)(bb + 5 * 8192 + tn * 256);
                const f32x2v vv2 = *(const LAS f32x2v*)(vb + tn * 256);
                f32x2v d0 = (f32x2v){s0.x, s0.y} * (f32x2v){nv.x, nv.y}; d0 = (f32x2v){s0.z, s0.w} * (f32x2v){nv.z, nv.w} + d0;
                f32x2v d1 = (f32x2v){s1.x, s1.y} * (f32x2v){nv.x, nv.y}; d1 = (f32x2v){s1.z, s1.w} * (f32x2v){nv.z, nv.w} + d1;
                const float sa0 = red16(d0.x + d0.y), sa1 = red16(d1.x + d1.y);
                const f32x4 q0 = s0 * wv + kv * vv.x, q1 = s1 * wv + kv * vv.y;
                s0 = bv * sa0 + q0; s1 = bv * sa1 + q1;
                f32x2v y0 = (f32x2v){s0.x, s0.y} * (f32x2v){rv.x, rv.y}; y0 = (f32x2v){s0.z, s0.w} * (f32x2v){rv.z, rv.w} + y0;
                f32x2v y1 = (f32x2v){s1.x, s1.y} * (f32x2v){rv.x, rv.y}; y1 = (f32x2v){s1.z, s1.w} * (f32x2v){rv.z, rv.w} + y1;
                const float ya = red16(y0.x + y0.y), yc = red16(y1.x + y1.y);
                yb[tt * 16] = (f32x2v){ya, yc};
                rv = rv2; wv = wv2; kv = kv2; nv = nv2; bv = bv2; vv = vv2;
            }
        }
        __syncthreads();
    }
    if (loader) SCAN_YOUT(SEQ / 32 - 1, (SEQ / 32 - 1) & 1);
#undef SCAN_STAGE
#undef SCAN_YOUT
    __syncthreads();
}

DI void mix_phase(const Frame& F0, int l, char* ldsg) { Frame F = refresh(F0);
#ifndef SKIP_SCAN
    if ((int)blockIdx.x < SCAN_WGS) { scan_wg(F, (int)blockIdx.x); if (PROBE & 2) scan_wg(F, (int)blockIdx.x); }
#endif
    const float* lq1 = INP(F, 3) + l * 32; const float* lk1 = INP(F, 4) + l * 32; const float* lq2 = INP(F, 5) + l * 32; const float* lk2 = INP(F, 6) + l * 32;
    float d1 = 0.f, d2 = 0.f;
    for (int i = 0; i < 32; ++i) { d1 += lq1[i] * lk1[i]; d2 += lq2[i] * lk2[i]; }
    const float lambda_init = (l == 0) ? 0.2f : 0.35550906759f;
    const float lam = __expf(d1) - __expf(d2) + lambda_init;
    const float* sg = INP(F, 7) + l * 64;
    volatile LAS unsigned* qslot = (volatile LAS unsigned*)(F.lds + MISC_OFF + 64);
    for (int rep = 0; rep < ((PROBE & 4) ? 2 : 1); ++rep)
    for (;;) {
        if (F.tid == 0) *qslot = atomicAdd(F_ctl + 64 * (1 + l + 2 * rep), 1u);
        __syncthreads();
        const unsigned idx = (unsigned)__builtin_amdgcn_readfirstlane((int)*qslot);
        __syncthreads();
        if (idx >= (unsigned)ATT_ITEMS) break;
        const int qb = 15 - (int)(idx / 48u), bh = (int)(idx % 48u), b = bh / 6, h = bh % 6;
        const attn_body::bf16* P = (const attn_body::bf16*)F_PROJ;
#ifndef SKIP_ATT
#pragma unroll 1
        for (int ns = 0; ns < 2; ++ns)
            attn_body::attn_unit<8>(b, h, qb, ns, lam, sg, 1.f - lambda_init, P, P + 384, P + 768, (attn_body::bf16*)F_MIX, ldsg);
#endif
    }
}

__global__ void __launch_bounds__(NWAVES * 64, 2) mega_fwd(Args args) {
    extern __shared__ __attribute__((aligned(16))) unsigned char lds[];
    cg::grid_group grid = cg::this_grid();
    Frame F;
    F.lds = (LAS unsigned char*)lds;
    F.tid = threadIdx.x; F.lane = F.tid & 63; F.wave = __builtin_amdgcn_readfirstlane(F.tid >> 6);
    F.G = gridDim.x; F.gw = (int)blockIdx.x * NWAVES + F.wave; F.NGW = F.G * NWAVES;
    F.in = args.in; F.out = args.out; F.ws = args.ws;
    const int G = F.G;
    if (F.tid < 32) ((LAS unsigned*)(F.lds + MISC_OFF))[F.tid] = 0u;
    __syncthreads();
    XcdBarrier bar = xcd_barrier_post((unsigned*)(args.ws + WS_CTL) + CW_BAR, (volatile LAS unsigned*)(F.lds + MISC_OFF) + 8);

    prologue(F);
    rms_rows_bf16(F, INP(F, 0), F_XB);
    grid.sync();
#pragma unroll 1
    for (int l = 0; l < 2; ++l) {
        {
            pg8::Gemm g{F_XB, F_WIN + (size_t)l * NIN * DMODEL, M, NIN, DMODEL}; pg8::StaticOrder S; int bx = blockIdx.x; asm volatile("" : "+s"(bx)); S.init(M, NIN, G, bx);
            pg8::EpiBf16S<0> E{F_PROJ, NIN};
            GEMMCALL0 pg8::gemm_phase<pg8::EpiBf16S<0>, pg8::StaticOrder, true, true>(F.lds, g, S, E);
            if (PROBE & 1) { __syncthreads(); pg8::gemm_phase<pg8::EpiBf16S<0>, pg8::StaticOrder, true, true>(F.lds, g, S, E); }
        }
        xcd_barrier(bar);
#ifndef SKIP_PREP
        prep_phase(F, l);
        if (PROBE & 8) { __syncthreads(); prep_phase(F, l); }
#endif
        xcd_barrier(bar);
        mix_phase(F, l, (char*)lds);
        xcd_barrier(bar);
#ifndef SKIP_POST
        post_phase(F, l);
#endif
        xcd_barrier(bar);
        {
            pg8::Gemm g{F_MIX, F_WOUT + (size_t)l * DMODEL * DMODEL, M, DMODEL, DMODEL}; pg8::StaticOrder S; int bx = blockIdx.x; asm volatile("" : "+s"(bx)); S.init(M, DMODEL, G, bx);
            pg8::EpiResF32 E{l == 0 ? INP(F, 0) : (const float*)F.out, F.out, DMODEL};
            GEMMCALL1 pg8::gemm_phase<pg8::EpiResF32, pg8::StaticOrder, true, true>(F.lds, g, S, E);
        }
        xcd_barrier(bar);
        rms_rows_bf16(F, F.out, F_XB);
        if (PROBE & 16) { xcd_barrier(bar); rms_rows_bf16(F, F.out, F_XB); xcd_barrier(bar); rms_rows_bf16(F, F.out, F_XB); }
        if (PROBE & 32) { for (int q = 0; q < 10; ++q) xcd_barrier(bar); }
        xcd_barrier(bar);
        {
            pg8::Gemm g{F_XB, F_WUP + (size_t)l * FF * DMODEL, M, FF, DMODEL}; pg8::StaticOrder S; int bx = blockIdx.x; asm volatile("" : "+s"(bx)); S.init(M, FF, G, bx);
            pg8::EpiBf16S<2> E{F_HID, FF};
            GEMMCALL2 pg8::gemm_phase<pg8::EpiBf16S<2>, pg8::StaticOrder, true, true>(F.lds, g, S, E);
            if (PROBE & 1) { __syncthreads(); pg8::gemm_phase<pg8::EpiBf16S<2>, pg8::StaticOrder, true, true>(F.lds, g, S, E); }
        }
        xcd_barrier(bar);
        {
            pg8::Gemm g{F_HID, F_WDN + (size_t)l * DMODEL * FF, M, DMODEL, FF}; pg8::StaticOrder S; int bx = blockIdx.x; asm volatile("" : "+s"(bx)); S.init(M, DMODEL, G, bx);
            pg8::EpiResF32 E{(const float*)F.out, F.out, DMODEL};
            GEMMCALL3 pg8::gemm_phase<pg8::EpiResF32, pg8::StaticOrder, true, true>(F.lds, g, S, E);
        }
        xcd_barrier(bar);
        if (l == 0) { rms_rows_bf16(F, F.out, F_XB); xcd_barrier(bar); }
    }
    final_norm(F, F.out, INP(F, 24));
}

extern "C" void kernel_launch(void* const* d_in, const int* in_sizes, int n_in, void* d_out, int out_size, void* d_ws, size_t ws_size, hipStream_t stream) {
    static int grid = 0;
    if (grid == 0) {
        if (n_in != 25 || in_sizes[0] != M * DMODEL || out_size != M * DMODEL || ws_size < WS_END) {
            fprintf(stderr, "kernel_launch: unexpected problem geometry (n_in %d, in0 %d, out %d, ws %zu)\n", n_in, n_in > 0 ? in_sizes[0] : -1, out_size, ws_size); grid = -1; return; }
        int dev = 0, cus = 0, per_cu = 0;
        if (hipGetDevice(&dev) != hipSuccess || hipDeviceGetAttribute(&cus, hipDeviceAttributeMultiprocessorCount, dev) != hipSuccess) { grid = -1; return; }
        if (hipFuncSetAttribute((const void*)mega_fwd, hipFuncAttributeMaxDynamicSharedMemorySize, LDS_BYTES) != hipSuccess) { fprintf(stderr, "kernel_launch: hipFuncSetAttribute failed\n"); grid = -1; return; }
        if (hipOccupancyMaxActiveBlocksPerMultiprocessor(&per_cu, (const void*)mega_fwd, NWAVES * 64, LDS_BYTES) != hipSuccess || per_cu < 1) { fprintf(stderr, "kernel_launch: occupancy query gave %d\n", per_cu); (void)hipGetLastError(); per_cu = 1; }
        grid = cus * per_cu;
    }
    if (grid < 0) return;
    (void)hipMemsetAsync((char*)d_ws + WS_CTL, 0, CTL_ZERO_BYTES, stream);
    Args a{};
    for (int i = 0; i < 25; ++i) a.in[i] = (const float*)d_in[i];
    a.out = (float*)d_out; a.ws = (unsigned char*)d_ws; a.i0 = 0; a.i1 = 0;
    void* kargs[] = {&a};
    const hipError_t e = hipLaunchCooperativeKernel((const void*)mega_fwd, dim3(grid), dim3(NWAVES * 64), kargs, LDS_BYTES, stream);
    if (e != hipSuccess) fprintf(stderr, "kernel_launch: cooperative launch failed: %s (grid %d)\n", hipGetErrorString(e), grid);
}
```

```cpp
#include <hip/hip_runtime.h>
#include <hip/hip_cooperative_groups.h>
#include <hip/hip_bf16.h>
#include <cstdio>
#include <cstdint>
#include <cmath>
namespace pg8 {
#define PG8_LAS __attribute__((address_space(3)))
typedef unsigned short bf16_t;
typedef short bf16x8 __attribute__((ext_vector_type(8)));
typedef float f32x4 __attribute__((ext_vector_type(4)));
typedef unsigned u32x4 __attribute__((ext_vector_type(4)));
constexpr int BM = 256, BK = 64, HALF = 128, HTB = HALF * BK * 2  , STAGE_BYTES = 8 * HTB, NXCD = 8, WGM = 8;

__host__ __device__ __forceinline__ int lds_byte(int r, int c) { const int st = (r >> 4) * 2 + (c >> 5), rr = r & 15, cc = c & 31, ob = rr * 64 + cc * 2; return st * 1024 + (ob ^ (((ob >> 9) & 1) << 5)); }
__host__ __device__ __forceinline__ void stage_rc(int b, int& R, int& C) { const int st = b / 1024, sb = b % 1024, swz = sb ^ (((sb >> 9) & 1) << 5); R = (st >> 1) * 16 + swz / 64; C = (st & 1) * 32 + (swz % 64) / 2; }
__host__ __device__ __forceinline__ int perm32(int rho) { const int n = rho >> 4, i = rho & 15; return 8 * (i >> 2) + 4 * n + (i & 3); }

struct Unit { int pm, pn; };
struct Gemm { const bf16_t* A; const bf16_t* Bt; int M, N, K; };

struct StaticOrder {
    int nM, nN, nwg, G, c;
    __host__ __device__ void init(int M, int N, int G_, int c_) { nM = M / BM; nN = N / BM; nwg = nM * nN; G = G_; c = c_; }
    __host__ __device__ bool next(int i, Unit& u) const {
        const long L = (long)i * G + c; if (L >= nwg) return false;
        int wgid = (int)L; { const int q = nwg / NXCD, r = nwg % NXCD, xcd = wgid % NXCD, off = wgid / NXCD; wgid = (xcd < r ? xcd * (q + 1) : r * (q + 1) + (xcd - r) * q) + off; }
        const int nig = WGM * nN, gid = wgid / nig, fm = gid * WGM, gsz = (nM - fm) < WGM ? (nM - fm) : WGM;
        u.pm = fm + ((wgid % nig) % gsz); u.pn = (wgid % nig) / gsz; return true;
    }
    __device__ __forceinline__ void a_ready(const Unit&) const {}
    __device__ __forceinline__ void done(const Unit&) const {}
};

__device__ __forceinline__ unsigned cvt_pk_bf16(float lo, float hi) { unsigned r; asm volatile("v_cvt_pk_bf16_f32 %0, %1, %2" : "=v"(r) : "v"(lo), "v"(hi)); return r; }
typedef float f32x2 __attribute__((ext_vector_type(2)));
template <int ACT  > struct EpiBf16S {
    static constexpr bool PERM = true, AFTER_DRAIN = false;
    bf16_t* O; int ldc;
    __device__ __forceinline__ void operator()(const f32x4 (&acc)[2][2][4][2], const Unit& u, int wr, int wc, int fr, int fq) const {
        const int row0 = u.pm * BM + wr * 64 + fr; const int col0 = u.pn * BM + wc * 32 + 8 * fq;
#pragma unroll
        for (int ai = 0; ai < 2; ++ai)
#pragma unroll
            for (int m = 0; m < 4; ++m) { bf16_t* rowp = O + (size_t)(row0 + ai * HALF + m * 16) * ldc + col0;
#pragma unroll
                for (int bj = 0; bj < 2; ++bj) { f32x4 v0 = acc[ai][bj][m][0], v1 = acc[ai][bj][m][1];
                    if (ACT == 2) {
#pragma unroll
                        for (int e = 0; e < 4; ++e) { float a = v0[e] > 0.f ? v0[e] : 0.f; v0[e] = a * a; float b = v1[e] > 0.f ? v1[e] : 0.f; v1[e] = b * b; } }
                    u32x4 w; w.x = cvt_pk_bf16(v0[0], v0[1]); w.y = cvt_pk_bf16(v0[2], v0[3]); w.z = cvt_pk_bf16(v1[0], v1[1]); w.w = cvt_pk_bf16(v1[2], v1[3]);
                    *(u32x4*)(rowp + bj * HALF) = w; } }
    }
};
struct EpiResF32 {
    static constexpr bool PERM = false, AFTER_DRAIN = false;
    const float* base; float* out; int ldc;
    __device__ __forceinline__ void operator()(const f32x4 (&acc)[2][2][4][2], const Unit& u, int wr, int wc, int fr, int fq) const {
        const int col0 = u.pn * BM + wc * 32 + 4 * fq;
#pragma unroll
        for (int ai = 0; ai < 2; ++ai)
#pragma unroll
            for (int m = 0; m < 4; ++m) { const int r = u.pm * BM + ai * HALF + wr * 64 + m * 16 + fr; const size_t off = (size_t)r * ldc + col0;
#pragma unroll
                for (int bj = 0; bj < 2; ++bj)
#pragma unroll
                    for (int n = 0; n < 2; ++n) { const size_t idx = off + bj * HALF + n * 16; const f32x4 bs = *(const f32x4*)(base + idx); *(f32x4*)(out + idx) = bs + acc[ai][bj][m][n]; }
                asm volatile("" ::: "memory"); }
    }
};
template <class Epi, class Sched, bool ALIGN_EPI = false, bool SP2 = false>
__device__ __forceinline__ void gemm_phase(PG8_LAS unsigned char* lds, const Gemm g, const Sched& S, const Epi& E) {
    int tid_ = threadIdx.x; asm volatile("" : "+v"(tid_)); const int tid = tid_, wid = __builtin_amdgcn_readfirstlane(tid >> 6), lane = tid & 63, wr = wid >> 2, wc = wid & 3, fr = lane & 15, fq = lane >> 4;
    const int K = g.K, nt = K / BK;
    unsigned voffA[2], voffB[2];
#pragma unroll
    for (int i = 0; i < 2; ++i) { int R, C; stage_rc(tid * 16 + i * 8192, R, C); const int Rb = Epi::PERM ? ((R & ~31) + perm32(R & 31)) : R;
        voffA[i] = (unsigned)(R * K + C) * 2u; voffB[i] = (unsigned)(Rb * K + C) * 2u; }
    const size_t kstep = (size_t)(BK * 2);
    const size_t hstep = (size_t)HALF * K * 2;
    const size_t tstep = 2 * hstep;
    const unsigned ldsw = (unsigned)wid * 1024u;
    const int aoff = lds_byte(wr * 64 + fr, fq * 8), boff = lds_byte(wc * 32 + fr, fq * 8);
#define PG8_SA(b, h) (((b) * 2 + (h)) * HTB)
#define PG8_SB(b, h) ((4 + (b) * 2 + (h)) * HTB)
#define PG8_STAGE(bufoff, gbase, voff) do { _Pragma("unroll") for (int _i = 0; _i < 2; ++_i) \
        __builtin_amdgcn_global_load_lds((const unsigned*)((const char*)(gbase) + (voff)[_i]), (PG8_LAS unsigned*)(lds + (bufoff) + ldsw + _i * 8192), 16, 0, 0); } while (0)
#define PG8_LDA(dst, b, h) do { _Pragma("unroll") for (int m = 0; m < 4; ++m) _Pragma("unroll") for (int k = 0; k < 2; ++k) dst[m][k] = *(const PG8_LAS bf16x8*)(lds + PG8_SA(b, h) + aoff + m * 2048 + k * 1024); } while (0)
#define PG8_LDB(dst, b, h) do { _Pragma("unroll") for (int n = 0; n < 2; ++n) _Pragma("unroll") for (int k = 0; k < 2; ++k) dst[n][k] = *(const PG8_LAS bf16x8*)(lds + PG8_SB(b, h) + boff + n * 2048 + k * 1024); } while (0)
#define PG8_MMA(ai, bj, At, Bt) do { __builtin_amdgcn_s_setprio(1); _Pragma("unroll") for (int m = 0; m < 4; ++m) _Pragma("unroll") for (int n = 0; n < 2; ++n) _Pragma("unroll") for (int k = 0; k < 2; ++k) \
        acc[ai][bj][m][n] = __builtin_amdgcn_mfma_f32_16x16x32_bf16(Bt[n][k], At[m][k], acc[ai][bj][m][n], 0, 0, 0); __builtin_amdgcn_s_setprio(0); } while (0)
#define PG8_WAIT_V(n) asm volatile("s_waitcnt vmcnt(" #n ")" ::: "memory")
#define PG8_WAIT_L(n) asm volatile("s_waitcnt lgkmcnt(" #n ")" ::: "memory")
#define PG8_BAR __builtin_amdgcn_s_barrier()
#define PG8_SCHED __builtin_amdgcn_sched_barrier(0)
    Unit cur, nxt; int ui = 0;
    if (!S.next(0, cur)) return;
    f32x4 acc[2][2][4][2];
#pragma unroll
    for (int a = 0; a < 2; ++a)
#pragma unroll
        for (int b = 0; b < 2; ++b)
#pragma unroll
            for (int m = 0; m < 4; ++m)
#pragma unroll
                for (int n = 0; n < 2; ++n) acc[a][b][m][n] = (f32x4){0.f, 0.f, 0.f, 0.f};
    bf16x8 At[4][2], B0[2][2], B1[2][2];
    const char* cA = (const char*)g.A + (size_t)cur.pm * tstep; const char* cB = (const char*)g.Bt + (size_t)cur.pn * tstep;
    S.a_ready(cur);
    if constexpr (SP2) {
        PG8_STAGE(PG8_SB(0, 0), cB, voffB); PG8_STAGE(PG8_SB(0, 1), cB + hstep, voffB); PG8_STAGE(PG8_SA(0, 0), cA, voffA); PG8_STAGE(PG8_SA(0, 1), cA + hstep, voffA);
        if (wr == 1) PG8_BAR;
        PG8_WAIT_V(2); PG8_BAR;
        PG8_STAGE(PG8_SB(1, 0), cB + kstep, voffB); PG8_STAGE(PG8_SA(1, 0), cA + kstep, voffA); PG8_STAGE(PG8_SB(1, 1), cB + hstep + kstep, voffB);
        PG8_WAIT_V(6); PG8_BAR;
    } else {
        PG8_STAGE(PG8_SB(0, 0), cB, voffB); PG8_STAGE(PG8_SA(0, 0), cA, voffA); PG8_STAGE(PG8_SB(0, 1), cB + hstep, voffB); PG8_STAGE(PG8_SA(0, 1), cA + hstep, voffA);
        if (wr == 1) PG8_BAR;
        PG8_WAIT_V(4); PG8_BAR;
        PG8_STAGE(PG8_SB(1, 0), cB + kstep, voffB); PG8_STAGE(PG8_SA(1, 0), cA + kstep, voffA); PG8_STAGE(PG8_SB(1, 1), cB + hstep + kstep, voffB);
        PG8_WAIT_V(6); PG8_BAR;
    }
    for (;;) {
        const bool has_next = S.next(ui + 1, nxt);
        const char* nA = has_next ? (const char*)g.A + (size_t)nxt.pm * tstep : cA; const char* nB = has_next ? (const char*)g.Bt + (size_t)nxt.pn * tstep : cB;
        for (int t = 0; t < nt; t += 2) {
            const bool last = (t == nt - 2);
            const char* a1 = cA + (size_t)(t + 1) * kstep;
            const char* a2 = last ? nA : cA + (size_t)(t + 2) * kstep; const char* b2 = last ? nB : cB + (size_t)(t + 2) * kstep;
            const char* a3 = a2 + kstep; const char* b3 = b2 + kstep;
            if (last && has_next) S.a_ready(nxt);
            if constexpr (SP2) {
            PG8_LDB(B0, 0, 0); PG8_LDB(B1, 0, 1); PG8_SCHED; PG8_LDA(At, 0, 0); PG8_STAGE(PG8_SA(1, 1), a1 + hstep, voffA);
            PG8_WAIT_V(8); PG8_WAIT_L(0); PG8_BAR; PG8_MMA(0, 0, At, B0); PG8_MMA(0, 1, At, B1); PG8_BAR; PG8_SCHED;
            PG8_LDA(At, 0, 1); PG8_STAGE(PG8_SB(0, 0), b2, voffB); PG8_STAGE(PG8_SB(0, 1), b2 + hstep, voffB); PG8_STAGE(PG8_SA(0, 0), a2, voffA);
            PG8_WAIT_V(8); PG8_WAIT_L(0); PG8_BAR; PG8_MMA(1, 0, At, B0); PG8_MMA(1, 1, At, B1); PG8_BAR; PG8_SCHED;
            PG8_LDB(B0, 1, 0); PG8_LDB(B1, 1, 1); PG8_SCHED; PG8_LDA(At, 1, 0); PG8_STAGE(PG8_SA(0, 1), a2 + hstep, voffA);
            PG8_WAIT_V(8); PG8_WAIT_L(0); PG8_BAR; PG8_MMA(0, 0, At, B0); PG8_MMA(0, 1, At, B1); PG8_BAR; PG8_SCHED;
            PG8_LDA(At, 1, 1); PG8_STAGE(PG8_SB(1, 0), b3, voffB); PG8_STAGE(PG8_SB(1, 1), b3 + hstep, voffB); PG8_STAGE(PG8_SA(1, 0), a3, voffA);
            PG8_WAIT_V(8); PG8_WAIT_L(0); PG8_BAR; PG8_MMA(1, 0, At, B0); PG8_MMA(1, 1, At, B1); PG8_BAR; PG8_SCHED;
            } else {
            PG8_LDB(B0, 0, 0); PG8_SCHED; PG8_LDA(At, 0, 0); PG8_STAGE(PG8_SA(1, 1), a1 + hstep, voffA);
            PG8_WAIT_L(8); PG8_BAR; PG8_WAIT_L(0); PG8_MMA(0, 0, At, B0); PG8_BAR; PG8_SCHED;
            PG8_LDB(B1, 0, 1); PG8_STAGE(PG8_SB(0, 0), b2, voffB);
            PG8_BAR; PG8_WAIT_L(0); PG8_MMA(0, 1, At, B1); PG8_BAR;
            PG8_LDA(At, 0, 1); PG8_STAGE(PG8_SA(0, 0), a2, voffA);
            PG8_BAR; PG8_WAIT_L(0); PG8_MMA(1, 0, At, B0); PG8_BAR; PG8_SCHED;
            PG8_STAGE(PG8_SB(0, 1), b2 + hstep, voffB);
            PG8_WAIT_V(6); PG8_BAR; PG8_MMA(1, 1, At, B1); PG8_BAR;
            PG8_LDB(B0, 1, 0); PG8_SCHED; PG8_LDA(At, 1, 0); PG8_STAGE(PG8_SA(0, 1), a2 + hstep, voffA);
            PG8_WAIT_L(8); PG8_BAR; PG8_WAIT_L(0); PG8_MMA(0, 0, At, B0); PG8_BAR; PG8_SCHED;
            PG8_LDB(B1, 1, 1); PG8_STAGE(PG8_SB(1, 0), b3, voffB);
            PG8_BAR; PG8_WAIT_L(0); PG8_MMA(0, 1, At, B1); PG8_BAR;
            PG8_LDA(At, 1, 1); PG8_STAGE(PG8_SA(1, 0), a3, voffA);
            PG8_BAR; PG8_WAIT_L(0); PG8_MMA(1, 0, At, B0); PG8_BAR; PG8_SCHED;
            PG8_STAGE(PG8_SB(1, 1), b3 + hstep, voffB);
            PG8_WAIT_V(6); PG8_BAR; PG8_MMA(1, 1, At, B1); PG8_BAR;
            }
        }
        if constexpr (ALIGN_EPI) { if (wr == 0) PG8_BAR; }
        if constexpr (!Epi::AFTER_DRAIN) { E(acc, cur, wr, wc, fr, fq); S.done(cur); }
        if (!has_next) break;
#pragma unroll
        for (int a = 0; a < 2; ++a)
#pragma unroll
            for (int b = 0; b < 2; ++b)
#pragma unroll
                for (int m = 0; m < 4; ++m)
#pragma unroll
                    for (int n = 0; n < 2; ++n) acc[a][b][m][n] = (f32x4){0.f, 0.f, 0.f, 0.f};
        cur = nxt; cA = nA; cB = nB; ++ui;
        if constexpr (ALIGN_EPI) { if (wr == 1) PG8_BAR; }
    }
    PG8_WAIT_V(0);
    if constexpr (!ALIGN_EPI) { if (wr == 0) PG8_BAR; }
    PG8_BAR;
    if constexpr (Epi::AFTER_DRAIN) { E.fused(acc, cur, wr, wc, fr, fq, lds, wid, lane); S.done(cur); }
#undef PG8_SA
#undef PG8_SB
#undef PG8_STAGE
#undef PG8_LDA
#undef PG8_LDB
#undef PG8_MMA
#undef PG8_WAIT_V
#undef PG8_WAIT_L
#undef PG8_BAR
#undef PG8_SCHED
}
}

#define PG8_SP2 true
#define PG8_ALIGN true
namespace attn_body {
using bf16=__hip_bfloat16;
using bf16x8=__attribute__((ext_vector_type(8)))short;
using s16x4=__attribute__((ext_vector_type(4)))short;
using f32x16=__attribute__((ext_vector_type(16)))float;
using u32x4=__attribute__((ext_vector_type(4)))unsigned;
constexpr int BATCH=8,NHEAD=6,SEQ=4096,D=64,DM=3328,OPITCH=1024;
constexpr int NW=8,QBLK=32,QB=QBLK*NW,KVBLK=64,NQB=SEQ/QB;
constexpr int ATTN_PITCH=DM, ATTN_UNIT_ROWS=QB;
__device__ __forceinline__ int crow(int r,int hi){return (r&3)+8*(r>>2)+4*hi;}
#define SBAR() __builtin_amdgcn_sched_barrier(0)
__device__ __forceinline__ void cmask(f32x16&p0,f32x16&p1,int jb,int qrel,int hi){
  const float NEG=-INFINITY; int kb=64*jb+4*hi;
  #pragma unroll
  for(int r=0;r<16;++r){int kv=kb+(r&3)+8*(r>>2); if(kv>qrel)p0[r]=NEG; if(kv+32>qrel)p1[r]=NEG;}
}

constexpr int NSLOT=3, SLOTB=8192;
constexpr int LDS_K=0, LDS_V=NSLOT*SLOTB, LDS_WS=2*NSLOT*SLOTB, LDS_OST=LDS_WS+NW*64*4, LDS_OST1=LDS_OST+NW*4096, LDS_BYTES=LDS_OST1+NW*4096;
constexpr float C2=0.17677669529663687f*1.4426950408889634f;
__device__ __forceinline__ void glds16(const void*gsrc,unsigned lds_dst){unsigned keep;
  asm volatile("s_mov_b32 %0, m0\n\ts_mov_b32 m0, %2\n\ts_nop 0\n\tglobal_load_lds_dwordx4 %1, off\n\ts_mov_b32 m0, %0":"=&s"(keep):"v"(gsrc),"s"(lds_dst):"memory");}
__device__ __forceinline__ float max3f(float a,float b,float c){float r;asm("v_max3_f32 %0, %1, %2, %3":"=v"(r):"v"(a),"v"(b),"v"(c));return r;}
__device__ __forceinline__ float max2f(float a,float b){float r;asm("v_max_f32_e32 %0, %1, %2":"=v"(r):"v"(a),"v"(b));return r;}
__device__ __forceinline__ float fadd_s(float a,float b){float r;asm("v_add_f32_e32 %0, %1, %2":"=v"(r):"v"(a),"v"(b));return r;}
__device__ __forceinline__ float fsub_s(float a,float b){float r;asm("v_sub_f32_e32 %0, %1, %2":"=v"(r):"v"(a),"v"(b));return r;}
typedef float f32x2_t __attribute__((ext_vector_type(2))); typedef __bf16 bf16x2_t __attribute__((ext_vector_type(2)));
__device__ __forceinline__ unsigned cvtpk_s(float lo,float hi){f32x2_t v={lo,hi};bf16x2_t b=__builtin_convertvector(v,bf16x2_t);return __builtin_bit_cast(unsigned,b);}
#define WAIT_BAR(N) asm volatile("s_waitcnt vmcnt(" #N ") lgkmcnt(0)\n\ts_barrier":::"memory")

__device__ __forceinline__ void qkt(f32x16&p0,f32x16&p1,const char*Kslot,const bf16x8*qr,const f32x16&negm,int r32,int hi){
  const char*kb=Kslot+hi*1024+r32*16;
  #pragma unroll
  for(int d0=0;d0<4;++d0){
    const bf16x8 b0=*reinterpret_cast<const bf16x8*>(kb+d0*2048);
    const bf16x8 b1=*reinterpret_cast<const bf16x8*>(kb+d0*2048+512);
    if(d0==0){p0=__builtin_amdgcn_mfma_f32_32x32x16_bf16(b0,qr[0],negm,0,0,0);p1=__builtin_amdgcn_mfma_f32_32x32x16_bf16(b1,qr[0],negm,0,0,0);}
    else{p0=__builtin_amdgcn_mfma_f32_32x32x16_bf16(b0,qr[d0],p0,0,0,0);p1=__builtin_amdgcn_mfma_f32_32x32x16_bf16(b1,qr[d0],p1,0,0,0);}}
}
typedef __attribute__((address_space(3))) const char* lds_cptr;
typedef short v4i16_t __attribute__((ext_vector_type(4)));
__device__ __forceinline__ void kload8(bf16x8*kf,lds_cptr kp){
  kf[0]=*(const __attribute__((address_space(3))) bf16x8*)(kp);      kf[1]=*(const __attribute__((address_space(3))) bf16x8*)(kp+512);
  kf[2]=*(const __attribute__((address_space(3))) bf16x8*)(kp+2048); kf[3]=*(const __attribute__((address_space(3))) bf16x8*)(kp+2560);
  kf[4]=*(const __attribute__((address_space(3))) bf16x8*)(kp+4096); kf[5]=*(const __attribute__((address_space(3))) bf16x8*)(kp+4608);
  kf[6]=*(const __attribute__((address_space(3))) bf16x8*)(kp+6144); kf[7]=*(const __attribute__((address_space(3))) bf16x8*)(kp+6656);
}
__device__ __forceinline__ void kload2(bf16x8*kf,lds_cptr kp,int j){ kf[2*j]=*(const __attribute__((address_space(3))) bf16x8*)(kp+j*2048); kf[2*j+1]=*(const __attribute__((address_space(3))) bf16x8*)(kp+j*2048+512); }
__device__ __forceinline__ s16x4 vtr(lds_cptr p){ return __builtin_bit_cast(s16x4,__builtin_amdgcn_ds_read_tr16_b64_v4i16((__attribute__((address_space(3))) v4i16_t*)p)); }
__device__ __forceinline__ float rowmax(const f32x16&p0,const f32x16&p1){
  float a=max3f(p0[0],p0[1],p1[0]),b=max3f(p0[2],p0[3],p1[1]);a=max3f(a,p1[2],p1[3]);
  #pragma unroll
  for(int r=4;r<16;r+=4){a=max3f(a,p0[r],p0[r+1]);b=max3f(b,p0[r+2],p0[r+3]);a=max3f(a,p1[r],p1[r+1]);b=max3f(b,p1[r+2],p1[r+3]);}
  const float m=max2f(a,b);
  auto rr=__builtin_amdgcn_permlane32_swap(__float_as_uint(m),__float_as_uint(m),false,false);
  return max2f(__uint_as_float(rr[0]),__uint_as_float(rr[1]));
}
__device__ __forceinline__ void pv(f32x16*o,int vb,bf16x8 pa0,bf16x8 pa1,bf16x8 pa2,bf16x8 pa3){
  #pragma unroll
  for(int d0=0;d0<2;++d0){s16x4 lo[4],hi[4];
    #pragma unroll
    for(int ks=0;ks<4;++ks){
      asm volatile("ds_read_b64_tr_b16 %0,%1 offset:%c2":"=&v"(lo[ks]):"v"(vb),"i"(d0*4096+ks*1024):"memory");
      asm volatile("ds_read_b64_tr_b16 %0,%1 offset:%c2":"=&v"(hi[ks]):"v"(vb),"i"(d0*4096+ks*1024+512):"memory");}
    asm volatile("s_waitcnt lgkmcnt(0)":::"memory");SBAR();
    #define PK(k) (bf16x8){lo[k][0],lo[k][1],lo[k][2],lo[k][3],hi[k][0],hi[k][1],hi[k][2],hi[k][3]}
    o[d0]=__builtin_amdgcn_mfma_f32_32x32x16_bf16(pa0,PK(0),o[d0],0,0,0);
    o[d0]=__builtin_amdgcn_mfma_f32_32x32x16_bf16(pa1,PK(1),o[d0],0,0,0);
    o[d0]=__builtin_amdgcn_mfma_f32_32x32x16_bf16(pa2,PK(2),o[d0],0,0,0);
    o[d0]=__builtin_amdgcn_mfma_f32_32x32x16_bf16(pa3,PK(3),o[d0],0,0,0);
    #undef PK
  }
}

#ifndef ATTN_STORE16
#define ATTN_STORE16(p,v) (*(u32x4*)(p)=(v))
#endif
template<int THRL> __device__ __forceinline__ void attn_unit(int b,int h,int qb,int nsel,float lam,const float*subg,float omli,const bf16*Q,const bf16*__restrict__ K,const bf16*__restrict__ V,bf16*O,char*shm){
  int tid_=threadIdx.x; asm volatile("":"+v"(tid_)); const int tid=tid_,lane=tid&63,r32=lane&31,hi=lane>>5; const int wid=__builtin_amdgcn_readfirstlane(tid>>6);
  const long rowbase=(long)b*SEQ; const int q0=qb*QB;
  const bf16*Qw=Q+(rowbase+q0+wid*QBLK)*DM+h*D;
  const bf16*Kh=K+rowbase*DM+h*D,*Vh=V+rowbase*DM+h*D;
  const unsigned lds0=(unsigned)(uintptr_t)shm;
  float*wsf=(float*)(shm+LDS_WS)+wid*64;
  const bf16*ksrc=Kh+(long)lane*DM+wid*8;
  const bf16*vsrc=Vh+(long)(16*(wid&3)+(lane>>2))*DM+(wid>>2)*32+(lane&3)*8;
  const unsigned kdst=lds0+LDS_K+wid*1024, vdst=lds0+LDS_V+wid*1024;
  #define DMA_K(t,slot) glds16(ksrc+(long)(t)*KVBLK*DM,(unsigned)__builtin_amdgcn_readfirstlane(kdst+(slot)))
  #define DMA_V(t,slot) glds16(vsrc+(long)(t)*KVBLK*DM,(unsigned)__builtin_amdgcn_readfirstlane(vdst+(slot)))
  const int vb0=(int)(lds0+LDS_V)+((lane>>4)&1)*32+(lane&3)*8+(4*hi+((lane&15)>>2))*64;
  const char*Kbase=shm+LDS_K; bf16x8 kf[8];
  const lds_cptr shm3=(lds_cptr)shm; const lds_cptr kp0=shm3+LDS_K+hi*1024+r32*16; const lds_cptr vp0=shm3+LDS_V+((lane>>4)&1)*32+(lane&3)*8+(4*hi+((lane&15)>>2))*64;
  const int NT=(q0+QB)/KVBLK;
  DMA_K(0,0);DMA_V(0,0);DMA_K(1,SLOTB);
  bf16x8 qr[4];
  #pragma unroll
  for(int d0=0;d0<4;++d0){qr[d0]=*reinterpret_cast<const bf16x8*>(&Qw[(long)r32*DM+d0*16+hi*8]); if((d0>>1)!=nsel)qr[d0]=bf16x8{0,0,0,0,0,0,0,0};}
  float mhat=0.f,l_reg=0.f;f32x16 o[2];o[0]=f32x16{};o[1]=f32x16{};f32x16 negm=f32x16{};asm volatile("":"+v"(negm));
  const int qrel=wid*QBLK+r32;
  #define CMASK(P0,P1,t) do{int jb_=(t)-(NT-4); if(jb_>=0)cmask(P0,P1,jb_,qrel,hi);}while(0)
  bool resc=false;
  #define START(P0,P1) do{ const float rm=rowmax(P0,P1); resc=false; \
    { const float dl=rm; mhat=fadd_s(mhat,dl); \
      _Pragma("unroll") for(int r=0;r<16;++r){P0[r]=fsub_s(P0[r],dl);P1[r]=fsub_s(P1[r],dl);} \
      _Pragma("unroll") for(int r=0;r<16;++r)negm[r]=-mhat; asm volatile("":"+v"(negm)); } \
    _Pragma("unroll") for(int r=0;r<16;++r)P0[r]=__builtin_amdgcn_exp2f(P0[r]); }while(0)
  #define RESC() do{ if(resc){ asm volatile("s_waitcnt lgkmcnt(0)":::"memory"); \
      _Pragma("unroll") for(int d_=0;d_<2;++d_) _Pragma("unroll") for(int r=0;r<16;++r)o[d_][r]*=wsf[crow(r,hi)]; } }while(0)
  f32x16 pA0,pA1,pB0,pB1;
  int sl_prev=0,sl_cur=0,sl_next=SLOTB;
  #define ROT() do{sl_prev=sl_cur;sl_cur=sl_next;sl_next=(sl_next==(NSLOT-1)*SLOTB)?0:sl_next+SLOTB;}while(0)
  DMA_K(2,2*SLOTB);
  WAIT_BAR(3);
  qkt(pA0,pA1,Kbase,qr,negm,r32,hi);asm volatile("s_nop 15\n\ts_nop 7":"+v"(pA0),"+v"(pA1));CMASK(pA0,pA1,0);
  START(pA0,pA1);
  _Pragma("unroll") for(int r=0;r<16;++r)pA1[r]=__builtin_amdgcn_exp2f(pA1[r]);
  WAIT_BAR(0);
  DMA_K(3,0);DMA_V(1,SLOTB);
  ROT();
  kload8(kf,kp0+sl_cur);
  WAIT_BAR(2);
  s16x4 vlo[8],vhi[8]; u32x4 pw0,pw1,pw2,pw3;
  #define PKW(P,B) cvtpk_s(P[B],P[B+1])
  #define PAF(k) __builtin_bit_cast(bf16x8,pw##k)
  #define VFR(i) (bf16x8){vlo[i][0],vlo[i][1],vlo[i][2],vlo[i][3],vhi[i][0],vhi[i][1],vhi[i][2],vhi[i][3]}
  #define PIN(x) asm volatile("":"+v"(x))
  #define MX3(a,b,c) __builtin_fmaxf(__builtin_fmaxf((a),(b)),(c))
  #define GAPA(MF,A0,A1,A2,A3,W0,W1,PW) do{ MF; sacc+=A0; sacc+=A1; sacc+=A2; sacc+=A3; PIN(sacc); W0; W1; PIN(PW); SBAR(); }while(0)
  #define EX(v) __builtin_amdgcn_exp2f(v)
  #define GAPB(MF,X,B) do{ MF; X[B]=EX(X[B]); X[B+1]=EX(X[B+1]); X[B+2]=EX(X[B+2]); X[B+3]=EX(X[B+3]); PIN(X); SBAR(); }while(0)
  #define VRD(i) do{ vlo[i]=vtr(vp_+(((i)>>2)*4096+((i)&3)*1024)); vhi[i]=vtr(vp_+(((i)>>2)*4096+((i)&3)*1024+512)); }while(0)
  #define KRD(G,j) do{ if(G){ kload2(kf,kp0+sl_next,j); SBAR(); } }while(0)
  #define STEP(C0,C1,P0,P1,t,GK,GV,GL) do{ SBAR(); \
    const lds_cptr vp_=vp0+sl_prev; \
    VRD(0); SBAR(); float sacc=(P0[0]+P0[1]); \
    GAPA(C0=__builtin_amdgcn_mfma_f32_32x32x16_bf16(kf[0],qr[0],negm,0,0,0), P0[2],P0[3],P0[4],P0[5],     pw0[0]=PKW(P0,0), pw0[1]=PKW(P0,2), pw0); \
    VRD(4); SBAR(); GAPA(C1=__builtin_amdgcn_mfma_f32_32x32x16_bf16(kf[1],qr[0],negm,0,0,0), P0[6],P0[7],P0[8],P0[9],     pw0[2]=PKW(P0,4), pw0[3]=PKW(P0,6), pw0); \
    VRD(1); SBAR(); GAPA(C0=__builtin_amdgcn_mfma_f32_32x32x16_bf16(kf[2],qr[1],C0,0,0,0),   P0[10],P0[11],P0[12],P0[13], pw1[0]=PKW(P0,8), pw1[1]=PKW(P0,10), pw1); \
    VRD(5); SBAR(); GAPA(C1=__builtin_amdgcn_mfma_f32_32x32x16_bf16(kf[3],qr[1],C1,0,0,0),   P0[14],P0[15],P1[0],P1[1],   pw1[2]=PKW(P0,12),pw1[3]=PKW(P0,14), pw1); \
    VRD(2); SBAR(); GAPA(C0=__builtin_amdgcn_mfma_f32_32x32x16_bf16(kf[4],qr[2],C0,0,0,0),   P1[2],P1[3],P1[4],P1[5],     pw2[0]=PKW(P1,0), pw2[1]=PKW(P1,2), pw2); \
    VRD(6); SBAR(); GAPA(C1=__builtin_amdgcn_mfma_f32_32x32x16_bf16(kf[5],qr[2],C1,0,0,0),   P1[6],P1[7],P1[8],P1[9],     pw2[2]=PKW(P1,4), pw2[3]=PKW(P1,6), pw2); \
    VRD(3); SBAR(); GAPA(C0=__builtin_amdgcn_mfma_f32_32x32x16_bf16(kf[6],qr[3],C0,0,0,0),   P1[10],P1[11],P1[12],P1[13], pw3[0]=PKW(P1,8), pw3[1]=PKW(P1,10), pw3); \
    VRD(7); SBAR(); GAPA(C1=__builtin_amdgcn_mfma_f32_32x32x16_bf16(kf[7],qr[3],C1,0,0,0),   P1[14],P1[15],0.f,0.f,       pw3[2]=PKW(P1,12),pw3[3]=PKW(P1,14), pw3); \
    l_reg+=sacc; \
    if(GK){DMA_K((t)+3,sl_cur);} if(GV){DMA_V((t)+1,sl_next);} \
    CMASK(C0,C1,t); \
    { float a=MX3(C0[0],C0[1],C1[0]),b=MX3(C0[2],C0[3],C1[1]); a=MX3(a,C1[2],C1[3]); \
      _Pragma("unroll") for(int r=4;r<16;r+=4){a=MX3(a,C0[r],C0[r+1]);b=MX3(b,C0[r+2],C0[r+3]);a=MX3(a,C1[r],C1[r+1]);b=MX3(b,C1[r+2],C1[r+3]);} \
      float rm=__builtin_fmaxf(a,b); { auto rr=__builtin_amdgcn_permlane32_swap(__float_as_uint(rm),__float_as_uint(rm),false,false); rm=__builtin_fmaxf(__uint_as_float(rr[0]),__uint_as_float(rr[1])); } \
      resc=false; \
      if(__builtin_expect(__any(rm>(float)THRL),0)){ const float dl=__builtin_fmaxf(rm,0.f); mhat+=dl; \
        _Pragma("unroll") for(int r=0;r<16;++r){C0[r]-=dl;C1[r]-=dl;} \
        _Pragma("unroll") for(int r=0;r<16;++r)negm[r]=-mhat; asm volatile("":"+v"(negm)); \
        const float f=__builtin_amdgcn_exp2f(-dl); l_reg*=f; if(hi==0)wsf[r32]=f; resc=true; } } \
    SBAR(); \
    GAPB(o[0]=__builtin_amdgcn_mfma_f32_32x32x16_bf16(PAF(0),VFR(0),o[0],0,0,0), C0,0); \
    GAPB(o[1]=__builtin_amdgcn_mfma_f32_32x32x16_bf16(PAF(0),VFR(4),o[1],0,0,0), C0,4); \
    KRD(GL,0); GAPB(o[0]=__builtin_amdgcn_mfma_f32_32x32x16_bf16(PAF(1),VFR(1),o[0],0,0,0), C0,8); \
    KRD(GL,1); GAPB(o[1]=__builtin_amdgcn_mfma_f32_32x32x16_bf16(PAF(1),VFR(5),o[1],0,0,0), C0,12); \
    KRD(GL,2); GAPB(o[0]=__builtin_amdgcn_mfma_f32_32x32x16_bf16(PAF(2),VFR(2),o[0],0,0,0), C1,0); \
    KRD(GL,3); GAPB(o[1]=__builtin_amdgcn_mfma_f32_32x32x16_bf16(PAF(2),VFR(6),o[1],0,0,0), C1,4); \
    GAPB(o[0]=__builtin_amdgcn_mfma_f32_32x32x16_bf16(PAF(3),VFR(3),o[0],0,0,0), C1,8); \
    GAPB(o[1]=__builtin_amdgcn_mfma_f32_32x32x16_bf16(PAF(3),VFR(7),o[1],0,0,0), C1,12); \
    }while(0)
  int t=1;
  #undef CMASK
  #define CMASK(P0,P1,t) do{}while(0)
  for(;t+5<NT;t+=2){
    STEP(pB0,pB1,pA0,pA1,t,true,true,true);     WAIT_BAR(2); RESC(); ROT();
    STEP(pA0,pA1,pB0,pB1,t+1,true,true,true);   WAIT_BAR(2); RESC(); ROT();
  }
  #undef CMASK
  #define CMASK(P0,P1,t) do{int jb_=(t)-(NT-4); if(jb_>=0)cmask(P0,P1,jb_,qrel,hi);}while(0)
  #define ENDW(tt) do{ if((tt)+3<NT){WAIT_BAR(2);} else if((tt)+2<NT){WAIT_BAR(1);} else {WAIT_BAR(0);} }while(0)
  for(;t+1<NT;t+=2){
    STEP(pB0,pB1,pA0,pA1,t,(t+3<NT),(t+1<NT),(t+1<NT));       ENDW(t);   RESC(); ROT();
    STEP(pA0,pA1,pB0,pB1,t+1,(t+4<NT),(t+2<NT),(t+2<NT));     ENDW(t+1); RESC(); ROT();
  }
  STEP(pB0,pB1,pA0,pA1,NT-1,false,false,false); RESC();
  { float sacc=pB0[0]+pB0[1]; _Pragma("unroll") for(int r=2;r<16;++r)sacc+=pB0[r]; _Pragma("unroll") for(int r=0;r<16;++r)sacc+=pB1[r]; l_reg+=sacc;
    pw0=(u32x4){PKW(pB0,0),PKW(pB0,2),PKW(pB0,4),PKW(pB0,6)};pw1=(u32x4){PKW(pB0,8),PKW(pB0,10),PKW(pB0,12),PKW(pB0,14)};pw2=(u32x4){PKW(pB1,0),PKW(pB1,2),PKW(pB1,4),PKW(pB1,6)};pw3=(u32x4){PKW(pB1,8),PKW(pB1,10),PKW(pB1,12),PKW(pB1,14)};
    SBAR(); pv(o,vb0+sl_cur,PAF(0),PAF(1),PAF(2),PAF(3)); }
  #undef PKW
  #undef PAF
  #undef VFR
  #undef PIN
  #undef MX3
  #undef GAPA
  #undef GAPB
  #undef EX
  #undef VRD
  #undef KRD
  #undef STEP
  #undef ENDW
  {auto rr=__builtin_amdgcn_permlane32_swap(__float_as_uint(l_reg),__float_as_uint(l_reg),false,false);l_reg=__uint_as_float(rr[0])+__uint_as_float(rr[1]);}
  if(hi==0)wsf[32+r32]=l_reg;asm volatile("s_waitcnt lgkmcnt(0)":::"memory");
  float rli[16];
  #pragma unroll
  for(int r=0;r<16;++r)rli[r]=__builtin_amdgcn_rcpf(wsf[32+crow(r,hi)]);
  bf16*Ow=O+(rowbase+q0+wid*QBLK)*OPITCH+h*D;
  { bf16*stg=(bf16*)(shm+(nsel==0?LDS_OST1:LDS_OST))+wid*2048;
    #pragma unroll
    for(int r=0;r<16;++r){const int orow=crow(r,hi);
      #pragma unroll
      for(int d0=0;d0<2;++d0)stg[orow*64+d0*32+r32]=__float2bfloat16(o[d0][r]*rli[r]);}
    asm volatile("s_waitcnt lgkmcnt(0)":::"memory");
    if(nsel==1){ const bf16*stg1=(const bf16*)(shm+LDS_OST1)+wid*2048;
      #pragma unroll
      for(int i=0;i<4;++i){const int row=i*8+(lane>>3),ch=lane&7; const u32x4 v2=*(const u32x4*)(stg+row*64+ch*8); const u32x4 v1=*(const u32x4*)(stg1+row*64+ch*8);
        float dd[8]; float ss=0.f;
        #pragma unroll
        for(int j=0;j<4;++j){ const float a0=__uint_as_float(v1[j]<<16),a1=__uint_as_float(v1[j]&0xffff0000u),b0=__uint_as_float(v2[j]<<16),b1=__uint_as_float(v2[j]&0xffff0000u);
          dd[2*j]=a0-lam*b0; dd[2*j+1]=a1-lam*b1; ss+=dd[2*j]*dd[2*j]+dd[2*j+1]*dd[2*j+1]; }
        ss+=__shfl_xor(ss,1); ss+=__shfl_xor(ss,2); ss+=__shfl_xor(ss,4);
        const float rs=omli/sqrtf(ss*(1.0f/64.0f)+1e-6f);
        u32x4 w;
        #pragma unroll
        for(int j=0;j<4;++j) w[j]=cvtpk_s(dd[2*j]*rs*subg[ch*8+2*j],dd[2*j+1]*rs*subg[ch*8+2*j+1]);
        ATTN_STORE16(Ow+(long)row*OPITCH+ch*8,w);} } }
  asm volatile("s_waitcnt lgkmcnt(0)\n\ts_barrier":::"memory");
  #undef DMA_K
  #undef DMA_V
  #undef CMASK
  #undef START
  #undef RESC
  #undef ROT

}
#undef SBAR
#undef WAIT_BAR
}
#ifndef GOFF
#define GOFF 0
#endif
#define GEMMCALL0 if (!((GOFF) & 1))
#define GEMMCALL1 if (!((GOFF) & 2))
#define GEMMCALL2 if (!((GOFF) & 4))
#define GEMMCALL3 if (!((GOFF) & 8))
namespace cg = cooperative_groups;
#define GAS __attribute__((address_space(1)))
#define LAS __attribute__((address_space(3)))
#define DI __device__ __forceinline__
typedef unsigned short bf16;
typedef unsigned v4u __attribute__((ext_vector_type(4)));
typedef unsigned v2u __attribute__((ext_vector_type(2)));
typedef float f32x4 __attribute__((ext_vector_type(4)));
typedef short bf16x8 __attribute__((ext_vector_type(8)));

constexpr int NWAVES = 8;
constexpr int DMODEL = 1024, SEQ = 4096, M = 32768, NIN = 3328, FF = 4096;
constexpr int RW = 384, RCOLS = 1408, ROFF = 1920, COFF = 1152;
constexpr float NORM_EPS = 1e-6f, GN_EPS = 64e-5f;
constexpr size_t MiB = 1u << 20;
constexpr size_t WS_CTL = 0, CTL_ZERO_BYTES = 65536;
constexpr int CW_BAR = 4096;
constexpr size_t WS_WIN = 1 * MiB, WS_WOUT = 14 * MiB, WS_WUP = 18 * MiB, WS_WDN = 34 * MiB, WS_LORA = 50 * MiB;
constexpr size_t WS_XB = 51 * MiB, WS_PROJ = 115 * MiB, WS_MIX = 323 * MiB, WS_S = 387 * MiB, WS_END = 507 * MiB;
constexpr size_t WS_HID = 115 * MiB;
constexpr size_t SARR = (size_t)M * RW;
constexpr int LORA_L = 384 * 64 * 2 + 384 * 128;
constexpr int LDS_BYTES = 147456, MISC_OFF = 131072;
constexpr int SCAN_WGS = 96, ATT_ITEMS = 768;

#ifndef PROBE
#define PROBE 0
#endif
struct Args { const float* in[25]; float* out; unsigned char* ws; int i0, i1; };

DI float wave_sum(float v) {
#pragma unroll
    for (int o = 1; o < 64; o <<= 1) v += __shfl_xor(v, o);
    return v;
}
DI unsigned f2bf(float f) { unsigned u = __builtin_bit_cast(unsigned, f); return (u + 0x7fffu + ((u >> 16) & 1u)) >> 16; }
DI unsigned pk2(float lo, float hi) { return f2bf(lo) | (f2bf(hi) << 16); }
DI float bflo(unsigned w) { return __uint_as_float(w << 16); }
DI float bfhi(unsigned w) { return __uint_as_float(w & 0xffff0000u); }
DI float bf1(const bf16* p) { return __uint_as_float(((unsigned)*p) << 16); }
DI void unpack8(v4u w, float* f) { f[0] = bflo(w.x); f[1] = bfhi(w.x); f[2] = bflo(w.y); f[3] = bfhi(w.y); f[4] = bflo(w.z); f[5] = bfhi(w.z); f[6] = bflo(w.w); f[7] = bfhi(w.w); }
DI v4u pack8(const float* f) { v4u o; o.x = pk2(f[0], f[1]); o.y = pk2(f[2], f[3]); o.z = pk2(f[4], f[5]); o.w = pk2(f[6], f[7]); return o; }
DI float sigmoidf_(float x) { return 1.f / (1.f + __expf(-x)); }
DI float tanhf_(float x) { const float e = __expf(2.f * x); return 1.f - 2.f / (e + 1.f); }
template <int CTRL> DI float dpp_add(float x) { return x + __int_as_float(__builtin_amdgcn_update_dpp(0, __float_as_int(x), CTRL, 0xf, 0xf, true)); }
DI float red16(float x) { x = dpp_add<0xB1>(x); x = dpp_add<0x4E>(x); x = dpp_add<0x141>(x); x = dpp_add<0x140>(x); return x; }

#define XB_TMO      128
#define XB_XCNT(j)  (256  + 64 * (j))
#define XB_XSUB(j)  (1280 + 64 * (j))
#define XB_XGEN(j)  (2304 + 64 * (j))
#define XB_TOP      3328
#define XB_TOPGEN   3392
#define XCD_BAR_WORDS 3456
#define XB_SPIN_CAP (1u << 18)

__device__ __forceinline__ unsigned xb_ld(unsigned* p)              { return __hip_atomic_load(p, __ATOMIC_RELAXED, __HIP_MEMORY_SCOPE_AGENT); }
__device__ __forceinline__ unsigned xb_add(unsigned* p, unsigned v) { return __hip_atomic_fetch_add(p, v, __ATOMIC_RELAXED, __HIP_MEMORY_SCOPE_AGENT); }
__device__ __forceinline__ unsigned xb_xcc_id() { return (unsigned)__builtin_amdgcn_s_getreg((3 << 11) | 20) & 0xFu; }
#define XB_SPIN(cond, bar) do { unsigned _sp = 0; while (cond) { __builtin_amdgcn_s_sleep(1); \
    if ((++_sp & 255u) == 0u) { if (xb_ld(&(bar)[XB_TMO])) break; if (_sp > XB_SPIN_CAP) { atomicAdd(&(bar)[XB_TMO], 1u); break; } } } } while (0)

struct XcdBarrier {
    unsigned* bar; unsigned x;
    volatile LAS unsigned* st;
};

__device__ __forceinline__ XcdBarrier xcd_barrier_post(unsigned* bar, volatile LAS unsigned* st) {
    XcdBarrier b; b.bar = bar; b.x = xb_xcc_id(); b.st = st;
    if (threadIdx.x == 0) (void)xb_add(&bar[XB_XCNT(b.x)], 1u);
    return b;
}
__device__ __forceinline__ void xcd_barrier_complete(unsigned* bar, unsigned x, unsigned& nloc, unsigned& nx) {
    const unsigned G = gridDim.x * gridDim.y * gridDim.z;
    unsigned sum, cnt, mine, sp = 0u;
    for (;;) {
        sum = 0u; cnt = 0u; mine = 0u;
#pragma unroll
        for (unsigned j = 0; j < 16; ++j) { const unsigned c = xb_ld(&bar[XB_XCNT(j)]); sum += c; cnt += (c > 0u) ? 1u : 0u; mine = (j == x) ? c : mine; }
        if (sum == G) break;
        __builtin_amdgcn_s_sleep(1);
        if ((++sp & 255u) == 0u) { if (xb_ld(&bar[XB_TMO])) break; if (sp > XB_SPIN_CAP) { atomicAdd(&bar[XB_TMO], 1u); break; } }
    }
    nloc = mine > 0u ? mine : 1u; nx = cnt > 0u ? cnt : 1u;
}

__device__ __forceinline__ void xcd_barrier(const XcdBarrier& b) {
    asm volatile("s_waitcnt vmcnt(0)" ::: "memory");
    __syncthreads();
    if (threadIdx.x == 0) {
        unsigned* bar = b.bar;
        __builtin_amdgcn_s_waitcnt(0);
        unsigned nloc = b.st[0], nx = b.st[1];
        if (nloc == 0u) { xcd_barrier_complete(bar, b.x, nloc, nx); b.st[0] = nloc; b.st[1] = nx; }
        const unsigned old = xb_add(&bar[XB_XSUB(b.x)], 1u);
        const unsigned gen = old / nloc;
        if (old + 1u == (gen + 1u) * nloc) {
            __builtin_amdgcn_fence(__ATOMIC_RELEASE, "agent");
            asm volatile("s_waitcnt vmcnt(0)" ::: "memory");
            const unsigned og = xb_add(&bar[XB_TOP], 1u);
            const unsigned tg = og / nx;
            if (og + 1u == (tg + 1u) * nx) xb_add(&bar[XB_TOPGEN], 1u);
            else XB_SPIN(xb_ld(&bar[XB_TOPGEN]) == tg, bar);
            __builtin_amdgcn_fence(__ATOMIC_ACQUIRE, "agent");
            xb_add(&bar[XB_XGEN(b.x)], 1u);
            asm volatile("s_waitcnt vmcnt(0)" ::: "memory");
        } else {
            XB_SPIN(xb_ld(&bar[XB_XGEN(b.x)]) == gen, bar);
            __builtin_amdgcn_fence(__ATOMIC_ACQUIRE, "agent");
            asm volatile("s_waitcnt vmcnt(0)" ::: "memory");
        }
    }
    __syncthreads();
}


struct Frame {
    LAS unsigned char* lds;
    int tid, lane, wave, G, gw, NGW;
    const float* const* in;
    float* out; unsigned char* ws;
};
DI const float* INP(const Frame& F, int k) { asm volatile("" : "+s"(k)); return F.in[k]; }
#define F_WIN  ((bf16*)(F.ws + WS_WIN))
#define F_WOUT ((bf16*)(F.ws + WS_WOUT))
#define F_WUP  ((bf16*)(F.ws + WS_WUP))
#define F_WDN  ((bf16*)(F.ws + WS_WDN))
#define F_LORA ((bf16*)(F.ws + WS_LORA))
#define F_XB   ((bf16*)(F.ws + WS_XB))
#define F_PROJ ((bf16*)(F.ws + WS_PROJ))
#define F_MIX  ((bf16*)(F.ws + WS_MIX))
#define F_HID  ((bf16*)(F.ws + WS_HID))
#define F_S_r  ((bf16*)(F.ws + WS_XB))
#define F_S_ld ((bf16*)(F.ws + WS_XB) + SARR)
#define F_S_k  ((bf16*)(F.ws + WS_S))
#define F_S_v  ((bf16*)(F.ws + WS_S) + SARR)
#define F_S_n  ((bf16*)(F.ws + WS_S) + 2 * SARR)
#define F_S_b  ((bf16*)(F.ws + WS_S) + 3 * SARR)
#define F_S_g  ((bf16*)(F.ws + WS_S) + 4 * SARR)
#define F_ctl  ((unsigned*)(F.ws + WS_CTL))

DI void transpose_item(const float* W, int K, int N, bf16* WT, LAS float* scr, int item, int lane, const float* gk, float cs, int csn) {
    const int nblk = N / 32, kb = item / nblk, nb = item % nblk, k0 = 64 * kb, n0 = 32 * nb;
    const float colscale = (n0 + (lane & 31) < csn) ? cs : 1.f;
#pragma unroll 8
    for (int i = 0; i < 32; ++i) { const int kk = 2 * i + (lane >> 5); float v = W[(size_t)(k0 + kk) * N + n0 + (lane & 31)]; if (gk) v *= gk[k0 + kk]; scr[kk * 33 + (lane & 31)] = v * colscale; }
    asm volatile("s_waitcnt lgkmcnt(0)" ::: "memory");
    const int c = lane & 7;
#pragma unroll
    for (int j = 0; j < 4; ++j) { const int n = (lane >> 3) + 8 * j; const LAS float* s = scr + (8 * c) * 33 + n;
        v4u o; o.x = pk2(s[0 * 33], s[1 * 33]); o.y = pk2(s[2 * 33], s[3 * 33]); o.z = pk2(s[4 * 33], s[5 * 33]); o.w = pk2(s[6 * 33], s[7 * 33]);
        *(v4u*)(WT + (size_t)(n0 + n) * K + k0 + 8 * c) = o; }
    asm volatile("s_waitcnt lgkmcnt(0)" ::: "memory");
}
DI Frame refresh(const Frame& F0) { Frame F = F0; int t = threadIdx.x; asm volatile("" : "+v"(t)); int bxx = blockIdx.x; asm volatile("" : "+s"(bxx)); F.tid = t; F.lane = t & 63; F.wave = __builtin_amdgcn_readfirstlane(t >> 6); F.gw = bxx * NWAVES + F.wave; return F; }
DI void prologue(const Frame& F0) { Frame F = refresh(F0);
    LAS float* scr = (LAS float*)(F.lds + F.wave * 16384);
    constexpr int I_IN = 16 * 104, I_OUT = 16 * 32, I_UP = 16 * 128, I_DN = 64 * 32, I_LW = 12, I_LG = 24;
    constexpr int PER = I_IN + I_OUT + I_UP + I_DN + 2 * I_LW + I_LG;
    constexpr float C2 = 0.17677669529663687f * 1.4426950408889634f;
    for (int it = F.gw; it < 2 * PER; it += F.NGW) {
        const int l = it / PER; int r = it % PER;
        if (r < I_IN) { transpose_item(INP(F, 2) + (size_t)l * DMODEL * NIN, DMODEL, NIN, F_WIN + (size_t)l * NIN * DMODEL, scr, r, F.lane, INP(F, 1) + l * DMODEL, C2, 384); continue; } r -= I_IN;
        if (r < I_OUT) { transpose_item(INP(F, 20) + (size_t)l * DMODEL * DMODEL, DMODEL, DMODEL, F_WOUT + (size_t)l * DMODEL * DMODEL, scr, r, F.lane, nullptr, 1.f, 0); continue; } r -= I_OUT;
        if (r < I_UP) { transpose_item(INP(F, 22) + (size_t)l * DMODEL * FF, DMODEL, FF, F_WUP + (size_t)l * FF * DMODEL, scr, r, F.lane, INP(F, 21) + l * DMODEL, 1.f, 0); continue; } r -= I_UP;
        if (r < I_DN) { transpose_item(INP(F, 23) + (size_t)l * FF * DMODEL, FF, DMODEL, F_WDN + (size_t)l * DMODEL * FF, scr, r, F.lane, nullptr, 1.f, 0); continue; } r -= I_DN;
        bf16* L = F_LORA + (size_t)l * LORA_L;
        if (r < I_LW) { transpose_item(INP(F, 11) + (size_t)l * 64 * RW, 64, RW, L, scr, r, F.lane, nullptr, 1.f, 0); continue; } r -= I_LW;
        if (r < I_LW) { transpose_item(INP(F, 13) + (size_t)l * 64 * RW, 64, RW, L + RW * 64, scr, r, F.lane, nullptr, 1.f, 0); continue; } r -= I_LW;
        transpose_item(INP(F, 14) + (size_t)l * 128 * RW, 128, RW, L + 2 * RW * 64, scr, r, F.lane, nullptr, 1.f, 0);
    }
}
DI void rms_rows_bf16(const Frame& F0, const float* src, bf16* dst) { Frame F = refresh(F0);
    for (int m = F.gw; m < M; m += F.NGW) {
        const f32x4* xr = (const f32x4*)(src + (size_t)m * DMODEL) + F.lane;
        f32x4 v[4]; float s2 = 0.f;
#pragma unroll
        for (int j = 0; j < 4; ++j) { v[j] = xr[64 * j]; s2 += (v[j].x * v[j].x + v[j].y * v[j].y) + (v[j].z * v[j].z + v[j].w * v[j].w); }
        const float rstd = 1.f / sqrtf(wave_sum(s2) * (1.f / DMODEL) + NORM_EPS);
        v2u* o8 = (v2u*)(dst + (size_t)m * DMODEL) + F.lane;
#pragma unroll
        for (int j = 0; j < 4; ++j) { v2u w; w.x = pk2(v[j].x * rstd, v[j].y * rstd); w.y = pk2(v[j].z * rstd, v[j].w * rstd); o8[64 * j] = w; }
    }
}
DI void final_norm(const Frame& F0, float* x, const float* g) { Frame F = refresh(F0);
    for (int m = F.gw; m < M; m += F.NGW) {
        f32x4* xr = (f32x4*)(x + (size_t)m * DMODEL) + F.lane; const f32x4* gr = (const f32x4*)g + F.lane;
        f32x4 v[4]; float s2 = 0.f;
#pragma unroll
        for (int j = 0; j < 4; ++j) { v[j] = xr[64 * j]; s2 += (v[j].x * v[j].x + v[j].y * v[j].y) + (v[j].z * v[j].z + v[j].w * v[j].w); }
        const float rstd = 1.f / sqrtf(wave_sum(s2) * (1.f / DMODEL) + NORM_EPS);
#pragma unroll
        for (int j = 0; j < 4; ++j) xr[64 * j] = v[j] * rstd * gr[64 * j];
    }
}

DI void loadz8(const bf16* prow, bool first, const float* mu, int col, float* z) {
    const v4u p = *(const v4u*)(prow + col); v4u q = (v4u){0u, 0u, 0u, 0u}; if (!first) q = *(const v4u*)(prow - NIN + col);
    const f32x4 m0 = *(const f32x4*)(mu + col), m1 = *(const f32x4*)(mu + col + 4);
    float pf[8], qf[8]; unpack8(p, pf); unpack8(q, qf);
#pragma unroll
    for (int j = 0; j < 4; ++j) { z[j] = pf[j] + m0[j] * (qf[j] - pf[j]); z[4 + j] = pf[4 + j] + m1[j] * (qf[4 + j] - pf[4 + j]); }
}
DI float loadz1(const bf16* prow, bool first, float mu, int col) { const float p = bf1(prow + col); const float q = first ? 0.f : bf1(prow - NIN + col); return p + mu * (q - p); }

DI void prep_phase(const Frame& F0, int l) { Frame F = refresh(F0);
    const float* mu = INP(F, 9) + l * RCOLS;
    const float* w0 = INP(F, 10) + l * RW; const float* a0 = INP(F, 12) + l * RW; const float* kkw = INP(F, 15) + l * RW; const float* kaw = INP(F, 16) + l * RW;
    const bf16* WUT = F_LORA + (size_t)l * LORA_L; const bf16* AUT = WUT + RW * 64; const bf16* GUT = AUT + RW * 64;
    const int row = F.lane & 15, kq = F.lane >> 4, tok = F.lane >> 2, cq = (F.lane & 3) * 16;
    LAS float* LW = (LAS float*)(F.lds + F.wave * 16384);
    for (int tile = F.gw; tile < M / 16; tile += F.NGW) {
        const int t0 = tile * 16;
        bf16x8 Aw[2], Aa[2], Ag[4];
        { const int t = t0 + row; const bool first = (t % SEQ) == 0; const bf16* prow = F_PROJ + (size_t)t * NIN + ROFF; float z[8];
#pragma unroll
          for (int ks = 0; ks < 2; ++ks) { loadz8(prow, first, mu, 1152 + ks * 32 + kq * 8, z);
#pragma unroll
              for (int j = 0; j < 8; ++j) z[j] = tanhf_(z[j]);
              Aw[ks] = __builtin_bit_cast(bf16x8, pack8(z)); }
#pragma unroll
          for (int ks = 0; ks < 2; ++ks) { loadz8(prow, first, mu, 1216 + ks * 32 + kq * 8, z); Aa[ks] = __builtin_bit_cast(bf16x8, pack8(z)); }
#pragma unroll
          for (int ks = 0; ks < 4; ++ks) { loadz8(prow, first, mu, 1280 + ks * 32 + kq * 8, z);
#pragma unroll
              for (int j = 0; j < 8; ++j) z[j] = sigmoidf_(z[j]);
              Ag[ks] = __builtin_bit_cast(bf16x8, pack8(z)); } }
#pragma unroll 1
        for (int hd = 0; hd < 6; ++hd) {
#pragma unroll
            for (int cgi = 0; cgi < 4; ++cgi) {
                const int ch = hd * 64 + cgi * 16 + row;
                f32x4 cw = (f32x4){0.f, 0.f, 0.f, 0.f}, ca = cw, cgt = cw;
#pragma unroll
                for (int ks = 0; ks < 2; ++ks) {
                    const bf16x8 bw = *(const bf16x8*)(WUT + (size_t)ch * 64 + ks * 32 + kq * 8); cw = __builtin_amdgcn_mfma_f32_16x16x32_bf16(Aw[ks], bw, cw, 0, 0, 0);
                    const bf16x8 ba = *(const bf16x8*)(AUT + (size_t)ch * 64 + ks * 32 + kq * 8); ca = __builtin_amdgcn_mfma_f32_16x16x32_bf16(Aa[ks], ba, ca, 0, 0, 0); }
#pragma unroll
                for (int ks = 0; ks < 4; ++ks) { const bf16x8 bg = *(const bf16x8*)(GUT + (size_t)ch * 128 + ks * 32 + kq * 8); cgt = __builtin_amdgcn_mfma_f32_16x16x32_bf16(Ag[ks], bg, cgt, 0, 0, 0); }
#pragma unroll
                for (int j = 0; j < 4; ++j) { LAS float* d = LW + (kq * 4 + j) * 68 + cgi * 16 + row; d[0] = cw[j]; d[16 * 68] = ca[j]; d[32 * 68] = cgt[j]; }
            }
            asm volatile("s_waitcnt lgkmcnt(0)" ::: "memory");
            const int t = t0 + tok; const bool first = (t % SEQ) == 0; const bf16* prow = F_PROJ + (size_t)t * NIN + ROFF; const int ch0 = hd * 64 + cq;
            float kkq[16], aq[16]; float ss = 0.f;
#pragma unroll
            for (int sub = 0; sub < 2; ++sub) {
                const int ch = ch0 + sub * 8; const size_t idx = (size_t)t * RW + ch;
                float zr[8], zk[8], zv[8], wl[8], al[8], gl[8], pw0[8], pa0[8], pkk[8], pka[8], ldv[8], kpv[8];
                loadz8(prow, first, mu, ch, zr); loadz8(prow, first, mu, RW + ch, zk); loadz8(prow, first, mu, 2 * RW + ch, zv);
                const LAS float* lw = LW + tok * 68 + cq + sub * 8;
#pragma unroll
                for (int hh = 0; hh < 2; ++hh) { const f32x4 x0 = *(const LAS f32x4*)(lw + 4 * hh), x1 = *(const LAS f32x4*)(lw + 16 * 68 + 4 * hh), x2 = *(const LAS f32x4*)(lw + 32 * 68 + 4 * hh);
                    const f32x4 p0 = *(const f32x4*)(w0 + ch + 4 * hh), p1 = *(const f32x4*)(a0 + ch + 4 * hh), p2 = *(const f32x4*)(kkw + ch + 4 * hh), p3 = *(const f32x4*)(kaw + ch + 4 * hh);
#pragma unroll
                    for (int e = 0; e < 4; ++e) { wl[4 * hh + e] = x0[e]; al[4 * hh + e] = x1[e]; gl[4 * hh + e] = x2[e]; pw0[4 * hh + e] = p0[e]; pa0[4 * hh + e] = p1[e]; pkk[4 * hh + e] = p2[e]; pka[4 * hh + e] = p3[e]; } }
#pragma unroll
                for (int j = 0; j < 8; ++j) {
                    const float xs = -(pw0[j] + wl[j]); const float sp = fmaxf(xs, 0.f) + __logf(1.f + __expf(-fabsf(xs)));
                    ldv[j] = -__expf(-sp - 0.5f);
                    const float a = sigmoidf_(pa0[j] + al[j]);
                    const float kk = zk[j] * pkk[j]; kpv[j] = zk[j] * (1.f + (a - 1.f) * pka[j]);
                    kkq[sub * 8 + j] = kk; aq[sub * 8 + j] = a; ss += kk * kk;
                }
                *(v4u*)(F_S_r + idx) = pack8(zr); *(v4u*)(F_S_ld + idx) = pack8(ldv); *(v4u*)(F_S_k + idx) = pack8(kpv); *(v4u*)(F_S_v + idx) = pack8(zv); *(v4u*)(F_S_g + idx) = pack8(gl);
            }
            ss += __shfl_xor(ss, 1); ss += __shfl_xor(ss, 2);
            const float inv = 1.f / fmaxf(sqrtf(ss), 1e-12f);
#pragma unroll
            for (int sub = 0; sub < 2; ++sub) { float nn[8], bbv[8];
#pragma unroll
                for (int j = 0; j < 8; ++j) { const float kn = kkq[sub * 8 + j] * inv; nn[j] = -kn; bbv[j] = kn * aq[sub * 8 + j]; }
                const size_t idx = (size_t)t * RW + ch0 + sub * 8; *(v4u*)(F_S_n + idx) = pack8(nn); *(v4u*)(F_S_b + idx) = pack8(bbv); }
            asm volatile("s_waitcnt lgkmcnt(0)" ::: "memory");
        }
    }
    const float* cw_ = INP(F, 8) + l * 3 * 256;
    for (int it = F.gw; it < M / 2; it += F.NGW) {
        const int t = it * 2 + (F.lane >> 5), c8 = (F.lane & 31) * 8, pos = t % SEQ;
        const bf16* base = F_PROJ + (size_t)t * NIN + COFF + c8;
        float b8[8], g8[8], u8[8], acc[8], w8[8];
        unpack8(*(const v4u*)base, b8);
#pragma unroll
        for (int j = 0; j < 8; ++j) acc[j] = 0.f;
#pragma unroll
        for (int d = 0; d < 3; ++d) {
            const int back = 2 - d;
            if (pos >= back) {
                const bf16* pb = base - (size_t)back * NIN;
                unpack8(*(const v4u*)(pb + 256), g8); unpack8(*(const v4u*)(pb + 512), u8);
                const f32x4 wa = *(const f32x4*)(cw_ + d * 256 + c8), wb = *(const f32x4*)(cw_ + d * 256 + c8 + 4);
                w8[0] = wa.x; w8[1] = wa.y; w8[2] = wa.z; w8[3] = wa.w; w8[4] = wb.x; w8[5] = wb.y; w8[6] = wb.z; w8[7] = wb.w;
#pragma unroll
                for (int j = 0; j < 8; ++j) acc[j] += w8[j] * (g8[j] * u8[j]);
            }
        }
#pragma unroll
        for (int j = 0; j < 8; ++j) acc[j] *= b8[j];
        *(v4u*)(F_MIX + (size_t)t * DMODEL + 384 + c8) = pack8(acc);
    }
}

DI void post_phase(const Frame& F0, int l) { Frame F = refresh(F0);
    const float* rk = INP(F, 17) + l * RW; const float* lg = INP(F, 18) + l * RW; const float* lb = INP(F, 19) + l * RW;
    for (int it = F.gw; it < M * 6 / 8; it += F.NGW) {
        const int pair = it * 8 + (F.lane >> 3), t = pair / 6, hd = pair % 6, ch = hd * 64 + (F.lane & 7) * 8;
        bf16* yp = F_MIX + (size_t)t * DMODEL + 640 + ch; const size_t idx = (size_t)t * RW + ch;
        float y[8], r[8], k[8], v[8], g[8], o[8];
        unpack8(*(const v4u*)yp, y); unpack8(*(const v4u*)(F_S_r + idx), r); unpack8(*(const v4u*)(F_S_k + idx), k); unpack8(*(const v4u*)(F_S_v + idx), v); unpack8(*(const v4u*)(F_S_g + idx), g);
        float s = 0.f, dot = 0.f;
#pragma unroll
        for (int j = 0; j < 8; ++j) { s += y[j]; dot += r[j] * k[j] * rk[ch + j]; }
        s += __shfl_xor(s, 1); s += __shfl_xor(s, 2); s += __shfl_xor(s, 4);
        dot += __shfl_xor(dot, 1); dot += __shfl_xor(dot, 2); dot += __shfl_xor(dot, 4);
        const float mean = s * (1.f / 64.f); float q = 0.f;
#pragma unroll
        for (int j = 0; j < 8; ++j) { const float d = y[j] - mean; q += d * d; }
        q += __shfl_xor(q, 1); q += __shfl_xor(q, 2); q += __shfl_xor(q, 4);
        const float rstd = 1.f / sqrtf(q * (1.f / 64.f) + GN_EPS);
#pragma unroll
        for (int j = 0; j < 8; ++j) o[j] = ((y[j] - mean) * rstd * lg[ch + j] + lb[ch + j] + dot * v[j]) * g[j];
        *(v4u*)yp = pack8(o);
    }
}

DI void scan_wg(const Frame& F0, int sw) { Frame F = refresh(F0);
    const int bh = sw >> 1, half = sw & 1, b = bh / 6, hd = bh % 6;
    const size_t tb = (size_t)b * SEQ; const int cb = hd * 64;
    LAS unsigned char* const lds = F.lds;
    constexpr int BUFB = 6 * 8192, YOFF = 2 * BUFB;
    const bool loader = F.wave >= 4; const int ltid = F.tid - 256;
#define SCAN_STAGE(c, bufsel, P0, NP, STRIDE) do { _Pragma("unroll") for (int i = 0; i < (NP); ++i) { const int p = (P0) + (STRIDE) * i, a = p >> 8, tt = (p & 255) >> 3, c8 = (p & 7) * 8; \
        const bf16* src = (a == 0 ? F_S_r : a == 1 ? F_S_ld : a == 2 ? F_S_k : a == 3 ? F_S_v : a == 4 ? F_S_n : F_S_b); \
        const v4u raw = *(const v4u*)(src + (tb + (size_t)(c) * 32 + tt) * RW + cb + c8); \
        float f[8]; unpack8(raw, f); if (a == 1) { _Pragma("unroll") for (int j = 0; j < 8; ++j) f[j] = __expf(f[j]); } \
        LAS f32x4* d = (LAS f32x4*)(lds + (bufsel) * BUFB + a * 8192 + tt * 256 + c8 * 4); d[0] = (f32x4){f[0], f[1], f[2], f[3]}; d[1] = (f32x4){f[4], f[5], f[6], f[7]}; } } while (0)
#define SCAN_YOUT(c, bufsel) do { _Pragma("unroll") for (int i = 0; i < 2; ++i) { const int e = ltid + 256 * i, tt = e >> 4, r2 = (e & 15) * 2; \
        const LAS float* ys = (const LAS float*)(lds + YOFF + (bufsel) * 4096) + tt * 32 + r2; \
        *(unsigned*)(F_MIX + (tb + (size_t)(c) * 32 + tt) * DMODEL + 640 + cb + half * 32 + r2) = pk2(ys[0], ys[1]); } } while (0)
    SCAN_STAGE(0, 0, F.tid, 3, 512);
    __syncthreads();
    typedef float f32x2v __attribute__((ext_vector_type(2)));
    const int rp = F.wave * 8 + (F.lane >> 4) * 2, kp = F.lane & 15;
    f32x4 s0 = (f32x4){0.f, 0.f, 0.f, 0.f}, s1 = s0;
#pragma unroll 1
    for (int c = 0; c < SEQ / 32; ++c) {
        const int cur = c & 1;
        if (loader) {
            if (c + 1 < SEQ / 32) SCAN_STAGE(c + 1, cur ^ 1, ltid, 6, 256);
            if (c > 0) SCAN_YOUT(c - 1, cur ^ 1);
        } else {
            const LAS unsigned char* bb = lds + cur * BUFB + kp * 16;
            const LAS unsigned char* vb = lds + cur * BUFB + 3 * 8192 + (half * 32 + rp) * 4;
            LAS f32x2v* yb = (LAS f32x2v*)(lds + YOFF + cur * 4096 + rp * 4);
            f32x4 rv = *(const LAS f32x4*)(bb + 0 * 8192), wv = *(const LAS f32x4*)(bb + 1 * 8192), kv = *(const LAS f32x4*)(bb + 2 * 8192);
            f32x4 nv = *(const LAS f32x4*)(bb + 4 * 8192), bv = *(const LAS f32x4*)(bb + 5 * 8192);
            f32x2v vv = *(const LAS f32x2v*)(vb);
#pragma unroll 8
            for (int tt = 0; tt < 32; ++tt) {
                const int tn = (tt + 1) & 31;
                const f32x4 rv2 = *(const LAS f32x4*)(bb + 0 * 8192 + tn * 256), wv2 = *(const LAS f32x4*)(bb + 1 * 8192 + tn * 256), kv2 = *(const LAS f32x4*)(bb + 2 * 8192 + tn * 256);
                const f32x4 nv2 = *(const LAS f32x4*)(bb + 4 * 8192 + tn * 256), bv2 = *(const LAS f32x4*)(bb + 5 * 8192 + tn * 256);
                const f32x2v vv2 = *(const LAS f32x2v*)(vb + tn * 256);
                f32x2v d0 = (f32x2v){s0.x, s0.y} * (f32x2v){nv.x, nv.y}; d0 = (f32x2v){s0.z, s0.w} * (f32x2v){nv.z, nv.w} + d0;
                f32x2v d1 = (f32x2v){s1.x, s1.y} * (f32x2v){nv.x, nv.y}; d1 = (f32x2v){s1.z, s1.w} * (f32x2v){nv.z, nv.w} + d1;
                const float sa0 = red16(d0.x + d0.y), sa1 = red16(d1.x + d1.y);
                const f32x4 q0 = s0 * wv + kv * vv.x, q1 = s1 * wv + kv * vv.y;
                s0 = bv * sa0 + q0; s1 = bv * sa1 + q1;
                f32x2v y0 = (f32x2v){s0.x, s0.y} * (f32x2v){rv.x, rv.y}; y0 = (f32x2v){s0.z, s0.w} * (f32x2v){rv.z, rv.w} + y0;
                f32x2v y1 = (f32x2v){s1.x, s1.y} * (f32x2v){rv.x, rv.y}; y1 = (f32x2v){s1.z, s1.w} * (f32x2v){rv.z, rv.w} + y1;
                const float ya = red16(y0.x + y0.y), yc = red16(y1.x + y1.y);
                yb[tt * 16] = (f32x2v){ya, yc};
                rv = rv2; wv = wv2; kv = kv2; nv = nv2; bv = bv2; vv = vv2;
            }
        }
        __syncthreads();
    }
    if (loader) SCAN_YOUT(SEQ / 32 - 1, (SEQ / 32 - 1) & 1);
#undef SCAN_STAGE
#undef SCAN_YOUT
    __syncthreads();
}

DI void mix_phase(const Frame& F0, int l, char* ldsg) { Frame F = refresh(F0);
#ifndef SKIP_SCAN
    if ((int)blockIdx.x < SCAN_WGS) { scan_wg(F, (int)blockIdx.x); if (PROBE & 2) scan_wg(F, (int)blockIdx.x); }
#endif
    const float* lq1 = INP(F, 3) + l * 32; const float* lk1 = INP(F, 4) + l * 32; const float* lq2 = INP(F, 5) + l * 32; const float* lk2 = INP(F, 6) + l * 32;
    float d1 = 0.f, d2 = 0.f;
    for (int i = 0; i < 32; ++i) { d1 += lq1[i] * lk1[i]; d2 += lq2[i] * lk2[i]; }
    const float lambda_init = (l == 0) ? 0.2f : 0.35550906759f;
    const float lam = __expf(d1) - __expf(d2) + lambda_init;
    const float* sg = INP(F, 7) + l * 64;
    volatile LAS unsigned* qslot = (volatile LAS unsigned*)(F.lds + MISC_OFF + 64);
    for (int rep = 0; rep < ((PROBE & 4) ? 2 : 1); ++rep)
    for (;;) {
        if (F.tid == 0) *qslot = atomicAdd(F_ctl + 64 * (1 + l + 2 * rep), 1u);
        __syncthreads();
        const unsigned idx = (unsigned)__builtin_amdgcn_readfirstlane((int)*qslot);
        __syncthreads();
        if (idx >= (unsigned)ATT_ITEMS) break;
        const int qb = 15 - (int)(idx / 48u), bh = (int)(idx % 48u), b = bh / 6, h = bh % 6;
        const attn_body::bf16* P = (const attn_body::bf16*)F_PROJ;
#ifndef SKIP_ATT
#pragma unroll 1
        for (int ns = 0; ns < 2; ++ns)
            attn_body::attn_unit<8>(b, h, qb, ns, lam, sg, 1.f - lambda_init, P, P + 384, P + 768, (attn_body::bf16*)F_MIX, ldsg);
#endif
    }
}

__global__ void __launch_bounds__(NWAVES * 64, 2) mega_fwd(Args args) {
    extern __shared__ __attribute__((aligned(16))) unsigned char lds[];
    cg::grid_group grid = cg::this_grid();
    Frame F;
    F.lds = (LAS unsigned char*)lds;
    F.tid = threadIdx.x; F.lane = F.tid & 63; F.wave = __builtin_amdgcn_readfirstlane(F.tid >> 6);
    F.G = gridDim.x; F.gw = (int)blockIdx.x * NWAVES + F.wave; F.NGW = F.G * NWAVES;
    F.in = args.in; F.out = args.out; F.ws = args.ws;
    const int G = F.G;
    if (F.tid < 32) ((LAS unsigned*)(F.lds + MISC_OFF))[F.tid] = 0u;
    __syncthreads();
    XcdBarrier bar = xcd_barrier_post((unsigned*)(args.ws + WS_CTL) + CW_BAR, (volatile LAS unsigned*)(F.lds + MISC_OFF) + 8);

    prologue(F);
    rms_rows_bf16(F, INP(F, 0), F_XB);
    grid.sync();
#pragma unroll 1
    for (int l = 0; l < 2; ++l) {
        {
            pg8::Gemm g{F_XB, F_WIN + (size_t)l * NIN * DMODEL, M, NIN, DMODEL}; pg8::StaticOrder S; int bx = blockIdx.x; asm volatile("" : "+s"(bx)); S.init(M, NIN, G, bx);
            pg8::EpiBf16S<0> E{F_PROJ, NIN};
            GEMMCALL0 pg8::gemm_phase<pg8::EpiBf16S<0>, pg8::StaticOrder, true, true>(F.lds, g, S, E);
            if (PROBE & 1) { __syncthreads(); pg8::gemm_phase<pg8::EpiBf16S<0>, pg8::StaticOrder, true, true>(F.lds, g, S, E); }
        }
        xcd_barrier(bar);
#ifndef SKIP_PREP
        prep_phase(F, l);
        if (PROBE & 8) { __syncthreads(); prep_phase(F, l); }
#endif
        xcd_barrier(bar);
        mix_phase(F, l, (char*)lds);
        xcd_barrier(bar);
#ifndef SKIP_POST
        post_phase(F, l);
#endif
        xcd_barrier(bar);
        {
            pg8::Gemm g{F_MIX, F_WOUT + (size_t)l * DMODEL * DMODEL, M, DMODEL, DMODEL}; pg8::StaticOrder S; int bx = blockIdx.x; asm volatile("" : "+s"(bx)); S.init(M, DMODEL, G, bx);
            pg8::EpiResF32 E{l == 0 ? INP(F, 0) : (const float*)F.out, F.out, DMODEL};
            GEMMCALL1 pg8::gemm_phase<pg8::EpiResF32, pg8::StaticOrder, true, true>(F.lds, g, S, E);
        }
        xcd_barrier(bar);
        rms_rows_bf16(F, F.out, F_XB);
        if (PROBE & 16) { xcd_barrier(bar); rms_rows_bf16(F, F.out, F_XB); xcd_barrier(bar); rms_rows_bf16(F, F.out, F_XB); }
        if (PROBE & 32) { for (int q = 0; q < 10; ++q) xcd_barrier(bar); }
        xcd_barrier(bar);
        {
            pg8::Gemm g{F_XB, F_WUP + (size_t)l * FF * DMODEL, M, FF, DMODEL}; pg8::StaticOrder S; int bx = blockIdx.x; asm volatile("" : "+s"(bx)); S.init(M, FF, G, bx);
            pg8::EpiBf16S<2> E{F_HID, FF};
            GEMMCALL2 pg8::gemm_phase<pg8::EpiBf16S<2>, pg8::StaticOrder, true, true>(F.lds, g, S, E);
            if (PROBE & 1) { __syncthreads(); pg8::gemm_phase<pg8::EpiBf16S<2>, pg8::StaticOrder, true, true>(F.lds, g, S, E); }
        }
        xcd_barrier(bar);
        {
            pg8::Gemm g{F_HID, F_WDN + (size_t)l * DMODEL * FF, M, DMODEL, FF}; pg8::StaticOrder S; int bx = blockIdx.x; asm volatile("" : "+s"(bx)); S.init(M, DMODEL, G, bx);
            pg8::EpiResF32 E{(const float*)F.out, F.out, DMODEL};
            GEMMCALL3 pg8::gemm_phase<pg8::EpiResF32, pg8::StaticOrder, true, true>(F.lds, g, S, E);
        }
        xcd_barrier(bar);
        if (l == 0) { rms_rows_bf16(F, F.out, F_XB); xcd_barrier(bar); }
    }
    final_norm(F, F.out, INP(F, 24));
}

extern "C" void kernel_launch(void* const* d_in, const int* in_sizes, int n_in, void* d_out, int out_size, void* d_ws, size_t ws_size, hipStream_t stream) {
    static int grid = 0;
    if (grid == 0) {
        if (n_in != 25 || in_sizes[0] != M * DMODEL || out_size != M * DMODEL || ws_size < WS_END) {
            fprintf(stderr, "kernel_launch: unexpected problem geometry (n_in %d, in0 %d, out %d, ws %zu)\n", n_in, n_in > 0 ? in_sizes[0] : -1, out_size, ws_size); grid = -1; return; }
        int dev = 0, cus = 0, per_cu = 0;
        if (hipGetDevice(&dev) != hipSuccess || hipDeviceGetAttribute(&cus, hipDeviceAttributeMultiprocessorCount, dev) != hipSuccess) { grid = -1; return; }
        if (hipFuncSetAttribute((const void*)mega_fwd, hipFuncAttributeMaxDynamicSharedMemorySize, LDS_BYTES) != hipSuccess) { fprintf(stderr, "kernel_launch: hipFuncSetAttribute failed\n"); grid = -1; return; }
        if (hipOccupancyMaxActiveBlocksPerMultiprocessor(&per_cu, (const void*)mega_fwd, NWAVES * 64, LDS_BYTES) != hipSuccess || per_cu < 1) { fprintf(stderr, "kernel_launch: occupancy query gave %d\n", per_cu); (void)hipGetLastError(); per_cu = 1; }
        grid = cus * per_cu;
    }
    if (grid < 0) return;
    (void)hipMemsetAsync((char*)d_ws + WS_CTL, 0, CTL_ZERO_BYTES, stream);
    Args a{};
    for (int i = 0; i < 25; ++i) a.in[i] = (const float*)d_in[i];
    a.out = (float*)d_out; a.ws = (unsigned char*)d_ws; a.i0 = 0; a.i1 = 0;
    void* kargs[] = {&a};
    const hipError_t e = hipLaunchCooperativeKernel((const void*)mega_fwd, dim3(grid), dim3(NWAVES * 64), kargs, LDS_BYTES, stream);
    if (e != hipSuccess) fprintf(stderr, "kernel_launch: cooperative launch failed: %s (grid %d)\n", hipGetErrorString(e), grid);
}
```

```cpp
#include <hip/hip_runtime.h>
#include <hip/hip_cooperative_groups.h>
#include <hip/hip_bf16.h>
#include <cstdio>
#include <cstdint>
#include <cmath>
namespace pg8 {
#define PG8_LAS __attribute__((address_space(3)))
typedef unsigned short bf16_t;
typedef short bf16x8 __attribute__((ext_vector_type(8)));
typedef float f32x4 __attribute__((ext_vector_type(4)));
typedef unsigned u32x4 __attribute__((ext_vector_type(4)));
constexpr int BM = 256, BK = 64, HALF = 128, HTB = HALF * BK * 2  , STAGE_BYTES = 8 * HTB, NXCD = 8, WGM = 8;

__host__ __device__ __forceinline__ int lds_byte(int r, int c) { const int st = (r >> 4) * 2 + (c >> 5), rr = r & 15, cc = c & 31, ob = rr * 64 + cc * 2; return st * 1024 + (ob ^ (((ob >> 9) & 1) << 5)); }
__host__ __device__ __forceinline__ void stage_rc(int b, int& R, int& C) { const int st = b / 1024, sb = b % 1024, swz = sb ^ (((sb >> 9) & 1) << 5); R = (st >> 1) * 16 + swz / 64; C = (st & 1) * 32 + (swz % 64) / 2; }
__host__ __device__ __forceinline__ int perm32(int rho) { const int n = rho >> 4, i = rho & 15; return 8 * (i >> 2) + 4 * n + (i & 3); }

struct Unit { int pm, pn; };
struct Gemm { const bf16_t* A; const bf16_t* Bt; int M, N, K; };

struct StaticOrder {
    int nM, nN, nwg, G, c;
    __host__ __device__ void init(int M, int N, int G_, int c_) { nM = M / BM; nN = N / BM; nwg = nM * nN; G = G_; c = c_; }
    __host__ __device__ bool next(int i, Unit& u) const {
        const long L = (long)i * G + c; if (L >= nwg) return false;
        int wgid = (int)L; { const int q = nwg / NXCD, r = nwg % NXCD, xcd = wgid % NXCD, off = wgid / NXCD; wgid = (xcd < r ? xcd * (q + 1) : r * (q + 1) + (xcd - r) * q) + off; }
        const int nig = WGM * nN, gid = wgid / nig, fm = gid * WGM, gsz = (nM - fm) < WGM ? (nM - fm) : WGM;
        u.pm = fm + ((wgid % nig) % gsz); u.pn = (wgid % nig) / gsz; return true;
    }
    __device__ __forceinline__ void a_ready(const Unit&) const {}
    __device__ __forceinline__ void done(const Unit&) const {}
};

__device__ __forceinline__ unsigned cvt_pk_bf16(float lo, float hi) { unsigned r; asm volatile("v_cvt_pk_bf16_f32 %0, %1, %2" : "=v"(r) : "v"(lo), "v"(hi)); return r; }
typedef float f32x2 __attribute__((ext_vector_type(2)));
template <int ACT  > struct EpiBf16S {
    static constexpr bool PERM = true, AFTER_DRAIN = false;
    bf16_t* O; int ldc; const float* ss;
    __device__ __forceinline__ void operator()(const f32x4 (&acc)[2][2][4][2], const Unit& u, int wr, int wc, int fr, int fq) const {
        const int row0 = u.pm * BM + wr * 64 + fr; const int col0 = u.pn * BM + wc * 32 + 8 * fq;
#pragma unroll
        for (int ai = 0; ai < 2; ++ai)
#pragma unroll
            for (int m = 0; m < 4; ++m) { bf16_t* rowp = O + (size_t)(row0 + ai * HALF + m * 16) * ldc + col0;
                const float rs = ss ? 1.0f / sqrtf(ss[row0 + ai * HALF + m * 16] * (1.0f / 1024.0f) + 1e-6f) : 1.0f;
#pragma unroll
                for (int bj = 0; bj < 2; ++bj) { f32x4 v0 = acc[ai][bj][m][0] * rs, v1 = acc[ai][bj][m][1] * rs;
                    if (ACT == 2) {
#pragma unroll
                        for (int e = 0; e < 4; ++e) { float a = v0[e] > 0.f ? v0[e] : 0.f; v0[e] = a * a; float b = v1[e] > 0.f ? v1[e] : 0.f; v1[e] = b * b; } }
                    u32x4 w; w.x = cvt_pk_bf16(v0[0], v0[1]); w.y = cvt_pk_bf16(v0[2], v0[3]); w.z = cvt_pk_bf16(v1[0], v1[1]); w.w = cvt_pk_bf16(v1[2], v1[3]);
                    *(u32x4*)(rowp + bj * HALF) = w; } }
    }
};
struct EpiResF32 {
    static constexpr bool PERM = false, AFTER_DRAIN = false;
    const float* base; float* out; int ldc; bf16_t* xb; float* ss;
    __device__ __forceinline__ void operator()(const f32x4 (&acc)[2][2][4][2], const Unit& u, int wr, int wc, int fr, int fq) const {
        const int col0 = u.pn * BM + wc * 32 + 4 * fq;
#pragma unroll
        for (int ai = 0; ai < 2; ++ai)
#pragma unroll
            for (int m = 0; m < 4; ++m) { const int r = u.pm * BM + ai * HALF + wr * 64 + m * 16 + fr; const size_t off = (size_t)r * ldc + col0; float sq = 0.f;
#pragma unroll
                for (int bj = 0; bj < 2; ++bj)
#pragma unroll
                    for (int n = 0; n < 2; ++n) { const size_t idx = off + bj * HALF + n * 16; const f32x4 bs = *(const f32x4*)(base + idx); const f32x4 o = bs + acc[ai][bj][m][n]; *(f32x4*)(out + idx) = o;
                        sq += (o[0] * o[0] + o[1] * o[1]) + (o[2] * o[2] + o[3] * o[3]);
                        typedef unsigned u32x2_ __attribute__((ext_vector_type(2))); u32x2_ w; w.x = cvt_pk_bf16(o[0], o[1]); w.y = cvt_pk_bf16(o[2], o[3]); *(u32x2_*)(xb + idx) = w; }
                sq += __shfl_xor(sq, 16); sq += __shfl_xor(sq, 32);
                if (fq == 0) unsafeAtomicAdd(ss + r, sq);
                asm volatile("" ::: "memory"); }
    }
};
template <class Epi, class Sched, bool ALIGN_EPI = false, bool SP2 = false>
__device__ __forceinline__ void gemm_phase(PG8_LAS unsigned char* lds, const Gemm g, const Sched& S, const Epi& E) {
    int tid_ = threadIdx.x; asm volatile("" : "+v"(tid_)); const int tid = tid_, wid = __builtin_amdgcn_readfirstlane(tid >> 6), lane = tid & 63, wr = wid >> 2, wc = wid & 3, fr = lane & 15, fq = lane >> 4;
    const int K = g.K, nt = K / BK;
    unsigned voffA[2], voffB[2];
#pragma unroll
    for (int i = 0; i < 2; ++i) { int R, C; stage_rc(tid * 16 + i * 8192, R, C); const int Rb = Epi::PERM ? ((R & ~31) + perm32(R & 31)) : R;
        voffA[i] = (unsigned)(R * K + C) * 2u; voffB[i] = (unsigned)(Rb * K + C) * 2u; }
    const size_t kstep = (size_t)(BK * 2);
    const size_t hstep = (size_t)HALF * K * 2;
    const size_t tstep = 2 * hstep;
    const unsigned ldsw = (unsigned)wid * 1024u;
    const int aoff = lds_byte(wr * 64 + fr, fq * 8), boff = lds_byte(wc * 32 + fr, fq * 8);
#define PG8_SA(b, h) (((b) * 2 + (h)) * HTB)
#define PG8_SB(b, h) ((4 + (b) * 2 + (h)) * HTB)
#define PG8_STAGE(bufoff, gbase, voff) do { _Pragma("unroll") for (int _i = 0; _i < 2; ++_i) \
        __builtin_amdgcn_global_load_lds((const unsigned*)((const char*)(gbase) + (voff)[_i]), (PG8_LAS unsigned*)(lds + (bufoff) + ldsw + _i * 8192), 16, 0, 0); } while (0)
#define PG8_LDA(dst, b, h) do { _Pragma("unroll") for (int m = 0; m < 4; ++m) _Pragma("unroll") for (int k = 0; k < 2; ++k) dst[m][k] = *(const PG8_LAS bf16x8*)(lds + PG8_SA(b, h) + aoff + m * 2048 + k * 1024); } while (0)
#define PG8_LDB(dst, b, h) do { _Pragma("unroll") for (int n = 0; n < 2; ++n) _Pragma("unroll") for (int k = 0; k < 2; ++k) dst[n][k] = *(const PG8_LAS bf16x8*)(lds + PG8_SB(b, h) + boff + n * 2048 + k * 1024); } while (0)
#define PG8_MMA(ai, bj, At, Bt) do { __builtin_amdgcn_s_setprio(1); _Pragma("unroll") for (int m = 0; m < 4; ++m) _Pragma("unroll") for (int n = 0; n < 2; ++n) _Pragma("unroll") for (int k = 0; k < 2; ++k) \
        acc[ai][bj][m][n] = __builtin_amdgcn_mfma_f32_16x16x32_bf16(Bt[n][k], At[m][k], acc[ai][bj][m][n], 0, 0, 0); __builtin_amdgcn_s_setprio(0); } while (0)
#define PG8_WAIT_V(n) asm volatile("s_waitcnt vmcnt(" #n ")" ::: "memory")
#define PG8_WAIT_L(n) asm volatile("s_waitcnt lgkmcnt(" #n ")" ::: "memory")
#define PG8_BAR __builtin_amdgcn_s_barrier()
#define PG8_SCHED __builtin_amdgcn_sched_barrier(0)
    Unit cur, nxt; int ui = 0;
    if (!S.next(0, cur)) return;
    f32x4 acc[2][2][4][2];
#pragma unroll
    for (int a = 0; a < 2; ++a)
#pragma unroll
        for (int b = 0; b < 2; ++b)
#pragma unroll
            for (int m = 0; m < 4; ++m)
#pragma unroll
                for (int n = 0; n < 2; ++n) acc[a][b][m][n] = (f32x4){0.f, 0.f, 0.f, 0.f};
    bf16x8 At[4][2], B0[2][2], B1[2][2];
    const char* cA = (const char*)g.A + (size_t)cur.pm * tstep; const char* cB = (const char*)g.Bt + (size_t)cur.pn * tstep;
    S.a_ready(cur);
    if constexpr (SP2) {
        PG8_STAGE(PG8_SB(0, 0), cB, voffB); PG8_STAGE(PG8_SB(0, 1), cB + hstep, voffB); PG8_STAGE(PG8_SA(0, 0), cA, voffA); PG8_STAGE(PG8_SA(0, 1), cA + hstep, voffA);
        if (wr == 1) PG8_BAR;
        PG8_WAIT_V(2); PG8_BAR;
        PG8_STAGE(PG8_SB(1, 0), cB + kstep, voffB); PG8_STAGE(PG8_SA(1, 0), cA + kstep, voffA); PG8_STAGE(PG8_SB(1, 1), cB + hstep + kstep, voffB);
        PG8_WAIT_V(6); PG8_BAR;
    } else {
        PG8_STAGE(PG8_SB(0, 0), cB, voffB); PG8_STAGE(PG8_SA(0, 0), cA, voffA); PG8_STAGE(PG8_SB(0, 1), cB + hstep, voffB); PG8_STAGE(PG8_SA(0, 1), cA + hstep, voffA);
        if (wr == 1) PG8_BAR;
        PG8_WAIT_V(4); PG8_BAR;
        PG8_STAGE(PG8_SB(1, 0), cB + kstep, voffB); PG8_STAGE(PG8_SA(1, 0), cA + kstep, voffA); PG8_STAGE(PG8_SB(1, 1), cB + hstep + kstep, voffB);
        PG8_WAIT_V(6); PG8_BAR;
    }
    for (;;) {
        const bool has_next = S.next(ui + 1, nxt);
        const char* nA = has_next ? (const char*)g.A + (size_t)nxt.pm * tstep : cA; const char* nB = has_next ? (const char*)g.Bt + (size_t)nxt.pn * tstep : cB;
        for (int t = 0; t < nt; t += 2) {
            const bool last = (t == nt - 2);
            const char* a1 = cA + (size_t)(t + 1) * kstep;
            const char* a2 = last ? nA : cA + (size_t)(t + 2) * kstep; const char* b2 = last ? nB : cB + (size_t)(t + 2) * kstep;
            const char* a3 = a2 + kstep; const char* b3 = b2 + kstep;
            if (last && has_next) S.a_ready(nxt);
            if constexpr (SP2) {
            PG8_LDB(B0, 0, 0); PG8_LDB(B1, 0, 1); PG8_SCHED; PG8_LDA(At, 0, 0); PG8_STAGE(PG8_SA(1, 1), a1 + hstep, voffA);
            PG8_WAIT_V(8); PG8_WAIT_L(0); PG8_BAR; PG8_MMA(0, 0, At, B0); PG8_MMA(0, 1, At, B1); PG8_BAR; PG8_SCHED;
            PG8_LDA(At, 0, 1); PG8_STAGE(PG8_SB(0, 0), b2, voffB); PG8_STAGE(PG8_SB(0, 1), b2 + hstep, voffB); PG8_STAGE(PG8_SA(0, 0), a2, voffA);
            PG8_WAIT_V(8); PG8_WAIT_L(0); PG8_BAR; PG8_MMA(1, 0, At, B0); PG8_MMA(1, 1, At, B1); PG8_BAR; PG8_SCHED;
            PG8_LDB(B0, 1, 0); PG8_LDB(B1, 1, 1); PG8_SCHED; PG8_LDA(At, 1, 0); PG8_STAGE(PG8_SA(0, 1), a2 + hstep, voffA);
            PG8_WAIT_V(8); PG8_WAIT_L(0); PG8_BAR; PG8_MMA(0, 0, At, B0); PG8_MMA(0, 1, At, B1); PG8_BAR; PG8_SCHED;
            PG8_LDA(At, 1, 1); PG8_STAGE(PG8_SB(1, 0), b3, voffB); PG8_STAGE(PG8_SB(1, 1), b3 + hstep, voffB); PG8_STAGE(PG8_SA(1, 0), a3, voffA);
            PG8_WAIT_V(8); PG8_WAIT_L(0); PG8_BAR; PG8_MMA(1, 0, At, B0); PG8_MMA(1, 1, At, B1); PG8_BAR; PG8_SCHED;
            } else {
            PG8_LDB(B0, 0, 0); PG8_SCHED; PG8_LDA(At, 0, 0); PG8_STAGE(PG8_SA(1, 1), a1 + hstep, voffA);
            PG8_WAIT_L(8); PG8_BAR; PG8_WAIT_L(0); PG8_MMA(0, 0, At, B0); PG8_BAR; PG8_SCHED;
            PG8_LDB(B1, 0, 1); PG8_STAGE(PG8_SB(0, 0), b2, voffB);
            PG8_BAR; PG8_WAIT_L(0); PG8_MMA(0, 1, At, B1); PG8_BAR;
            PG8_LDA(At, 0, 1); PG8_STAGE(PG8_SA(0, 0), a2, voffA);
            PG8_BAR; PG8_WAIT_L(0); PG8_MMA(1, 0, At, B0); PG8_BAR; PG8_SCHED;
            PG8_STAGE(PG8_SB(0, 1), b2 + hstep, voffB);
            PG8_WAIT_V(6); PG8_BAR; PG8_MMA(1, 1, At, B1); PG8_BAR;
            PG8_LDB(B0, 1, 0); PG8_SCHED; PG8_LDA(At, 1, 0); PG8_STAGE(PG8_SA(0, 1), a2 + hstep, voffA);
            PG8_WAIT_L(8); PG8_BAR; PG8_WAIT_L(0); PG8_MMA(0, 0, At, B0); PG8_BAR; PG8_SCHED;
            PG8_LDB(B1, 1, 1); PG8_STAGE(PG8_SB(1, 0), b3, voffB);
            PG8_BAR; PG8_WAIT_L(0); PG8_MMA(0, 1, At, B1); PG8_BAR;
            PG8_LDA(At, 1, 1); PG8_STAGE(PG8_SA(1, 0), a3, voffA);
            PG8_BAR; PG8_WAIT_L(0); PG8_MMA(1, 0, At, B0); PG8_BAR; PG8_SCHED;
            PG8_STAGE(PG8_SB(1, 1), b3 + hstep, voffB);
            PG8_WAIT_V(6); PG8_BAR; PG8_MMA(1, 1, At, B1); PG8_BAR;
            }
        }
        if constexpr (ALIGN_EPI) { if (wr == 0) PG8_BAR; }
        if constexpr (!Epi::AFTER_DRAIN) { E(acc, cur, wr, wc, fr, fq); S.done(cur); }
        if (!has_next) break;
#pragma unroll
        for (int a = 0; a < 2; ++a)
#pragma unroll
            for (int b = 0; b < 2; ++b)
#pragma unroll
                for (int m = 0; m < 4; ++m)
#pragma unroll
                    for (int n = 0; n < 2; ++n) acc[a][b][m][n] = (f32x4){0.f, 0.f, 0.f, 0.f};
        cur = nxt; cA = nA; cB = nB; ++ui;
        if constexpr (ALIGN_EPI) { if (wr == 1) PG8_BAR; }
    }
    PG8_WAIT_V(0);
    if constexpr (!ALIGN_EPI) { if (wr == 0) PG8_BAR; }
    PG8_BAR;
    if constexpr (Epi::AFTER_DRAIN) { E.fused(acc, cur, wr, wc, fr, fq, lds, wid, lane); S.done(cur); }
#undef PG8_SA
#undef PG8_SB
#undef PG8_STAGE
#undef PG8_LDA
#undef PG8_LDB
#undef PG8_MMA
#undef PG8_WAIT_V
#undef PG8_WAIT_L
#undef PG8_BAR
#undef PG8_SCHED
}
}

#define PG8_SP2 true
#define PG8_ALIGN true
namespace attn_body {
using bf16=__hip_bfloat16;
using bf16x8=__attribute__((ext_vector_type(8)))short;
using s16x4=__attribute__((ext_vector_type(4)))short;
using f32x16=__attribute__((ext_vector_type(16)))float;
using u32x4=__attribute__((ext_vector_type(4)))unsigned;
constexpr int BATCH=8,NHEAD=6,SEQ=4096,D=64,DM=3328,OPITCH=1024;
constexpr int NW=8,QBLK=32,QB=QBLK*NW,KVBLK=64,NQB=SEQ/QB;
constexpr int ATTN_PITCH=DM, ATTN_UNIT_ROWS=QB;
__device__ __forceinline__ int crow(int r,int hi){return (r&3)+8*(r>>2)+4*hi;}
#define SBAR() __builtin_amdgcn_sched_barrier(0)
__device__ __forceinline__ void cmask(f32x16&p0,f32x16&p1,int jb,int qrel,int hi){
  const float NEG=-INFINITY; int kb=64*jb+4*hi;
  #pragma unroll
  for(int r=0;r<16;++r){int kv=kb+(r&3)+8*(r>>2); if(kv>qrel)p0[r]=NEG; if(kv+32>qrel)p1[r]=NEG;}
}

constexpr int NSLOT=3, SLOTB=8192;
constexpr int LDS_K=0, LDS_V=NSLOT*SLOTB, LDS_WS=2*NSLOT*SLOTB, LDS_OST=LDS_WS+NW*64*4, LDS_OST1=LDS_OST+NW*4096, LDS_BYTES=LDS_OST1+NW*4096;
constexpr float C2=0.17677669529663687f*1.4426950408889634f;
__device__ __forceinline__ void glds16(const void*gsrc,unsigned lds_dst){unsigned keep;
  asm volatile("s_mov_b32 %0, m0\n\ts_mov_b32 m0, %2\n\ts_nop 0\n\tglobal_load_lds_dwordx4 %1, off\n\ts_mov_b32 m0, %0":"=&s"(keep):"v"(gsrc),"s"(lds_dst):"memory");}
__device__ __forceinline__ float max3f(float a,float b,float c){float r;asm("v_max3_f32 %0, %1, %2, %3":"=v"(r):"v"(a),"v"(b),"v"(c));return r;}
__device__ __forceinline__ float max2f(float a,float b){float r;asm("v_max_f32_e32 %0, %1, %2":"=v"(r):"v"(a),"v"(b));return r;}
__device__ __forceinline__ float fadd_s(float a,float b){float r;asm("v_add_f32_e32 %0, %1, %2":"=v"(r):"v"(a),"v"(b));return r;}
__device__ __forceinline__ float fsub_s(float a,float b){float r;asm("v_sub_f32_e32 %0, %1, %2":"=v"(r):"v"(a),"v"(b));return r;}
typedef float f32x2_t __attribute__((ext_vector_type(2))); typedef __bf16 bf16x2_t __attribute__((ext_vector_type(2)));
__device__ __forceinline__ unsigned cvtpk_s(float lo,float hi){f32x2_t v={lo,hi};bf16x2_t b=__builtin_convertvector(v,bf16x2_t);return __builtin_bit_cast(unsigned,b);}
#define WAIT_BAR(N) asm volatile("s_waitcnt vmcnt(" #N ") lgkmcnt(0)\n\ts_barrier":::"memory")

__device__ __forceinline__ void qkt(f32x16&p0,f32x16&p1,const char*Kslot,const bf16x8*qr,const f32x16&negm,int r32,int hi){
  const char*kb=Kslot+hi*1024+r32*16;
  #pragma unroll
  for(int d0=0;d0<4;++d0){
    const bf16x8 b0=*reinterpret_cast<const bf16x8*>(kb+d0*2048);
    const bf16x8 b1=*reinterpret_cast<const bf16x8*>(kb+d0*2048+512);
    if(d0==0){p0=__builtin_amdgcn_mfma_f32_32x32x16_bf16(b0,qr[0],negm,0,0,0);p1=__builtin_amdgcn_mfma_f32_32x32x16_bf16(b1,qr[0],negm,0,0,0);}
    else{p0=__builtin_amdgcn_mfma_f32_32x32x16_bf16(b0,qr[d0],p0,0,0,0);p1=__builtin_amdgcn_mfma_f32_32x32x16_bf16(b1,qr[d0],p1,0,0,0);}}
}
typedef __attribute__((address_space(3))) const char* lds_cptr;
typedef short v4i16_t __attribute__((ext_vector_type(4)));
__device__ __forceinline__ void kload8(bf16x8*kf,lds_cptr kp){
  kf[0]=*(const __attribute__((address_space(3))) bf16x8*)(kp);      kf[1]=*(const __attribute__((address_space(3))) bf16x8*)(kp+512);
  kf[2]=*(const __attribute__((address_space(3))) bf16x8*)(kp+2048); kf[3]=*(const __attribute__((address_space(3))) bf16x8*)(kp+2560);
  kf[4]=*(const __attribute__((address_space(3))) bf16x8*)(kp+4096); kf[5]=*(const __attribute__((address_space(3))) bf16x8*)(kp+4608);
  kf[6]=*(const __attribute__((address_space(3))) bf16x8*)(kp+6144); kf[7]=*(const __attribute__((address_space(3))) bf16x8*)(kp+6656);
}
__device__ __forceinline__ void kload2(bf16x8*kf,lds_cptr kp,int j){ kf[2*j]=*(const __attribute__((address_space(3))) bf16x8*)(kp+j*2048); kf[2*j+1]=*(const __attribute__((address_space(3))) bf16x8*)(kp+j*2048+512); }
__device__ __forceinline__ s16x4 vtr(lds_cptr p){ return __builtin_bit_cast(s16x4,__builtin_amdgcn_ds_read_tr16_b64_v4i16((__attribute__((address_space(3))) v4i16_t*)p)); }
__device__ __forceinline__ float rowmax(const f32x16&p0,const f32x16&p1){
  float a=max3f(p0[0],p0[1],p1[0]),b=max3f(p0[2],p0[3],p1[1]);a=max3f(a,p1[2],p1[3]);
  #pragma unroll
  for(int r=4;r<16;r+=4){a=max3f(a,p0[r],p0[r+1]);b=max3f(b,p0[r+2],p0[r+3]);a=max3f(a,p1[r],p1[r+1]);b=max3f(b,p1[r+2],p1[r+3]);}
  const float m=max2f(a,b);
  auto rr=__builtin_amdgcn_permlane32_swap(__float_as_uint(m),__float_as_uint(m),false,false);
  return max2f(__uint_as_float(rr[0]),__uint_as_float(rr[1]));
}
__device__ __forceinline__ void pv(f32x16*o,int vb,bf16x8 pa0,bf16x8 pa1,bf16x8 pa2,bf16x8 pa3){
  #pragma unroll
  for(int d0=0;d0<2;++d0){s16x4 lo[4],hi[4];
    #pragma unroll
    for(int ks=0;ks<4;++ks){
      asm volatile("ds_read_b64_tr_b16 %0,%1 offset:%c2":"=&v"(lo[ks]):"v"(vb),"i"(d0*4096+ks*1024):"memory");
      asm volatile("ds_read_b64_tr_b16 %0,%1 offset:%c2":"=&v"(hi[ks]):"v"(vb),"i"(d0*4096+ks*1024+512):"memory");}
    asm volatile("s_waitcnt lgkmcnt(0)":::"memory");SBAR();
    #define PK(k) (bf16x8){lo[k][0],lo[k][1],lo[k][2],lo[k][3],hi[k][0],hi[k][1],hi[k][2],hi[k][3]}
    o[d0]=__builtin_amdgcn_mfma_f32_32x32x16_bf16(pa0,PK(0),o[d0],0,0,0);
    o[d0]=__builtin_amdgcn_mfma_f32_32x32x16_bf16(pa1,PK(1),o[d0],0,0,0);
    o[d0]=__builtin_amdgcn_mfma_f32_32x32x16_bf16(pa2,PK(2),o[d0],0,0,0);
    o[d0]=__builtin_amdgcn_mfma_f32_32x32x16_bf16(pa3,PK(3),o[d0],0,0,0);
    #undef PK
  }
}

#ifndef ATTN_STORE16
#define ATTN_STORE16(p,v) (*(u32x4*)(p)=(v))
#endif
template<int THRL> __device__ __forceinline__ void attn_unit(int b,int h,int qb,int nsel,float lam,const float*subg,float omli,const bf16*Q,const bf16*__restrict__ K,const bf16*__restrict__ V,bf16*O,char*shm){
  int tid_=threadIdx.x; asm volatile("":"+v"(tid_)); const int tid=tid_,lane=tid&63,r32=lane&31,hi=lane>>5; const int wid=__builtin_amdgcn_readfirstlane(tid>>6);
  const long rowbase=(long)b*SEQ; const int q0=qb*QB;
  const bf16*Qw=Q+(rowbase+q0+wid*QBLK)*DM+h*D;
  const bf16*Kh=K+rowbase*DM+h*D,*Vh=V+rowbase*DM+h*D;
  const unsigned lds0=(unsigned)(uintptr_t)shm;
  float*wsf=(float*)(shm+LDS_WS)+wid*64;
  const bf16*ksrc=Kh+(long)lane*DM+wid*8;
  const bf16*vsrc=Vh+(long)(16*(wid&3)+(lane>>2))*DM+(wid>>2)*32+(lane&3)*8;
  const unsigned kdst=lds0+LDS_K+wid*1024, vdst=lds0+LDS_V+wid*1024;
  #define DMA_K(t,slot) glds16(ksrc+(long)(t)*KVBLK*DM,(unsigned)__builtin_amdgcn_readfirstlane(kdst+(slot)))
  #define DMA_V(t,slot) glds16(vsrc+(long)(t)*KVBLK*DM,(unsigned)__builtin_amdgcn_readfirstlane(vdst+(slot)))
  const int vb0=(int)(lds0+LDS_V)+((lane>>4)&1)*32+(lane&3)*8+(4*hi+((lane&15)>>2))*64;
  const char*Kbase=shm+LDS_K; bf16x8 kf[8];
  const lds_cptr shm3=(lds_cptr)shm; const lds_cptr kp0=shm3+LDS_K+hi*1024+r32*16; const lds_cptr vp0=shm3+LDS_V+((lane>>4)&1)*32+(lane&3)*8+(4*hi+((lane&15)>>2))*64;
  const int NT=(q0+QB)/KVBLK;
  DMA_K(0,0);DMA_V(0,0);DMA_K(1,SLOTB);
  bf16x8 qr[4];
  #pragma unroll
  for(int d0=0;d0<4;++d0){qr[d0]=*reinterpret_cast<const bf16x8*>(&Qw[(long)r32*DM+d0*16+hi*8]); if((d0>>1)!=nsel)qr[d0]=bf16x8{0,0,0,0,0,0,0,0};}
  float mhat=0.f,l_reg=0.f;f32x16 o[2];o[0]=f32x16{};o[1]=f32x16{};f32x16 negm=f32x16{};asm volatile("":"+v"(negm));
  const int qrel=wid*QBLK+r32;
  #define CMASK(P0,P1,t) do{int jb_=(t)-(NT-4); if(jb_>=0)cmask(P0,P1,jb_,qrel,hi);}while(0)
  bool resc=false;
  #define START(P0,P1) do{ const float rm=rowmax(P0,P1); resc=false; \
    { const float dl=rm; mhat=fadd_s(mhat,dl); \
      _Pragma("unroll") for(int r=0;r<16;++r){P0[r]=fsub_s(P0[r],dl);P1[r]=fsub_s(P1[r],dl);} \
      _Pragma("unroll") for(int r=0;r<16;++r)negm[r]=-mhat; asm volatile("":"+v"(negm)); } \
    _Pragma("unroll") for(int r=0;r<16;++r)P0[r]=__builtin_amdgcn_exp2f(P0[r]); }while(0)
  #define RESC() do{ if(resc){ asm volatile("s_waitcnt lgkmcnt(0)":::"memory"); \
      _Pragma("unroll") for(int d_=0;d_<2;++d_) _Pragma("unroll") for(int r=0;r<16;++r)o[d_][r]*=wsf[crow(r,hi)]; } }while(0)
  f32x16 pA0,pA1,pB0,pB1;
  int sl_prev=0,sl_cur=0,sl_next=SLOTB;
  #define ROT() do{sl_prev=sl_cur;sl_cur=sl_next;sl_next=(sl_next==(NSLOT-1)*SLOTB)?0:sl_next+SLOTB;}while(0)
  DMA_K(2,2*SLOTB);
  WAIT_BAR(3);
  qkt(pA0,pA1,Kbase,qr,negm,r32,hi);asm volatile("s_nop 15\n\ts_nop 7":"+v"(pA0),"+v"(pA1));CMASK(pA0,pA1,0);
  START(pA0,pA1);
  _Pragma("unroll") for(int r=0;r<16;++r)pA1[r]=__builtin_amdgcn_exp2f(pA1[r]);
  WAIT_BAR(0);
  DMA_K(3,0);DMA_V(1,SLOTB);
  ROT();
  kload8(kf,kp0+sl_cur);
  WAIT_BAR(2);
  s16x4 vlo[8],vhi[8]; u32x4 pw0,pw1,pw2,pw3;
  #define PKW(P,B) cvtpk_s(P[B],P[B+1])
  #define PAF(k) __builtin_bit_cast(bf16x8,pw##k)
  #define VFR(i) (bf16x8){vlo[i][0],vlo[i][1],vlo[i][2],vlo[i][3],vhi[i][0],vhi[i][1],vhi[i][2],vhi[i][3]}
  #define PIN(x) asm volatile("":"+v"(x))
  #define MX3(a,b,c) __builtin_fmaxf(__builtin_fmaxf((a),(b)),(c))
  #define GAPA(MF,A0,A1,A2,A3,W0,W1,PW) do{ MF; sacc+=A0; sacc+=A1; sacc+=A2; sacc+=A3; PIN(sacc); W0; W1; PIN(PW); SBAR(); }while(0)
  #define EX(v) __builtin_amdgcn_exp2f(v)
  #define GAPB(MF,X,B) do{ MF; X[B]=EX(X[B]); X[B+1]=EX(X[B+1]); X[B+2]=EX(X[B+2]); X[B+3]=EX(X[B+3]); PIN(X); SBAR(); }while(0)
  #define VRD(i) do{ vlo[i]=vtr(vp_+(((i)>>2)*4096+((i)&3)*1024)); vhi[i]=vtr(vp_+(((i)>>2)*4096+((i)&3)*1024+512)); }while(0)
  #define KRD(G,j) do{ if(G){ kload2(kf,kp0+sl_next,j); SBAR(); } }while(0)
  #define STEP(C0,C1,P0,P1,t,GK,GV,GL) do{ SBAR(); \
    const lds_cptr vp_=vp0+sl_prev; \
    VRD(0); SBAR(); float sacc=(P0[0]+P0[1]); \
    GAPA(C0=__builtin_amdgcn_mfma_f32_32x32x16_bf16(kf[0],qr[0],negm,0,0,0), P0[2],P0[3],P0[4],P0[5],     pw0[0]=PKW(P0,0), pw0[1]=PKW(P0,2), pw0); \
    VRD(4); SBAR(); GAPA(C1=__builtin_amdgcn_mfma_f32_32x32x16_bf16(kf[1],qr[0],negm,0,0,0), P0[6],P0[7],P0[8],P0[9],     pw0[2]=PKW(P0,4), pw0[3]=PKW(P0,6), pw0); \
    VRD(1); SBAR(); GAPA(C0=__builtin_amdgcn_mfma_f32_32x32x16_bf16(kf[2],qr[1],C0,0,0,0),   P0[10],P0[11],P0[12],P0[13], pw1[0]=PKW(P0,8), pw1[1]=PKW(P0,10), pw1); \
    VRD(5); SBAR(); GAPA(C1=__builtin_amdgcn_mfma_f32_32x32x16_bf16(kf[3],qr[1],C1,0,0,0),   P0[14],P0[15],P1[0],P1[1],   pw1[2]=PKW(P0,12),pw1[3]=PKW(P0,14), pw1); \
    VRD(2); SBAR(); GAPA(C0=__builtin_amdgcn_mfma_f32_32x32x16_bf16(kf[4],qr[2],C0,0,0,0),   P1[2],P1[3],P1[4],P1[5],     pw2[0]=PKW(P1,0), pw2[1]=PKW(P1,2), pw2); \
    VRD(6); SBAR(); GAPA(C1=__builtin_amdgcn_mfma_f32_32x32x16_bf16(kf[5],qr[2],C1,0,0,0),   P1[6],P1[7],P1[8],P1[9],     pw2[2]=PKW(P1,4), pw2[3]=PKW(P1,6), pw2); \
    VRD(3); SBAR(); GAPA(C0=__builtin_amdgcn_mfma_f32_32x32x16_bf16(kf[6],qr[3],C0,0,0,0),   P1[10],P1[11],P1[12],P1[13], pw3[0]=PKW(P1,8), pw3[1]=PKW(P1,10), pw3); \
    VRD(7); SBAR(); GAPA(C1=__builtin_amdgcn_mfma_f32_32x32x16_bf16(kf[7],qr[3],C1,0,0,0),   P1[14],P1[15],0.f,0.f,       pw3[2]=PKW(P1,12),pw3[3]=PKW(P1,14), pw3); \
    l_reg+=sacc; \
    if(GK){DMA_K((t)+3,sl_cur);} if(GV){DMA_V((t)+1,sl_next);} \
    CMASK(C0,C1,t); \
    { float a=MX3(C0[0],C0[1],C1[0]),b=MX3(C0[2],C0[3],C1[1]); a=MX3(a,C1[2],C1[3]); \
      _Pragma("unroll") for(int r=4;r<16;r+=4){a=MX3(a,C0[r],C0[r+1]);b=MX3(b,C0[r+2],C0[r+3]);a=MX3(a,C1[r],C1[r+1]);b=MX3(b,C1[r+2],C1[r+3]);} \
      float rm=__builtin_fmaxf(a,b); { auto rr=__builtin_amdgcn_permlane32_swap(__float_as_uint(rm),__float_as_uint(rm),false,false); rm=__builtin_fmaxf(__uint_as_float(rr[0]),__uint_as_float(rr[1])); } \
      resc=false; \
      if(__builtin_expect(__any(rm>(float)THRL),0)){ const float dl=__builtin_fmaxf(rm,0.f); mhat+=dl; \
        _Pragma("unroll") for(int r=0;r<16;++r){C0[r]-=dl;C1[r]-=dl;} \
        _Pragma("unroll") for(int r=0;r<16;++r)negm[r]=-mhat; asm volatile("":"+v"(negm)); \
        const float f=__builtin_amdgcn_exp2f(-dl); l_reg*=f; if(hi==0)wsf[r32]=f; resc=true; } } \
    SBAR(); \
    GAPB(o[0]=__builtin_amdgcn_mfma_f32_32x32x16_bf16(PAF(0),VFR(0),o[0],0,0,0), C0,0); \
    GAPB(o[1]=__builtin_amdgcn_mfma_f32_32x32x16_bf16(PAF(0),VFR(4),o[1],0,0,0), C0,4); \
    KRD(GL,0); GAPB(o[0]=__builtin_amdgcn_mfma_f32_32x32x16_bf16(PAF(1),VFR(1),o[0],0,0,0), C0,8); \
    KRD(GL,1); GAPB(o[1]=__builtin_amdgcn_mfma_f32_32x32x16_bf16(PAF(1),VFR(5),o[1],0,0,0), C0,12); \
    KRD(GL,2); GAPB(o[0]=__builtin_amdgcn_mfma_f32_32x32x16_bf16(PAF(2),VFR(2),o[0],0,0,0), C1,0); \
    KRD(GL,3); GAPB(o[1]=__builtin_amdgcn_mfma_f32_32x32x16_bf16(PAF(2),VFR(6),o[1],0,0,0), C1,4); \
    GAPB(o[0]=__builtin_amdgcn_mfma_f32_32x32x16_bf16(PAF(3),VFR(3),o[0],0,0,0), C1,8); \
    GAPB(o[1]=__builtin_amdgcn_mfma_f32_32x32x16_bf16(PAF(3),VFR(7),o[1],0,0,0), C1,12); \
    }while(0)
  int t=1;
  #undef CMASK
  #define CMASK(P0,P1,t) do{}while(0)
  for(;t+5<NT;t+=2){
    STEP(pB0,pB1,pA0,pA1,t,true,true,true);     WAIT_BAR(2); RESC(); ROT();
    STEP(pA0,pA1,pB0,pB1,t+1,true,true,true);   WAIT_BAR(2); RESC(); ROT();
  }
  #undef CMASK
  #define CMASK(P0,P1,t) do{int jb_=(t)-(NT-4); if(jb_>=0)cmask(P0,P1,jb_,qrel,hi);}while(0)
  #define ENDW(tt) do{ if((tt)+3<NT){WAIT_BAR(2);} else if((tt)+2<NT){WAIT_BAR(1);} else {WAIT_BAR(0);} }while(0)
  for(;t+1<NT;t+=2){
    STEP(pB0,pB1,pA0,pA1,t,(t+3<NT),(t+1<NT),(t+1<NT));       ENDW(t);   RESC(); ROT();
    STEP(pA0,pA1,pB0,pB1,t+1,(t+4<NT),(t+2<NT),(t+2<NT));     ENDW(t+1); RESC(); ROT();
  }
  STEP(pB0,pB1,pA0,pA1,NT-1,false,false,false); RESC();
  { float sacc=pB0[0]+pB0[1]; _Pragma("unroll") for(int r=2;r<16;++r)sacc+=pB0[r]; _Pragma("unroll") for(int r=0;r<16;++r)sacc+=pB1[r]; l_reg+=sacc;
    pw0=(u32x4){PKW(pB0,0),PKW(pB0,2),PKW(pB0,4),PKW(pB0,6)};pw1=(u32x4){PKW(pB0,8),PKW(pB0,10),PKW(pB0,12),PKW(pB0,14)};pw2=(u32x4){PKW(pB1,0),PKW(pB1,2),PKW(pB1,4),PKW(pB1,6)};pw3=(u32x4){PKW(pB1,8),PKW(pB1,10),PKW(pB1,12),PKW(pB1,14)};
    SBAR(); pv(o,vb0+sl_cur,PAF(0),PAF(1),PAF(2),PAF(3)); }
  #undef PKW
  #undef PAF
  #undef VFR
  #undef PIN
  #undef MX3
  #undef GAPA
  #undef GAPB
  #undef EX
  #undef VRD
  #undef KRD
  #undef STEP
  #undef ENDW
  {auto rr=__builtin_amdgcn_permlane32_swap(__float_as_uint(l_reg),__float_as_uint(l_reg),false,false);l_reg=__uint_as_float(rr[0])+__uint_as_float(rr[1]);}
  if(hi==0)wsf[32+r32]=l_reg;asm volatile("s_waitcnt lgkmcnt(0)":::"memory");
  float rli[16];
  #pragma unroll
  for(int r=0;r<16;++r)rli[r]=__builtin_amdgcn_rcpf(wsf[32+crow(r,hi)]);
  bf16*Ow=O+(rowbase+q0+wid*QBLK)*OPITCH+h*D;
  { bf16*stg=(bf16*)(shm+(nsel==0?LDS_OST1:LDS_OST))+wid*2048;
    #pragma unroll
    for(int r=0;r<16;++r){const int orow=crow(r,hi);
      #pragma unroll
      for(int d0=0;d0<2;++d0)stg[orow*64+d0*32+r32]=__float2bfloat16(o[d0][r]*rli[r]);}
    asm volatile("s_waitcnt lgkmcnt(0)":::"memory");
    if(nsel==1){ const bf16*stg1=(const bf16*)(shm+LDS_OST1)+wid*2048;
      #pragma unroll
      for(int i=0;i<4;++i){const int row=i*8+(lane>>3),ch=lane&7; const u32x4 v2=*(const u32x4*)(stg+row*64+ch*8); const u32x4 v1=*(const u32x4*)(stg1+row*64+ch*8);
        float dd[8]; float ss=0.f;
        #pragma unroll
        for(int j=0;j<4;++j){ const float a0=__uint_as_float(v1[j]<<16),a1=__uint_as_float(v1[j]&0xffff0000u),b0=__uint_as_float(v2[j]<<16),b1=__uint_as_float(v2[j]&0xffff0000u);
          dd[2*j]=a0-lam*b0; dd[2*j+1]=a1-lam*b1; ss+=dd[2*j]*dd[2*j]+dd[2*j+1]*dd[2*j+1]; }
        ss+=__shfl_xor(ss,1); ss+=__shfl_xor(ss,2); ss+=__shfl_xor(ss,4);
        const float rs=omli/sqrtf(ss*(1.0f/64.0f)+1e-6f);
        u32x4 w;
        #pragma unroll
        for(int j=0;j<4;++j) w[j]=cvtpk_s(dd[2*j]*rs*subg[ch*8+2*j],dd[2*j+1]*rs*subg[ch*8+2*j+1]);
        ATTN_STORE16(Ow+(long)row*OPITCH+ch*8,w);} } }
  asm volatile("s_waitcnt lgkmcnt(0)\n\ts_barrier":::"memory");
  #undef DMA_K
  #undef DMA_V
  #undef CMASK
  #undef START
  #undef RESC
  #undef ROT

}
#undef SBAR
#undef WAIT_BAR
}
#ifndef GOFF
#define GOFF 0
#endif
#define GEMMCALL0 if (!((GOFF) & 1))
#define GEMMCALL1 if (!((GOFF) & 2))
#define GEMMCALL2 if (!((GOFF) & 4))
#define GEMMCALL3 if (!((GOFF) & 8))
namespace cg = cooperative_groups;
#define GAS __attribute__((address_space(1)))
#define LAS __attribute__((address_space(3)))
#define DI __device__ __forceinline__
typedef unsigned short bf16;
typedef unsigned v4u __attribute__((ext_vector_type(4)));
typedef unsigned v2u __attribute__((ext_vector_type(2)));
typedef float f32x4 __attribute__((ext_vector_type(4)));
typedef short bf16x8 __attribute__((ext_vector_type(8)));

constexpr int NWAVES = 8;
constexpr int DMODEL = 1024, SEQ = 4096, M = 32768, NIN = 3328, FF = 4096;
constexpr int RW = 384, RCOLS = 1408, ROFF = 1920, COFF = 1152;
constexpr float NORM_EPS = 1e-6f, GN_EPS = 64e-5f;
constexpr size_t MiB = 1u << 20;
constexpr size_t WS_CTL = 0, CTL_ZERO_BYTES = 65536;
constexpr int CW_BAR = 4096;
constexpr size_t WS_SS = 128 * 1024;
constexpr size_t WS_WIN = 1 * MiB, WS_WOUT = 14 * MiB, WS_WUP = 18 * MiB, WS_WDN = 34 * MiB, WS_LORA = 50 * MiB;
constexpr size_t WS_XB = 51 * MiB, WS_PROJ = 115 * MiB, WS_MIX = 323 * MiB, WS_S = 387 * MiB, WS_END = 507 * MiB;
constexpr size_t WS_HID = 115 * MiB;
constexpr size_t SARR = (size_t)M * RW;
constexpr int LORA_L = 384 * 64 * 2 + 384 * 128;
constexpr int LDS_BYTES = 147456, MISC_OFF = 131072;
constexpr int SCAN_WGS = 96, ATT_ITEMS = 768;

#ifndef PROBE
#define PROBE 0
#endif
struct Args { const float* in[25]; float* out; unsigned char* ws; int i0, i1; };

DI float wave_sum(float v) {
#pragma unroll
    for (int o = 1; o < 64; o <<= 1) v += __shfl_xor(v, o);
    return v;
}
DI unsigned f2bf(float f) { unsigned u = __builtin_bit_cast(unsigned, f); return (u + 0x7fffu + ((u >> 16) & 1u)) >> 16; }
DI unsigned pk2(float lo, float hi) { return f2bf(lo) | (f2bf(hi) << 16); }
DI float bflo(unsigned w) { return __uint_as_float(w << 16); }
DI float bfhi(unsigned w) { return __uint_as_float(w & 0xffff0000u); }
DI float bf1(const bf16* p) { return __uint_as_float(((unsigned)*p) << 16); }
DI void unpack8(v4u w, float* f) { f[0] = bflo(w.x); f[1] = bfhi(w.x); f[2] = bflo(w.y); f[3] = bfhi(w.y); f[4] = bflo(w.z); f[5] = bfhi(w.z); f[6] = bflo(w.w); f[7] = bfhi(w.w); }
DI v4u pack8(const float* f) { v4u o; o.x = pk2(f[0], f[1]); o.y = pk2(f[2], f[3]); o.z = pk2(f[4], f[5]); o.w = pk2(f[6], f[7]); return o; }
DI float sigmoidf_(float x) { return 1.f / (1.f + __expf(-x)); }
DI float tanhf_(float x) { const float e = __expf(2.f * x); return 1.f - 2.f / (e + 1.f); }
template <int CTRL> DI float dpp_add(float x) { return x + __int_as_float(__builtin_amdgcn_update_dpp(0, __float_as_int(x), CTRL, 0xf, 0xf, true)); }
DI float red16(float x) { x = dpp_add<0xB1>(x); x = dpp_add<0x4E>(x); x = dpp_add<0x141>(x); x = dpp_add<0x140>(x); return x; }

#define XB_TMO      128
#define XB_XCNT(j)  (256  + 64 * (j))
#define XB_XSUB(j)  (1280 + 64 * (j))
#define XB_XGEN(j)  (2304 + 64 * (j))
#define XB_TOP      3328
#define XB_TOPGEN   3392
#define XCD_BAR_WORDS 3456
#define XB_SPIN_CAP (1u << 18)

__device__ __forceinline__ unsigned xb_ld(unsigned* p)              { return __hip_atomic_load(p, __ATOMIC_RELAXED, __HIP_MEMORY_SCOPE_AGENT); }
__device__ __forceinline__ unsigned xb_add(unsigned* p, unsigned v) { return __hip_atomic_fetch_add(p, v, __ATOMIC_RELAXED, __HIP_MEMORY_SCOPE_AGENT); }
__device__ __forceinline__ unsigned xb_xcc_id() { return (unsigned)__builtin_amdgcn_s_getreg((3 << 11) | 20) & 0xFu; }
#define XB_SPIN(cond, bar) do { unsigned _sp = 0; while (cond) { __builtin_amdgcn_s_sleep(1); \
    if ((++_sp & 255u) == 0u) { if (xb_ld(&(bar)[XB_TMO])) break; if (_sp > XB_SPIN_CAP) { atomicAdd(&(bar)[XB_TMO], 1u); break; } } } } while (0)

struct XcdBarrier {
    unsigned* bar; unsigned x;
    volatile LAS unsigned* st;
};

__device__ __forceinline__ XcdBarrier xcd_barrier_post(unsigned* bar, volatile LAS unsigned* st) {
    XcdBarrier b; b.bar = bar; b.x = xb_xcc_id(); b.st = st;
    if (threadIdx.x == 0) (void)xb_add(&bar[XB_XCNT(b.x)], 1u);
    return b;
}
__device__ __forceinline__ void xcd_barrier_complete(unsigned* bar, unsigned x, unsigned& nloc, unsigned& nx) {
    const unsigned G = gridDim.x * gridDim.y * gridDim.z;
    unsigned sum, cnt, mine, sp = 0u;
    for (;;) {
        sum = 0u; cnt = 0u; mine = 0u;
#pragma unroll
        for (unsigned j = 0; j < 16; ++j) { const unsigned c = xb_ld(&bar[XB_XCNT(j)]); sum += c; cnt += (c > 0u) ? 1u : 0u; mine = (j == x) ? c : mine; }
        if (sum == G) break;
        __builtin_amdgcn_s_sleep(1);
        if ((++sp & 255u) == 0u) { if (xb_ld(&bar[XB_TMO])) break; if (sp > XB_SPIN_CAP) { atomicAdd(&bar[XB_TMO], 1u); break; } }
    }
    nloc = mine > 0u ? mine : 1u; nx = cnt > 0u ? cnt : 1u;
}

__device__ __forceinline__ void xcd_barrier(const XcdBarrier& b) {
    asm volatile("s_waitcnt vmcnt(0)" ::: "memory");
    __syncthreads();
    if (threadIdx.x == 0) {
        unsigned* bar = b.bar;
        __builtin_amdgcn_s_waitcnt(0);
        unsigned nloc = b.st[0], nx = b.st[1];
        if (nloc == 0u) { xcd_barrier_complete(bar, b.x, nloc, nx); b.st[0] = nloc; b.st[1] = nx; }
        const unsigned old = xb_add(&bar[XB_XSUB(b.x)], 1u);
        const unsigned gen = old / nloc;
        if (old + 1u == (gen + 1u) * nloc) {
            __builtin_amdgcn_fence(__ATOMIC_RELEASE, "agent");
            asm volatile("s_waitcnt vmcnt(0)" ::: "memory");
            const unsigned og = xb_add(&bar[XB_TOP], 1u);
            const unsigned tg = og / nx;
            if (og + 1u == (tg + 1u) * nx) xb_add(&bar[XB_TOPGEN], 1u);
            else XB_SPIN(xb_ld(&bar[XB_TOPGEN]) == tg, bar);
            __builtin_amdgcn_fence(__ATOMIC_ACQUIRE, "agent");
            xb_add(&bar[XB_XGEN(b.x)], 1u);
            asm volatile("s_waitcnt vmcnt(0)" ::: "memory");
        } else {
            XB_SPIN(xb_ld(&bar[XB_XGEN(b.x)]) == gen, bar);
            __builtin_amdgcn_fence(__ATOMIC_ACQUIRE, "agent");
            asm volatile("s_waitcnt vmcnt(0)" ::: "memory");
        }
    }
    __syncthreads();
}


struct Frame {
    LAS unsigned char* lds;
    int tid, lane, wave, G, gw, NGW;
    const float* const* in;
    float* out; unsigned char* ws;
};
DI const float* INP(const Frame& F, int k) { asm volatile("" : "+s"(k)); return F.in[k]; }
#define F_WIN  ((bf16*)(F.ws + WS_WIN))
#define F_WOUT ((bf16*)(F.ws + WS_WOUT))
#define F_WUP  ((bf16*)(F.ws + WS_WUP))
#define F_WDN  ((bf16*)(F.ws + WS_WDN))
#define F_LORA ((bf16*)(F.ws + WS_LORA))
#define F_XB   ((bf16*)(F.ws + WS_XB))
#define F_PROJ ((bf16*)(F.ws + WS_PROJ))
#define F_MIX  ((bf16*)(F.ws + WS_MIX))
#define F_HID  ((bf16*)(F.ws + WS_HID))
#define F_S_r  ((bf16*)(F.ws + WS_XB))
#define F_S_ld ((bf16*)(F.ws + WS_XB) + SARR)
#define F_S_k  ((bf16*)(F.ws + WS_S))
#define F_S_v  ((bf16*)(F.ws + WS_S) + SARR)
#define F_S_n  ((bf16*)(F.ws + WS_S) + 2 * SARR)
#define F_S_b  ((bf16*)(F.ws + WS_S) + 3 * SARR)
#define F_S_g  ((bf16*)(F.ws + WS_S) + 4 * SARR)
#define F_ctl  ((unsigned*)(F.ws + WS_CTL))

DI void transpose_item(const float* W, int K, int N, bf16* WT, LAS float* scr, int item, int lane, const float* gk, float cs, int csn) {
    const int nblk = N / 32, kb = item / nblk, nb = item % nblk, k0 = 64 * kb, n0 = 32 * nb;
    const float colscale = (n0 + (lane & 31) < csn) ? cs : 1.f;
#pragma unroll 8
    for (int i = 0; i < 32; ++i) { const int kk = 2 * i + (lane >> 5); float v = W[(size_t)(k0 + kk) * N + n0 + (lane & 31)]; if (gk) v *= gk[k0 + kk]; scr[kk * 33 + (lane & 31)] = v * colscale; }
    asm volatile("s_waitcnt lgkmcnt(0)" ::: "memory");
    const int c = lane & 7;
#pragma unroll
    for (int j = 0; j < 4; ++j) { const int n = (lane >> 3) + 8 * j; const LAS float* s = scr + (8 * c) * 33 + n;
        v4u o; o.x = pk2(s[0 * 33], s[1 * 33]); o.y = pk2(s[2 * 33], s[3 * 33]); o.z = pk2(s[4 * 33], s[5 * 33]); o.w = pk2(s[6 * 33], s[7 * 33]);
        *(v4u*)(WT + (size_t)(n0 + n) * K + k0 + 8 * c) = o; }
    asm volatile("s_waitcnt lgkmcnt(0)" ::: "memory");
}
DI Frame refresh(const Frame& F0) { Frame F = F0; int t = threadIdx.x; asm volatile("" : "+v"(t)); int bxx = blockIdx.x; asm volatile("" : "+s"(bxx)); F.tid = t; F.lane = t & 63; F.wave = __builtin_amdgcn_readfirstlane(t >> 6); F.gw = bxx * NWAVES + F.wave; return F; }
DI void prologue(const Frame& F0) { Frame F = refresh(F0);
    LAS float* scr = (LAS float*)(F.lds + F.wave * 16384);
    constexpr int I_IN = 16 * 104, I_OUT = 16 * 32, I_UP = 16 * 128, I_DN = 64 * 32, I_LW = 12, I_LG = 24;
    constexpr int PER = I_IN + I_OUT + I_UP + I_DN + 2 * I_LW + I_LG;
    constexpr float C2 = 0.17677669529663687f * 1.4426950408889634f;
    for (int it = F.gw; it < 2 * PER; it += F.NGW) {
        const int l = it / PER; int r = it % PER;
        if (r < I_IN) { transpose_item(INP(F, 2) + (size_t)l * DMODEL * NIN, DMODEL, NIN, F_WIN + (size_t)l * NIN * DMODEL, scr, r, F.lane, INP(F, 1) + l * DMODEL, C2, 384); continue; } r -= I_IN;
        if (r < I_OUT) { transpose_item(INP(F, 20) + (size_t)l * DMODEL * DMODEL, DMODEL, DMODEL, F_WOUT + (size_t)l * DMODEL * DMODEL, scr, r, F.lane, nullptr, 1.f, 0); continue; } r -= I_OUT;
        if (r < I_UP) { transpose_item(INP(F, 22) + (size_t)l * DMODEL * FF, DMODEL, FF, F_WUP + (size_t)l * FF * DMODEL, scr, r, F.lane, INP(F, 21) + l * DMODEL, 1.f, 0); continue; } r -= I_UP;
        if (r < I_DN) { transpose_item(INP(F, 23) + (size_t)l * FF * DMODEL, FF, DMODEL, F_WDN + (size_t)l * DMODEL * FF, scr, r, F.lane, nullptr, 1.f, 0); continue; } r -= I_DN;
        bf16* L = F_LORA + (size_t)l * LORA_L;
        if (r < I_LW) { transpose_item(INP(F, 11) + (size_t)l * 64 * RW, 64, RW, L, scr, r, F.lane, nullptr, 1.f, 0); continue; } r -= I_LW;
        if (r < I_LW) { transpose_item(INP(F, 13) + (size_t)l * 64 * RW, 64, RW, L + RW * 64, scr, r, F.lane, nullptr, 1.f, 0); continue; } r -= I_LW;
        transpose_item(INP(F, 14) + (size_t)l * 128 * RW, 128, RW, L + 2 * RW * 64, scr, r, F.lane, nullptr, 1.f, 0);
    }
}
DI void rms_rows_bf16(const Frame& F0, const float* src, bf16* dst) { Frame F = refresh(F0);
    for (int m = F.gw; m < M; m += F.NGW) {
        const f32x4* xr = (const f32x4*)(src + (size_t)m * DMODEL) + F.lane;
        f32x4 v[4]; float s2 = 0.f;
#pragma unroll
        for (int j = 0; j < 4; ++j) { v[j] = xr[64 * j]; s2 += (v[j].x * v[j].x + v[j].y * v[j].y) + (v[j].z * v[j].z + v[j].w * v[j].w); }
        const float rstd = 1.f / sqrtf(wave_sum(s2) * (1.f / DMODEL) + NORM_EPS);
        v2u* o8 = (v2u*)(dst + (size_t)m * DMODEL) + F.lane;
#pragma unroll
        for (int j = 0; j < 4; ++j) { v2u w; w.x = pk2(v[j].x * rstd, v[j].y * rstd); w.y = pk2(v[j].z * rstd, v[j].w * rstd); o8[64 * j] = w; }
    }
}
DI void final_norm(const Frame& F0, float* x, const float* g) { Frame F = refresh(F0);
    for (int m = F.gw; m < M; m += F.NGW) {
        f32x4* xr = (f32x4*)(x + (size_t)m * DMODEL) + F.lane; const f32x4* gr = (const f32x4*)g + F.lane;
        f32x4 v[4]; float s2 = 0.f;
#pragma unroll
        for (int j = 0; j < 4; ++j) { v[j] = xr[64 * j]; s2 += (v[j].x * v[j].x + v[j].y * v[j].y) + (v[j].z * v[j].z + v[j].w * v[j].w); }
        const float rstd = 1.f / sqrtf(wave_sum(s2) * (1.f / DMODEL) + NORM_EPS);
#pragma unroll
        for (int j = 0; j < 4; ++j) xr[64 * j] = v[j] * rstd * gr[64 * j];
    }
}

DI void loadz8(const bf16* prow, bool first, const float* mu, int col, float* z) {
    const v4u p = *(const v4u*)(prow + col); v4u q = (v4u){0u, 0u, 0u, 0u}; if (!first) q = *(const v4u*)(prow - NIN + col);
    const f32x4 m0 = *(const f32x4*)(mu + col), m1 = *(const f32x4*)(mu + col + 4);
    float pf[8], qf[8]; unpack8(p, pf); unpack8(q, qf);
#pragma unroll
    for (int j = 0; j < 4; ++j) { z[j] = pf[j] + m0[j] * (qf[j] - pf[j]); z[4 + j] = pf[4 + j] + m1[j] * (qf[4 + j] - pf[4 + j]); }
}
DI float loadz1(const bf16* prow, bool first, float mu, int col) { const float p = bf1(prow + col); const float q = first ? 0.f : bf1(prow - NIN + col); return p + mu * (q - p); }

DI void prep_phase(const Frame& F0, int l) { Frame F = refresh(F0);
    const float* mu = INP(F, 9) + l * RCOLS;
    const float* w0 = INP(F, 10) + l * RW; const float* a0 = INP(F, 12) + l * RW; const float* kkw = INP(F, 15) + l * RW; const float* kaw = INP(F, 16) + l * RW;
    const bf16* WUT = F_LORA + (size_t)l * LORA_L; const bf16* AUT = WUT + RW * 64; const bf16* GUT = AUT + RW * 64;
    const int row = F.lane & 15, kq = F.lane >> 4, tok = F.lane >> 2, cq = (F.lane & 3) * 16;
    LAS float* LW = (LAS float*)(F.lds + F.wave * 16384);
    for (int tile = F.gw; tile < M / 16; tile += F.NGW) {
        const int t0 = tile * 16;
        bf16x8 Aw[2], Aa[2], Ag[4];
        { const int t = t0 + row; const bool first = (t % SEQ) == 0; const bf16* prow = F_PROJ + (size_t)t * NIN + ROFF; float z[8];
#pragma unroll
          for (int ks = 0; ks < 2; ++ks) { loadz8(prow, first, mu, 1152 + ks * 32 + kq * 8, z);
#pragma unroll
              for (int j = 0; j < 8; ++j) z[j] = tanhf_(z[j]);
              Aw[ks] = __builtin_bit_cast(bf16x8, pack8(z)); }
#pragma unroll
          for (int ks = 0; ks < 2; ++ks) { loadz8(prow, first, mu, 1216 + ks * 32 + kq * 8, z); Aa[ks] = __builtin_bit_cast(bf16x8, pack8(z)); }
#pragma unroll
          for (int ks = 0; ks < 4; ++ks) { loadz8(prow, first, mu, 1280 + ks * 32 + kq * 8, z);
#pragma unroll
              for (int j = 0; j < 8; ++j) z[j] = sigmoidf_(z[j]);
              Ag[ks] = __builtin_bit_cast(bf16x8, pack8(z)); } }
#pragma unroll 1
        for (int hd = 0; hd < 6; ++hd) {
#pragma unroll
            for (int cgi = 0; cgi < 4; ++cgi) {
                const int ch = hd * 64 + cgi * 16 + row;
                f32x4 cw = (f32x4){0.f, 0.f, 0.f, 0.f}, ca = cw, cgt = cw;
#pragma unroll
                for (int ks = 0; ks < 2; ++ks) {
                    const bf16x8 bw = *(const bf16x8*)(WUT + (size_t)ch * 64 + ks * 32 + kq * 8); cw = __builtin_amdgcn_mfma_f32_16x16x32_bf16(Aw[ks], bw, cw, 0, 0, 0);
                    const bf16x8 ba = *(const bf16x8*)(AUT + (size_t)ch * 64 + ks * 32 + kq * 8); ca = __builtin_amdgcn_mfma_f32_16x16x32_bf16(Aa[ks], ba, ca, 0, 0, 0); }
#pragma unroll
                for (int ks = 0; ks < 4; ++ks) { const bf16x8 bg = *(const bf16x8*)(GUT + (size_t)ch * 128 + ks * 32 + kq * 8); cgt = __builtin_amdgcn_mfma_f32_16x16x32_bf16(Ag[ks], bg, cgt, 0, 0, 0); }
#pragma unroll
                for (int j = 0; j < 4; ++j) { LAS float* d = LW + (kq * 4 + j) * 68 + cgi * 16 + row; d[0] = cw[j]; d[16 * 68] = ca[j]; d[32 * 68] = cgt[j]; }
            }
            asm volatile("s_waitcnt lgkmcnt(0)" ::: "memory");
            const int t = t0 + tok; const bool first = (t % SEQ) == 0; const bf16* prow = F_PROJ + (size_t)t * NIN + ROFF; const int ch0 = hd * 64 + cq;
            float kkq[16], aq[16]; float ss = 0.f;
#pragma unroll
            for (int sub = 0; sub < 2; ++sub) {
                const int ch = ch0 + sub * 8; const size_t idx = (size_t)t * RW + ch;
                float zr[8], zk[8], zv[8], wl[8], al[8], gl[8], pw0[8], pa0[8], pkk[8], pka[8], ldv[8], kpv[8];
                loadz8(prow, first, mu, ch, zr); loadz8(prow, first, mu, RW + ch, zk); loadz8(prow, first, mu, 2 * RW + ch, zv);
                const LAS float* lw = LW + tok * 68 + cq + sub * 8;
#pragma unroll
                for (int hh = 0; hh < 2; ++hh) { const f32x4 x0 = *(const LAS f32x4*)(lw + 4 * hh), x1 = *(const LAS f32x4*)(lw + 16 * 68 + 4 * hh), x2 = *(const LAS f32x4*)(lw + 32 * 68 + 4 * hh);
                    const f32x4 p0 = *(const f32x4*)(w0 + ch + 4 * hh), p1 = *(const f32x4*)(a0 + ch + 4 * hh), p2 = *(const f32x4*)(kkw + ch + 4 * hh), p3 = *(const f32x4*)(kaw + ch + 4 * hh);
#pragma unroll
                    for (int e = 0; e < 4; ++e) { wl[4 * hh + e] = x0[e]; al[4 * hh + e] = x1[e]; gl[4 * hh + e] = x2[e]; pw0[4 * hh + e] = p0[e]; pa0[4 * hh + e] = p1[e]; pkk[4 * hh + e] = p2[e]; pka[4 * hh + e] = p3[e]; } }
#pragma unroll
                for (int j = 0; j < 8; ++j) {
                    const float xs = -(pw0[j] + wl[j]); const float sp = fmaxf(xs, 0.f) + __logf(1.f + __expf(-fabsf(xs)));
                    ldv[j] = -__expf(-sp - 0.5f);
                    const float a = sigmoidf_(pa0[j] + al[j]);
                    const float kk = zk[j] * pkk[j]; kpv[j] = zk[j] * (1.f + (a - 1.f) * pka[j]);
                    kkq[sub * 8 + j] = kk; aq[sub * 8 + j] = a; ss += kk * kk;
                }
                *(v4u*)(F_S_r + idx) = pack8(zr); *(v4u*)(F_S_ld + idx) = pack8(ldv); *(v4u*)(F_S_k + idx) = pack8(kpv); *(v4u*)(F_S_v + idx) = pack8(zv); *(v4u*)(F_S_g + idx) = pack8(gl);
            }
            ss += __shfl_xor(ss, 1); ss += __shfl_xor(ss, 2);
            const float inv = 1.f / fmaxf(sqrtf(ss), 1e-12f);
#pragma unroll
            for (int sub = 0; sub < 2; ++sub) { float nn[8], bbv[8];
#pragma unroll
                for (int j = 0; j < 8; ++j) { const float kn = kkq[sub * 8 + j] * inv; nn[j] = -kn; bbv[j] = kn * aq[sub * 8 + j]; }
                const size_t idx = (size_t)t * RW + ch0 + sub * 8; *(v4u*)(F_S_n + idx) = pack8(nn); *(v4u*)(F_S_b + idx) = pack8(bbv); }
            asm volatile("s_waitcnt lgkmcnt(0)" ::: "memory");
        }
    }
    const float* cw_ = INP(F, 8) + l * 3 * 256;
    for (int it = F.gw; it < M / 2; it += F.NGW) {
        const int t = it * 2 + (F.lane >> 5), c8 = (F.lane & 31) * 8, pos = t % SEQ;
        const bf16* base = F_PROJ + (size_t)t * NIN + COFF + c8;
        float b8[8], g8[8], u8[8], acc[8], w8[8];
        unpack8(*(const v4u*)base, b8);
#pragma unroll
        for (int j = 0; j < 8; ++j) acc[j] = 0.f;
#pragma unroll
        for (int d = 0; d < 3; ++d) {
            const int back = 2 - d;
            if (pos >= back) {
                const bf16* pb = base - (size_t)back * NIN;
                unpack8(*(const v4u*)(pb + 256), g8); unpack8(*(const v4u*)(pb + 512), u8);
                const f32x4 wa = *(const f32x4*)(cw_ + d * 256 + c8), wb = *(const f32x4*)(cw_ + d * 256 + c8 + 4);
                w8[0] = wa.x; w8[1] = wa.y; w8[2] = wa.z; w8[3] = wa.w; w8[4] = wb.x; w8[5] = wb.y; w8[6] = wb.z; w8[7] = wb.w;
#pragma unroll
                for (int j = 0; j < 8; ++j) acc[j] += w8[j] * (g8[j] * u8[j]);
            }
        }
#pragma unroll
        for (int j = 0; j < 8; ++j) acc[j] *= b8[j];
        *(v4u*)(F_MIX + (size_t)t * DMODEL + 384 + c8) = pack8(acc);
    }
}

DI void post_phase(const Frame& F0, int l) { Frame F = refresh(F0);
    const float* rk = INP(F, 17) + l * RW; const float* lg = INP(F, 18) + l * RW; const float* lb = INP(F, 19) + l * RW;
    for (int it = F.gw; it < M * 6 / 8; it += F.NGW) {
        const int pair = it * 8 + (F.lane >> 3), t = pair / 6, hd = pair % 6, ch = hd * 64 + (F.lane & 7) * 8;
        bf16* yp = F_MIX + (size_t)t * DMODEL + 640 + ch; const size_t idx = (size_t)t * RW + ch;
        float y[8], r[8], k[8], v[8], g[8], o[8];
        unpack8(*(const v4u*)yp, y); unpack8(*(const v4u*)(F_S_r + idx), r); unpack8(*(const v4u*)(F_S_k + idx), k); unpack8(*(const v4u*)(F_S_v + idx), v); unpack8(*(const v4u*)(F_S_g + idx), g);
        float s = 0.f, dot = 0.f;
#pragma unroll
        for (int j = 0; j < 8; ++j) { s += y[j]; dot += r[j] * k[j] * rk[ch + j]; }
        s += __shfl_xor(s, 1); s += __shfl_xor(s, 2); s += __shfl_xor(s, 4);
        dot += __shfl_xor(dot, 1); dot += __shfl_xor(dot, 2); dot += __shfl_xor(dot, 4);
        const float mean = s * (1.f / 64.f); float q = 0.f;
#pragma unroll
        for (int j = 0; j < 8; ++j) { const float d = y[j] - mean; q += d * d; }
        q += __shfl_xor(q, 1); q += __shfl_xor(q, 2); q += __shfl_xor(q, 4);
        const float rstd = 1.f / sqrtf(q * (1.f / 64.f) + GN_EPS);
#pragma unroll
        for (int j = 0; j < 8; ++j) o[j] = ((y[j] - mean) * rstd * lg[ch + j] + lb[ch + j] + dot * v[j]) * g[j];
        *(v4u*)yp = pack8(o);
    }
}

DI void scan_wg(const Frame& F0, int sw) { Frame F = refresh(F0);
    const int bh = sw >> 1, half = sw & 1, b = bh / 6, hd = bh % 6;
    const size_t tb = (size_t)b * SEQ; const int cb = hd * 64;
    LAS unsigned char* const lds = F.lds;
    constexpr int BUFB = 6 * 8192, YOFF = 2 * BUFB;
    const bool loader = F.wave >= 4; const int ltid = F.tid - 256;
#define SCAN_STAGE(c, bufsel, P0, NP, STRIDE) do { _Pragma("unroll") for (int i = 0; i < (NP); ++i) { const int p = (P0) + (STRIDE) * i, a = p >> 8, tt = (p & 255) >> 3, c8 = (p & 7) * 8; \
        const bf16* src = (a == 0 ? F_S_r : a == 1 ? F_S_ld : a == 2 ? F_S_k : a == 3 ? F_S_v : a == 4 ? F_S_n : F_S_b); \
        const v4u raw = *(const v4u*)(src + (tb + (size_t)(c) * 32 + tt) * RW + cb + c8); \
        float f[8]; unpack8(raw, f); if (a == 1) { _Pragma("unroll") for (int j = 0; j < 8; ++j) f[j] = __expf(f[j]); } \
        LAS f32x4* d = (LAS f32x4*)(lds + (bufsel) * BUFB + a * 8192 + tt * 256 + c8 * 4); d[0] = (f32x4){f[0], f[1], f[2], f[3]}; d[1] = (f32x4){f[4], f[5], f[6], f[7]}; } } while (0)
#define SCAN_YOUT(c, bufsel) do { _Pragma("unroll") for (int i = 0; i < 2; ++i) { const int e = ltid + 256 * i, tt = e >> 4, r2 = (e & 15) * 2; \
        const LAS float* ys = (const LAS float*)(lds + YOFF + (bufsel) * 4096) + tt * 32 + r2; \
        *(unsigned*)(F_MIX + (tb + (size_t)(c) * 32 + tt) * DMODEL + 640 + cb + half * 32 + r2) = pk2(ys[0], ys[1]); } } while (0)
    SCAN_STAGE(0, 0, F.tid, 3, 512);
    __syncthreads();
    typedef float f32x2v __attribute__((ext_vector_type(2)));
    const int rp = F.wave * 8 + (F.lane >> 4) * 2, kp = F.lane & 15;
    f32x4 s0 = (f32x4){0.f, 0.f, 0.f, 0.f}, s1 = s0;
#pragma unroll 1
    for (int c = 0; c < SEQ / 32; ++c) {
        const int cur = c & 1;
        if (loader) {
            if (c + 1 < SEQ / 32) SCAN_STAGE(c + 1, cur ^ 1, ltid, 6, 256);
            if (c > 0) SCAN_YOUT(c - 1, cur ^ 1);
        } else {
            const LAS unsigned char* bb = lds + cur * BUFB + kp * 16;
            const LAS unsigned char* vb = lds + cur * BUFB + 3 * 8192 + (half * 32 + rp) * 4;
            LAS f32x2v* yb = (LAS f32x2v*)(lds + YOFF + cur * 4096 + rp * 4);
            f32x4 rv = *(const LAS f32x4*)(bb + 0 * 8192), wv = *(const LAS f32x4*)(bb + 1 * 8192), kv = *(const LAS f32x4*)(bb + 2 * 8192);
            f32x4 nv = *(const LAS f32x4*)(bb + 4 * 8192), bv = *(const LAS f32x4*)(bb + 5 * 8192);
            f32x2v vv = *(const LAS f32x2v*)(vb);
#pragma unroll 8
            for (int tt = 0; tt < 32; ++tt) {
                const int tn = (tt + 1) & 31;
                const f32x4 rv2 = *(const LAS f32x4*)(bb + 0 * 8192 + tn * 256), wv2 = *(const LAS f32x4*)(bb + 1 * 8192 + tn * 256), kv2 = *(const LAS f32x4*)(bb + 2 * 8192 + tn * 256);
                const f32x4 nv2 = *(const LAS f32x4*)(bb + 4 * 8192 + tn * 256), bv2 = *(const LAS f32x4*)(bb + 5 * 8192 + tn * 256);
                const f32x2v vv2 = *(const LAS f32x2v*)(vb + tn * 256);
                f32x2v d0 = (f32x2v){s0.x, s0.y} * (f32x2v){nv.x, nv.y}; d0 = (f32x2v){s0.z, s0.w} * (f32x2v){nv.z, nv.w} + d0;
                f32x2v d1 = (f32x2v){s1.x, s1.y} * (f32x2v){nv.x, nv.y}; d1 = (f32x2v){s1.z, s1.w} * (f32x2v){nv.z, nv.w} + d1;
                const float sa0 = red16(d0.x + d0.y), sa1 = red16(d1.x + d1.y);
                const f32x4 q0 = s0 * wv + kv * vv.x, q1 = s1 * wv + kv * vv.y;
                s0 = bv * sa0 + q0; s1 = bv * sa1 + q1;
                f32x2v y0 = (f32x2v){s0.x, s0.y} * (f32x2v){rv.x, rv.y}; y0 = (f32x2v){s0.z, s0.w} * (f32x2v){rv.z, rv.w} + y0;
                f32x2v y1 = (f32x2v){s1.x, s1.y} * (f32x2v){rv.x, rv.y}; y1 = (f32x2v){s1.z, s1.w} * (f32x2v){rv.z, rv.w} + y1;
                const float ya = red16(y0.x + y0.y), yc = red16(y1.x + y1.y);
                yb[tt * 16] = (f32x2v){ya, yc};
                rv = rv2; wv = wv2; kv = kv2; nv = nv2; bv = bv2; vv = vv2;
            }
        }
        __syncthreads();
    }
    if (loader) SCAN_YOUT(SEQ / 32 - 1, (SEQ / 32 - 1) & 1);
#undef SCAN_STAGE
#undef SCAN_YOUT
    __syncthreads();
}

DI void mix_phase(const Frame& F0, int l, char* ldsg) { Frame F = refresh(F0);
#ifndef SKIP_SCAN
    if ((int)blockIdx.x < SCAN_WGS) { scan_wg(F, (int)blockIdx.x); if (PROBE & 2) scan_wg(F, (int)blockIdx.x); }
#endif
    const float* lq1 = INP(F, 3) + l * 32; const float* lk1 = INP(F, 4) + l * 32; const float* lq2 = INP(F, 5) + l * 32; const float* lk2 = INP(F, 6) + l * 32;
    float d1 = 0.f, d2 = 0.f;
    for (int i = 0; i < 32; ++i) { d1 += lq1[i] * lk1[i]; d2 += lq2[i] * lk2[i]; }
    const float lambda_init = (l == 0) ? 0.2f : 0.35550906759f;
    const float lam = __expf(d1) - __expf(d2) + lambda_init;
    const float* sg = INP(F, 7) + l * 64;
    volatile LAS unsigned* qslot = (volatile LAS unsigned*)(F.lds + MISC_OFF + 64);
    for (int rep = 0; rep < ((PROBE & 4) ? 2 : 1); ++rep)
    for (;;) {
        if (F.tid == 0) *qslot = atomicAdd(F_ctl + 64 * (1 + l + 2 * rep), 1u);
        __syncthreads();
        const unsigned idx = (unsigned)__builtin_amdgcn_readfirstlane((int)*qslot);
        __syncthreads();
        if (idx >= (unsigned)ATT_ITEMS) break;
        const int qb = 15 - (int)(idx / 48u), bh = (int)(idx % 48u), b = bh / 6, h = bh % 6;
        const attn_body::bf16* P = (const attn_body::bf16*)F_PROJ;
#ifndef SKIP_ATT
#pragma unroll 1
        for (int ns = 0; ns < 2; ++ns)
            attn_body::attn_unit<8>(b, h, qb, ns, lam, sg, 1.f - lambda_init, P, P + 384, P + 768, (attn_body::bf16*)F_MIX, ldsg);
#endif
    }
}

__global__ void __launch_bounds__(NWAVES * 64, 2) mega_fwd(Args args) {
    extern __shared__ __attribute__((aligned(16))) unsigned char lds[];
    cg::grid_group grid = cg::this_grid();
    Frame F;
    F.lds = (LAS unsigned char*)lds;
    F.tid = threadIdx.x; F.lane = F.tid & 63; F.wave = __builtin_amdgcn_readfirstlane(F.tid >> 6);
    F.G = gridDim.x; F.gw = (int)blockIdx.x * NWAVES + F.wave; F.NGW = F.G * NWAVES;
    F.in = args.in; F.out = args.out; F.ws = args.ws;
    const int G = F.G;
    if (F.tid < 32) ((LAS unsigned*)(F.lds + MISC_OFF))[F.tid] = 0u;
    __syncthreads();
    XcdBarrier bar = xcd_barrier_post((unsigned*)(args.ws + WS_CTL) + CW_BAR, (volatile LAS unsigned*)(F.lds + MISC_OFF) + 8);

    prologue(F);
    { float* ssz = (float*)(args.ws + WS_SS); for (int i = (int)blockIdx.x * 512 + (int)threadIdx.x; i < 4 * M; i += (int)gridDim.x * 512) ssz[i] = 0.f; }
    rms_rows_bf16(F, INP(F, 0), F_XB);
    grid.sync();
#pragma unroll 1
    for (int l = 0; l < 2; ++l) {
        {
            pg8::Gemm g{F_XB, F_WIN + (size_t)l * NIN * DMODEL, M, NIN, DMODEL}; pg8::StaticOrder S; int bx = blockIdx.x; asm volatile("" : "+s"(bx)); S.init(M, NIN, G, bx);
            pg8::EpiBf16S<0> E{F_PROJ, NIN, l == 0 ? (const float*)nullptr : (const float*)(args.ws + WS_SS) + (size_t)1 * M};
            GEMMCALL0 pg8::gemm_phase<pg8::EpiBf16S<0>, pg8::StaticOrder, true, true>(F.lds, g, S, E);
            if (PROBE & 1) { __syncthreads(); pg8::gemm_phase<pg8::EpiBf16S<0>, pg8::StaticOrder, true, true>(F.lds, g, S, E); }
        }
        xcd_barrier(bar);
#ifndef SKIP_PREP
        prep_phase(F, l);
        if (PROBE & 8) { __syncthreads(); prep_phase(F, l); }
#endif
        xcd_barrier(bar);
        mix_phase(F, l, (char*)lds);
        xcd_barrier(bar);
#ifndef SKIP_POST
        post_phase(F, l);
#endif
        xcd_barrier(bar);
        {
            pg8::Gemm g{F_MIX, F_WOUT + (size_t)l * DMODEL * DMODEL, M, DMODEL, DMODEL}; pg8::StaticOrder S; int bx = blockIdx.x; asm volatile("" : "+s"(bx)); S.init(M, DMODEL, G, bx);
            pg8::EpiResF32 E{l == 0 ? INP(F, 0) : (const float*)F.out, F.out, DMODEL, F_XB, (float*)(args.ws + WS_SS) + (size_t)(2 * l) * M};
            GEMMCALL1 pg8::gemm_phase<pg8::EpiResF32, pg8::StaticOrder, true, true>(F.lds, g, S, E);
        }
        xcd_barrier(bar);
        {
            pg8::Gemm g{F_XB, F_WUP + (size_t)l * FF * DMODEL, M, FF, DMODEL}; pg8::StaticOrder S; int bx = blockIdx.x; asm volatile("" : "+s"(bx)); S.init(M, FF, G, bx);
            pg8::EpiBf16S<2> E{F_HID, FF, (const float*)(args.ws + WS_SS) + (size_t)(2 * l) * M};
            GEMMCALL2 pg8::gemm_phase<pg8::EpiBf16S<2>, pg8::StaticOrder, true, true>(F.lds, g, S, E);
            if (PROBE & 1) { __syncthreads(); pg8::gemm_phase<pg8::EpiBf16S<2>, pg8::StaticOrder, true, true>(F.lds, g, S, E); }
        }
        xcd_barrier(bar);
        {
            pg8::Gemm g{F_HID, F_WDN + (size_t)l * DMODEL * FF, M, DMODEL, FF}; pg8::StaticOrder S; int bx = blockIdx.x; asm volatile("" : "+s"(bx)); S.init(M, DMODEL, G, bx);
            pg8::EpiResF32 E{(const float*)F.out, F.out, DMODEL, F_XB, (float*)(args.ws + WS_SS) + (size_t)(2 * l + 1) * M};
            GEMMCALL3 pg8::gemm_phase<pg8::EpiResF32, pg8::StaticOrder, true, true>(F.lds, g, S, E);
        }
        xcd_barrier(bar);
    }
    final_norm(F, F.out, INP(F, 24));
}

extern "C" void kernel_launch(void* const* d_in, const int* in_sizes, int n_in, void* d_out, int out_size, void* d_ws, size_t ws_size, hipStream_t stream) {
    static int grid = 0;
    if (grid == 0) {
        if (n_in != 25 || in_sizes[0] != M * DMODEL || out_size != M * DMODEL || ws_size < WS_END) {
            fprintf(stderr, "kernel_launch: unexpected problem geometry (n_in %d, in0 %d, out %d, ws %zu)\n", n_in, n_in > 0 ? in_sizes[0] : -1, out_size, ws_size); grid = -1; return; }
        int dev = 0, cus = 0, per_cu = 0;
        if (hipGetDevice(&dev) != hipSuccess || hipDeviceGetAttribute(&cus, hipDeviceAttributeMultiprocessorCount, dev) != hipSuccess) { grid = -1; return; }
        if (hipFuncSetAttribute((const void*)mega_fwd, hipFuncAttributeMaxDynamicSharedMemorySize, LDS_BYTES) != hipSuccess) { fprintf(stderr, "kernel_launch: hipFuncSetAttribute failed\n"); grid = -1; return; }
        if (hipOccupancyMaxActiveBlocksPerMultiprocessor(&per_cu, (const void*)mega_fwd, NWAVES * 64, LDS_BYTES) != hipSuccess || per_cu < 1) { fprintf(stderr, "kernel_launch: occupancy query gave %d\n", per_cu); (void)hipGetLastError(); per_cu = 1; }
        grid = cus * per_cu;
    }
    if (grid < 0) return;
    (void)hipMemsetAsync((char*)d_ws + WS_CTL, 0, CTL_ZERO_BYTES, stream);
    Args a{};
    for (int i = 0; i < 25; ++i) a.in[i] = (const float*)d_in[i];
    a.out = (float*)d_out; a.ws = (unsigned char*)d_ws; a.i0 = 0; a.i1 = 0;
    void* kargs[] = {&a};
    const hipError_t e = hipLaunchCooperativeKernel((const void*)mega_fwd, dim3(grid), dim3(NWAVES * 64), kargs, LDS_BYTES, stream);
    if (e != hipSuccess) fprintf(stderr, "kernel_launch: cooperative launch failed: %s (grid %d)\n", hipGetErrorString(e), grid);
}
```

```cpp
#include <hip/hip_runtime.h>
#include <hip/hip_cooperative_groups.h>
#include <hip/hip_bf16.h>
#include <cstdio>
#include <cstdint>
#include <cmath>
namespace pg8 {
#define PG8_LAS __attribute__((address_space(3)))
typedef unsigned short bf16_t;
typedef short bf16x8 __attribute__((ext_vector_type(8)));
typedef float f32x4 __attribute__((ext_vector_type(4)));
typedef unsigned u32x4 __attribute__((ext_vector_type(4)));
constexpr int BM = 256, BK = 64, HALF = 128, HTB = HALF * BK * 2  , STAGE_BYTES = 8 * HTB, NXCD = 8, WGM = 8;

__host__ __device__ __forceinline__ int lds_byte(int r, int c) { const int st = (r >> 4) * 2 + (c >> 5), rr = r & 15, cc = c & 31, ob = rr * 64 + cc * 2; return st * 1024 + (ob ^ (((ob >> 9) & 1) << 5)); }
__host__ __device__ __forceinline__ void stage_rc(int b, int& R, int& C) { const int st = b / 1024, sb = b % 1024, swz = sb ^ (((sb >> 9) & 1) << 5); R = (st >> 1) * 16 + swz / 64; C = (st & 1) * 32 + (swz % 64) / 2; }
__host__ __device__ __forceinline__ int perm32(int rho) { const int n = rho >> 4, i = rho & 15; return 8 * (i >> 2) + 4 * n + (i & 3); }

struct Unit { int pm, pn; };
struct Gemm { const bf16_t* A; const bf16_t* Bt; int M, N, K; };

struct StaticOrder {
    int nM, nN, nwg, G, c;
    __host__ __device__ void init(int M, int N, int G_, int c_) { nM = M / BM; nN = N / BM; nwg = nM * nN; G = G_; c = c_; }
    __host__ __device__ bool next(int i, Unit& u) const {
        const long L = (long)i * G + c; if (L >= nwg) return false;
        int wgid = (int)L; { const int q = nwg / NXCD, r = nwg % NXCD, xcd = wgid % NXCD, off = wgid / NXCD; wgid = (xcd < r ? xcd * (q + 1) : r * (q + 1) + (xcd - r) * q) + off; }
        const int nig = WGM * nN, gid = wgid / nig, fm = gid * WGM, gsz = (nM - fm) < WGM ? (nM - fm) : WGM;
        u.pm = fm + ((wgid % nig) % gsz); u.pn = (wgid % nig) / gsz; return true;
    }
    __device__ __forceinline__ void a_ready(const Unit&) const {}
    __device__ __forceinline__ void done(const Unit&) const {}
};

__device__ __forceinline__ unsigned cvt_pk_bf16(float lo, float hi) { unsigned r; asm volatile("v_cvt_pk_bf16_f32 %0, %1, %2" : "=v"(r) : "v"(lo), "v"(hi)); return r; }
typedef float f32x2 __attribute__((ext_vector_type(2)));
template <int ACT  > struct EpiBf16S {
    static constexpr bool PERM = true, AFTER_DRAIN = false;
    bf16_t* O; int ldc; const float* ss;
    __device__ __forceinline__ void operator()(const f32x4 (&acc)[2][2][4][2], const Unit& u, int wr, int wc, int fr, int fq) const {
        const int row0 = u.pm * BM + wr * 64 + fr; const int col0 = u.pn * BM + wc * 32 + 8 * fq;
#pragma unroll
        for (int ai = 0; ai < 2; ++ai)
#pragma unroll
            for (int m = 0; m < 4; ++m) { bf16_t* rowp = O + (size_t)(row0 + ai * HALF + m * 16) * ldc + col0;
                const float rs = ss ? 1.0f / sqrtf(ss[row0 + ai * HALF + m * 16] * (1.0f / 1024.0f) + 1e-6f) : 1.0f;
#pragma unroll
                for (int bj = 0; bj < 2; ++bj) { f32x4 v0 = acc[ai][bj][m][0] * rs, v1 = acc[ai][bj][m][1] * rs;
                    if (ACT == 2) {
#pragma unroll
                        for (int e = 0; e < 4; ++e) { float a = v0[e] > 0.f ? v0[e] : 0.f; v0[e] = a * a; float b = v1[e] > 0.f ? v1[e] : 0.f; v1[e] = b * b; } }
                    u32x4 w; w.x = cvt_pk_bf16(v0[0], v0[1]); w.y = cvt_pk_bf16(v0[2], v0[3]); w.z = cvt_pk_bf16(v1[0], v1[1]); w.w = cvt_pk_bf16(v1[2], v1[3]);
                    *(u32x4*)(rowp + bj * HALF) = w; } }
    }
};
struct EpiResF32 {
    static constexpr bool PERM = true, AFTER_DRAIN = false;
    const float* base; float* out; int ldc; bf16_t* xb; float* ss;
    __device__ __forceinline__ void operator()(const f32x4 (&acc)[2][2][4][2], const Unit& u, int wr, int wc, int fr, int fq) const {
        const int col0 = u.pn * BM + wc * 32 + 8 * fq;
#pragma unroll
        for (int ai = 0; ai < 2; ++ai)
#pragma unroll
            for (int m = 0; m < 4; ++m) { const int r = u.pm * BM + ai * HALF + wr * 64 + m * 16 + fr; const size_t off = (size_t)r * ldc + col0; float sq = 0.f;
#pragma unroll
                for (int bj = 0; bj < 2; ++bj) { const size_t idx = off + bj * HALF;
                    const f32x4 b0 = *(const f32x4*)(base + idx), b1 = *(const f32x4*)(base + idx + 4);
                    const f32x4 o0 = b0 + acc[ai][bj][m][0], o1 = b1 + acc[ai][bj][m][1];
                    *(f32x4*)(out + idx) = o0; *(f32x4*)(out + idx + 4) = o1;
                    sq += ((o0[0] * o0[0] + o0[1] * o0[1]) + (o0[2] * o0[2] + o0[3] * o0[3])) + ((o1[0] * o1[0] + o1[1] * o1[1]) + (o1[2] * o1[2] + o1[3] * o1[3]));
                    u32x4 w; w.x = cvt_pk_bf16(o0[0], o0[1]); w.y = cvt_pk_bf16(o0[2], o0[3]); w.z = cvt_pk_bf16(o1[0], o1[1]); w.w = cvt_pk_bf16(o1[2], o1[3]);
                    *(u32x4*)(xb + idx) = w; }
                sq += __shfl_xor(sq, 16); sq += __shfl_xor(sq, 32);
                if (fq == 0) unsafeAtomicAdd(ss + r, sq);
                asm volatile("" ::: "memory"); }
    }
};
template <class Epi, class Sched, bool ALIGN_EPI = false, bool SP2 = false>
__device__ __forceinline__ void gemm_phase(PG8_LAS unsigned char* lds, const Gemm g, const Sched& S, const Epi& E) {
    int tid_ = threadIdx.x; asm volatile("" : "+v"(tid_)); const int tid = tid_, wid = __builtin_amdgcn_readfirstlane(tid >> 6), lane = tid & 63, wr = wid >> 2, wc = wid & 3, fr = lane & 15, fq = lane >> 4;
    const int K = g.K, nt = K / BK;
    unsigned voffA[2], voffB[2];
#pragma unroll
    for (int i = 0; i < 2; ++i) { int R, C; stage_rc(tid * 16 + i * 8192, R, C); const int Rb = Epi::PERM ? ((R & ~31) + perm32(R & 31)) : R;
        voffA[i] = (unsigned)(R * K + C) * 2u; voffB[i] = (unsigned)(Rb * K + C) * 2u; }
    const size_t kstep = (size_t)(BK * 2);
    const size_t hstep = (size_t)HALF * K * 2;
    const size_t tstep = 2 * hstep;
    const unsigned ldsw = (unsigned)wid * 1024u;
    const int aoff = lds_byte(wr * 64 + fr, fq * 8), boff = lds_byte(wc * 32 + fr, fq * 8);
#define PG8_SA(b, h) (((b) * 2 + (h)) * HTB)
#define PG8_SB(b, h) ((4 + (b) * 2 + (h)) * HTB)
#define PG8_STAGE(bufoff, gbase, voff) do { _Pragma("unroll") for (int _i = 0; _i < 2; ++_i) \
        __builtin_amdgcn_global_load_lds((const unsigned*)((const char*)(gbase) + (voff)[_i]), (PG8_LAS unsigned*)(lds + (bufoff) + ldsw + _i * 8192), 16, 0, 0); } while (0)
#define PG8_LDA(dst, b, h) do { _Pragma("unroll") for (int m = 0; m < 4; ++m) _Pragma("unroll") for (int k = 0; k < 2; ++k) dst[m][k] = *(const PG8_LAS bf16x8*)(lds + PG8_SA(b, h) + aoff + m * 2048 + k * 1024); } while (0)
#define PG8_LDB(dst, b, h) do { _Pragma("unroll") for (int n = 0; n < 2; ++n) _Pragma("unroll") for (int k = 0; k < 2; ++k) dst[n][k] = *(const PG8_LAS bf16x8*)(lds + PG8_SB(b, h) + boff + n * 2048 + k * 1024); } while (0)
#define PG8_MMA(ai, bj, At, Bt) do { __builtin_amdgcn_s_setprio(1); _Pragma("unroll") for (int m = 0; m < 4; ++m) _Pragma("unroll") for (int n = 0; n < 2; ++n) _Pragma("unroll") for (int k = 0; k < 2; ++k) \
        acc[ai][bj][m][n] = __builtin_amdgcn_mfma_f32_16x16x32_bf16(Bt[n][k], At[m][k], acc[ai][bj][m][n], 0, 0, 0); __builtin_amdgcn_s_setprio(0); } while (0)
#define PG8_WAIT_V(n) asm volatile("s_waitcnt vmcnt(" #n ")" ::: "memory")
#define PG8_WAIT_L(n) asm volatile("s_waitcnt lgkmcnt(" #n ")" ::: "memory")
#define PG8_BAR __builtin_amdgcn_s_barrier()
#define PG8_SCHED __builtin_amdgcn_sched_barrier(0)
    Unit cur, nxt; int ui = 0;
    if (!S.next(0, cur)) return;
    f32x4 acc[2][2][4][2];
#pragma unroll
    for (int a = 0; a < 2; ++a)
#pragma unroll
        for (int b = 0; b < 2; ++b)
#pragma unroll
            for (int m = 0; m < 4; ++m)
#pragma unroll
                for (int n = 0; n < 2; ++n) acc[a][b][m][n] = (f32x4){0.f, 0.f, 0.f, 0.f};
    bf16x8 At[4][2], B0[2][2], B1[2][2];
    const char* cA = (const char*)g.A + (size_t)cur.pm * tstep; const char* cB = (const char*)g.Bt + (size_t)cur.pn * tstep;
    S.a_ready(cur);
    if constexpr (SP2) {
        PG8_STAGE(PG8_SB(0, 0), cB, voffB); PG8_STAGE(PG8_SB(0, 1), cB + hstep, voffB); PG8_STAGE(PG8_SA(0, 0), cA, voffA); PG8_STAGE(PG8_SA(0, 1), cA + hstep, voffA);
        if (wr == 1) PG8_BAR;
        PG8_WAIT_V(2); PG8_BAR;
        PG8_STAGE(PG8_SB(1, 0), cB + kstep, voffB); PG8_STAGE(PG8_SA(1, 0), cA + kstep, voffA); PG8_STAGE(PG8_SB(1, 1), cB + hstep + kstep, voffB);
        PG8_WAIT_V(6); PG8_BAR;
    } else {
        PG8_STAGE(PG8_SB(0, 0), cB, voffB); PG8_STAGE(PG8_SA(0, 0), cA, voffA); PG8_STAGE(PG8_SB(0, 1), cB + hstep, voffB); PG8_STAGE(PG8_SA(0, 1), cA + hstep, voffA);
        if (wr == 1) PG8_BAR;
        PG8_WAIT_V(4); PG8_BAR;
        PG8_STAGE(PG8_SB(1, 0), cB + kstep, voffB); PG8_STAGE(PG8_SA(1, 0), cA + kstep, voffA); PG8_STAGE(PG8_SB(1, 1), cB + hstep + kstep, voffB);
        PG8_WAIT_V(6); PG8_BAR;
    }
    for (;;) {
        const bool has_next = S.next(ui + 1, nxt);
        const char* nA = has_next ? (const char*)g.A + (size_t)nxt.pm * tstep : cA; const char* nB = has_next ? (const char*)g.Bt + (size_t)nxt.pn * tstep : cB;
        for (int t = 0; t < nt; t += 2) {
            const bool last = (t == nt - 2);
            const char* a1 = cA + (size_t)(t + 1) * kstep;
            const char* a2 = last ? nA : cA + (size_t)(t + 2) * kstep; const char* b2 = last ? nB : cB + (size_t)(t + 2) * kstep;
            const char* a3 = a2 + kstep; const char* b3 = b2 + kstep;
            if (last && has_next) S.a_ready(nxt);
            if constexpr (SP2) {
            PG8_LDB(B0, 0, 0); PG8_LDB(B1, 0, 1); PG8_SCHED; PG8_LDA(At, 0, 0); PG8_STAGE(PG8_SA(1, 1), a1 + hstep, voffA);
            PG8_WAIT_V(8); PG8_WAIT_L(0); PG8_BAR; PG8_MMA(0, 0, At, B0); PG8_MMA(0, 1, At, B1); PG8_BAR; PG8_SCHED;
            PG8_LDA(At, 0, 1); PG8_STAGE(PG8_SB(0, 0), b2, voffB); PG8_STAGE(PG8_SB(0, 1), b2 + hstep, voffB); PG8_STAGE(PG8_SA(0, 0), a2, voffA);
            PG8_WAIT_V(8); PG8_WAIT_L(0); PG8_BAR; PG8_MMA(1, 0, At, B0); PG8_MMA(1, 1, At, B1); PG8_BAR; PG8_SCHED;
            PG8_LDB(B0, 1, 0); PG8_LDB(B1, 1, 1); PG8_SCHED; PG8_LDA(At, 1, 0); PG8_STAGE(PG8_SA(0, 1), a2 + hstep, voffA);
            PG8_WAIT_V(8); PG8_WAIT_L(0); PG8_BAR; PG8_MMA(0, 0, At, B0); PG8_MMA(0, 1, At, B1); PG8_BAR; PG8_SCHED;
            PG8_LDA(At, 1, 1); PG8_STAGE(PG8_SB(1, 0), b3, voffB); PG8_STAGE(PG8_SB(1, 1), b3 + hstep, voffB); PG8_STAGE(PG8_SA(1, 0), a3, voffA);
            PG8_WAIT_V(8); PG8_WAIT_L(0); PG8_BAR; PG8_MMA(1, 0, At, B0); PG8_MMA(1, 1, At, B1); PG8_BAR; PG8_SCHED;
            } else {
            PG8_LDB(B0, 0, 0); PG8_SCHED; PG8_LDA(At, 0, 0); PG8_STAGE(PG8_SA(1, 1), a1 + hstep, voffA);
            PG8_WAIT_L(8); PG8_BAR; PG8_WAIT_L(0); PG8_MMA(0, 0, At, B0); PG8_BAR; PG8_SCHED;
            PG8_LDB(B1, 0, 1); PG8_STAGE(PG8_SB(0, 0), b2, voffB);
            PG8_BAR; PG8_WAIT_L(0); PG8_MMA(0, 1, At, B1); PG8_BAR;
            PG8_LDA(At, 0, 1); PG8_STAGE(PG8_SA(0, 0), a2, voffA);
            PG8_BAR; PG8_WAIT_L(0); PG8_MMA(1, 0, At, B0); PG8_BAR; PG8_SCHED;
            PG8_STAGE(PG8_SB(0, 1), b2 + hstep, voffB);
            PG8_WAIT_V(6); PG8_BAR; PG8_MMA(1, 1, At, B1); PG8_BAR;
            PG8_LDB(B0, 1, 0); PG8_SCHED; PG8_LDA(At, 1, 0); PG8_STAGE(PG8_SA(0, 1), a2 + hstep, voffA);
            PG8_WAIT_L(8); PG8_BAR; PG8_WAIT_L(0); PG8_MMA(0, 0, At, B0); PG8_BAR; PG8_SCHED;
            PG8_LDB(B1, 1, 1); PG8_STAGE(PG8_SB(1, 0), b3, voffB);
            PG8_BAR; PG8_WAIT_L(0); PG8_MMA(0, 1, At, B1); PG8_BAR;
            PG8_LDA(At, 1, 1); PG8_STAGE(PG8_SA(1, 0), a3, voffA);
            PG8_BAR; PG8_WAIT_L(0); PG8_MMA(1, 0, At, B0); PG8_BAR; PG8_SCHED;
            PG8_STAGE(PG8_SB(1, 1), b3 + hstep, voffB);
            PG8_WAIT_V(6); PG8_BAR; PG8_MMA(1, 1, At, B1); PG8_BAR;
            }
        }
        if constexpr (ALIGN_EPI) { if (wr == 0) PG8_BAR; }
        if constexpr (!Epi::AFTER_DRAIN) { E(acc, cur, wr, wc, fr, fq); S.done(cur); }
        if (!has_next) break;
#pragma unroll
        for (int a = 0; a < 2; ++a)
#pragma unroll
            for (int b = 0; b < 2; ++b)
#pragma unroll
                for (int m = 0; m < 4; ++m)
#pragma unroll
                    for (int n = 0; n < 2; ++n) acc[a][b][m][n] = (f32x4){0.f, 0.f, 0.f, 0.f};
        cur = nxt; cA = nA; cB = nB; ++ui;
        if constexpr (ALIGN_EPI) { if (wr == 1) PG8_BAR; }
    }
    PG8_WAIT_V(0);
    if constexpr (!ALIGN_EPI) { if (wr == 0) PG8_BAR; }
    PG8_BAR;
    if constexpr (Epi::AFTER_DRAIN) { E.fused(acc, cur, wr, wc, fr, fq, lds, wid, lane); S.done(cur); }
#undef PG8_SA
#undef PG8_SB
#undef PG8_STAGE
#undef PG8_LDA
#undef PG8_LDB
#undef PG8_MMA
#undef PG8_WAIT_V
#undef PG8_WAIT_L
#undef PG8_BAR
#undef PG8_SCHED
}
}

#define PG8_SP2 true
#define PG8_ALIGN true
namespace attn_body {
using bf16=__hip_bfloat16;
using bf16x8=__attribute__((ext_vector_type(8)))short;
using s16x4=__attribute__((ext_vector_type(4)))short;
using f32x16=__attribute__((ext_vector_type(16)))float;
using u32x4=__attribute__((ext_vector_type(4)))unsigned;
constexpr int BATCH=8,NHEAD=6,SEQ=4096,D=64,DM=3328,OPITCH=1024;
constexpr int NW=8,QBLK=32,QB=QBLK*NW,KVBLK=64,NQB=SEQ/QB;
constexpr int ATTN_PITCH=DM, ATTN_UNIT_ROWS=QB;
__device__ __forceinline__ int crow(int r,int hi){return (r&3)+8*(r>>2)+4*hi;}
#define SBAR() __builtin_amdgcn_sched_barrier(0)
__device__ __forceinline__ void cmask(f32x16&p0,f32x16&p1,int jb,int qrel,int hi){
  const float NEG=-INFINITY; int kb=64*jb+4*hi;
  #pragma unroll
  for(int r=0;r<16;++r){int kv=kb+(r&3)+8*(r>>2); if(kv>qrel)p0[r]=NEG; if(kv+32>qrel)p1[r]=NEG;}
}

constexpr int NSLOT=3, SLOTB=8192;
constexpr int LDS_K=0, LDS_V=NSLOT*SLOTB, LDS_WS=2*NSLOT*SLOTB, LDS_OST=LDS_WS+NW*64*4, LDS_OST1=LDS_OST+NW*4096, LDS_BYTES=LDS_OST1+NW*4096;
constexpr float C2=0.17677669529663687f*1.4426950408889634f;
__device__ __forceinline__ void glds16(const void*gsrc,unsigned lds_dst){unsigned keep;
  asm volatile("s_mov_b32 %0, m0\n\ts_mov_b32 m0, %2\n\ts_nop 0\n\tglobal_load_lds_dwordx4 %1, off\n\ts_mov_b32 m0, %0":"=&s"(keep):"v"(gsrc),"s"(lds_dst):"memory");}
__device__ __forceinline__ float max3f(float a,float b,float c){float r;asm("v_max3_f32 %0, %1, %2, %3":"=v"(r):"v"(a),"v"(b),"v"(c));return r;}
__device__ __forceinline__ float max2f(float a,float b){float r;asm("v_max_f32_e32 %0, %1, %2":"=v"(r):"v"(a),"v"(b));return r;}
__device__ __forceinline__ float fadd_s(float a,float b){float r;asm("v_add_f32_e32 %0, %1, %2":"=v"(r):"v"(a),"v"(b));return r;}
__device__ __forceinline__ float fsub_s(float a,float b){float r;asm("v_sub_f32_e32 %0, %1, %2":"=v"(r):"v"(a),"v"(b));return r;}
typedef float f32x2_t __attribute__((ext_vector_type(2))); typedef __bf16 bf16x2_t __attribute__((ext_vector_type(2)));
__device__ __forceinline__ unsigned cvtpk_s(float lo,float hi){f32x2_t v={lo,hi};bf16x2_t b=__builtin_convertvector(v,bf16x2_t);return __builtin_bit_cast(unsigned,b);}
#define WAIT_BAR(N) asm volatile("s_waitcnt vmcnt(" #N ") lgkmcnt(0)\n\ts_barrier":::"memory")

__device__ __forceinline__ void qkt(f32x16&p0,f32x16&p1,const char*Kslot,const bf16x8*qr,const f32x16&negm,int r32,int hi){
  const char*kb=Kslot+hi*1024+r32*16;
  #pragma unroll
  for(int d0=0;d0<4;++d0){
    const bf16x8 b0=*reinterpret_cast<const bf16x8*>(kb+d0*2048);
    const bf16x8 b1=*reinterpret_cast<const bf16x8*>(kb+d0*2048+512);
    if(d0==0){p0=__builtin_amdgcn_mfma_f32_32x32x16_bf16(b0,qr[0],negm,0,0,0);p1=__builtin_amdgcn_mfma_f32_32x32x16_bf16(b1,qr[0],negm,0,0,0);}
    else{p0=__builtin_amdgcn_mfma_f32_32x32x16_bf16(b0,qr[d0],p0,0,0,0);p1=__builtin_amdgcn_mfma_f32_32x32x16_bf16(b1,qr[d0],p1,0,0,0);}}
}
typedef __attribute__((address_space(3))) const char* lds_cptr;
typedef short v4i16_t __attribute__((ext_vector_type(4)));
__device__ __forceinline__ void kload8(bf16x8*kf,lds_cptr kp){
  kf[0]=*(const __attribute__((address_space(3))) bf16x8*)(kp);      kf[1]=*(const __attribute__((address_space(3))) bf16x8*)(kp+512);
  kf[2]=*(const __attribute__((address_space(3))) bf16x8*)(kp+2048); kf[3]=*(const __attribute__((address_space(3))) bf16x8*)(kp+2560);
  kf[4]=*(const __attribute__((address_space(3))) bf16x8*)(kp+4096); kf[5]=*(const __attribute__((address_space(3))) bf16x8*)(kp+4608);
  kf[6]=*(const __attribute__((address_space(3))) bf16x8*)(kp+6144); kf[7]=*(const __attribute__((address_space(3))) bf16x8*)(kp+6656);
}
__device__ __forceinline__ void kload2(bf16x8*kf,lds_cptr kp,int j){ kf[2*j]=*(const __attribute__((address_space(3))) bf16x8*)(kp+j*2048); kf[2*j+1]=*(const __attribute__((address_space(3))) bf16x8*)(kp+j*2048+512); }
__device__ __forceinline__ s16x4 vtr(lds_cptr p){ return __builtin_bit_cast(s16x4,__builtin_amdgcn_ds_read_tr16_b64_v4i16((__attribute__((address_space(3))) v4i16_t*)p)); }
__device__ __forceinline__ float rowmax(const f32x16&p0,const f32x16&p1){
  float a=max3f(p0[0],p0[1],p1[0]),b=max3f(p0[2],p0[3],p1[1]);a=max3f(a,p1[2],p1[3]);
  #pragma unroll
  for(int r=4;r<16;r+=4){a=max3f(a,p0[r],p0[r+1]);b=max3f(b,p0[r+2],p0[r+3]);a=max3f(a,p1[r],p1[r+1]);b=max3f(b,p1[r+2],p1[r+3]);}
  const float m=max2f(a,b);
  auto rr=__builtin_amdgcn_permlane32_swap(__float_as_uint(m),__float_as_uint(m),false,false);
  return max2f(__uint_as_float(rr[0]),__uint_as_float(rr[1]));
}
__device__ __forceinline__ void pv(f32x16*o,int vb,bf16x8 pa0,bf16x8 pa1,bf16x8 pa2,bf16x8 pa3){
  #pragma unroll
  for(int d0=0;d0<2;++d0){s16x4 lo[4],hi[4];
    #pragma unroll
    for(int ks=0;ks<4;++ks){
      asm volatile("ds_read_b64_tr_b16 %0,%1 offset:%c2":"=&v"(lo[ks]):"v"(vb),"i"(d0*4096+ks*1024):"memory");
      asm volatile("ds_read_b64_tr_b16 %0,%1 offset:%c2":"=&v"(hi[ks]):"v"(vb),"i"(d0*4096+ks*1024+512):"memory");}
    asm volatile("s_waitcnt lgkmcnt(0)":::"memory");SBAR();
    #define PK(k) (bf16x8){lo[k][0],lo[k][1],lo[k][2],lo[k][3],hi[k][0],hi[k][1],hi[k][2],hi[k][3]}
    o[d0]=__builtin_amdgcn_mfma_f32_32x32x16_bf16(pa0,PK(0),o[d0],0,0,0);
    o[d0]=__builtin_amdgcn_mfma_f32_32x32x16_bf16(pa1,PK(1),o[d0],0,0,0);
    o[d0]=__builtin_amdgcn_mfma_f32_32x32x16_bf16(pa2,PK(2),o[d0],0,0,0);
    o[d0]=__builtin_amdgcn_mfma_f32_32x32x16_bf16(pa3,PK(3),o[d0],0,0,0);
    #undef PK
  }
}

#ifndef ATTN_STORE16
#define ATTN_STORE16(p,v) (*(u32x4*)(p)=(v))
#endif
template<int THRL> __device__ __forceinline__ void attn_unit(int b,int h,int qb,int nsel,float lam,const float*subg,float omli,const bf16*Q,const bf16*__restrict__ K,const bf16*__restrict__ V,bf16*O,char*shm){
  int tid_=threadIdx.x; asm volatile("":"+v"(tid_)); const int tid=tid_,lane=tid&63,r32=lane&31,hi=lane>>5; const int wid=__builtin_amdgcn_readfirstlane(tid>>6);
  const long rowbase=(long)b*SEQ; const int q0=qb*QB;
  const bf16*Qw=Q+(rowbase+q0+wid*QBLK)*DM+h*D;
  const bf16*Kh=K+rowbase*DM+h*D,*Vh=V+rowbase*DM+h*D;
  const unsigned lds0=(unsigned)(uintptr_t)shm;
  float*wsf=(float*)(shm+LDS_WS)+wid*64;
  const bf16*ksrc=Kh+(long)lane*DM+wid*8;
  const bf16*vsrc=Vh+(long)(16*(wid&3)+(lane>>2))*DM+(wid>>2)*32+(lane&3)*8;
  const unsigned kdst=lds0+LDS_K+wid*1024, vdst=lds0+LDS_V+wid*1024;
  #define DMA_K(t,slot) glds16(ksrc+(long)(t)*KVBLK*DM,(unsigned)__builtin_amdgcn_readfirstlane(kdst+(slot)))
  #define DMA_V(t,slot) glds16(vsrc+(long)(t)*KVBLK*DM,(unsigned)__builtin_amdgcn_readfirstlane(vdst+(slot)))
  const int vb0=(int)(lds0+LDS_V)+((lane>>4)&1)*32+(lane&3)*8+(4*hi+((lane&15)>>2))*64;
  const char*Kbase=shm+LDS_K; bf16x8 kf[8];
  const lds_cptr shm3=(lds_cptr)shm; const lds_cptr kp0=shm3+LDS_K+hi*1024+r32*16; const lds_cptr vp0=shm3+LDS_V+((lane>>4)&1)*32+(lane&3)*8+(4*hi+((lane&15)>>2))*64;
  const int NT=(q0+QB)/KVBLK;
  DMA_K(0,0);DMA_V(0,0);DMA_K(1,SLOTB);
  bf16x8 qr[4];
  #pragma unroll
  for(int d0=0;d0<4;++d0){qr[d0]=*reinterpret_cast<const bf16x8*>(&Qw[(long)r32*DM+d0*16+hi*8]); if((d0>>1)!=nsel)qr[d0]=bf16x8{0,0,0,0,0,0,0,0};}
  float mhat=0.f,l_reg=0.f;f32x16 o[2];o[0]=f32x16{};o[1]=f32x16{};f32x16 negm=f32x16{};asm volatile("":"+v"(negm));
  const int qrel=wid*QBLK+r32;
  #define CMASK(P0,P1,t) do{int jb_=(t)-(NT-4); if(jb_>=0)cmask(P0,P1,jb_,qrel,hi);}while(0)
  bool resc=false;
  #define START(P0,P1) do{ const float rm=rowmax(P0,P1); resc=false; \
    { const float dl=rm; mhat=fadd_s(mhat,dl); \
      _Pragma("unroll") for(int r=0;r<16;++r){P0[r]=fsub_s(P0[r],dl);P1[r]=fsub_s(P1[r],dl);} \
      _Pragma("unroll") for(int r=0;r<16;++r)negm[r]=-mhat; asm volatile("":"+v"(negm)); } \
    _Pragma("unroll") for(int r=0;r<16;++r)P0[r]=__builtin_amdgcn_exp2f(P0[r]); }while(0)
  #define RESC() do{ if(resc){ asm volatile("s_waitcnt lgkmcnt(0)":::"memory"); \
      _Pragma("unroll") for(int d_=0;d_<2;++d_) _Pragma("unroll") for(int r=0;r<16;++r)o[d_][r]*=wsf[crow(r,hi)]; } }while(0)
  f32x16 pA0,pA1,pB0,pB1;
  int sl_prev=0,sl_cur=0,sl_next=SLOTB;
  #define ROT() do{sl_prev=sl_cur;sl_cur=sl_next;sl_next=(sl_next==(NSLOT-1)*SLOTB)?0:sl_next+SLOTB;}while(0)
  DMA_K(2,2*SLOTB);
  WAIT_BAR(3);
  qkt(pA0,pA1,Kbase,qr,negm,r32,hi);asm volatile("s_nop 15\n\ts_nop 7":"+v"(pA0),"+v"(pA1));CMASK(pA0,pA1,0);
  START(pA0,pA1);
  _Pragma("unroll") for(int r=0;r<16;++r)pA1[r]=__builtin_amdgcn_exp2f(pA1[r]);
  WAIT_BAR(0);
  DMA_K(3,0);DMA_V(1,SLOTB);
  ROT();
  kload8(kf,kp0+sl_cur);
  WAIT_BAR(2);
  s16x4 vlo[8],vhi[8]; u32x4 pw0,pw1,pw2,pw3;
  #define PKW(P,B) cvtpk_s(P[B],P[B+1])
  #define PAF(k) __builtin_bit_cast(bf16x8,pw##k)
  #define VFR(i) (bf16x8){vlo[i][0],vlo[i][1],vlo[i][2],vlo[i][3],vhi[i][0],vhi[i][1],vhi[i][2],vhi[i][3]}
  #define PIN(x) asm volatile("":"+v"(x))
  #define MX3(a,b,c) __builtin_fmaxf(__builtin_fmaxf((a),(b)),(c))
  #define GAPA(MF,A0,A1,A2,A3,W0,W1,PW) do{ MF; sacc+=A0; sacc+=A1; sacc+=A2; sacc+=A3; PIN(sacc); W0; W1; PIN(PW); SBAR(); }while(0)
  #define EX(v) __builtin_amdgcn_exp2f(v)
  #define GAPB(MF,X,B) do{ MF; X[B]=EX(X[B]); X[B+1]=EX(X[B+1]); X[B+2]=EX(X[B+2]); X[B+3]=EX(X[B+3]); PIN(X); SBAR(); }while(0)
  #define VRD(i) do{ vlo[i]=vtr(vp_+(((i)>>2)*4096+((i)&3)*1024)); vhi[i]=vtr(vp_+(((i)>>2)*4096+((i)&3)*1024+512)); }while(0)
  #define KRD(G,j) do{ if(G){ kload2(kf,kp0+sl_next,j); SBAR(); } }while(0)
  #define STEP(C0,C1,P0,P1,t,GK,GV,GL) do{ SBAR(); \
    const lds_cptr vp_=vp0+sl_prev; \
    VRD(0); SBAR(); float sacc=(P0[0]+P0[1]); \
    GAPA(C0=__builtin_amdgcn_mfma_f32_32x32x16_bf16(kf[0],qr[0],negm,0,0,0), P0[2],P0[3],P0[4],P0[5],     pw0[0]=PKW(P0,0), pw0[1]=PKW(P0,2), pw0); \
    VRD(4); SBAR(); GAPA(C1=__builtin_amdgcn_mfma_f32_32x32x16_bf16(kf[1],qr[0],negm,0,0,0), P0[6],P0[7],P0[8],P0[9],     pw0[2]=PKW(P0,4), pw0[3]=PKW(P0,6), pw0); \
    VRD(1); SBAR(); GAPA(C0=__builtin_amdgcn_mfma_f32_32x32x16_bf16(kf[2],qr[1],C0,0,0,0),   P0[10],P0[11],P0[12],P0[13], pw1[0]=PKW(P0,8), pw1[1]=PKW(P0,10), pw1); \
    VRD(5); SBAR(); GAPA(C1=__builtin_amdgcn_mfma_f32_32x32x16_bf16(kf[3],qr[1],C1,0,0,0),   P0[14],P0[15],P1[0],P1[1],   pw1[2]=PKW(P0,12),pw1[3]=PKW(P0,14), pw1); \
    VRD(2); SBAR(); GAPA(C0=__builtin_amdgcn_mfma_f32_32x32x16_bf16(kf[4],qr[2],C0,0,0,0),   P1[2],P1[3],P1[4],P1[5],     pw2[0]=PKW(P1,0), pw2[1]=PKW(P1,2), pw2); \
    VRD(6); SBAR(); GAPA(C1=__builtin_amdgcn_mfma_f32_32x32x16_bf16(kf[5],qr[2],C1,0,0,0),   P1[6],P1[7],P1[8],P1[9],     pw2[2]=PKW(P1,4), pw2[3]=PKW(P1,6), pw2); \
    VRD(3); SBAR(); GAPA(C0=__builtin_amdgcn_mfma_f32_32x32x16_bf16(kf[6],qr[3],C0,0,0,0),   P1[10],P1[11],P1[12],P1[13], pw3[0]=PKW(P1,8), pw3[1]=PKW(P1,10), pw3); \
    VRD(7); SBAR(); GAPA(C1=__builtin_amdgcn_mfma_f32_32x32x16_bf16(kf[7],qr[3],C1,0,0,0),   P1[14],P1[15],0.f,0.f,       pw3[2]=PKW(P1,12),pw3[3]=PKW(P1,14), pw3); \
    l_reg+=sacc; \
    if(GK){DMA_K((t)+3,sl_cur);} if(GV){DMA_V((t)+1,sl_next);} \
    CMASK(C0,C1,t); \
    { float a=MX3(C0[0],C0[1],C1[0]),b=MX3(C0[2],C0[3],C1[1]); a=MX3(a,C1[2],C1[3]); \
      _Pragma("unroll") for(int r=4;r<16;r+=4){a=MX3(a,C0[r],C0[r+1]);b=MX3(b,C0[r+2],C0[r+3]);a=MX3(a,C1[r],C1[r+1]);b=MX3(b,C1[r+2],C1[r+3]);} \
      float rm=__builtin_fmaxf(a,b); { auto rr=__builtin_amdgcn_permlane32_swap(__float_as_uint(rm),__float_as_uint(rm),false,false); rm=__builtin_fmaxf(__uint_as_float(rr[0]),__uint_as_float(rr[1])); } \
      resc=false; \
      if(__builtin_expect(__any(rm>(float)THRL),0)){ const float dl=__builtin_fmaxf(rm,0.f); mhat+=dl; \
        _Pragma("unroll") for(int r=0;r<16;++r){C0[r]-=dl;C1[r]-=dl;} \
        _Pragma("unroll") for(int r=0;r<16;++r)negm[r]=-mhat; asm volatile("":"+v"(negm)); \
        const float f=__builtin_amdgcn_exp2f(-dl); l_reg*=f; if(hi==0)wsf[r32]=f; resc=true; } } \
    SBAR(); \
    GAPB(o[0]=__builtin_amdgcn_mfma_f32_32x32x16_bf16(PAF(0),VFR(0),o[0],0,0,0), C0,0); \
    GAPB(o[1]=__builtin_amdgcn_mfma_f32_32x32x16_bf16(PAF(0),VFR(4),o[1],0,0,0), C0,4); \
    KRD(GL,0); GAPB(o[0]=__builtin_amdgcn_mfma_f32_32x32x16_bf16(PAF(1),VFR(1),o[0],0,0,0), C0,8); \
    KRD(GL,1); GAPB(o[1]=__builtin_amdgcn_mfma_f32_32x32x16_bf16(PAF(1),VFR(5),o[1],0,0,0), C0,12); \
    KRD(GL,2); GAPB(o[0]=__builtin_amdgcn_mfma_f32_32x32x16_bf16(PAF(2),VFR(2),o[0],0,0,0), C1,0); \
    KRD(GL,3); GAPB(o[1]=__builtin_amdgcn_mfma_f32_32x32x16_bf16(PAF(2),VFR(6),o[1],0,0,0), C1,4); \
    GAPB(o[0]=__builtin_amdgcn_mfma_f32_32x32x16_bf16(PAF(3),VFR(3),o[0],0,0,0), C1,8); \
    GAPB(o[1]=__builtin_amdgcn_mfma_f32_32x32x16_bf16(PAF(3),VFR(7),o[1],0,0,0), C1,12); \
    }while(0)
  int t=1;
  #undef CMASK
  #define CMASK(P0,P1,t) do{}while(0)
  for(;t+5<NT;t+=2){
    STEP(pB0,pB1,pA0,pA1,t,true,true,true);     WAIT_BAR(2); RESC(); ROT();
    STEP(pA0,pA1,pB0,pB1,t+1,true,true,true);   WAIT_BAR(2); RESC(); ROT();
  }
  #undef CMASK
  #define CMASK(P0,P1,t) do{int jb_=(t)-(NT-4); if(jb_>=0)cmask(P0,P1,jb_,qrel,hi);}while(0)
  #define ENDW(tt) do{ if((tt)+3<NT){WAIT_BAR(2);} else if((tt)+2<NT){WAIT_BAR(1);} else {WAIT_BAR(0);} }while(0)
  for(;t+1<NT;t+=2){
    STEP(pB0,pB1,pA0,pA1,t,(t+3<NT),(t+1<NT),(t+1<NT));       ENDW(t);   RESC(); ROT();
    STEP(pA0,pA1,pB0,pB1,t+1,(t+4<NT),(t+2<NT),(t+2<NT));     ENDW(t+1); RESC(); ROT();
  }
  STEP(pB0,pB1,pA0,pA1,NT-1,false,false,false); RESC();
  { float sacc=pB0[0]+pB0[1]; _Pragma("unroll") for(int r=2;r<16;++r)sacc+=pB0[r]; _Pragma("unroll") for(int r=0;r<16;++r)sacc+=pB1[r]; l_reg+=sacc;
    pw0=(u32x4){PKW(pB0,0),PKW(pB0,2),PKW(pB0,4),PKW(pB0,6)};pw1=(u32x4){PKW(pB0,8),PKW(pB0,10),PKW(pB0,12),PKW(pB0,14)};pw2=(u32x4){PKW(pB1,0),PKW(pB1,2),PKW(pB1,4),PKW(pB1,6)};pw3=(u32x4){PKW(pB1,8),PKW(pB1,10),PKW(pB1,12),PKW(pB1,14)};
    SBAR(); pv(o,vb0+sl_cur,PAF(0),PAF(1),PAF(2),PAF(3)); }
  #undef PKW
  #undef PAF
  #undef VFR
  #undef PIN
  #undef MX3
  #undef GAPA
  #undef GAPB
  #undef EX
  #undef VRD
  #undef KRD
  #undef STEP
  #undef ENDW
  {auto rr=__builtin_amdgcn_permlane32_swap(__float_as_uint(l_reg),__float_as_uint(l_reg),false,false);l_reg=__uint_as_float(rr[0])+__uint_as_float(rr[1]);}
  if(hi==0)wsf[32+r32]=l_reg;asm volatile("s_waitcnt lgkmcnt(0)":::"memory");
  float rli[16];
  #pragma unroll
  for(int r=0;r<16;++r)rli[r]=__builtin_amdgcn_rcpf(wsf[32+crow(r,hi)]);
  bf16*Ow=O+(rowbase+q0+wid*QBLK)*OPITCH+h*D;
  { bf16*stg=(bf16*)(shm+(nsel==0?LDS_OST1:LDS_OST))+wid*2048;
    #pragma unroll
    for(int r=0;r<16;++r){const int orow=crow(r,hi);
      #pragma unroll
      for(int d0=0;d0<2;++d0)stg[orow*64+d0*32+r32]=__float2bfloat16(o[d0][r]*rli[r]);}
    asm volatile("s_waitcnt lgkmcnt(0)":::"memory");
    if(nsel==1){ const bf16*stg1=(const bf16*)(shm+LDS_OST1)+wid*2048;
      #pragma unroll
      for(int i=0;i<4;++i){const int row=i*8+(lane>>3),ch=lane&7; const u32x4 v2=*(const u32x4*)(stg+row*64+ch*8); const u32x4 v1=*(const u32x4*)(stg1+row*64+ch*8);
        float dd[8]; float ss=0.f;
        #pragma unroll
        for(int j=0;j<4;++j){ const float a0=__uint_as_float(v1[j]<<16),a1=__uint_as_float(v1[j]&0xffff0000u),b0=__uint_as_float(v2[j]<<16),b1=__uint_as_float(v2[j]&0xffff0000u);
          dd[2*j]=a0-lam*b0; dd[2*j+1]=a1-lam*b1; ss+=dd[2*j]*dd[2*j]+dd[2*j+1]*dd[2*j+1]; }
        ss+=__shfl_xor(ss,1); ss+=__shfl_xor(ss,2); ss+=__shfl_xor(ss,4);
        const float rs=omli/sqrtf(ss*(1.0f/64.0f)+1e-6f);
        u32x4 w;
        #pragma unroll
        for(int j=0;j<4;++j) w[j]=cvtpk_s(dd[2*j]*rs*subg[ch*8+2*j],dd[2*j+1]*rs*subg[ch*8+2*j+1]);
        ATTN_STORE16(Ow+(long)row*OPITCH+ch*8,w);} } }
  asm volatile("s_waitcnt lgkmcnt(0)\n\ts_barrier":::"memory");
  #undef DMA_K
  #undef DMA_V
  #undef CMASK
  #undef START
  #undef RESC
  #undef ROT

}
#undef SBAR
#undef WAIT_BAR
}
#ifndef GOFF
#define GOFF 0
#endif
#define GEMMCALL0 if (!((GOFF) & 1))
#define GEMMCALL1 if (!((GOFF) & 2))
#define GEMMCALL2 if (!((GOFF) & 4))
#define GEMMCALL3 if (!((GOFF) & 8))
namespace cg = cooperative_groups;
#define GAS __attribute__((address_space(1)))
#define LAS __attribute__((address_space(3)))
#define DI __device__ __forceinline__
typedef unsigned short bf16;
typedef unsigned v4u __attribute__((ext_vector_type(4)));
typedef unsigned v2u __attribute__((ext_vector_type(2)));
typedef float f32x4 __attribute__((ext_vector_type(4)));
typedef short bf16x8 __attribute__((ext_vector_type(8)));

constexpr int NWAVES = 8;
constexpr int DMODEL = 1024, SEQ = 4096, M = 32768, NIN = 3328, FF = 4096;
constexpr int RW = 384, RCOLS = 1408, ROFF = 1920, COFF = 1152;
constexpr float NORM_EPS = 1e-6f, GN_EPS = 64e-5f;
constexpr size_t MiB = 1u << 20;
constexpr size_t WS_CTL = 0, CTL_ZERO_BYTES = 65536;
constexpr int CW_BAR = 4096;
constexpr size_t WS_SS = 128 * 1024;
constexpr size_t WS_WIN = 1 * MiB, WS_WOUT = 14 * MiB, WS_WUP = 18 * MiB, WS_WDN = 34 * MiB, WS_LORA = 50 * MiB;
constexpr size_t WS_XB = 51 * MiB, WS_PROJ = 115 * MiB, WS_MIX = 323 * MiB, WS_S = 387 * MiB, WS_END = 507 * MiB;
constexpr size_t WS_HID = 115 * MiB;
constexpr size_t SARR = (size_t)M * RW;
constexpr int LORA_L = 384 * 64 * 2 + 384 * 128;
constexpr int LDS_BYTES = 147456, MISC_OFF = 131072;
constexpr int SCAN_WGS = 96, ATT_ITEMS = 768;

#ifndef PROBE
#define PROBE 0
#endif
struct Args { const float* in[25]; float* out; unsigned char* ws; int i0, i1; };

DI float wave_sum(float v) {
#pragma unroll
    for (int o = 1; o < 64; o <<= 1) v += __shfl_xor(v, o);
    return v;
}
DI unsigned f2bf(float f) { unsigned u = __builtin_bit_cast(unsigned, f); return (u + 0x7fffu + ((u >> 16) & 1u)) >> 16; }
DI unsigned pk2(float lo, float hi) { return f2bf(lo) | (f2bf(hi) << 16); }
DI float bflo(unsigned w) { return __uint_as_float(w << 16); }
DI float bfhi(unsigned w) { return __uint_as_float(w & 0xffff0000u); }
DI float bf1(const bf16* p) { return __uint_as_float(((unsigned)*p) << 16); }
DI void unpack8(v4u w, float* f) { f[0] = bflo(w.x); f[1] = bfhi(w.x); f[2] = bflo(w.y); f[3] = bfhi(w.y); f[4] = bflo(w.z); f[5] = bfhi(w.z); f[6] = bflo(w.w); f[7] = bfhi(w.w); }
DI v4u pack8(const float* f) { v4u o; o.x = pk2(f[0], f[1]); o.y = pk2(f[2], f[3]); o.z = pk2(f[4], f[5]); o.w = pk2(f[6], f[7]); return o; }
DI float sigmoidf_(float x) { return 1.f / (1.f + __expf(-x)); }
DI float tanhf_(float x) { const float e = __expf(2.f * x); return 1.f - 2.f / (e + 1.f); }
template <int CTRL> DI float dpp_add(float x) { return x + __int_as_float(__builtin_amdgcn_update_dpp(0, __float_as_int(x), CTRL, 0xf, 0xf, true)); }
DI float red16(float x) { x = dpp_add<0xB1>(x); x = dpp_add<0x4E>(x); x = dpp_add<0x141>(x); x = dpp_add<0x140>(x); return x; }

#define XB_TMO      128
#define XB_XCNT(j)  (256  + 64 * (j))
#define XB_XSUB(j)  (1280 + 64 * (j))
#define XB_XGEN(j)  (2304 + 64 * (j))
#define XB_TOP      3328
#define XB_TOPGEN   3392
#define XCD_BAR_WORDS 3456
#define XB_SPIN_CAP (1u << 18)

__device__ __forceinline__ unsigned xb_ld(unsigned* p)              { return __hip_atomic_load(p, __ATOMIC_RELAXED, __HIP_MEMORY_SCOPE_AGENT); }
__device__ __forceinline__ unsigned xb_add(unsigned* p, unsigned v) { return __hip_atomic_fetch_add(p, v, __ATOMIC_RELAXED, __HIP_MEMORY_SCOPE_AGENT); }
__device__ __forceinline__ unsigned xb_xcc_id() { return (unsigned)__builtin_amdgcn_s_getreg((3 << 11) | 20) & 0xFu; }
#define XB_SPIN(cond, bar) do { unsigned _sp = 0; while (cond) { __builtin_amdgcn_s_sleep(1); \
    if ((++_sp & 255u) == 0u) { if (xb_ld(&(bar)[XB_TMO])) break; if (_sp > XB_SPIN_CAP) { atomicAdd(&(bar)[XB_TMO], 1u); break; } } } } while (0)

struct XcdBarrier {
    unsigned* bar; unsigned x;
    volatile LAS unsigned* st;
};

__device__ __forceinline__ XcdBarrier xcd_barrier_post(unsigned* bar, volatile LAS unsigned* st) {
    XcdBarrier b; b.bar = bar; b.x = xb_xcc_id(); b.st = st;
    if (threadIdx.x == 0) (void)xb_add(&bar[XB_XCNT(b.x)], 1u);
    return b;
}
__device__ __forceinline__ void xcd_barrier_complete(unsigned* bar, unsigned x, unsigned& nloc, unsigned& nx) {
    const unsigned G = gridDim.x * gridDim.y * gridDim.z;
    unsigned sum, cnt, mine, sp = 0u;
    for (;;) {
        sum = 0u; cnt = 0u; mine = 0u;
#pragma unroll
        for (unsigned j = 0; j < 16; ++j) { const unsigned c = xb_ld(&bar[XB_XCNT(j)]); sum += c; cnt += (c > 0u) ? 1u : 0u; mine = (j == x) ? c : mine; }
        if (sum == G) break;
        __builtin_amdgcn_s_sleep(1);
        if ((++sp & 255u) == 0u) { if (xb_ld(&bar[XB_TMO])) break; if (sp > XB_SPIN_CAP) { atomicAdd(&bar[XB_TMO], 1u); break; } }
    }
    nloc = mine > 0u ? mine : 1u; nx = cnt > 0u ? cnt : 1u;
}

__device__ __forceinline__ void xcd_barrier(const XcdBarrier& b) {
    asm volatile("s_waitcnt vmcnt(0)" ::: "memory");
    __syncthreads();
    if (threadIdx.x == 0) {
        unsigned* bar = b.bar;
        __builtin_amdgcn_s_waitcnt(0);
        unsigned nloc = b.st[0], nx = b.st[1];
        if (nloc == 0u) { xcd_barrier_complete(bar, b.x, nloc, nx); b.st[0] = nloc; b.st[1] = nx; }
        const unsigned old = xb_add(&bar[XB_XSUB(b.x)], 1u);
        const unsigned gen = old / nloc;
        if (old + 1u == (gen + 1u) * nloc) {
            __builtin_amdgcn_fence(__ATOMIC_RELEASE, "agent");
            asm volatile("s_waitcnt vmcnt(0)" ::: "memory");
            const unsigned og = xb_add(&bar[XB_TOP], 1u);
            const unsigned tg = og / nx;
            if (og + 1u == (tg + 1u) * nx) xb_add(&bar[XB_TOPGEN], 1u);
            else XB_SPIN(xb_ld(&bar[XB_TOPGEN]) == tg, bar);
            __builtin_amdgcn_fence(__ATOMIC_ACQUIRE, "agent");
            xb_add(&bar[XB_XGEN(b.x)], 1u);
            asm volatile("s_waitcnt vmcnt(0)" ::: "memory");
        } else {
            XB_SPIN(xb_ld(&bar[XB_XGEN(b.x)]) == gen, bar);
            __builtin_amdgcn_fence(__ATOMIC_ACQUIRE, "agent");
            asm volatile("s_waitcnt vmcnt(0)" ::: "memory");
        }
    }
    __syncthreads();
}


struct Frame {
    LAS unsigned char* lds;
    int tid, lane, wave, G, gw, NGW;
    const float* const* in;
    float* out; unsigned char* ws;
};
DI const float* INP(const Frame& F, int k) { asm volatile("" : "+s"(k)); return F.in[k]; }
#define F_WIN  ((bf16*)(F.ws + WS_WIN))
#define F_WOUT ((bf16*)(F.ws + WS_WOUT))
#define F_WUP  ((bf16*)(F.ws + WS_WUP))
#define F_WDN  ((bf16*)(F.ws + WS_WDN))
#define F_LORA ((bf16*)(F.ws + WS_LORA))
#define F_XB   ((bf16*)(F.ws + WS_XB))
#define F_PROJ ((bf16*)(F.ws + WS_PROJ))
#define F_MIX  ((bf16*)(F.ws + WS_MIX))
#define F_HID  ((bf16*)(F.ws + WS_HID))
#define F_S_r  ((bf16*)(F.ws + WS_XB))
#define F_S_ld ((bf16*)(F.ws + WS_XB) + SARR)
#define F_S_k  ((bf16*)(F.ws + WS_S))
#define F_S_v  ((bf16*)(F.ws + WS_S) + SARR)
#define F_S_n  ((bf16*)(F.ws + WS_S) + 2 * SARR)
#define F_S_b  ((bf16*)(F.ws + WS_S) + 3 * SARR)
#define F_S_g  ((bf16*)(F.ws + WS_S) + 4 * SARR)
#define F_ctl  ((unsigned*)(F.ws + WS_CTL))

DI void transpose_item(const float* W, int K, int N, bf16* WT, LAS float* scr, int item, int lane, const float* gk, float cs, int csn) {
    const int nblk = N / 32, kb = item / nblk, nb = item % nblk, k0 = 64 * kb, n0 = 32 * nb;
    const float colscale = (n0 + (lane & 31) < csn) ? cs : 1.f;
#pragma unroll 8
    for (int i = 0; i < 32; ++i) { const int kk = 2 * i + (lane >> 5); float v = W[(size_t)(k0 + kk) * N + n0 + (lane & 31)]; if (gk) v *= gk[k0 + kk]; scr[kk * 33 + (lane & 31)] = v * colscale; }
    asm volatile("s_waitcnt lgkmcnt(0)" ::: "memory");
    const int c = lane & 7;
#pragma unroll
    for (int j = 0; j < 4; ++j) { const int n = (lane >> 3) + 8 * j; const LAS float* s = scr + (8 * c) * 33 + n;
        v4u o; o.x = pk2(s[0 * 33], s[1 * 33]); o.y = pk2(s[2 * 33], s[3 * 33]); o.z = pk2(s[4 * 33], s[5 * 33]); o.w = pk2(s[6 * 33], s[7 * 33]);
        *(v4u*)(WT + (size_t)(n0 + n) * K + k0 + 8 * c) = o; }
    asm volatile("s_waitcnt lgkmcnt(0)" ::: "memory");
}
DI Frame refresh(const Frame& F0) { Frame F = F0; int t = threadIdx.x; asm volatile("" : "+v"(t)); int bxx = blockIdx.x; asm volatile("" : "+s"(bxx)); F.tid = t; F.lane = t & 63; F.wave = __builtin_amdgcn_readfirstlane(t >> 6); F.gw = bxx * NWAVES + F.wave; return F; }
DI void prologue(const Frame& F0) { Frame F = refresh(F0);
    LAS float* scr = (LAS float*)(F.lds + F.wave * 16384);
    constexpr int I_IN = 16 * 104, I_OUT = 16 * 32, I_UP = 16 * 128, I_DN = 64 * 32, I_LW = 12, I_LG = 24;
    constexpr int PER = I_IN + I_OUT + I_UP + I_DN + 2 * I_LW + I_LG;
    constexpr float C2 = 0.17677669529663687f * 1.4426950408889634f;
    for (int it = F.gw; it < 2 * PER; it += F.NGW) {
        const int l = it / PER; int r = it % PER;
        if (r < I_IN) { transpose_item(INP(F, 2) + (size_t)l * DMODEL * NIN, DMODEL, NIN, F_WIN + (size_t)l * NIN * DMODEL, scr, r, F.lane, INP(F, 1) + l * DMODEL, C2, 384); continue; } r -= I_IN;
        if (r < I_OUT) { transpose_item(INP(F, 20) + (size_t)l * DMODEL * DMODEL, DMODEL, DMODEL, F_WOUT + (size_t)l * DMODEL * DMODEL, scr, r, F.lane, nullptr, 1.f, 0); continue; } r -= I_OUT;
        if (r < I_UP) { transpose_item(INP(F, 22) + (size_t)l * DMODEL * FF, DMODEL, FF, F_WUP + (size_t)l * FF * DMODEL, scr, r, F.lane, INP(F, 21) + l * DMODEL, 1.f, 0); continue; } r -= I_UP;
        if (r < I_DN) { transpose_item(INP(F, 23) + (size_t)l * FF * DMODEL, FF, DMODEL, F_WDN + (size_t)l * DMODEL * FF, scr, r, F.lane, nullptr, 1.f, 0); continue; } r -= I_DN;
        bf16* L = F_LORA + (size_t)l * LORA_L;
        if (r < I_LW) { transpose_item(INP(F, 11) + (size_t)l * 64 * RW, 64, RW, L, scr, r, F.lane, nullptr, 1.f, 0); continue; } r -= I_LW;
        if (r < I_LW) { transpose_item(INP(F, 13) + (size_t)l * 64 * RW, 64, RW, L + RW * 64, scr, r, F.lane, nullptr, 1.f, 0); continue; } r -= I_LW;
        transpose_item(INP(F, 14) + (size_t)l * 128 * RW, 128, RW, L + 2 * RW * 64, scr, r, F.lane, nullptr, 1.f, 0);
    }
}
DI void rms_rows_bf16(const Frame& F0, const float* src, bf16* dst) { Frame F = refresh(F0);
    for (int m = F.gw; m < M; m += F.NGW) {
        const f32x4* xr = (const f32x4*)(src + (size_t)m * DMODEL) + F.lane;
        f32x4 v[4]; float s2 = 0.f;
#pragma unroll
        for (int j = 0; j < 4; ++j) { v[j] = xr[64 * j]; s2 += (v[j].x * v[j].x + v[j].y * v[j].y) + (v[j].z * v[j].z + v[j].w * v[j].w); }
        const float rstd = 1.f / sqrtf(wave_sum(s2) * (1.f / DMODEL) + NORM_EPS);
        v2u* o8 = (v2u*)(dst + (size_t)m * DMODEL) + F.lane;
#pragma unroll
        for (int j = 0; j < 4; ++j) { v2u w; w.x = pk2(v[j].x * rstd, v[j].y * rstd); w.y = pk2(v[j].z * rstd, v[j].w * rstd); o8[64 * j] = w; }
    }
}
DI void final_norm(const Frame& F0, float* x, const float* g) { Frame F = refresh(F0);
    for (int m = F.gw; m < M; m += F.NGW) {
        f32x4* xr = (f32x4*)(x + (size_t)m * DMODEL) + F.lane; const f32x4* gr = (const f32x4*)g + F.lane;
        f32x4 v[4]; float s2 = 0.f;
#pragma unroll
        for (int j = 0; j < 4; ++j) { v[j] = xr[64 * j]; s2 += (v[j].x * v[j].x + v[j].y * v[j].y) + (v[j].z * v[j].z + v[j].w * v[j].w); }
        const float rstd = 1.f / sqrtf(wave_sum(s2) * (1.f / DMODEL) + NORM_EPS);
#pragma unroll
        for (int j = 0; j < 4; ++j) xr[64 * j] = v[j] * rstd * gr[64 * j];
    }
}

DI void loadz8(const bf16* prow, bool first, const float* mu, int col, float* z) {
    const v4u p = *(const v4u*)(prow + col); v4u q = (v4u){0u, 0u, 0u, 0u}; if (!first) q = *(const v4u*)(prow - NIN + col);
    const f32x4 m0 = *(const f32x4*)(mu + col), m1 = *(const f32x4*)(mu + col + 4);
    float pf[8], qf[8]; unpack8(p, pf); unpack8(q, qf);
#pragma unroll
    for (int j = 0; j < 4; ++j) { z[j] = pf[j] + m0[j] * (qf[j] - pf[j]); z[4 + j] = pf[4 + j] + m1[j] * (qf[4 + j] - pf[4 + j]); }
}
DI float loadz1(const bf16* prow, bool first, float mu, int col) { const float p = bf1(prow + col); const float q = first ? 0.f : bf1(prow - NIN + col); return p + mu * (q - p); }

DI void prep_phase(const Frame& F0, int l) { Frame F = refresh(F0);
    const float* mu = INP(F, 9) + l * RCOLS;
    const float* w0 = INP(F, 10) + l * RW; const float* a0 = INP(F, 12) + l * RW; const float* kkw = INP(F, 15) + l * RW; const float* kaw = INP(F, 16) + l * RW;
    const bf16* WUT = F_LORA + (size_t)l * LORA_L; const bf16* AUT = WUT + RW * 64; const bf16* GUT = AUT + RW * 64;
    const int row = F.lane & 15, kq = F.lane >> 4, tok = F.lane >> 2, cq = (F.lane & 3) * 16;
    LAS float* LW = (LAS float*)(F.lds + F.wave * 16384);
    for (int tile = F.gw; tile < M / 16; tile += F.NGW) {
        const int t0 = tile * 16;
        bf16x8 Aw[2], Aa[2], Ag[4];
        { const int t = t0 + row; const bool first = (t % SEQ) == 0; const bf16* prow = F_PROJ + (size_t)t * NIN + ROFF; float z[8];
#pragma unroll
          for (int ks = 0; ks < 2; ++ks) { loadz8(prow, first, mu, 1152 + ks * 32 + kq * 8, z);
#pragma unroll
              for (int j = 0; j < 8; ++j) z[j] = tanhf_(z[j]);
              Aw[ks] = __builtin_bit_cast(bf16x8, pack8(z)); }
#pragma unroll
          for (int ks = 0; ks < 2; ++ks) { loadz8(prow, first, mu, 1216 + ks * 32 + kq * 8, z); Aa[ks] = __builtin_bit_cast(bf16x8, pack8(z)); }
#pragma unroll
          for (int ks = 0; ks < 4; ++ks) { loadz8(prow, first, mu, 1280 + ks * 32 + kq * 8, z);
#pragma unroll
              for (int j = 0; j < 8; ++j) z[j] = sigmoidf_(z[j]);
              Ag[ks] = __builtin_bit_cast(bf16x8, pack8(z)); } }
#pragma unroll 1
        for (int hd = 0; hd < 6; ++hd) {
#pragma unroll
            for (int cgi = 0; cgi < 4; ++cgi) {
                const int ch = hd * 64 + cgi * 16 + row;
                f32x4 cw = (f32x4){0.f, 0.f, 0.f, 0.f}, ca = cw, cgt = cw;
#pragma unroll
                for (int ks = 0; ks < 2; ++ks) {
                    const bf16x8 bw = *(const bf16x8*)(WUT + (size_t)ch * 64 + ks * 32 + kq * 8); cw = __builtin_amdgcn_mfma_f32_16x16x32_bf16(Aw[ks], bw, cw, 0, 0, 0);
                    const bf16x8 ba = *(const bf16x8*)(AUT + (size_t)ch * 64 + ks * 32 + kq * 8); ca = __builtin_amdgcn_mfma_f32_16x16x32_bf16(Aa[ks], ba, ca, 0, 0, 0); }
#pragma unroll
                for (int ks = 0; ks < 4; ++ks) { const bf16x8 bg = *(const bf16x8*)(GUT + (size_t)ch * 128 + ks * 32 + kq * 8); cgt = __builtin_amdgcn_mfma_f32_16x16x32_bf16(Ag[ks], bg, cgt, 0, 0, 0); }
#pragma unroll
                for (int j = 0; j < 4; ++j) { LAS float* d = LW + (kq * 4 + j) * 68 + cgi * 16 + row; d[0] = cw[j]; d[16 * 68] = ca[j]; d[32 * 68] = cgt[j]; }
            }
            asm volatile("s_waitcnt lgkmcnt(0)" ::: "memory");
            const int t = t0 + tok; const bool first = (t % SEQ) == 0; const bf16* prow = F_PROJ + (size_t)t * NIN + ROFF; const int ch0 = hd * 64 + cq;
            float kkq[16], aq[16]; float ss = 0.f;
#pragma unroll
            for (int sub = 0; sub < 2; ++sub) {
                const int ch = ch0 + sub * 8; const size_t idx = (size_t)t * RW + ch;
                float zr[8], zk[8], zv[8], wl[8], al[8], gl[8], pw0[8], pa0[8], pkk[8], pka[8], ldv[8], kpv[8];
                loadz8(prow, first, mu, ch, zr); loadz8(prow, first, mu, RW + ch, zk); loadz8(prow, first, mu, 2 * RW + ch, zv);
                const LAS float* lw = LW + tok * 68 + cq + sub * 8;
#pragma unroll
                for (int hh = 0; hh < 2; ++hh) { const f32x4 x0 = *(const LAS f32x4*)(lw + 4 * hh), x1 = *(const LAS f32x4*)(lw + 16 * 68 + 4 * hh), x2 = *(const LAS f32x4*)(lw + 32 * 68 + 4 * hh);
                    const f32x4 p0 = *(const f32x4*)(w0 + ch + 4 * hh), p1 = *(const f32x4*)(a0 + ch + 4 * hh), p2 = *(const f32x4*)(kkw + ch + 4 * hh), p3 = *(const f32x4*)(kaw + ch + 4 * hh);
#pragma unroll
                    for (int e = 0; e < 4; ++e) { wl[4 * hh + e] = x0[e]; al[4 * hh + e] = x1[e]; gl[4 * hh + e] = x2[e]; pw0[4 * hh + e] = p0[e]; pa0[4 * hh + e] = p1[e]; pkk[4 * hh + e] = p2[e]; pka[4 * hh + e] = p3[e]; } }
#pragma unroll
                for (int j = 0; j < 8; ++j) {
                    const float xs = -(pw0[j] + wl[j]); const float sp = fmaxf(xs, 0.f) + __logf(1.f + __expf(-fabsf(xs)));
                    ldv[j] = -__expf(-sp - 0.5f);
                    const float a = sigmoidf_(pa0[j] + al[j]);
                    const float kk = zk[j] * pkk[j]; kpv[j] = zk[j] * (1.f + (a - 1.f) * pka[j]);
                    kkq[sub * 8 + j] = kk; aq[sub * 8 + j] = a; ss += kk * kk;
                }
                *(v4u*)(F_S_r + idx) = pack8(zr); *(v4u*)(F_S_ld + idx) = pack8(ldv); *(v4u*)(F_S_k + idx) = pack8(kpv); *(v4u*)(F_S_v + idx) = pack8(zv); *(v4u*)(F_S_g + idx) = pack8(gl);
            }
            ss += __shfl_xor(ss, 1); ss += __shfl_xor(ss, 2);
            const float inv = 1.f / fmaxf(sqrtf(ss), 1e-12f);
#pragma unroll
            for (int sub = 0; sub < 2; ++sub) { float nn[8], bbv[8];
#pragma unroll
                for (int j = 0; j < 8; ++j) { const float kn = kkq[sub * 8 + j] * inv; nn[j] = -kn; bbv[j] = kn * aq[sub * 8 + j]; }
                const size_t idx = (size_t)t * RW + ch0 + sub * 8; *(v4u*)(F_S_n + idx) = pack8(nn); *(v4u*)(F_S_b + idx) = pack8(bbv); }
            asm volatile("s_waitcnt lgkmcnt(0)" ::: "memory");
        }
    }
    const float* cw_ = INP(F, 8) + l * 3 * 256;
    for (int it = F.gw; it < M / 2; it += F.NGW) {
        const int t = it * 2 + (F.lane >> 5), c8 = (F.lane & 31) * 8, pos = t % SEQ;
        const bf16* base = F_PROJ + (size_t)t * NIN + COFF + c8;
        float b8[8], g8[8], u8[8], acc[8], w8[8];
        unpack8(*(const v4u*)base, b8);
#pragma unroll
        for (int j = 0; j < 8; ++j) acc[j] = 0.f;
#pragma unroll
        for (int d = 0; d < 3; ++d) {
            const int back = 2 - d;
            if (pos >= back) {
                const bf16* pb = base - (size_t)back * NIN;
                unpack8(*(const v4u*)(pb + 256), g8); unpack8(*(const v4u*)(pb + 512), u8);
                const f32x4 wa = *(const f32x4*)(cw_ + d * 256 + c8), wb = *(const f32x4*)(cw_ + d * 256 + c8 + 4);
                w8[0] = wa.x; w8[1] = wa.y; w8[2] = wa.z; w8[3] = wa.w; w8[4] = wb.x; w8[5] = wb.y; w8[6] = wb.z; w8[7] = wb.w;
#pragma unroll
                for (int j = 0; j < 8; ++j) acc[j] += w8[j] * (g8[j] * u8[j]);
            }
        }
#pragma unroll
        for (int j = 0; j < 8; ++j) acc[j] *= b8[j];
        *(v4u*)(F_MIX + (size_t)t * DMODEL + 384 + c8) = pack8(acc);
    }
}

DI void post_phase(const Frame& F0, int l, bf16* alt = nullptr) { Frame F = refresh(F0);
    const float* rk = INP(F, 17) + l * RW; const float* lg = INP(F, 18) + l * RW; const float* lb = INP(F, 19) + l * RW;
    for (int it = F.gw; it < M * 6 / 8; it += F.NGW) {
        const int pair = it * 8 + (F.lane >> 3), t = pair / 6, hd = pair % 6, ch = hd * 64 + (F.lane & 7) * 8;
        bf16* yp = F_MIX + (size_t)t * DMODEL + 640 + ch; const size_t idx = (size_t)t * RW + ch;
        float y[8], r[8], k[8], v[8], g[8], o[8];
        unpack8(*(const v4u*)yp, y); unpack8(*(const v4u*)(F_S_r + idx), r); unpack8(*(const v4u*)(F_S_k + idx), k); unpack8(*(const v4u*)(F_S_v + idx), v); unpack8(*(const v4u*)(F_S_g + idx), g);
        float s = 0.f, dot = 0.f;
#pragma unroll
        for (int j = 0; j < 8; ++j) { s += y[j]; dot += r[j] * k[j] * rk[ch + j]; }
        s += __shfl_xor(s, 1); s += __shfl_xor(s, 2); s += __shfl_xor(s, 4);
        dot += __shfl_xor(dot, 1); dot += __shfl_xor(dot, 2); dot += __shfl_xor(dot, 4);
        const float mean = s * (1.f / 64.f); float q = 0.f;
#pragma unroll
        for (int j = 0; j < 8; ++j) { const float d = y[j] - mean; q += d * d; }
        q += __shfl_xor(q, 1); q += __shfl_xor(q, 2); q += __shfl_xor(q, 4);
        const float rstd = 1.f / sqrtf(q * (1.f / 64.f) + GN_EPS);
#pragma unroll
        for (int j = 0; j < 8; ++j) o[j] = ((y[j] - mean) * rstd * lg[ch + j] + lb[ch + j] + dot * v[j]) * g[j];
        if (alt) *(v4u*)(alt + (size_t)t * DMODEL + 640 + ch) = pack8(o); else *(v4u*)yp = pack8(o);
    }
}

DI void scan_wg(const Frame& F0, int sw) { Frame F = refresh(F0);
    const int bh = sw >> 1, half = sw & 1, b = bh / 6, hd = bh % 6;
    const size_t tb = (size_t)b * SEQ; const int cb = hd * 64;
    LAS unsigned char* const lds = F.lds;
    constexpr int BUFB = 6 * 8192, YOFF = 2 * BUFB;
    const bool loader = F.wave >= 4; const int ltid = F.tid - 256;
#define SCAN_STAGE(c, bufsel, P0, NP, STRIDE) do { _Pragma("unroll") for (int i = 0; i < (NP); ++i) { const int p = (P0) + (STRIDE) * i, a = p >> 8, tt = (p & 255) >> 3, c8 = (p & 7) * 8; \
        const bf16* src = (a == 0 ? F_S_r : a == 1 ? F_S_ld : a == 2 ? F_S_k : a == 3 ? F_S_v : a == 4 ? F_S_n : F_S_b); \
        const v4u raw = *(const v4u*)(src + (tb + (size_t)(c) * 32 + tt) * RW + cb + c8); \
        float f[8]; unpack8(raw, f); if (a == 1) { _Pragma("unroll") for (int j = 0; j < 8; ++j) f[j] = __expf(f[j]); } \
        LAS f32x4* d = (LAS f32x4*)(lds + (bufsel) * BUFB + a * 8192 + tt * 256 + c8 * 4); d[0] = (f32x4){f[0], f[1], f[2], f[3]}; d[1] = (f32x4){f[4], f[5], f[6], f[7]}; } } while (0)
#define SCAN_YOUT(c, bufsel) do { _Pragma("unroll") for (int i = 0; i < 2; ++i) { const int e = ltid + 256 * i, tt = e >> 4, r2 = (e & 15) * 2; \
        const LAS float* ys = (const LAS float*)(lds + YOFF + (bufsel) * 4096) + tt * 32 + r2; \
        *(unsigned*)(F_MIX + (tb + (size_t)(c) * 32 + tt) * DMODEL + 640 + cb + half * 32 + r2) = pk2(ys[0], ys[1]); } } while (0)
    SCAN_STAGE(0, 0, F.tid, 3, 512);
    __syncthreads();
    typedef float f32x2v __attribute__((ext_vector_type(2)));
    const int rp = F.wave * 8 + (F.lane >> 4) * 2, kp = F.lane & 15;
    f32x4 s0 = (f32x4){0.f, 0.f, 0.f, 0.f}, s1 = s0;
#pragma unroll 1
    for (int c = 0; c < SEQ / 32; ++c) {
        const int cur = c & 1;
        if (loader) {
            if (c + 1 < SEQ / 32) SCAN_STAGE(c + 1, cur ^ 1, ltid, 6, 256);
            if (c > 0) SCAN_YOUT(c - 1, cur ^ 1);
        } else {
            const LAS unsigned char* bb = lds + cur * BUFB + kp * 16;
            const LAS unsigned char* vb = lds + cur * BUFB + 3 * 8192 + (half * 32 + rp) * 4;
            LAS f32x2v* yb = (LAS f32x2v*)(lds + YOFF + cur * 4096 + rp * 4);
            f32x4 rv = *(const LAS f32x4*)(bb + 0 * 8192), wv = *(const LAS f32x4*)(bb + 1 * 8192), kv = *(const LAS f32x4*)(bb + 2 * 8192);
            f32x4 nv = *(const LAS f32x4*)(bb + 4 * 8192), bv = *(const LAS f32x4*)(bb + 5 * 8192);
            f32x2v vv = *(const LAS f32x2v*)(vb);
#pragma unroll 8
            for (int tt = 0; tt < 32; ++tt) {
                const int tn = (tt + 1) & 31;
                const f32x4 rv2 = *(const LAS f32x4*)(bb + 0 * 8192 + tn * 256), wv2 = *(const LAS f32x4*)(bb + 1 * 8192 + tn * 256), kv2 = *(const LAS f32x4*)(bb + 2 * 8192 + tn * 256);
                const f32x4 nv2 = *(const LAS f32x4*)(bb + 4 * 8192 + tn * 256), bv2 = *(const LAS f32x4*)(bb + 5 * 8192 + tn * 256);
                const f32x2v vv2 = *(const LAS f32x2v*)(vb + tn * 256);
                f32x2v d0 = (f32x2v){s0.x, s0.y} * (f32x2v){nv.x, nv.y}; d0 = (f32x2v){s0.z, s0.w} * (f32x2v){nv.z, nv.w} + d0;
                f32x2v d1 = (f32x2v){s1.x, s1.y} * (f32x2v){nv.x, nv.y}; d1 = (f32x2v){s1.z, s1.w} * (f32x2v){nv.z, nv.w} + d1;
                const float sa0 = red16(d0.x + d0.y), sa1 = red16(d1.x + d1.y);
                const f32x4 q0 = s0 * wv + kv * vv.x, q1 = s1 * wv + kv * vv.y;
                s0 = bv * sa0 + q0; s1 = bv * sa1 + q1;
                f32x2v y0 = (f32x2v){s0.x, s0.y} * (f32x2v){rv.x, rv.y}; y0 = (f32x2v){s0.z, s0.w} * (f32x2v){rv.z, rv.w} + y0;
                f32x2v y1 = (f32x2v){s1.x, s1.y} * (f32x2v){rv.x, rv.y}; y1 = (f32x2v){s1.z, s1.w} * (f32x2v){rv.z, rv.w} + y1;
                const float ya = red16(y0.x + y0.y), yc = red16(y1.x + y1.y);
                yb[tt * 16] = (f32x2v){ya, yc};
                rv = rv2; wv = wv2; kv = kv2; nv = nv2; bv = bv2; vv = vv2;
            }
        }
        __syncthreads();
    }
    if (loader) SCAN_YOUT(SEQ / 32 - 1, (SEQ / 32 - 1) & 1);
#undef SCAN_STAGE
#undef SCAN_YOUT
    __syncthreads();
}

DI void mix_phase(const Frame& F0, int l, char* ldsg) { Frame F = refresh(F0);
#ifndef SKIP_SCAN
    if ((int)blockIdx.x < SCAN_WGS) { scan_wg(F, (int)blockIdx.x); if (PROBE & 2) scan_wg(F, (int)blockIdx.x); }
#endif
    const float* lq1 = INP(F, 3) + l * 32; const float* lk1 = INP(F, 4) + l * 32; const float* lq2 = INP(F, 5) + l * 32; const float* lk2 = INP(F, 6) + l * 32;
    float d1 = 0.f, d2 = 0.f;
    for (int i = 0; i < 32; ++i) { d1 += lq1[i] * lk1[i]; d2 += lq2[i] * lk2[i]; }
    const float lambda_init = (l == 0) ? 0.2f : 0.35550906759f;
    const float lam = __expf(d1) - __expf(d2) + lambda_init;
    const float* sg = INP(F, 7) + l * 64;
    volatile LAS unsigned* qslot = (volatile LAS unsigned*)(F.lds + MISC_OFF + 64);
    for (int rep = 0; rep < ((PROBE & 4) ? 2 : 1); ++rep)
    for (;;) {
        if (F.tid == 0) *qslot = atomicAdd(F_ctl + 64 * (1 + l + 2 * rep), 1u);
        __syncthreads();
        const unsigned idx = (unsigned)__builtin_amdgcn_readfirstlane((int)*qslot);
        __syncthreads();
        if (idx >= (unsigned)ATT_ITEMS) break;
        const int qb = 15 - (int)(idx / 48u), bh = (int)(idx % 48u), b = bh / 6, h = bh % 6;
        const attn_body::bf16* P = (const attn_body::bf16*)F_PROJ;
#ifndef SKIP_ATT
#pragma unroll 1
        for (int ns = 0; ns < 2; ++ns)
            attn_body::attn_unit<8>(b, h, qb, ns, lam, sg, 1.f - lambda_init, P, P + 384, P + 768, (attn_body::bf16*)F_MIX, ldsg);
#endif
    }
}

__global__ void __launch_bounds__(NWAVES * 64, 2) mega_fwd(Args args) {
    extern __shared__ __attribute__((aligned(16))) unsigned char lds[];
    cg::grid_group grid = cg::this_grid();
    Frame F;
    F.lds = (LAS unsigned char*)lds;
    F.tid = threadIdx.x; F.lane = F.tid & 63; F.wave = __builtin_amdgcn_readfirstlane(F.tid >> 6);
    F.G = gridDim.x; F.gw = (int)blockIdx.x * NWAVES + F.wave; F.NGW = F.G * NWAVES;
    F.in = args.in; F.out = args.out; F.ws = args.ws;
    const int G = F.G;
    if (F.tid < 32) ((LAS unsigned*)(F.lds + MISC_OFF))[F.tid] = 0u;
    __syncthreads();
    XcdBarrier bar = xcd_barrier_post((unsigned*)(args.ws + WS_CTL) + CW_BAR, (volatile LAS unsigned*)(F.lds + MISC_OFF) + 8);

    prologue(F);
    if (PROBE & 64) { __syncthreads(); prologue(F); rms_rows_bf16(F, INP(F, 0), F_XB); }
    { float* ssz = (float*)(args.ws + WS_SS); for (int i = (int)blockIdx.x * 512 + (int)threadIdx.x; i < 4 * M; i += (int)gridDim.x * 512) ssz[i] = 0.f; }
    rms_rows_bf16(F, INP(F, 0), F_XB);
    grid.sync();
#pragma unroll 1
    for (int l = 0; l < 2; ++l) {
        {
            pg8::Gemm g{F_XB, F_WIN + (size_t)l * NIN * DMODEL, M, NIN, DMODEL}; pg8::StaticOrder S; int bx = blockIdx.x; asm volatile("" : "+s"(bx)); S.init(M, NIN, G, bx);
            pg8::EpiBf16S<0> E{F_PROJ, NIN, l == 0 ? (const float*)nullptr : (const float*)(args.ws + WS_SS) + (size_t)1 * M};
            GEMMCALL0 pg8::gemm_phase<pg8::EpiBf16S<0>, pg8::StaticOrder, true, true>(F.lds, g, S, E);
            if (PROBE & 1) { __syncthreads(); pg8::gemm_phase<pg8::EpiBf16S<0>, pg8::StaticOrder, true, true>(F.lds, g, S, E); }
        }
        xcd_barrier(bar);
#ifndef SKIP_PREP
        prep_phase(F, l);
        if (PROBE & 8) { __syncthreads(); prep_phase(F, l); }
#endif
        xcd_barrier(bar);
        mix_phase(F, l, (char*)lds);
        xcd_barrier(bar);
#ifndef SKIP_POST
        post_phase(F, l);
        if (PROBE & 128) { __syncthreads(); post_phase(F, l, (bf16*)(F.ws + WS_S)); }
#endif
        xcd_barrier(bar);
        {
            pg8::Gemm g{F_MIX, F_WOUT + (size_t)l * DMODEL * DMODEL, M, DMODEL, DMODEL}; pg8::StaticOrder S; int bx = blockIdx.x; asm volatile("" : "+s"(bx)); S.init(M, DMODEL, G, bx);
            pg8::EpiResF32 E{l == 0 ? INP(F, 0) : (const float*)F.out, F.out, DMODEL, F_XB, (float*)(args.ws + WS_SS) + (size_t)(2 * l) * M};
            GEMMCALL1 pg8::gemm_phase<pg8::EpiResF32, pg8::StaticOrder, true, true>(F.lds, g, S, E);
            if ((PROBE & 256) && l == 0) { __syncthreads(); pg8::EpiResF32 E2{INP(F, 0), F.out, DMODEL, F_XB, (float*)(args.ws + WS_SS) + (size_t)3 * M}; pg8::gemm_phase<pg8::EpiResF32, pg8::StaticOrder, true, true>(F.lds, g, S, E2); }
        }
        xcd_barrier(bar);
        {
            pg8::Gemm g{F_XB, F_WUP + (size_t)l * FF * DMODEL, M, FF, DMODEL}; pg8::StaticOrder S; int bx = blockIdx.x; asm volatile("" : "+s"(bx)); S.init(M, FF, G, bx);
            pg8::EpiBf16S<2> E{F_HID, FF, (const float*)(args.ws + WS_SS) + (size_t)(2 * l) * M};
            GEMMCALL2 pg8::gemm_phase<pg8::EpiBf16S<2>, pg8::StaticOrder, true, true>(F.lds, g, S, E);
            if (PROBE & 1) { __syncthreads(); pg8::gemm_phase<pg8::EpiBf16S<2>, pg8::StaticOrder, true, true>(F.lds, g, S, E); }
        }
        xcd_barrier(bar);
        {
            pg8::Gemm g{F_HID, F_WDN + (size_t)l * DMODEL * FF, M, DMODEL, FF}; pg8::StaticOrder S; int bx = blockIdx.x; asm volatile("" : "+s"(bx)); S.init(M, DMODEL, G, bx);
            pg8::EpiResF32 E{(const float*)F.out, F.out, DMODEL, F_XB, (float*)(args.ws + WS_SS) + (size_t)(2 * l + 1) * M};
            GEMMCALL3 pg8::gemm_phase<pg8::EpiResF32, pg8::StaticOrder, true, true>(F.lds, g, S, E);
        }
        xcd_barrier(bar);
    }
    final_norm(F, F.out, INP(F, 24));
}

extern "C" void kernel_launch(void* const* d_in, const int* in_sizes, int n_in, void* d_out, int out_size, void* d_ws, size_t ws_size, hipStream_t stream) {
    static int grid = 0;
    if (grid == 0) {
        if (n_in != 25 || in_sizes[0] != M * DMODEL || out_size != M * DMODEL || ws_size < WS_END) {
            fprintf(stderr, "kernel_launch: unexpected problem geometry (n_in %d, in0 %d, out %d, ws %zu)\n", n_in, n_in > 0 ? in_sizes[0] : -1, out_size, ws_size); grid = -1; return; }
        int dev = 0, cus = 0, per_cu = 0;
        if (hipGetDevice(&dev) != hipSuccess || hipDeviceGetAttribute(&cus, hipDeviceAttributeMultiprocessorCount, dev) != hipSuccess) { grid = -1; return; }
        if (hipFuncSetAttribute((const void*)mega_fwd, hipFuncAttributeMaxDynamicSharedMemorySize, LDS_BYTES) != hipSuccess) { fprintf(stderr, "kernel_launch: hipFuncSetAttribute failed\n"); grid = -1; return; }
        if (hipOccupancyMaxActiveBlocksPerMultiprocessor(&per_cu, (const void*)mega_fwd, NWAVES * 64, LDS_BYTES) != hipSuccess || per_cu < 1) { fprintf(stderr, "kernel_launch: occupancy query gave %d\n", per_cu); (void)hipGetLastError(); per_cu = 1; }
        grid = cus * per_cu;
    }
    if (grid < 0) return;
    (void)hipMemsetAsync((char*)d_ws + WS_CTL, 0, CTL_ZERO_BYTES, stream);
    Args a{};
    for (int i = 0; i < 25; ++i) a.in[i] = (const float*)d_in[i];
    a.out = (float*)d_out; a.ws = (unsigned char*)d_ws; a.i0 = 0; a.i1 = 0;
    void* kargs[] = {&a};
    const hipError_t e = hipLaunchCooperativeKernel((const void*)mega_fwd, dim3(grid), dim3(NWAVES * 64), kargs, LDS_BYTES, stream);
    if (e != hipSuccess) fprintf(stderr, "kernel_launch: cooperative launch failed: %s (grid %d)\n", hipGetErrorString(e), grid);
}
```

```cpp
#include <hip/hip_runtime.h>
#include <hip/hip_cooperative_groups.h>
#include <hip/hip_bf16.h>
#include <cstdio>
#include <cstdint>
#include <cmath>
namespace pg8 {
#define PG8_LAS __attribute__((address_space(3)))
typedef unsigned short bf16_t;
typedef short bf16x8 __attribute__((ext_vector_type(8)));
typedef float f32x4 __attribute__((ext_vector_type(4)));
typedef unsigned u32x4 __attribute__((ext_vector_type(4)));
constexpr int BM = 256, BK = 64, HALF = 128, HTB = HALF * BK * 2  , STAGE_BYTES = 8 * HTB, NXCD = 8, WGM = 8;

__host__ __device__ __forceinline__ int lds_byte(int r, int c) { const int st = (r >> 4) * 2 + (c >> 5), rr = r & 15, cc = c & 31, ob = rr * 64 + cc * 2; return st * 1024 + (ob ^ (((ob >> 9) & 1) << 5)); }
__host__ __device__ __forceinline__ void stage_rc(int b, int& R, int& C) { const int st = b / 1024, sb = b % 1024, swz = sb ^ (((sb >> 9) & 1) << 5); R = (st >> 1) * 16 + swz / 64; C = (st & 1) * 32 + (swz % 64) / 2; }
__host__ __device__ __forceinline__ int perm32(int rho) { const int n = rho >> 4, i = rho & 15; return 8 * (i >> 2) + 4 * n + (i & 3); }

struct Unit { int pm, pn; };
struct Gemm { const bf16_t* A; const bf16_t* Bt; int M, N, K; };

struct StaticOrder {
    int nM, nN, nwg, G, c;
    __host__ __device__ void init(int M, int N, int G_, int c_) { nM = M / BM; nN = N / BM; nwg = nM * nN; G = G_; c = c_; }
    __host__ __device__ bool next(int i, Unit& u) const {
        const long L = (long)i * G + c; if (L >= nwg) return false;
        int wgid = (int)L; { const int q = nwg / NXCD, r = nwg % NXCD, xcd = wgid % NXCD, off = wgid / NXCD; wgid = (xcd < r ? xcd * (q + 1) : r * (q + 1) + (xcd - r) * q) + off; }
        const int nig = WGM * nN, gid = wgid / nig, fm = gid * WGM, gsz = (nM - fm) < WGM ? (nM - fm) : WGM;
        u.pm = fm + ((wgid % nig) % gsz); u.pn = (wgid % nig) / gsz; return true;
    }
    __device__ __forceinline__ void a_ready(const Unit&) const {}
    __device__ __forceinline__ void done(const Unit&) const {}
};

__device__ __forceinline__ unsigned cvt_pk_bf16(float lo, float hi) { unsigned r; asm volatile("v_cvt_pk_bf16_f32 %0, %1, %2" : "=v"(r) : "v"(lo), "v"(hi)); return r; }
typedef float f32x2 __attribute__((ext_vector_type(2)));
template <int ACT  > struct EpiBf16S {
    static constexpr bool PERM = true, AFTER_DRAIN = false;
    bf16_t* O; int ldc; const float* ss;
    __device__ __forceinline__ void operator()(const f32x4 (&acc)[2][2][4][2], const Unit& u, int wr, int wc, int fr, int fq) const {
        const int row0 = u.pm * BM + wr * 64 + fr; const int col0 = u.pn * BM + wc * 32 + 8 * fq;
        f32x4 sp[8]; float rs[8];
#pragma unroll
        for (int g = 0; g < 8; ++g) sp[g] = *(const f32x4*)(ss + (size_t)(row0 + (g >> 2) * HALF + (g & 3) * 16) * 16 + fq * 4);
#pragma unroll
        for (int g = 0; g < 8; ++g) { float t = (sp[g].x + sp[g].y) + (sp[g].z + sp[g].w); t += __shfl_xor(t, 16); t += __shfl_xor(t, 32); rs[g] = 1.0f / sqrtf(t * (1.0f / 1024.0f) + 1e-6f); }
#pragma unroll
        for (int ai = 0; ai < 2; ++ai)
#pragma unroll
            for (int m = 0; m < 4; ++m) { bf16_t* rowp = O + (size_t)(row0 + ai * HALF + m * 16) * ldc + col0; const float r_ = rs[ai * 4 + m];
#pragma unroll
                for (int bj = 0; bj < 2; ++bj) { f32x4 v0 = acc[ai][bj][m][0] * r_, v1 = acc[ai][bj][m][1] * r_;
                    if (ACT == 2) {
#pragma unroll
                        for (int e = 0; e < 4; ++e) { float a = v0[e] > 0.f ? v0[e] : 0.f; v0[e] = a * a; float b = v1[e] > 0.f ? v1[e] : 0.f; v1[e] = b * b; } }
                    u32x4 w; w.x = cvt_pk_bf16(v0[0], v0[1]); w.y = cvt_pk_bf16(v0[2], v0[3]); w.z = cvt_pk_bf16(v1[0], v1[1]); w.w = cvt_pk_bf16(v1[2], v1[3]);
                    __builtin_nontemporal_store(w, (u32x4*)(rowp + bj * HALF)); } }
    }
};
template <bool BASE_F32> struct EpiResBf16 {
    static constexpr bool PERM = true, AFTER_DRAIN = false;
    const float* basef; bf16_t* xb; int ldc; float* ss;
    __device__ __forceinline__ void operator()(const f32x4 (&acc)[2][2][4][2], const Unit& u, int wr, int wc, int fr, int fq) const {
        const int col0 = u.pn * BM + wc * 32 + 8 * fq;
        const size_t off0 = (size_t)(u.pm * BM + wr * 64 + fr) * ldc + col0;
        f32x4 cb[4], nb[4];
        auto ld = [&](size_t off, f32x4 (&d)[4]) {
            if (BASE_F32) {
#pragma unroll
                for (int q = 0; q < 4; ++q) d[q] = *(const f32x4*)(basef + off + (q >> 1) * HALF + (q & 1) * 4);
            } else {
#pragma unroll
                for (int bj = 0; bj < 2; ++bj) { const u32x4 w = __builtin_nontemporal_load((const u32x4*)(xb + off + bj * HALF));
                    d[2 * bj] = (f32x4){__uint_as_float(w.x << 16), __uint_as_float(w.x & 0xffff0000u), __uint_as_float(w.y << 16), __uint_as_float(w.y & 0xffff0000u)};
                    d[2 * bj + 1] = (f32x4){__uint_as_float(w.z << 16), __uint_as_float(w.z & 0xffff0000u), __uint_as_float(w.w << 16), __uint_as_float(w.w & 0xffff0000u)}; }
            }
        };
        ld(off0, cb);
#pragma unroll
        for (int g = 0; g < 8; ++g) { const int ai = g >> 2, m = g & 3; const size_t off = off0 + (size_t)(ai * HALF + m * 16) * ldc; const int r = u.pm * BM + ai * HALF + wr * 64 + m * 16 + fr;
            if (g < 7) ld(off0 + (size_t)(((g + 1) >> 2) * HALF + ((g + 1) & 3) * 16) * ldc, nb);
            float sq = 0.f;
#pragma unroll
            for (int bj = 0; bj < 2; ++bj) { const size_t idx = off + bj * HALF;
                const f32x4 o0 = cb[2 * bj] + acc[ai][bj][m][0], o1 = cb[2 * bj + 1] + acc[ai][bj][m][1];
                sq += ((o0[0] * o0[0] + o0[1] * o0[1]) + (o0[2] * o0[2] + o0[3] * o0[3])) + ((o1[0] * o1[0] + o1[1] * o1[1]) + (o1[2] * o1[2] + o1[3] * o1[3]));
                u32x4 w; w.x = cvt_pk_bf16(o0[0], o0[1]); w.y = cvt_pk_bf16(o0[2], o0[3]); w.z = cvt_pk_bf16(o1[0], o1[1]); w.w = cvt_pk_bf16(o1[2], o1[3]);
                *(u32x4*)(xb + idx) = w; }
            sq += __shfl_xor(sq, 16); sq += __shfl_xor(sq, 32);
            if (fq == 0) ss[(size_t)r * 16 + u.pn * 4 + wc] = sq;
#pragma unroll
            for (int q = 0; q < 4; ++q) cb[q] = nb[q];
            asm volatile("" ::: "memory"); }
    }
};
template <class Epi, class Sched, bool ALIGN_EPI = false, bool SP2 = false>
__device__ __forceinline__ void gemm_phase(PG8_LAS unsigned char* lds, const Gemm g, const Sched& S, const Epi& E) {
    int tid_ = threadIdx.x; asm volatile("" : "+v"(tid_)); const int tid = tid_, wid = __builtin_amdgcn_readfirstlane(tid >> 6), lane = tid & 63, wr = wid >> 2, wc = wid & 3, fr = lane & 15, fq = lane >> 4;
    const int K = g.K, nt = K / BK;
    unsigned voffA[2], voffB[2];
#pragma unroll
    for (int i = 0; i < 2; ++i) { int R, C; stage_rc(tid * 16 + i * 8192, R, C); const int Rb = Epi::PERM ? ((R & ~31) + perm32(R & 31)) : R;
        voffA[i] = (unsigned)(R * K + C) * 2u; voffB[i] = (unsigned)(Rb * K + C) * 2u; }
    const size_t kstep = (size_t)(BK * 2);
    const size_t hstep = (size_t)HALF * K * 2;
    const size_t tstep = 2 * hstep;
    const unsigned ldsw = (unsigned)wid * 1024u;
    const int aoff = lds_byte(wr * 64 + fr, fq * 8), boff = lds_byte(wc * 32 + fr, fq * 8);
#define PG8_SA(b, h) (((b) * 2 + (h)) * HTB)
#define PG8_SB(b, h) ((4 + (b) * 2 + (h)) * HTB)
#define PG8_STAGE(bufoff, gbase, voff) do { _Pragma("unroll") for (int _i = 0; _i < 2; ++_i) \
        __builtin_amdgcn_global_load_lds((const unsigned*)((const char*)(gbase) + (voff)[_i]), (PG8_LAS unsigned*)(lds + (bufoff) + ldsw + _i * 8192), 16, 0, 0); } while (0)
#define PG8_LDA(dst, b, h) do { _Pragma("unroll") for (int m = 0; m < 4; ++m) _Pragma("unroll") for (int k = 0; k < 2; ++k) dst[m][k] = *(const PG8_LAS bf16x8*)(lds + PG8_SA(b, h) + aoff + m * 2048 + k * 1024); } while (0)
#define PG8_LDB(dst, b, h) do { _Pragma("unroll") for (int n = 0; n < 2; ++n) _Pragma("unroll") for (int k = 0; k < 2; ++k) dst[n][k] = *(const PG8_LAS bf16x8*)(lds + PG8_SB(b, h) + boff + n * 2048 + k * 1024); } while (0)
#define PG8_MMA(ai, bj, At, Bt) do { __builtin_amdgcn_s_setprio(1); _Pragma("unroll") for (int m = 0; m < 4; ++m) _Pragma("unroll") for (int n = 0; n < 2; ++n) _Pragma("unroll") for (int k = 0; k < 2; ++k) \
        acc[ai][bj][m][n] = __builtin_amdgcn_mfma_f32_16x16x32_bf16(Bt[n][k], At[m][k], acc[ai][bj][m][n], 0, 0, 0); __builtin_amdgcn_s_setprio(0); } while (0)
#define PG8_WAIT_V(n) asm volatile("s_waitcnt vmcnt(" #n ")" ::: "memory")
#define PG8_WAIT_L(n) asm volatile("s_waitcnt lgkmcnt(" #n ")" ::: "memory")
#define PG8_BAR __builtin_amdgcn_s_barrier()
#define PG8_SCHED __builtin_amdgcn_sched_barrier(0)
    Unit cur, nxt; int ui = 0;
    if (!S.next(0, cur)) return;
    f32x4 acc[2][2][4][2];
#pragma unroll
    for (int a = 0; a < 2; ++a)
#pragma unroll
        for (int b = 0; b < 2; ++b)
#pragma unroll
            for (int m = 0; m < 4; ++m)
#pragma unroll
                for (int n = 0; n < 2; ++n) acc[a][b][m][n] = (f32x4){0.f, 0.f, 0.f, 0.f};
    bf16x8 At[4][2], B0[2][2], B1[2][2];
    const char* cA = (const char*)g.A + (size_t)cur.pm * tstep; const char* cB = (const char*)g.Bt + (size_t)cur.pn * tstep;
    S.a_ready(cur);
    if constexpr (SP2) {
        PG8_STAGE(PG8_SB(0, 0), cB, voffB); PG8_STAGE(PG8_SB(0, 1), cB + hstep, voffB); PG8_STAGE(PG8_SA(0, 0), cA, voffA); PG8_STAGE(PG8_SA(0, 1), cA + hstep, voffA);
        if (wr == 1) PG8_BAR;
        PG8_WAIT_V(2); PG8_BAR;
        PG8_STAGE(PG8_SB(1, 0), cB + kstep, voffB); PG8_STAGE(PG8_SA(1, 0), cA + kstep, voffA); PG8_STAGE(PG8_SB(1, 1), cB + hstep + kstep, voffB);
        PG8_WAIT_V(6); PG8_BAR;
    } else {
        PG8_STAGE(PG8_SB(0, 0), cB, voffB); PG8_STAGE(PG8_SA(0, 0), cA, voffA); PG8_STAGE(PG8_SB(0, 1), cB + hstep, voffB); PG8_STAGE(PG8_SA(0, 1), cA + hstep, voffA);
        if (wr == 1) PG8_BAR;
        PG8_WAIT_V(4); PG8_BAR;
        PG8_STAGE(PG8_SB(1, 0), cB + kstep, voffB); PG8_STAGE(PG8_SA(1, 0), cA + kstep, voffA); PG8_STAGE(PG8_SB(1, 1), cB + hstep + kstep, voffB);
        PG8_WAIT_V(6); PG8_BAR;
    }
    for (;;) {
        const bool has_next = S.next(ui + 1, nxt);
        const char* nA = has_next ? (const char*)g.A + (size_t)nxt.pm * tstep : cA; const char* nB = has_next ? (const char*)g.Bt + (size_t)nxt.pn * tstep : cB;
        for (int t = 0; t < nt; t += 2) {
            const bool last = (t == nt - 2);
            const char* a1 = cA + (size_t)(t + 1) * kstep;
            const char* a2 = last ? nA : cA + (size_t)(t + 2) * kstep; const char* b2 = last ? nB : cB + (size_t)(t + 2) * kstep;
            const char* a3 = a2 + kstep; const char* b3 = b2 + kstep;
            if (last && has_next) S.a_ready(nxt);
            if constexpr (SP2) {
            PG8_LDB(B0, 0, 0); PG8_LDB(B1, 0, 1); PG8_SCHED; PG8_LDA(At, 0, 0); PG8_STAGE(PG8_SA(1, 1), a1 + hstep, voffA);
            PG8_WAIT_V(8); PG8_WAIT_L(0); PG8_BAR; PG8_MMA(0, 0, At, B0); PG8_MMA(0, 1, At, B1); PG8_BAR; PG8_SCHED;
            PG8_LDA(At, 0, 1); PG8_STAGE(PG8_SB(0, 0), b2, voffB); PG8_STAGE(PG8_SB(0, 1), b2 + hstep, voffB); PG8_STAGE(PG8_SA(0, 0), a2, voffA);
            PG8_WAIT_V(8); PG8_WAIT_L(0); PG8_BAR; PG8_MMA(1, 0, At, B0); PG8_MMA(1, 1, At, B1); PG8_BAR; PG8_SCHED;
            PG8_LDB(B0, 1, 0); PG8_LDB(B1, 1, 1); PG8_SCHED; PG8_LDA(At, 1, 0); PG8_STAGE(PG8_SA(0, 1), a2 + hstep, voffA);
            PG8_WAIT_V(8); PG8_WAIT_L(0); PG8_BAR; PG8_MMA(0, 0, At, B0); PG8_MMA(0, 1, At, B1); PG8_BAR; PG8_SCHED;
            PG8_LDA(At, 1, 1); PG8_STAGE(PG8_SB(1, 0), b3, voffB); PG8_STAGE(PG8_SB(1, 1), b3 + hstep, voffB); PG8_STAGE(PG8_SA(1, 0), a3, voffA);
            PG8_WAIT_V(8); PG8_WAIT_L(0); PG8_BAR; PG8_MMA(1, 0, At, B0); PG8_MMA(1, 1, At, B1); PG8_BAR; PG8_SCHED;
            } else {
            PG8_LDB(B0, 0, 0); PG8_SCHED; PG8_LDA(At, 0, 0); PG8_STAGE(PG8_SA(1, 1), a1 + hstep, voffA);
            PG8_WAIT_L(8); PG8_BAR; PG8_WAIT_L(0); PG8_MMA(0, 0, At, B0); PG8_BAR; PG8_SCHED;
            PG8_LDB(B1, 0, 1); PG8_STAGE(PG8_SB(0, 0), b2, voffB);
            PG8_BAR; PG8_WAIT_L(0); PG8_MMA(0, 1, At, B1); PG8_BAR;
            PG8_LDA(At, 0, 1); PG8_STAGE(PG8_SA(0, 0), a2, voffA);
            PG8_BAR; PG8_WAIT_L(0); PG8_MMA(1, 0, At, B0); PG8_BAR; PG8_SCHED;
            PG8_STAGE(PG8_SB(0, 1), b2 + hstep, voffB);
            PG8_WAIT_V(6); PG8_BAR; PG8_MMA(1, 1, At, B1); PG8_BAR;
            PG8_LDB(B0, 1, 0); PG8_SCHED; PG8_LDA(At, 1, 0); PG8_STAGE(PG8_SA(0, 1), a2 + hstep, voffA);
            PG8_WAIT_L(8); PG8_BAR; PG8_WAIT_L(0); PG8_MMA(0, 0, At, B0); PG8_BAR; PG8_SCHED;
            PG8_LDB(B1, 1, 1); PG8_STAGE(PG8_SB(1, 0), b3, voffB);
            PG8_BAR; PG8_WAIT_L(0); PG8_MMA(0, 1, At, B1); PG8_BAR;
            PG8_LDA(At, 1, 1); PG8_STAGE(PG8_SA(1, 0), a3, voffA);
            PG8_BAR; PG8_WAIT_L(0); PG8_MMA(1, 0, At, B0); PG8_BAR; PG8_SCHED;
            PG8_STAGE(PG8_SB(1, 1), b3 + hstep, voffB);
            PG8_WAIT_V(6); PG8_BAR; PG8_MMA(1, 1, At, B1); PG8_BAR;
            }
        }
        if constexpr (ALIGN_EPI) { if (wr == 0) PG8_BAR; }
        if constexpr (!Epi::AFTER_DRAIN) { E(acc, cur, wr, wc, fr, fq); S.done(cur); }
        if (!has_next) break;
#pragma unroll
        for (int a = 0; a < 2; ++a)
#pragma unroll
            for (int b = 0; b < 2; ++b)
#pragma unroll
                for (int m = 0; m < 4; ++m)
#pragma unroll
                    for (int n = 0; n < 2; ++n) acc[a][b][m][n] = (f32x4){0.f, 0.f, 0.f, 0.f};
        cur = nxt; cA = nA; cB = nB; ++ui;
        if constexpr (ALIGN_EPI) { if (wr == 1) PG8_BAR; }
    }
    PG8_WAIT_V(0);
    if constexpr (!ALIGN_EPI) { if (wr == 0) PG8_BAR; }
    PG8_BAR;
    if constexpr (Epi::AFTER_DRAIN) { E.fused(acc, cur, wr, wc, fr, fq, lds, wid, lane); S.done(cur); }
#undef PG8_SA
#undef PG8_SB
#undef PG8_STAGE
#undef PG8_LDA
#undef PG8_LDB
#undef PG8_MMA
#undef PG8_WAIT_V
#undef PG8_WAIT_L
#undef PG8_BAR
#undef PG8_SCHED
}
}

#define PG8_SP2 true
#define PG8_ALIGN true
namespace attn_body {
using bf16=__hip_bfloat16;
using bf16x8=__attribute__((ext_vector_type(8)))short;
using s16x4=__attribute__((ext_vector_type(4)))short;
using f32x16=__attribute__((ext_vector_type(16)))float;
using u32x4=__attribute__((ext_vector_type(4)))unsigned;
constexpr int BATCH=8,NHEAD=6,SEQ=4096,D=64,DM=3328,OPITCH=1024;
constexpr int NW=8,QBLK=32,QB=QBLK*NW,KVBLK=64,NQB=SEQ/QB;
constexpr int ATTN_PITCH=DM, ATTN_UNIT_ROWS=QB;
__device__ __forceinline__ int crow(int r,int hi){return (r&3)+8*(r>>2)+4*hi;}
#define SBAR() __builtin_amdgcn_sched_barrier(0)
__device__ __forceinline__ void cmask(f32x16&p0,f32x16&p1,int jb,int qrel,int hi){
  const float NEG=-INFINITY; int kb=64*jb+4*hi;
  #pragma unroll
  for(int r=0;r<16;++r){int kv=kb+(r&3)+8*(r>>2); if(kv>qrel)p0[r]=NEG; if(kv+32>qrel)p1[r]=NEG;}
}

constexpr int NSLOT=3, SLOTB=8192;
constexpr int LDS_K=0, LDS_V=NSLOT*SLOTB, LDS_WS=2*NSLOT*SLOTB, LDS_OST=LDS_WS+NW*64*4, LDS_OST1=LDS_OST+NW*4096, LDS_BYTES=LDS_OST1+NW*4096;
constexpr float C2=0.17677669529663687f*1.4426950408889634f;
__device__ __forceinline__ void glds16(const void*gsrc,unsigned lds_dst){unsigned keep;
  asm volatile("s_mov_b32 %0, m0\n\ts_mov_b32 m0, %2\n\ts_nop 0\n\tglobal_load_lds_dwordx4 %1, off\n\ts_mov_b32 m0, %0":"=&s"(keep):"v"(gsrc),"s"(lds_dst):"memory");}
__device__ __forceinline__ float max3f(float a,float b,float c){float r;asm("v_max3_f32 %0, %1, %2, %3":"=v"(r):"v"(a),"v"(b),"v"(c));return r;}
__device__ __forceinline__ float max2f(float a,float b){float r;asm("v_max_f32_e32 %0, %1, %2":"=v"(r):"v"(a),"v"(b));return r;}
__device__ __forceinline__ float fadd_s(float a,float b){float r;asm("v_add_f32_e32 %0, %1, %2":"=v"(r):"v"(a),"v"(b));return r;}
__device__ __forceinline__ float fsub_s(float a,float b){float r;asm("v_sub_f32_e32 %0, %1, %2":"=v"(r):"v"(a),"v"(b));return r;}
typedef float f32x2_t __attribute__((ext_vector_type(2))); typedef __bf16 bf16x2_t __attribute__((ext_vector_type(2)));
__device__ __forceinline__ unsigned cvtpk_s(float lo,float hi){f32x2_t v={lo,hi};bf16x2_t b=__builtin_convertvector(v,bf16x2_t);return __builtin_bit_cast(unsigned,b);}
#define WAIT_BAR(N) asm volatile("s_waitcnt vmcnt(" #N ") lgkmcnt(0)\n\ts_barrier":::"memory")

__device__ __forceinline__ void qkt(f32x16&p0,f32x16&p1,const char*Kslot,const bf16x8*qr,const f32x16&negm,int r32,int hi){
  const char*kb=Kslot+hi*1024+r32*16;
  #pragma unroll
  for(int d0=0;d0<4;++d0){
    const bf16x8 b0=*reinterpret_cast<const bf16x8*>(kb+d0*2048);
    const bf16x8 b1=*reinterpret_cast<const bf16x8*>(kb+d0*2048+512);
    if(d0==0){p0=__builtin_amdgcn_mfma_f32_32x32x16_bf16(b0,qr[0],negm,0,0,0);p1=__builtin_amdgcn_mfma_f32_32x32x16_bf16(b1,qr[0],negm,0,0,0);}
    else{p0=__builtin_amdgcn_mfma_f32_32x32x16_bf16(b0,qr[d0],p0,0,0,0);p1=__builtin_amdgcn_mfma_f32_32x32x16_bf16(b1,qr[d0],p1,0,0,0);}}
}
typedef __attribute__((address_space(3))) const char* lds_cptr;
typedef short v4i16_t __attribute__((ext_vector_type(4)));
__device__ __forceinline__ void kload8(bf16x8*kf,lds_cptr kp){
  kf[0]=*(const __attribute__((address_space(3))) bf16x8*)(kp);      kf[1]=*(const __attribute__((address_space(3))) bf16x8*)(kp+512);
  kf[2]=*(const __attribute__((address_space(3))) bf16x8*)(kp+2048); kf[3]=*(const __attribute__((address_space(3))) bf16x8*)(kp+2560);
  kf[4]=*(const __attribute__((address_space(3))) bf16x8*)(kp+4096); kf[5]=*(const __attribute__((address_space(3))) bf16x8*)(kp+4608);
  kf[6]=*(const __attribute__((address_space(3))) bf16x8*)(kp+6144); kf[7]=*(const __attribute__((address_space(3))) bf16x8*)(kp+6656);
}
__device__ __forceinline__ void kload2(bf16x8*kf,lds_cptr kp,int j){ kf[2*j]=*(const __attribute__((address_space(3))) bf16x8*)(kp+j*2048); kf[2*j+1]=*(const __attribute__((address_space(3))) bf16x8*)(kp+j*2048+512); }
__device__ __forceinline__ s16x4 vtr(lds_cptr p){ return __builtin_bit_cast(s16x4,__builtin_amdgcn_ds_read_tr16_b64_v4i16((__attribute__((address_space(3))) v4i16_t*)p)); }
__device__ __forceinline__ float rowmax(const f32x16&p0,const f32x16&p1){
  float a=max3f(p0[0],p0[1],p1[0]),b=max3f(p0[2],p0[3],p1[1]);a=max3f(a,p1[2],p1[3]);
  #pragma unroll
  for(int r=4;r<16;r+=4){a=max3f(a,p0[r],p0[r+1]);b=max3f(b,p0[r+2],p0[r+3]);a=max3f(a,p1[r],p1[r+1]);b=max3f(b,p1[r+2],p1[r+3]);}
  const float m=max2f(a,b);
  auto rr=__builtin_amdgcn_permlane32_swap(__float_as_uint(m),__float_as_uint(m),false,false);
  return max2f(__uint_as_float(rr[0]),__uint_as_float(rr[1]));
}
__device__ __forceinline__ void pv(f32x16*o,int vb,bf16x8 pa0,bf16x8 pa1,bf16x8 pa2,bf16x8 pa3){
  #pragma unroll
  for(int d0=0;d0<2;++d0){s16x4 lo[4],hi[4];
    #pragma unroll
    for(int ks=0;ks<4;++ks){
      asm volatile("ds_read_b64_tr_b16 %0,%1 offset:%c2":"=&v"(lo[ks]):"v"(vb),"i"(d0*4096+ks*1024):"memory");
      asm volatile("ds_read_b64_tr_b16 %0,%1 offset:%c2":"=&v"(hi[ks]):"v"(vb),"i"(d0*4096+ks*1024+512):"memory");}
    asm volatile("s_waitcnt lgkmcnt(0)":::"memory");SBAR();
    #define PK(k) (bf16x8){lo[k][0],lo[k][1],lo[k][2],lo[k][3],hi[k][0],hi[k][1],hi[k][2],hi[k][3]}
    o[d0]=__builtin_amdgcn_mfma_f32_32x32x16_bf16(pa0,PK(0),o[d0],0,0,0);
    o[d0]=__builtin_amdgcn_mfma_f32_32x32x16_bf16(pa1,PK(1),o[d0],0,0,0);
    o[d0]=__builtin_amdgcn_mfma_f32_32x32x16_bf16(pa2,PK(2),o[d0],0,0,0);
    o[d0]=__builtin_amdgcn_mfma_f32_32x32x16_bf16(pa3,PK(3),o[d0],0,0,0);
    #undef PK
  }
}

#ifndef ATTN_STORE16
#define ATTN_STORE16(p,v) (*(u32x4*)(p)=(v))
#endif
template<int THRL> __device__ __forceinline__ void attn_unit(int b,int h,int qb,int nsel,float lam,const float*subg,float omli,const bf16*Q,const bf16*__restrict__ K,const bf16*__restrict__ V,bf16*O,char*shm){
  int tid_=threadIdx.x; asm volatile("":"+v"(tid_)); const int tid=tid_,lane=tid&63,r32=lane&31,hi=lane>>5; const int wid=__builtin_amdgcn_readfirstlane(tid>>6);
  const long rowbase=(long)b*SEQ; const int q0=qb*QB;
  const bf16*Qw=Q+(rowbase+q0+wid*QBLK)*DM+h*D;
  const bf16*Kh=K+rowbase*DM+h*D,*Vh=V+rowbase*DM+h*D;
  const unsigned lds0=(unsigned)(uintptr_t)shm;
  float*wsf=(float*)(shm+LDS_WS)+wid*64;
  const bf16*ksrc=Kh+(long)lane*DM+wid*8;
  const bf16*vsrc=Vh+(long)(16*(wid&3)+(lane>>2))*DM+(wid>>2)*32+(lane&3)*8;
  const unsigned kdst=lds0+LDS_K+wid*1024, vdst=lds0+LDS_V+wid*1024;
  #define DMA_K(t,slot) glds16(ksrc+(long)(t)*KVBLK*DM,(unsigned)__builtin_amdgcn_readfirstlane(kdst+(slot)))
  #define DMA_V(t,slot) glds16(vsrc+(long)(t)*KVBLK*DM,(unsigned)__builtin_amdgcn_readfirstlane(vdst+(slot)))
  const int vb0=(int)(lds0+LDS_V)+((lane>>4)&1)*32+(lane&3)*8+(4*hi+((lane&15)>>2))*64;
  const char*Kbase=shm+LDS_K; bf16x8 kf[8];
  const lds_cptr shm3=(lds_cptr)shm; const lds_cptr kp0=shm3+LDS_K+hi*1024+r32*16; const lds_cptr vp0=shm3+LDS_V+((lane>>4)&1)*32+(lane&3)*8+(4*hi+((lane&15)>>2))*64;
  const int NT=(q0+QB)/KVBLK;
  DMA_K(0,0);DMA_V(0,0);DMA_K(1,SLOTB);
  bf16x8 qr[4];
  #pragma unroll
  for(int d0=0;d0<4;++d0){qr[d0]=*reinterpret_cast<const bf16x8*>(&Qw[(long)r32*DM+d0*16+hi*8]); if((d0>>1)!=nsel)qr[d0]=bf16x8{0,0,0,0,0,0,0,0};}
  float mhat=0.f,l_reg=0.f;f32x16 o[2];o[0]=f32x16{};o[1]=f32x16{};f32x16 negm=f32x16{};asm volatile("":"+v"(negm));
  const int qrel=wid*QBLK+r32;
  #define CMASK(P0,P1,t) do{int jb_=(t)-(NT-4); if(jb_>=0)cmask(P0,P1,jb_,qrel,hi);}while(0)
  bool resc=false;
  #define START(P0,P1) do{ const float rm=rowmax(P0,P1); resc=false; \
    { const float dl=rm; mhat=fadd_s(mhat,dl); \
      _Pragma("unroll") for(int r=0;r<16;++r){P0[r]=fsub_s(P0[r],dl);P1[r]=fsub_s(P1[r],dl);} \
      _Pragma("unroll") for(int r=0;r<16;++r)negm[r]=-mhat; asm volatile("":"+v"(negm)); } \
    _Pragma("unroll") for(int r=0;r<16;++r)P0[r]=__builtin_amdgcn_exp2f(P0[r]); }while(0)
  #define RESC() do{ if(resc){ asm volatile("s_waitcnt lgkmcnt(0)":::"memory"); \
      _Pragma("unroll") for(int d_=0;d_<2;++d_) _Pragma("unroll") for(int r=0;r<16;++r)o[d_][r]*=wsf[crow(r,hi)]; } }while(0)
  f32x16 pA0,pA1,pB0,pB1;
  int sl_prev=0,sl_cur=0,sl_next=SLOTB;
  #define ROT() do{sl_prev=sl_cur;sl_cur=sl_next;sl_next=(sl_next==(NSLOT-1)*SLOTB)?0:sl_next+SLOTB;}while(0)
  DMA_K(2,2*SLOTB);
  WAIT_BAR(3);
  qkt(pA0,pA1,Kbase,qr,negm,r32,hi);asm volatile("s_nop 15\n\ts_nop 7":"+v"(pA0),"+v"(pA1));CMASK(pA0,pA1,0);
  START(pA0,pA1);
  _Pragma("unroll") for(int r=0;r<16;++r)pA1[r]=__builtin_amdgcn_exp2f(pA1[r]);
  WAIT_BAR(0);
  DMA_K(3,0);DMA_V(1,SLOTB);
  ROT();
  kload8(kf,kp0+sl_cur);
  WAIT_BAR(2);
  s16x4 vlo[8],vhi[8]; u32x4 pw0,pw1,pw2,pw3;
  #define PKW(P,B) cvtpk_s(P[B],P[B+1])
  #define PAF(k) __builtin_bit_cast(bf16x8,pw##k)
  #define VFR(i) (bf16x8){vlo[i][0],vlo[i][1],vlo[i][2],vlo[i][3],vhi[i][0],vhi[i][1],vhi[i][2],vhi[i][3]}
  #define PIN(x) asm volatile("":"+v"(x))
  #define MX3(a,b,c) __builtin_fmaxf(__builtin_fmaxf((a),(b)),(c))
  #define GAPA(MF,A0,A1,A2,A3,W0,W1,PW) do{ MF; sacc+=A0; sacc+=A1; sacc+=A2; sacc+=A3; PIN(sacc); W0; W1; PIN(PW); SBAR(); }while(0)
  #define EX(v) __builtin_amdgcn_exp2f(v)
  #define GAPB(MF,X,B) do{ MF; X[B]=EX(X[B]); X[B+1]=EX(X[B+1]); X[B+2]=EX(X[B+2]); X[B+3]=EX(X[B+3]); PIN(X); SBAR(); }while(0)
  #define VRD(i) do{ vlo[i]=vtr(vp_+(((i)>>2)*4096+((i)&3)*1024)); vhi[i]=vtr(vp_+(((i)>>2)*4096+((i)&3)*1024+512)); }while(0)
  #define KRD(G,j) do{ if(G){ kload2(kf,kp0+sl_next,j); SBAR(); } }while(0)
  #define STEP(C0,C1,P0,P1,t,GK,GV,GL) do{ SBAR(); \
    const lds_cptr vp_=vp0+sl_prev; \
    VRD(0); SBAR(); float sacc=(P0[0]+P0[1]); \
    GAPA(C0=__builtin_amdgcn_mfma_f32_32x32x16_bf16(kf[0],qr[0],negm,0,0,0), P0[2],P0[3],P0[4],P0[5],     pw0[0]=PKW(P0,0), pw0[1]=PKW(P0,2), pw0); \
    VRD(4); SBAR(); GAPA(C1=__builtin_amdgcn_mfma_f32_32x32x16_bf16(kf[1],qr[0],negm,0,0,0), P0[6],P0[7],P0[8],P0[9],     pw0[2]=PKW(P0,4), pw0[3]=PKW(P0,6), pw0); \
    VRD(1); SBAR(); GAPA(C0=__builtin_amdgcn_mfma_f32_32x32x16_bf16(kf[2],qr[1],C0,0,0,0),   P0[10],P0[11],P0[12],P0[13], pw1[0]=PKW(P0,8), pw1[1]=PKW(P0,10), pw1); \
    VRD(5); SBAR(); GAPA(C1=__builtin_amdgcn_mfma_f32_32x32x16_bf16(kf[3],qr[1],C1,0,0,0),   P0[14],P0[15],P1[0],P1[1],   pw1[2]=PKW(P0,12),pw1[3]=PKW(P0,14), pw1); \
    VRD(2); SBAR(); GAPA(C0=__builtin_amdgcn_mfma_f32_32x32x16_bf16(kf[4],qr[2],C0,0,0,0),   P1[2],P1[3],P1[4],P1[5],     pw2[0]=PKW(P1,0), pw2[1]=PKW(P1,2), pw2); \
    VRD(6); SBAR(); GAPA(C1=__builtin_amdgcn_mfma_f32_32x32x16_bf16(kf[5],qr[2],C1,0,0,0),   P1[6],P1[7],P1[8],P1[9],     pw2[2]=PKW(P1,4), pw2[3]=PKW(P1,6), pw2); \
    VRD(3); SBAR(); GAPA(C0=__builtin_amdgcn_mfma_f32_32x32x16_bf16(kf[6],qr[3],C0,0,0,0),   P1[10],P1[11],P1[12],P1[13], pw3[0]=PKW(P1,8), pw3[1]=PKW(P1,10), pw3); \
    VRD(7); SBAR(); GAPA(C1=__builtin_amdgcn_mfma_f32_32x32x16_bf16(kf[7],qr[3],C1,0,0,0),   P1[14],P1[15],0.f,0.f,       pw3[2]=PKW(P1,12),pw3[3]=PKW(P1,14), pw3); \
    l_reg+=sacc; \
    if(GK){DMA_K((t)+3,sl_cur);} if(GV){DMA_V((t)+1,sl_next);} \
    CMASK(C0,C1,t); \
    { float a=MX3(C0[0],C0[1],C1[0]),b=MX3(C0[2],C0[3],C1[1]); a=MX3(a,C1[2],C1[3]); \
      _Pragma("unroll") for(int r=4;r<16;r+=4){a=MX3(a,C0[r],C0[r+1]);b=MX3(b,C0[r+2],C0[r+3]);a=MX3(a,C1[r],C1[r+1]);b=MX3(b,C1[r+2],C1[r+3]);} \
      float rm=__builtin_fmaxf(a,b); { auto rr=__builtin_amdgcn_permlane32_swap(__float_as_uint(rm),__float_as_uint(rm),false,false); rm=__builtin_fmaxf(__uint_as_float(rr[0]),__uint_as_float(rr[1])); } \
      resc=false; \
      if(__builtin_expect(__any(rm>(float)THRL),0)){ const float dl=__builtin_fmaxf(rm,0.f); mhat+=dl; \
        _Pragma("unroll") for(int r=0;r<16;++r){C0[r]-=dl;C1[r]-=dl;} \
        _Pragma("unroll") for(int r=0;r<16;++r)negm[r]=-mhat; asm volatile("":"+v"(negm)); \
        const float f=__builtin_amdgcn_exp2f(-dl); l_reg*=f; if(hi==0)wsf[r32]=f; resc=true; } } \
    SBAR(); \
    GAPB(o[0]=__builtin_amdgcn_mfma_f32_32x32x16_bf16(PAF(0),VFR(0),o[0],0,0,0), C0,0); \
    GAPB(o[1]=__builtin_amdgcn_mfma_f32_32x32x16_bf16(PAF(0),VFR(4),o[1],0,0,0), C0,4); \
    KRD(GL,0); GAPB(o[0]=__builtin_amdgcn_mfma_f32_32x32x16_bf16(PAF(1),VFR(1),o[0],0,0,0), C0,8); \
    KRD(GL,1); GAPB(o[1]=__builtin_amdgcn_mfma_f32_32x32x16_bf16(PAF(1),VFR(5),o[1],0,0,0), C0,12); \
    KRD(GL,2); GAPB(o[0]=__builtin_amdgcn_mfma_f32_32x32x16_bf16(PAF(2),VFR(2),o[0],0,0,0), C1,0); \
    KRD(GL,3); GAPB(o[1]=__builtin_amdgcn_mfma_f32_32x32x16_bf16(PAF(2),VFR(6),o[1],0,0,0), C1,4); \
    GAPB(o[0]=__builtin_amdgcn_mfma_f32_32x32x16_bf16(PAF(3),VFR(3),o[0],0,0,0), C1,8); \
    GAPB(o[1]=__builtin_amdgcn_mfma_f32_32x32x16_bf16(PAF(3),VFR(7),o[1],0,0,0), C1,12); \
    }while(0)
  int t=1;
  #undef CMASK
  #define CMASK(P0,P1,t) do{}while(0)
  for(;t+5<NT;t+=2){
    STEP(pB0,pB1,pA0,pA1,t,true,true,true);     WAIT_BAR(2); RESC(); ROT();
    STEP(pA0,pA1,pB0,pB1,t+1,true,true,true);   WAIT_BAR(2); RESC(); ROT();
  }
  #undef CMASK
  #define CMASK(P0,P1,t) do{int jb_=(t)-(NT-4); if(jb_>=0)cmask(P0,P1,jb_,qrel,hi);}while(0)
  #define ENDW(tt) do{ if((tt)+3<NT){WAIT_BAR(2);} else if((tt)+2<NT){WAIT_BAR(1);} else {WAIT_BAR(0);} }while(0)
  for(;t+1<NT;t+=2){
    STEP(pB0,pB1,pA0,pA1,t,(t+3<NT),(t+1<NT),(t+1<NT));       ENDW(t);   RESC(); ROT();
    STEP(pA0,pA1,pB0,pB1,t+1,(t+4<NT),(t+2<NT),(t+2<NT));     ENDW(t+1); RESC(); ROT();
  }
  STEP(pB0,pB1,pA0,pA1,NT-1,false,false,false); RESC();
  { float sacc=pB0[0]+pB0[1]; _Pragma("unroll") for(int r=2;r<16;++r)sacc+=pB0[r]; _Pragma("unroll") for(int r=0;r<16;++r)sacc+=pB1[r]; l_reg+=sacc;
    pw0=(u32x4){PKW(pB0,0),PKW(pB0,2),PKW(pB0,4),PKW(pB0,6)};pw1=(u32x4){PKW(pB0,8),PKW(pB0,10),PKW(pB0,12),PKW(pB0,14)};pw2=(u32x4){PKW(pB1,0),PKW(pB1,2),PKW(pB1,4),PKW(pB1,6)};pw3=(u32x4){PKW(pB1,8),PKW(pB1,10),PKW(pB1,12),PKW(pB1,14)};
    SBAR(); pv(o,vb0+sl_cur,PAF(0),PAF(1),PAF(2),PAF(3)); }
  #undef PKW
  #undef PAF
  #undef VFR
  #undef PIN
  #undef MX3
  #undef GAPA
  #undef GAPB
  #undef EX
  #undef VRD
  #undef KRD
  #undef STEP
  #undef ENDW
  {auto rr=__builtin_amdgcn_permlane32_swap(__float_as_uint(l_reg),__float_as_uint(l_reg),false,false);l_reg=__uint_as_float(rr[0])+__uint_as_float(rr[1]);}
  if(hi==0)wsf[32+r32]=l_reg;asm volatile("s_waitcnt lgkmcnt(0)":::"memory");
  float rli[16];
  #pragma unroll
  for(int r=0;r<16;++r)rli[r]=__builtin_amdgcn_rcpf(wsf[32+crow(r,hi)]);
  bf16*Ow=O+(rowbase+q0+wid*QBLK)*OPITCH+h*D;
  { bf16*stg=(bf16*)(shm+(nsel==0?LDS_OST1:LDS_OST))+wid*2048;
    #pragma unroll
    for(int r=0;r<16;++r){const int orow=crow(r,hi);
      #pragma unroll
      for(int d0=0;d0<2;++d0)stg[orow*64+d0*32+r32]=__float2bfloat16(o[d0][r]*rli[r]);}
    asm volatile("s_waitcnt lgkmcnt(0)":::"memory");
    if(nsel==1){ const bf16*stg1=(const bf16*)(shm+LDS_OST1)+wid*2048;
      #pragma unroll
      for(int i=0;i<4;++i){const int row=i*8+(lane>>3),ch=lane&7; const u32x4 v2=*(const u32x4*)(stg+row*64+ch*8); const u32x4 v1=*(const u32x4*)(stg1+row*64+ch*8);
        float dd[8]; float ss=0.f;
        #pragma unroll
        for(int j=0;j<4;++j){ const float a0=__uint_as_float(v1[j]<<16),a1=__uint_as_float(v1[j]&0xffff0000u),b0=__uint_as_float(v2[j]<<16),b1=__uint_as_float(v2[j]&0xffff0000u);
          dd[2*j]=a0-lam*b0; dd[2*j+1]=a1-lam*b1; ss+=dd[2*j]*dd[2*j]+dd[2*j+1]*dd[2*j+1]; }
        ss+=__shfl_xor(ss,1); ss+=__shfl_xor(ss,2); ss+=__shfl_xor(ss,4);
        const float rs=omli/sqrtf(ss*(1.0f/64.0f)+1e-6f);
        u32x4 w;
        #pragma unroll
        for(int j=0;j<4;++j) w[j]=cvtpk_s(dd[2*j]*rs*subg[ch*8+2*j],dd[2*j+1]*rs*subg[ch*8+2*j+1]);
        ATTN_STORE16(Ow+(long)row*OPITCH+ch*8,w);} } }
  asm volatile("s_waitcnt lgkmcnt(0)\n\ts_barrier":::"memory");
  #undef DMA_K
  #undef DMA_V
  #undef CMASK
  #undef START
  #undef RESC
  #undef ROT

}
#undef SBAR
#undef WAIT_BAR
}
#ifndef GOFF
#define GOFF 0
#endif
#define GEMMCALL0 if (!((GOFF) & 1))
#define GEMMCALL1 if (!((GOFF) & 2))
#define GEMMCALL2 if (!((GOFF) & 4))
#define GEMMCALL3 if (!((GOFF) & 8))
namespace cg = cooperative_groups;
#define GAS __attribute__((address_space(1)))
#define LAS __attribute__((address_space(3)))
#define DI __device__ __forceinline__
typedef unsigned short bf16;
typedef unsigned v4u __attribute__((ext_vector_type(4)));
typedef unsigned v2u __attribute__((ext_vector_type(2)));
typedef float f32x4 __attribute__((ext_vector_type(4)));
typedef short bf16x8 __attribute__((ext_vector_type(8)));

constexpr int NWAVES = 8;
constexpr int DMODEL = 1024, SEQ = 4096, M = 32768, NIN = 3328, FF = 4096;
constexpr int RW = 384, RCOLS = 1408, ROFF = 1920, COFF = 1152;
constexpr float NORM_EPS = 1e-6f, GN_EPS = 64e-5f;
constexpr size_t MiB = 1u << 20;
constexpr size_t WS_CTL = 0, CTL_ZERO_BYTES = 65536;
constexpr int CW_BAR = 4096;
constexpr size_t WS_SS = 128 * 1024;
constexpr size_t WS_WIN = 1 * MiB, WS_WOUT = 14 * MiB, WS_WUP = 18 * MiB, WS_WDN = 34 * MiB, WS_LORA = 50 * MiB;
constexpr size_t WS_XB = 51 * MiB, WS_PROJ = 115 * MiB, WS_MIX = 323 * MiB, WS_S = 387 * MiB, WS_END = 507 * MiB;
constexpr size_t WS_HID = 115 * MiB;
constexpr size_t WS_AUX = 48 * MiB;
constexpr size_t WS_PT = WS_AUX + 12 * MiB, WS_DOTS = WS_PT + 2 * MiB;
constexpr int NITEMS = 48 * 128;
constexpr size_t SARR = (size_t)M * RW;
constexpr int LORA_L = 384 * 64 * 2 + 384 * 128;
constexpr int LDS_BYTES = 147456, MISC_OFF = 131072;
constexpr int SCAN_WGS = 48, ATT_ITEMS = 768;

#ifndef STAG1
#define STAG1 2000u
#endif
#ifndef STAG3
#define STAG3 3000u
#endif
#ifndef PROBE
#define PROBE 0
#endif
struct Args { const float* in[25]; float* out; unsigned char* ws; int i0, i1; };

DI float wave_sum(float v) {
#pragma unroll
    for (int o = 1; o < 64; o <<= 1) v += __shfl_xor(v, o);
    return v;
}
typedef float f32x2h __attribute__((ext_vector_type(2))); typedef __bf16 bf16x2h __attribute__((ext_vector_type(2)));
DI unsigned pk2(float lo, float hi) { f32x2h v = {lo, hi}; bf16x2h b = __builtin_convertvector(v, bf16x2h); return __builtin_bit_cast(unsigned, b); }
DI unsigned f2bf(float f) { return pk2(f, 0.f) & 0xffffu; }
DI float bflo(unsigned w) { return __uint_as_float(w << 16); }
DI float bfhi(unsigned w) { return __uint_as_float(w & 0xffff0000u); }
DI float bf1(const bf16* p) { return __uint_as_float(((unsigned)*p) << 16); }
DI void unpack8(v4u w, float* f) { f[0] = bflo(w.x); f[1] = bfhi(w.x); f[2] = bflo(w.y); f[3] = bfhi(w.y); f[4] = bflo(w.z); f[5] = bfhi(w.z); f[6] = bflo(w.w); f[7] = bfhi(w.w); }
DI v4u pack8(const float* f) { v4u o; o.x = pk2(f[0], f[1]); o.y = pk2(f[2], f[3]); o.z = pk2(f[4], f[5]); o.w = pk2(f[6], f[7]); return o; }
DI float sigmoidf_(float x) { return __builtin_amdgcn_rcpf(1.f + __expf(-x)); }
DI float tanhf_(float x) { const float e = __expf(2.f * x); return 1.f - 2.f * __builtin_amdgcn_rcpf(e + 1.f); }
template <int CTRL> DI float dpp_add(float x) { return x + __int_as_float(__builtin_amdgcn_update_dpp(0, __float_as_int(x), CTRL, 0xf, 0xf, true)); }
DI float red16(float x) { x = dpp_add<0xB1>(x); x = dpp_add<0x4E>(x); x = dpp_add<0x141>(x); x = dpp_add<0x140>(x); return x; }

#define XB_TMO      128
#define XB_XCNT(j)  (256  + 64 * (j))
#define XB_XSUB(j)  (1280 + 64 * (j))
#define XB_XGEN(j)  (2304 + 64 * (j))
#define XB_TOP      3328
#define XB_TOPGEN   3392
#define XCD_BAR_WORDS 3456
#define XB_SPIN_CAP (1u << 18)

__device__ __forceinline__ unsigned xb_ld(unsigned* p)              { return __hip_atomic_load(p, __ATOMIC_RELAXED, __HIP_MEMORY_SCOPE_AGENT); }
__device__ __forceinline__ unsigned xb_add(unsigned* p, unsigned v) { return __hip_atomic_fetch_add(p, v, __ATOMIC_RELAXED, __HIP_MEMORY_SCOPE_AGENT); }
__device__ __forceinline__ unsigned xb_xcc_id() { return (unsigned)__builtin_amdgcn_s_getreg((3 << 11) | 20) & 0xFu; }
#define XB_SPIN(cond, bar) do { unsigned _sp = 0; while (cond) { __builtin_amdgcn_s_sleep(1); \
    if ((++_sp & 255u) == 0u) { if (xb_ld(&(bar)[XB_TMO])) break; if (_sp > XB_SPIN_CAP) { atomicAdd(&(bar)[XB_TMO], 1u); break; } } } } while (0)

struct XcdBarrier {
    unsigned* bar; unsigned x;
    volatile LAS unsigned* st;
};

__device__ __forceinline__ XcdBarrier xcd_barrier_post(unsigned* bar, volatile LAS unsigned* st) {
    XcdBarrier b; b.bar = bar; b.x = xb_xcc_id(); b.st = st;
    if (threadIdx.x == 0) (void)xb_add(&bar[XB_XCNT(b.x)], 1u);
    return b;
}
__device__ __forceinline__ void xcd_barrier_complete(unsigned* bar, unsigned x, unsigned& nloc, unsigned& nx) {
    const unsigned G = gridDim.x * gridDim.y * gridDim.z;
    unsigned sum, cnt, mine, sp = 0u;
    for (;;) {
        sum = 0u; cnt = 0u; mine = 0u;
#pragma unroll
        for (unsigned j = 0; j < 16; ++j) { const unsigned c = xb_ld(&bar[XB_XCNT(j)]); sum += c; cnt += (c > 0u) ? 1u : 0u; mine = (j == x) ? c : mine; }
        if (sum == G) break;
        __builtin_amdgcn_s_sleep(1);
        if ((++sp & 255u) == 0u) { if (xb_ld(&bar[XB_TMO])) break; if (sp > XB_SPIN_CAP) { atomicAdd(&bar[XB_TMO], 1u); break; } }
    }
    nloc = mine > 0u ? mine : 1u; nx = cnt > 0u ? cnt : 1u;
}

__device__ __forceinline__ void xcd_barrier(const XcdBarrier& b) {
    asm volatile("s_waitcnt vmcnt(0)" ::: "memory");
    __syncthreads();
    if (threadIdx.x == 0) {
        unsigned* bar = b.bar; unsigned bx_ = xb_xcc_id(); asm volatile("" : "+s"(bx_));
        __builtin_amdgcn_s_waitcnt(0);
        unsigned nloc = b.st[0], nx = b.st[1];
        if (nloc == 0u) { xcd_barrier_complete(bar, bx_, nloc, nx); b.st[0] = nloc; b.st[1] = nx; }
        const unsigned old = xb_add(&bar[XB_XSUB(bx_)], 1u);
        const unsigned gen = old / nloc;
        if (old + 1u == (gen + 1u) * nloc) {
            __builtin_amdgcn_fence(__ATOMIC_RELEASE, "agent");
            asm volatile("s_waitcnt vmcnt(0)" ::: "memory");
            const unsigned og = xb_add(&bar[XB_TOP], 1u);
            const unsigned tg = og / nx;
            if (og + 1u == (tg + 1u) * nx) xb_add(&bar[XB_TOPGEN], 1u);
            else XB_SPIN(xb_ld(&bar[XB_TOPGEN]) == tg, bar);
            __builtin_amdgcn_fence(__ATOMIC_ACQUIRE, "agent");
            xb_add(&bar[XB_XGEN(bx_)], 1u);
            asm volatile("s_waitcnt vmcnt(0)" ::: "memory");
        } else {
            XB_SPIN(xb_ld(&bar[XB_XGEN(bx_)]) == gen, bar);
            __builtin_amdgcn_fence(__ATOMIC_ACQUIRE, "agent");
            asm volatile("s_waitcnt vmcnt(0)" ::: "memory");
        }
    }
    __syncthreads();
}


DI void seam_arrive(unsigned* w) { asm volatile("s_waitcnt vmcnt(0)" ::: "memory"); __syncthreads();
    if (threadIdx.x == 0) { __builtin_amdgcn_fence(__ATOMIC_RELEASE, "agent"); asm volatile("s_waitcnt vmcnt(0)" ::: "memory"); (void)__hip_atomic_fetch_add(w, 1u, __ATOMIC_RELAXED, __HIP_MEMORY_SCOPE_AGENT); } }
DI void seam_wait(unsigned* w, unsigned need) {
    if (threadIdx.x == 0) { unsigned sp = 0u; while (__hip_atomic_load(w, __ATOMIC_RELAXED, __HIP_MEMORY_SCOPE_AGENT) < need) { __builtin_amdgcn_s_sleep(1); if (++sp > (1u << 22)) break; }
        __builtin_amdgcn_fence(__ATOMIC_ACQUIRE, "agent"); asm volatile("s_waitcnt vmcnt(0)" ::: "memory"); }
    __syncthreads(); }
struct Frame {
    LAS unsigned char* lds;
    int tid, lane, wave, G, gw, NGW;
    const float* const* in;
    float* out; unsigned char* ws;
};
DI const float* INP(const Frame& F, int k) { asm volatile("" : "+s"(k)); return F.in[k]; }
#define SSP(k) ((float*)((unsigned char*)F.out + 64 * MiB) + (size_t)(k) * M * 16)
#define F_WIN  ((bf16*)(F.ws + WS_WIN))
#define F_WOUT ((bf16*)(F.ws + WS_WOUT))
#define F_WUP  ((bf16*)(F.ws + WS_WUP))
#define F_WDN  ((bf16*)(F.ws + WS_WDN))
#define F_LORA ((bf16*)(F.ws + WS_LORA))
#define F_XB   ((bf16*)(F.ws + WS_XB))
#define F_PROJ ((bf16*)(F.ws + WS_PROJ))
#define F_MIX  ((bf16*)(F.ws + WS_MIX))
#define F_HID  ((bf16*)(F.ws + WS_HID))
#define F_S_r  ((bf16*)F.out)
#define F_S_ld ((bf16*)F.out + SARR)
#define F_S_k  ((bf16*)(F.ws + WS_S))
#define F_S_v  ((bf16*)(F.ws + WS_S) + SARR)
#define F_S_n  ((bf16*)(F.ws + WS_S) + 2 * SARR)
#define F_S_b  ((bf16*)(F.ws + WS_S) + 3 * SARR)
#define F_S_g  ((bf16*)(F.ws + WS_S) + 4 * SARR)
#define F_ctl  ((unsigned*)(F.ws + WS_CTL))

DI void transpose_item(const float* W, int K, int N, bf16* WT, LAS float* scr, int item, int lane, const float* gk, float cs, int csn) {
    const int nblk = N / 32, kb = item / nblk, nb = item % nblk, k0 = 64 * kb, n0 = 32 * nb;
    const float colscale = (n0 + (lane & 31) < csn) ? cs : 1.f;
#pragma unroll 8
    for (int i = 0; i < 32; ++i) { const int kk = 2 * i + (lane >> 5); float v = __builtin_nontemporal_load(&W[(size_t)(k0 + kk) * N + n0 + (lane & 31)]); if (gk) v *= gk[k0 + kk]; scr[kk * 33 + (lane & 31)] = v * colscale; }
    asm volatile("s_waitcnt lgkmcnt(0)" ::: "memory");
    const int c = lane & 7;
#pragma unroll
    for (int j = 0; j < 4; ++j) { const int n = (lane >> 3) + 8 * j; const LAS float* s = scr + (8 * c) * 33 + n;
        v4u o; o.x = pk2(s[0 * 33], s[1 * 33]); o.y = pk2(s[2 * 33], s[3 * 33]); o.z = pk2(s[4 * 33], s[5 * 33]); o.w = pk2(s[6 * 33], s[7 * 33]);
        *(v4u*)(WT + (size_t)(n0 + n) * K + k0 + 8 * c) = o; }
    asm volatile("s_waitcnt lgkmcnt(0)" ::: "memory");
}
DI Frame refresh(const Frame& F0) { Frame F = F0; int t = threadIdx.x; asm volatile("" : "+v"(t)); int bxx = blockIdx.x; asm volatile("" : "+s"(bxx)); F.tid = t; F.lane = t & 63; F.wave = __builtin_amdgcn_readfirstlane(t >> 6); F.gw = bxx * NWAVES + F.wave; return F; }
DI void stagger(unsigned ticks) { if ((blockIdx.x >> 3) & 1) { const unsigned long long t0 = __builtin_amdgcn_s_memrealtime(); while (__builtin_amdgcn_s_memrealtime() - t0 < ticks) __builtin_amdgcn_s_sleep(8); } }
DI void prologue(const Frame& F0, int l, int w0, int nw) { Frame F = refresh(F0);
    LAS float* scr = (LAS float*)(F.lds + F.wave * 16384);
    constexpr int I_IN = 16 * 104, I_OUT = 16 * 32, I_UP = 16 * 128, I_DN = 64 * 32, I_LW = 12, I_LG = 24;
    constexpr int PER = I_IN + I_OUT + I_UP + I_DN + 2 * I_LW + I_LG;
    constexpr float C2 = 0.17677669529663687f * 1.4426950408889634f;
    for (int it = w0; it < PER; it += nw) {
        int r = it;
        if (r < I_IN) { transpose_item(INP(F, 2) + (size_t)l * DMODEL * NIN, DMODEL, NIN, F_WIN + (size_t)l * NIN * DMODEL, scr, r, F.lane, INP(F, 1) + l * DMODEL, C2, 384); continue; } r -= I_IN;
        if (r < I_OUT) { transpose_item(INP(F, 20) + (size_t)l * DMODEL * DMODEL, DMODEL, DMODEL, F_WOUT + (size_t)l * DMODEL * DMODEL, scr, r, F.lane, nullptr, 1.f, 0); continue; } r -= I_OUT;
        if (r < I_UP) { transpose_item(INP(F, 22) + (size_t)l * DMODEL * FF, DMODEL, FF, F_WUP + (size_t)l * FF * DMODEL, scr, r, F.lane, INP(F, 21) + l * DMODEL, 1.f, 0); continue; } r -= I_UP;
        if (r < I_DN) { transpose_item(INP(F, 23) + (size_t)l * FF * DMODEL, FF, DMODEL, F_WDN + (size_t)l * DMODEL * FF, scr, r, F.lane, nullptr, 1.f, 0); continue; } r -= I_DN;
        bf16* L = F_LORA + (size_t)l * LORA_L;
        if (r < I_LW) { transpose_item(INP(F, 11) + (size_t)l * 64 * RW, 64, RW, L, scr, r, F.lane, nullptr, 1.f, 0); continue; } r -= I_LW;
        if (r < I_LW) { transpose_item(INP(F, 13) + (size_t)l * 64 * RW, 64, RW, L + RW * 64, scr, r, F.lane, nullptr, 1.f, 0); continue; } r -= I_LW;
        transpose_item(INP(F, 14) + (size_t)l * 128 * RW, 128, RW, L + 2 * RW * 64, scr, r, F.lane, nullptr, 1.f, 0);
    }
}
DI void x_to_bf16(const Frame& F0, const float* src, bf16* dst, float* ss) { Frame F = refresh(F0);
    for (int m0 = F.gw; m0 < M; m0 += 4 * F.NGW) {
        f32x4 v[4][4];
#pragma unroll
        for (int q = 0; q < 4; ++q) { const int m = m0 + q * F.NGW; if (m < M) { const f32x4* xr = (const f32x4*)(src + (size_t)m * DMODEL) + F.lane;
#pragma unroll
            for (int j = 0; j < 4; ++j) v[q][j] = __builtin_nontemporal_load(&xr[64 * j]); } }
#pragma unroll
        for (int q = 0; q < 4; ++q) { const int m = m0 + q * F.NGW; if (m < M) { float s2 = 0.f;
#pragma unroll
            for (int j = 0; j < 4; ++j) s2 += (v[q][j].x * v[q][j].x + v[q][j].y * v[q][j].y) + (v[q][j].z * v[q][j].z + v[q][j].w * v[q][j].w);
            s2 = wave_sum(s2); if (F.lane < 16) ss[(size_t)m * 16 + F.lane] = (F.lane == 0) ? s2 : 0.f;
            v2u* o8 = (v2u*)(dst + (size_t)m * DMODEL) + F.lane;
#pragma unroll
            for (int j = 0; j < 4; ++j) { v2u w; w.x = pk2(v[q][j].x, v[q][j].y); w.y = pk2(v[q][j].z, v[q][j].w); o8[64 * j] = w; } } }
    }
}
DI void final_norm(const Frame& F0, const bf16* xb, float* out, const float* g) { Frame F = refresh(F0);
    const f32x4* gr = (const f32x4*)g + F.lane; f32x4 gv[4];
#pragma unroll
    for (int j = 0; j < 4; ++j) gv[j] = gr[64 * j];
    for (int m0 = F.gw; m0 < M; m0 += 4 * F.NGW) {
        v2u w[4][4];
#pragma unroll
        for (int q = 0; q < 4; ++q) { const int m = m0 + q * F.NGW; if (m < M) { const v2u* xr = (const v2u*)(xb + (size_t)m * DMODEL) + F.lane;
#pragma unroll
            for (int j = 0; j < 4; ++j) w[q][j] = __builtin_nontemporal_load(&xr[64 * j]); } }
#pragma unroll
        for (int q = 0; q < 4; ++q) { const int m = m0 + q * F.NGW; if (m < M) { f32x4 v[4]; float s2 = 0.f;
#pragma unroll
            for (int j = 0; j < 4; ++j) { v[j] = (f32x4){bflo(w[q][j].x), bfhi(w[q][j].x), bflo(w[q][j].y), bfhi(w[q][j].y)}; s2 += (v[j].x * v[j].x + v[j].y * v[j].y) + (v[j].z * v[j].z + v[j].w * v[j].w); }
            const float rstd = 1.f / sqrtf(wave_sum(s2) * (1.f / DMODEL) + NORM_EPS);
            f32x4* orow = (f32x4*)(out + (size_t)m * DMODEL) + F.lane;
#pragma unroll
            for (int j = 0; j < 4; ++j) __builtin_nontemporal_store(v[j] * rstd * gv[j], &orow[64 * j]); } }
    }
}

DI void loadz8(const bf16* prow, bool first, const float* mu, int col, float* z) {
    const v4u p = *(const v4u*)(prow + col); v4u q = (v4u){0u, 0u, 0u, 0u}; if (!first) q = *(const v4u*)(prow - NIN + col);
    const f32x4 m0 = *(const f32x4*)(mu + col), m1 = *(const f32x4*)(mu + col + 4);
    float pf[8], qf[8]; unpack8(p, pf); unpack8(q, qf);
#pragma unroll
    for (int j = 0; j < 4; ++j) { z[j] = pf[j] + m0[j] * (qf[j] - pf[j]); z[4 + j] = pf[4 + j] + m1[j] * (qf[4 + j] - pf[4 + j]); }
}
DI void loadz8L(const bf16* prow, bool first, const LAS float* mu, int col, float* z) {
    const v4u p = *(const v4u*)(prow + col); v4u q = (v4u){0u, 0u, 0u, 0u}; if (!first) q = *(const v4u*)(prow - NIN + col);
    const f32x4 m0 = *(const LAS f32x4*)(mu + col), m1 = *(const LAS f32x4*)(mu + col + 4);
    float pf[8], qf[8]; unpack8(p, pf); unpack8(q, qf);
#pragma unroll
    for (int j = 0; j < 4; ++j) { z[j] = pf[j] + m0[j] * (qf[j] - pf[j]); z[4 + j] = pf[4 + j] + m1[j] * (qf[4 + j] - pf[4 + j]); }
}
DI float loadz1(const bf16* prow, bool first, float mu, int col) { const float p = bf1(prow + col); const float q = first ? 0.f : bf1(prow - NIN + col); return p + mu * (q - p); }

DI void prep_phase(const Frame& F0, int l) { Frame F = refresh(F0);
    LAS float* PT = (LAS float*)(F.lds + MISC_OFF + 256);
    {   const float* srcs[6] = {INP(F, 10) + l * RW, INP(F, 12) + l * RW, INP(F, 15) + l * RW, INP(F, 16) + l * RW, INP(F, 17) + l * RW, INP(F, 9) + l * RCOLS};
        for (int i = F.tid; i < 5 * RW + RCOLS; i += NWAVES * 64) { const int a = i < 5 * RW ? i / RW : 5; PT[i] = srcs[a][i - a * RW]; }
        __syncthreads(); }
    const LAS float* w0 = PT; const LAS float* a0 = PT + RW; const LAS float* kkw = PT + 2 * RW; const LAS float* kaw = PT + 3 * RW; const LAS float* rkp = PT + 4 * RW; const LAS float* mu = PT + 5 * RW;
    const bf16* WUT = F_LORA + (size_t)l * LORA_L; const bf16* AUT = WUT + RW * 64; const bf16* GUT = AUT + RW * 64;
    const int row = F.lane & 15, kq = F.lane >> 4, tok = F.lane >> 2, cq = (F.lane & 3) * 16;
    LAS float* LW = (LAS float*)(F.lds + F.wave * 16384);
    for (int tile = F.gw; tile < M / 16; tile += F.NGW) {
        const int t0 = tile * 16;
        bf16x8 Aw[2], Aa[2], Ag[4];
        { const int t = t0 + row; const bool first = (t % SEQ) == 0; const bf16* prow = F_PROJ + (size_t)t * NIN + ROFF; float z[8];
#pragma unroll
          for (int ks = 0; ks < 2; ++ks) { loadz8L(prow, first, mu, 1152 + ks * 32 + kq * 8, z);
#pragma unroll
              for (int j = 0; j < 8; ++j) z[j] = tanhf_(z[j]);
              Aw[ks] = __builtin_bit_cast(bf16x8, pack8(z)); }
#pragma unroll
          for (int ks = 0; ks < 2; ++ks) { loadz8L(prow, first, mu, 1216 + ks * 32 + kq * 8, z); Aa[ks] = __builtin_bit_cast(bf16x8, pack8(z)); }
#pragma unroll
          for (int ks = 0; ks < 4; ++ks) { loadz8L(prow, first, mu, 1280 + ks * 32 + kq * 8, z);
#pragma unroll
              for (int j = 0; j < 8; ++j) z[j] = sigmoidf_(z[j]);
              Ag[ks] = __builtin_bit_cast(bf16x8, pack8(z)); } }
#pragma unroll 1
        for (int hq = 0; hq < 6; ++hq) { const int hd_ = hq + F.wave + (int)(blockIdx.x >> 3); const int hd = hd_ % 6;
            const int t = t0 + tok; const bool first = (t % SEQ) == 0; const bf16* prow = F_PROJ + (size_t)t * NIN + ROFF; const int ch0 = hd * 64 + cq;
            float zr2[2][8], zk2[2][8], zv2[2][8];
#pragma unroll
            for (int sub = 0; sub < 2; ++sub) { loadz8L(prow, first, mu, ch0 + sub * 8, zr2[sub]); loadz8L(prow, first, mu, RW + ch0 + sub * 8, zk2[sub]); loadz8L(prow, first, mu, 2 * RW + ch0 + sub * 8, zv2[sub]); }
#pragma unroll
            for (int cgi = 0; cgi < 4; ++cgi) {
                const int ch = hd * 64 + cgi * 16 + row;
                f32x4 cw = (f32x4){0.f, 0.f, 0.f, 0.f}, ca = cw, cgt = cw;
#pragma unroll
                for (int ks = 0; ks < 2; ++ks) {
                    const bf16x8 bw = *(const bf16x8*)(WUT + (size_t)ch * 64 + ks * 32 + kq * 8); cw = __builtin_amdgcn_mfma_f32_16x16x32_bf16(Aw[ks], bw, cw, 0, 0, 0);
                    const bf16x8 ba = *(const bf16x8*)(AUT + (size_t)ch * 64 + ks * 32 + kq * 8); ca = __builtin_amdgcn_mfma_f32_16x16x32_bf16(Aa[ks], ba, ca, 0, 0, 0); }
#pragma unroll
                for (int ks = 0; ks < 4; ++ks) { const bf16x8 bg = *(const bf16x8*)(GUT + (size_t)ch * 128 + ks * 32 + kq * 8); cgt = __builtin_amdgcn_mfma_f32_16x16x32_bf16(Ag[ks], bg, cgt, 0, 0, 0); }
#pragma unroll
                for (int j = 0; j < 4; ++j) { LAS float* d = LW + (kq * 4 + j) * 68 + cgi * 16 + row; d[0] = cw[j]; d[16 * 68] = ca[j]; d[32 * 68] = cgt[j]; }
            }
            asm volatile("s_waitcnt lgkmcnt(0)" ::: "memory");
            float kkq[16], aq[16]; float ss = 0.f, dotp = 0.f;
#pragma unroll
            for (int sub = 0; sub < 2; ++sub) {
                const int ch = ch0 + sub * 8; const size_t idx = (size_t)t * RW + ch;
                float (&zr)[8] = zr2[sub]; float (&zk)[8] = zk2[sub]; float (&zv)[8] = zv2[sub];
                float gl[8], ldv[8], kpv[8];
                const LAS float* lw = LW + tok * 68 + cq + sub * 8;
#pragma unroll
                for (int hh = 0; hh < 2; ++hh) { const f32x4 x0 = *(const LAS f32x4*)(lw + 4 * hh), x1 = *(const LAS f32x4*)(lw + 16 * 68 + 4 * hh), x2 = *(const LAS f32x4*)(lw + 32 * 68 + 4 * hh);
                    const f32x4 p0 = *(const LAS f32x4*)(w0 + ch + 4 * hh), p1 = *(const LAS f32x4*)(a0 + ch + 4 * hh), p2 = *(const LAS f32x4*)(kkw + ch + 4 * hh), p3 = *(const LAS f32x4*)(kaw + ch + 4 * hh), p4 = *(const LAS f32x4*)(rkp + ch + 4 * hh);
#pragma unroll
                    for (int e = 0; e < 4; ++e) { const int j = 4 * hh + e;
                        gl[j] = x2[e];
                        const float xs = -(p0[e] + x0[e]); const float sp = fmaxf(xs, 0.f) + __logf(1.f + __expf(-fabsf(xs)));
                        ldv[j] = -__expf(-sp - 0.5f);
                        const float a = sigmoidf_(p1[e] + x1[e]);
                        const float kk = zk[j] * p2[e]; kpv[j] = zk[j] * (1.f + (a - 1.f) * p3[e]);
                        kkq[sub * 8 + j] = kk; aq[sub * 8 + j] = a; ss += kk * kk; dotp += zr[j] * kpv[j] * p4[e];
                    } }
                *(v4u*)(F_S_ld + idx) = pack8(ldv); *(v4u*)(F_S_k + idx) = pack8(kpv); *(v4u*)(F_S_g + idx) = pack8(gl);
            }
            ss += __shfl_xor(ss, 1); ss += __shfl_xor(ss, 2);
            dotp += __shfl_xor(dotp, 1); dotp += __shfl_xor(dotp, 2);
            if ((F.lane & 3) == 0) ((float*)((unsigned char*)F.out + WS_DOTS))[(size_t)t * 6 + hd] = dotp;
            const float inv = __builtin_amdgcn_rsqf(fmaxf(ss, 1e-24f));
#pragma unroll
            for (int sub = 0; sub < 2; ++sub) { float nn[8], bbv[8];
#pragma unroll
                for (int j = 0; j < 8; ++j) { const float kn = kkq[sub * 8 + j] * inv; nn[j] = -kn; bbv[j] = kn * aq[sub * 8 + j]; }
                const size_t idx = (size_t)t * RW + ch0 + sub * 8; *(v4u*)(F_S_n + idx) = pack8(nn); *(v4u*)(F_S_b + idx) = pack8(bbv); }
            asm volatile("s_waitcnt lgkmcnt(0)" ::: "memory");
        }
    }
}

DI void conv_phase(const Frame& F0, int l, int w0, int nw) { Frame F = refresh(F0);
    const float* cw_ = INP(F, 8) + l * 3 * 256;
    for (int it = w0; it < M / 2; it += nw) {
        const int t = it * 2 + (F.lane >> 5), c8 = (F.lane & 31) * 8, pos = t % SEQ;
        const bf16* base = F_PROJ + (size_t)t * NIN + COFF + c8;
        float b8[8], g8[8], u8[8], acc[8], w8[8];
        unpack8(*(const v4u*)base, b8);
#pragma unroll
        for (int j = 0; j < 8; ++j) acc[j] = 0.f;
#pragma unroll
        for (int d = 0; d < 3; ++d) {
            const int back = 2 - d;
            if (pos >= back) {
                const bf16* pb = base - (size_t)back * NIN;
                unpack8(*(const v4u*)(pb + 256), g8); unpack8(*(const v4u*)(pb + 512), u8);
                const f32x4 wa = *(const f32x4*)(cw_ + d * 256 + c8), wb = *(const f32x4*)(cw_ + d * 256 + c8 + 4);
                w8[0] = wa.x; w8[1] = wa.y; w8[2] = wa.z; w8[3] = wa.w; w8[4] = wb.x; w8[5] = wb.y; w8[6] = wb.z; w8[7] = wb.w;
#pragma unroll
                for (int j = 0; j < 8; ++j) acc[j] += w8[j] * (g8[j] * u8[j]);
            }
        }
#pragma unroll
        for (int j = 0; j < 8; ++j) acc[j] *= b8[j];
        *(v4u*)(F_MIX + (size_t)t * DMODEL + 384 + c8) = pack8(acc);
    }
}

DI void post_phase(const Frame& F0, int l) { Frame F = refresh(F0);
    const float* lg = INP(F, 18) + l * RW; const float* lb = INP(F, 19) + l * RW; const float* mu = INP(F, 9) + l * RCOLS;
    for (int it = F.gw; it < M * 6 / 8; it += F.NGW) {
        const int pair = it * 8 + (F.lane >> 3), t = pair / 6, hd = pair % 6, ch = hd * 64 + (F.lane & 7) * 8;
        bf16* yp = F_MIX + (size_t)t * DMODEL + 640 + ch; const size_t idx = (size_t)t * RW + ch;
        float y[8], v[8], g[8], o[8];
        unpack8(*(const v4u*)yp, y); unpack8(*(const v4u*)(F_S_g + idx), g);
        loadz8(F_PROJ + (size_t)t * NIN + ROFF, (t % SEQ) == 0, mu, 2 * RW + ch, v);
        const float dot = ((const float*)((unsigned char*)F.out + WS_DOTS))[(size_t)t * 6 + hd];
        float s = 0.f;
#pragma unroll
        for (int j = 0; j < 8; ++j) s += y[j];
        s += __shfl_xor(s, 1); s += __shfl_xor(s, 2); s += __shfl_xor(s, 4);
        const float mean = s * (1.f / 64.f); float q = 0.f;
#pragma unroll
        for (int j = 0; j < 8; ++j) { const float d = y[j] - mean; q += d * d; }
        q += __shfl_xor(q, 1); q += __shfl_xor(q, 2); q += __shfl_xor(q, 4);
        const float rstd = 1.f / sqrtf(q * (1.f / 64.f) + GN_EPS);
#pragma unroll
        for (int j = 0; j < 8; ++j) o[j] = ((y[j] - mean) * rstd * lg[ch + j] + lb[ch + j] + dot * v[j]) * g[j];
        *(v4u*)yp = pack8(o);
    }
}


DI void scan_wg(const Frame& F0, int sw) { Frame F = refresh(F0);
    const int bh = sw >> 1, half = sw & 1, b = bh / 6, hd = bh % 6;
    const size_t tb = (size_t)b * SEQ; const int cb = hd * 64;
    LAS unsigned char* const lds = F.lds;
    constexpr int BUFB = 6 * 8192, YOFF = 2 * BUFB;
    const bool loader = F.wave >= 4; const int ltid = F.tid - 256;
#define SCAN_STAGE(c, bufsel, P0, NP, STRIDE) do { _Pragma("unroll") for (int i = 0; i < (NP); ++i) { const int p = (P0) + (STRIDE) * i, a = p >> 8, tt = (p & 255) >> 3, c8 = (p & 7) * 8; \
        const bf16* src = (a == 0 ? F_S_r : a == 1 ? F_S_ld : a == 2 ? F_S_k : a == 3 ? F_S_v : a == 4 ? F_S_n : F_S_b); \
        const v4u raw = *(const v4u*)(src + (tb + (size_t)(c) * 32 + tt) * RW + cb + c8); \
        float f[8]; unpack8(raw, f); if (a == 1) { _Pragma("unroll") for (int j = 0; j < 8; ++j) f[j] = __expf(f[j]); } \
        LAS f32x4* d = (LAS f32x4*)(lds + (bufsel) * BUFB + a * 8192 + tt * 256 + c8 * 4); d[0] = (f32x4){f[0], f[1], f[2], f[3]}; d[1] = (f32x4){f[4], f[5], f[6], f[7]}; } } while (0)
#define SCAN_YOUT(c, bufsel) do { _Pragma("unroll") for (int i = 0; i < 2; ++i) { const int e = ltid + 256 * i, tt = e >> 4, r2 = (e & 15) * 2; \
        const LAS float* ys = (const LAS float*)(lds + YOFF + (bufsel) * 4096) + tt * 32 + r2; \
        *(unsigned*)(F_MIX + (tb + (size_t)(c) * 32 + tt) * DMODEL + 640 + cb + half * 32 + r2) = pk2(ys[0], ys[1]); } } while (0)
    SCAN_STAGE(0, 0, F.tid, 3, 512);
    __syncthreads();
    typedef float f32x2v __attribute__((ext_vector_type(2)));
    const int rp = F.wave * 8 + (F.lane >> 4) * 2, kp = F.lane & 15;
    f32x4 s0 = (f32x4){0.f, 0.f, 0.f, 0.f}, s1 = s0;
#pragma unroll 1
    for (int c = 0; c < SEQ / 32; ++c) {
        const int cur = c & 1;
        if (loader) {
            if (c + 1 < SEQ / 32) SCAN_STAGE(c + 1, cur ^ 1, ltid, 6, 256);
            if (c > 0) SCAN_YOUT(c - 1, cur ^ 1);
        } else {
            const LAS unsigned char* bb = lds + cur * BUFB + kp * 16;
            const LAS unsigned char* vb = lds + cur * BUFB + 3 * 8192 + (half * 32 + rp) * 4;
            LAS f32x2v* yb = (LAS f32x2v*)(lds + YOFF + cur * 4096 + rp * 4);
            f32x4 rv = *(const LAS f32x4*)(bb + 0 * 8192), wv = *(const LAS f32x4*)(bb + 1 * 8192), kv = *(const LAS f32x4*)(bb + 2 * 8192);
            f32x4 nv = *(const LAS f32x4*)(bb + 4 * 8192), bv = *(const LAS f32x4*)(bb + 5 * 8192);
            f32x2v vv = *(const LAS f32x2v*)(vb);
#pragma unroll 8
            for (int tt = 0; tt < 32; ++tt) {
                const int tn = (tt + 1) & 31;
                const f32x4 rv2 = *(const LAS f32x4*)(bb + 0 * 8192 + tn * 256), wv2 = *(const LAS f32x4*)(bb + 1 * 8192 + tn * 256), kv2 = *(const LAS f32x4*)(bb + 2 * 8192 + tn * 256);
                const f32x4 nv2 = *(const LAS f32x4*)(bb + 4 * 8192 + tn * 256), bv2 = *(const LAS f32x4*)(bb + 5 * 8192 + tn * 256);
                const f32x2v vv2 = *(const LAS f32x2v*)(vb + tn * 256);
                f32x2v d0 = (f32x2v){s0.x, s0.y} * (f32x2v){nv.x, nv.y}; d0 = (f32x2v){s0.z, s0.w} * (f32x2v){nv.z, nv.w} + d0;
                f32x2v d1 = (f32x2v){s1.x, s1.y} * (f32x2v){nv.x, nv.y}; d1 = (f32x2v){s1.z, s1.w} * (f32x2v){nv.z, nv.w} + d1;
                const float sa0 = red16(d0.x + d0.y), sa1 = red16(d1.x + d1.y);
                const f32x4 q0 = s0 * wv + kv * vv.x, q1 = s1 * wv + kv * vv.y;
                s0 = bv * sa0 + q0; s1 = bv * sa1 + q1;
                f32x2v y0 = (f32x2v){s0.x, s0.y} * (f32x2v){rv.x, rv.y}; y0 = (f32x2v){s0.z, s0.w} * (f32x2v){rv.z, rv.w} + y0;
                f32x2v y1 = (f32x2v){s1.x, s1.y} * (f32x2v){rv.x, rv.y}; y1 = (f32x2v){s1.z, s1.w} * (f32x2v){rv.z, rv.w} + y1;
                const float ya = red16(y0.x + y0.y), yc = red16(y1.x + y1.y);
                yb[tt * 16] = (f32x2v){ya, yc};
                rv = rv2; wv = wv2; kv = kv2; nv = nv2; bv = bv2; vv = vv2;
            }
        }
        __syncthreads();
    }
    if (loader) SCAN_YOUT(SEQ / 32 - 1, (SEQ / 32 - 1) & 1);
#undef SCAN_STAGE
#undef SCAN_YOUT
    __syncthreads();
}

typedef float f32x16 __attribute__((ext_vector_type(16)));
typedef short s16x4 __attribute__((ext_vector_type(4)));
DI int crow_(int r, int h) { return (r & 3) + 8 * (r >> 2) + 4 * h; }
typedef float f32x2c __attribute__((ext_vector_type(2))); typedef __bf16 bf16x2c __attribute__((ext_vector_type(2)));
DI unsigned cvtpk(float lo, float hi) { f32x2c v = {lo, hi}; bf16x2c b = __builtin_convertvector(v, bf16x2c); return __builtin_bit_cast(unsigned, b); }
DI bf16x8 packregs(const f32x16& x, int s) {
    v4u p; p.x = cvtpk(x[8 * s + 0], x[8 * s + 1]); p.y = cvtpk(x[8 * s + 2], x[8 * s + 3]); p.z = cvtpk(x[8 * s + 4], x[8 * s + 5]); p.w = cvtpk(x[8 * s + 6], x[8 * s + 7]);
    return __builtin_bit_cast(bf16x8, p);
}
DI bf16x8 cat44(s16x4 lo, s16x4 hi) { return __builtin_shufflevector(lo, hi, 0, 1, 2, 3, 4, 5, 6, 7); }
#define MFMA32(a, b, c) __builtin_amdgcn_mfma_f32_32x32x16_bf16((a), (b), (c), 0, 0, 0)

DI void cprep_phase(const Frame& F0, int l) { Frame F = refresh(F0);
    const float* mu_ = INP(F, 9) + l * RCOLS;
    LAS unsigned char* const W = F.lds + F.wave * 16384;
    const int lane = F.lane, r32 = lane & 31, h = lane >> 5;
    const bool local = (F.NGW == M / 16);
    for (int it_ = 0; it_ < (local ? 3 : (NITEMS + F.NGW - 1) / F.NGW); ++it_) {
        int item;
        if (local) { const int li = F.wave * 3 + it_, cg_ = 4 * (int)blockIdx.x + li / 6; item = ((cg_ >> 7) * 6 + li % 6) * 128 + (cg_ & 127); }
        else { item = F.gw + it_ * F.NGW; if (item >= NITEMS) break; }
        const int bh = item >> 7, c = item & 127, b = bh / 6, hd = bh % 6;
        const size_t row0 = (size_t)b * SEQ + (size_t)c * 32;
        const size_t sbase = row0 * RW + hd * 64;
        {
            float lp = 0.f, Pcur = 1.f; unsigned btp[16], ktp[16], vtp[16]; float bprev = 0.f, kprev = 0.f, vprev = 0.f;
            const bf16* pj = F_PROJ + row0 * NIN + ROFF + hd * 64 + lane;
            const float mur = mu_[hd * 64 + lane], muv = mu_[2 * RW + hd * 64 + lane];
            float pr_prev = 0.f, pv_prev = 0.f; if (c != 0) { pr_prev = bf1(pj - NIN); pv_prev = bf1(pj - NIN + 2 * RW); }
#pragma unroll
            for (int hf = 0; hf < 4; ++hf) {
                unsigned short raw[8][6];
#pragma unroll
                for (int tq = 0; tq < 8; ++tq) { const size_t e = sbase + (size_t)(8 * hf + tq) * RW + lane; raw[tq][0] = F_S_ld[e]; raw[tq][1] = pj[(size_t)(8 * hf + tq) * NIN]; raw[tq][2] = F_S_n[e]; raw[tq][3] = F_S_b[e]; raw[tq][4] = F_S_k[e]; raw[tq][5] = pj[(size_t)(8 * hf + tq) * NIN + 2 * RW]; }
#pragma unroll
                for (int tq = 0; tq < 8; ++tq) { const int t = 8 * hf + tq;
                    const float ldv = __uint_as_float((unsigned)raw[tq][0] << 16), prw = __uint_as_float((unsigned)raw[tq][1] << 16), nn = __uint_as_float((unsigned)raw[tq][2] << 16), bb = __uint_as_float((unsigned)raw[tq][3] << 16), kk = __uint_as_float((unsigned)raw[tq][4] << 16), pvw = __uint_as_float((unsigned)raw[tq][5] << 16);
                    const float rr = prw + mur * (pr_prev - prw), vv = pvw + muv * (pv_prev - pvw); pr_prev = prw; pv_prev = pvw;
                    lp += ldv;
                    const float Pp = Pcur; const float P = __expf(lp), iP = __builtin_amdgcn_rcpf(P); Pcur = P;
                    const float rt = rr * P, nt = nn * Pp, bt = bb * iP, kt = kk * iP;
                    const int sw = (((lane >> 3) ^ (t & 7)) << 4) + (lane & 7) * 2 + t * 128;
                    *(LAS bf16*)(W + sw) = (bf16)f2bf(rt); *(LAS bf16*)(W + 4096 + sw) = (bf16)f2bf(nt); *(LAS bf16*)(W + 8192 + sw) = (bf16)f2bf(bt); *(LAS bf16*)(W + 12288 + sw) = (bf16)f2bf(kt);
                    if (t & 1) { btp[t >> 1] = pk2(bprev, bt); ktp[t >> 1] = pk2(kprev, kt); vtp[t >> 1] = pk2(vprev, vv); } else { bprev = bt; kprev = kt; vprev = vv; }
                }
            }
            ((float*)((unsigned char*)F.out + WS_PT))[(size_t)item * 64 + lane] = Pcur;
            const size_t te = sbase + (size_t)(lane >> 1) * RW + (lane & 1) * 32;
#pragma unroll
            for (int q = 0; q < 4; ++q) {
                *(v4u*)(F_S_b + te + q * 8) = (v4u){btp[4 * q], btp[4 * q + 1], btp[4 * q + 2], btp[4 * q + 3]};
                *(v4u*)(F_S_k + te + q * 8) = (v4u){ktp[4 * q], ktp[4 * q + 1], ktp[4 * q + 2], ktp[4 * q + 3]};
                *(v4u*)(F_S_ld + te + q * 8) = (v4u){vtp[4 * q], vtp[4 * q + 1], vtp[4 * q + 2], vtp[4 * q + 3]};
            }
        }
        asm volatile("s_waitcnt lgkmcnt(0)" ::: "memory");
        f32x16 Cnb, Cnk, Crb, Crk;
#pragma unroll
        for (int i = 0; i < 16; ++i) { Cnb[i] = 0.f; Cnk[i] = 0.f; Crb[i] = 0.f; Crk[i] = 0.f; }
#pragma unroll
        for (int s4 = 0; s4 < 4; ++s4) {
            const int fo = r32 * 128 + (((2 * s4 + h) ^ (r32 & 7)) << 4);
            const bf16x8 aR = *(const LAS bf16x8*)(W + fo), aN = *(const LAS bf16x8*)(W + 4096 + fo), bB = *(const LAS bf16x8*)(W + 8192 + fo), bK = *(const LAS bf16x8*)(W + 12288 + fo);
            Cnb = MFMA32(aN, bB, Cnb); Cnk = MFMA32(aN, bK, Cnk); Crb = MFMA32(aR, bB, Crb); Crk = MFMA32(aR, bK, Crk);
        }
#pragma unroll
        for (int i = 0; i < 16; ++i) { const int t = crow_(i, h); if (!(r32 < t)) { Cnb[i] = 0.f; Cnk[i] = 0.f; } if (!(r32 <= t)) { Crb[i] = 0.f; Crk[i] = 0.f; } }
        asm volatile("s_waitcnt lgkmcnt(0)" ::: "memory");
#pragma unroll
        for (int q = 0; q < 4; ++q) { const int p = lane + 64 * q, rr_ = p >> 3, cc = p & 7;
            *(v4u*)(F_S_r + sbase + (size_t)rr_ * RW + cc * 8) = *(const LAS v4u*)(W + rr_ * 128 + ((cc ^ (rr_ & 7)) << 4)); }
#pragma unroll
        for (int i = 0; i < 16; ++i) *(LAS float*)(W + 8192 + crow_(i, h) * 144 + r32 * 4) = Cnb[i];
        asm volatile("s_waitcnt lgkmcnt(0)" ::: "memory");
        {
            float X[32];
#pragma unroll
            for (int t = 0; t < 32; ++t) {
                float a0 = (t == r32) ? 1.f : 0.f, a1 = 0.f;
#pragma unroll
                for (int i4 = 0; i4 < (t + 3) / 4; ++i4) {
                    const f32x4 Lr = *(const LAS f32x4*)(W + 8192 + t * 144 + i4 * 16);
#pragma unroll
                    for (int e = 0; e < 4; ++e) { const int i = 4 * i4 + e; if (i < t) { if (e & 1) a1 += Lr[e] * X[i]; else a0 += Lr[e] * X[i]; } }
                }
                X[t] = a0 + a1;
            }
            asm volatile("s_waitcnt lgkmcnt(0)" ::: "memory");
#pragma unroll
            for (int t = 0; t < 32; ++t) *(LAS bf16*)(W + 12800 + t * 64 + r32 * 2) = (bf16)f2bf(X[t]);
        }
        asm volatile("s_waitcnt lgkmcnt(0)" ::: "memory");
        f32x16 Cw[2];
#pragma unroll
        for (int nt = 0; nt < 2; ++nt) {
#pragma unroll
            for (int i = 0; i < 16; ++i) Cw[nt][i] = 0.f;
#pragma unroll
            for (int s = 0; s < 2; ++s) {
                const bf16x8 a = *(const LAS bf16x8*)(W + 12800 + r32 * 64 + (2 * s + h) * 16);
                const int ch = 32 * nt + r32; unsigned short e[8];
#pragma unroll
                for (int j = 0; j < 8; ++j) { const int i = 16 * s + 8 * h + j; e[j] = *(const LAS bf16*)(W + 4096 + i * 128 + (((ch >> 3) ^ (i & 7)) << 4) + (ch & 7) * 2); }
                v4u bw; bw.x = e[0] | ((unsigned)e[1] << 16); bw.y = e[2] | ((unsigned)e[3] << 16); bw.z = e[4] | ((unsigned)e[5] << 16); bw.w = e[6] | ((unsigned)e[7] << 16);
                Cw[nt] = MFMA32(a, __builtin_bit_cast(bf16x8, bw), Cw[nt]);
            }
        }
        f32x16 Cm;
#pragma unroll
        for (int i = 0; i < 16; ++i) Cm[i] = 0.f;
#pragma unroll
        for (int s = 0; s < 2; ++s) {
            const s16x4 lo = *(const LAS s16x4*)(W + 12800 + r32 * 64 + (16 * s + 4 * h) * 2), hi = *(const LAS s16x4*)(W + 12800 + r32 * 64 + (16 * s + 8 + 4 * h) * 2);
            Cm = MFMA32(cat44(lo, hi), packregs(Cnk, s), Cm);
        }
        asm volatile("s_waitcnt lgkmcnt(0)" ::: "memory");
#pragma unroll
        for (int nt = 0; nt < 2; ++nt)
#pragma unroll
            for (int i = 0; i < 16; ++i) *(LAS bf16*)(W + crow_(i, h) * 128 + (32 * nt + r32) * 2) = (bf16)f2bf(Cw[nt][i]);
#pragma unroll
        for (int i = 0; i < 16; ++i) { const int o = crow_(i, h) * 64 + r32 * 2;
            *(LAS bf16*)(W + 4096 + o) = (bf16)f2bf(Crb[i]); *(LAS bf16*)(W + 6144 + o) = (bf16)f2bf(Cm[i]); *(LAS bf16*)(W + 8192 + o) = (bf16)f2bf(Crk[i]); }
        asm volatile("s_waitcnt lgkmcnt(0)" ::: "memory");
#pragma unroll
        for (int q = 0; q < 4; ++q) { const int p = lane + 64 * q, rr = p >> 3, cc = p & 7;
            *(v4u*)(F_S_n + sbase + (size_t)rr * RW + cc * 8) = *(const LAS v4u*)(W + rr * 128 + cc * 16); }
#pragma unroll
        for (int q = 0; q < 2; ++q) { const int p = lane + 64 * q, mr = p >> 2, cc = p & 3;
            *(v4u*)(F_S_v + sbase + (size_t)(mr >> 1) * RW + (mr & 1) * 32 + cc * 8) = *(const LAS v4u*)(W + 4096 + mr * 64 + cc * 16);
            *(v4u*)(F_S_v + sbase + (size_t)(16 + (mr >> 1)) * RW + (mr & 1) * 32 + cc * 8) = *(const LAS v4u*)(W + 6144 + mr * 64 + cc * 16);
            *(v4u*)((bf16*)((unsigned char*)F.out + WS_AUX) + (size_t)item * 1024 + mr * 32 + cc * 8) = *(const LAS v4u*)(W + 8192 + mr * 64 + cc * 16); }
        asm volatile("s_waitcnt vmcnt(0) lgkmcnt(0)" ::: "memory");
    }
}

DI void cs_consume(const LAS unsigned char* B, LAS unsigned char* ybuf, f32x16 (&Hacc)[2], bf16x8 (&Hpk)[2][2], int r32, int h, int vh) {
    bf16x8 Vf[2];
#pragma unroll
    for (int s = 0; s < 2; ++s) Vf[s] = *(const LAS bf16x8*)(B + 19456 + (32 * vh + r32) * 80 + (2 * s + h) * 16);
    f32x16 U;
#pragma unroll
    for (int i = 0; i < 16; ++i) U[i] = 0.f;
#pragma unroll
    for (int kt = 0; kt < 2; ++kt)
#pragma unroll
        for (int s = 0; s < 2; ++s) { const LAS unsigned char* ap = B + r32 * 144 + (32 * kt + 16 * s + 4 * h) * 2;
            U = MFMA32(cat44(*(const LAS s16x4*)ap, *(const LAS s16x4*)(ap + 16)), Hpk[kt][s], U); }
#pragma unroll
    for (int s = 0; s < 2; ++s) U = MFMA32(*(const LAS bf16x8*)(B + 27136 + r32 * 80 + (2 * s + h) * 16), Vf[s], U);
    bf16x8 Upk[2]; Upk[0] = packregs(U, 0); Upk[1] = packregs(U, 1);
    f32x16 Y;
#pragma unroll
    for (int i = 0; i < 16; ++i) Y[i] = 0.f;
#pragma unroll
    for (int kt = 0; kt < 2; ++kt)
#pragma unroll
        for (int s = 0; s < 2; ++s) { const LAS unsigned char* ap = B + 4608 + r32 * 144 + (32 * kt + 16 * s + 4 * h) * 2;
            Y = MFMA32(cat44(*(const LAS s16x4*)ap, *(const LAS s16x4*)(ap + 16)), Hpk[kt][s], Y); }
#pragma unroll
    for (int s = 0; s < 2; ++s) { const LAS unsigned char* ap = B + 24576 + r32 * 80 + (16 * s + 4 * h) * 2;
        Y = MFMA32(cat44(*(const LAS s16x4*)ap, *(const LAS s16x4*)(ap + 16)), Upk[s], Y);
        Y = MFMA32(*(const LAS bf16x8*)(B + 29696 + r32 * 80 + (2 * s + h) * 16), Vf[s], Y); }
    {   LAS float* yb = (LAS float*)ybuf + 32 * vh + r32;
#pragma unroll
        for (int i = 0; i < 16; ++i) yb[crow_(i, h) * 64] = Y[i]; }
#pragma unroll
    for (int kt = 0; kt < 2; ++kt) {
        f32x16 acc = Hacc[kt];
#pragma unroll
        for (int s = 0; s < 2; ++s) { const LAS unsigned char* ap = B + 9216 + (32 * kt + r32) * 80 + (16 * s + 4 * h) * 2;
            acc = MFMA32(cat44(*(const LAS s16x4*)ap, *(const LAS s16x4*)(ap + 16)), Upk[s], acc);
            acc = MFMA32(*(const LAS bf16x8*)(B + 14336 + (32 * kt + r32) * 80 + (2 * s + h) * 16), Vf[s], acc); }
#pragma unroll
        for (int g = 0; g < 4; ++g) { const f32x4 pt = *(const LAS f32x4*)(B + 32256 + (32 * kt + 8 * g + 4 * h) * 4);
            acc[4 * g] *= pt.x; acc[4 * g + 1] *= pt.y; acc[4 * g + 2] *= pt.z; acc[4 * g + 3] *= pt.w; }
        Hacc[kt] = acc; Hpk[kt][0] = packregs(acc, 0); Hpk[kt][1] = packregs(acc, 1);
    }
}

DI void cscan_wg(const Frame& F0, int bh, int l) { Frame F = refresh(F0);
    const int b = bh / 6, hd = bh % 6; const size_t tb = (size_t)b * SEQ; const int cb = hd * 64;
    LAS unsigned char* const lds = F.lds;
    constexpr int BUFB = 32512, YOFF = 3 * BUFB, YB = 8192, NCH = SEQ / 32;
    const int ltid = F.tid - 128;
    const bool loader = F.wave >= 2;
    v4u st0[5], st1[5], st2[5], st3[5];
#define CS_LOAD(c, ST) do { const size_t sb_ = (tb + (size_t)(c) * 32) * RW + cb; const int item_ = bh * 128 + (c); \
        _Pragma("unroll") for (int i = 0; i < 5; ++i) { const int p = ltid + 384 * i; \
            if (p < 1536) { const int a = p >> 8, sr = (p >> 3) & 31, cc = p & 7;              \
                const bf16* src = (a == 0 ? F_S_n : a == 1 ? F_S_r : a == 2 ? F_S_b : a == 3 ? F_S_k : a == 4 ? F_S_ld : F_S_v); \
                ST[i] = __builtin_nontemporal_load((const v4u*)(src + sb_ + (size_t)sr * RW + cc * 8)); } \
            else if (p < 1664) { const int q = p - 1536, mr = q >> 2, cc = q & 3; ST[i] = __builtin_nontemporal_load((const v4u*)((const bf16*)((unsigned char*)F.out + WS_AUX) + (size_t)item_ * 1024 + mr * 32 + cc * 8)); } \
            else if (p < 1680) { const int q = p - 1664; ST[i] = __builtin_nontemporal_load((const v4u*)((const float*)((unsigned char*)F.out + WS_PT) + (size_t)item_ * 64 + q * 4)); } } } while (0)
#define CS_WRITE(bufsel, ST) do { LAS unsigned char* B_ = lds + (bufsel) * BUFB; \
        _Pragma("unroll") for (int i = 0; i < 5; ++i) { const int p = ltid + 384 * i; \
            if (p < 1536) { const int a = p >> 8, sr = (p >> 3) & 31, cc = p & 7; \
                int dst; if (a < 2) dst = a * 4608 + sr * 144 + cc * 16; else if (a < 5) dst = 9216 + (a - 2) * 5120 + (2 * sr + (cc >> 2)) * 80 + (cc & 3) * 16; \
                else dst = 24576 + (sr >> 4) * 2560 + ((2 * sr + (cc >> 2)) & 31) * 80 + (cc & 3) * 16; \
                *(LAS v4u*)(B_ + dst) = ST[i]; } \
            else if (p < 1664) { const int q = p - 1536, mr = q >> 2, cc = q & 3; *(LAS v4u*)(B_ + 29696 + mr * 80 + cc * 16) = ST[i]; } \
            else if (p < 1680) { const int q = p - 1664; *(LAS v4u*)(B_ + 32256 + q * 16) = ST[i]; } } } while (0)
    const int pt_ = (ltid >> 3) & 31, v8 = (ltid & 7) * 8;
    float lgv[8], lbv[8]; v4u gq = (v4u){0u, 0u, 0u, 0u}; float dq = 0.f;
    if (loader) { const float* lg = INP(F, 18) + l * RW + cb + v8; const float* lb = INP(F, 19) + l * RW + cb + v8;
#pragma unroll
        for (int j = 0; j < 8; ++j) { lgv[j] = lg[j]; lbv[j] = lb[j]; } }
#define CS_GLOAD(c) do { if (ltid < 256) { const size_t row_ = tb + (size_t)(c) * 32 + pt_; gq = *(const v4u*)(F_S_g + row_ * RW + cb + v8); dq = ((const float*)((unsigned char*)F.out + WS_DOTS))[row_ * 6 + hd]; } } while (0)
#define CS_POST(c, ybsel, bufsel) do { if (ltid < 256) { const LAS float* ys = (const LAS float*)(lds + YOFF + (ybsel) * YB) + pt_ * 64 + v8; \
        float y[8], g[8], o[8]; const f32x4 y0 = *(const LAS f32x4*)ys, y1 = *(const LAS f32x4*)(ys + 4); y[0] = y0.x; y[1] = y0.y; y[2] = y0.z; y[3] = y0.w; y[4] = y1.x; y[5] = y1.y; y[6] = y1.z; y[7] = y1.w; \
        unpack8(gq, g); float s = 0.f; _Pragma("unroll") for (int j = 0; j < 8; ++j) s += y[j]; \
        s += __shfl_xor(s, 1); s += __shfl_xor(s, 2); s += __shfl_xor(s, 4); const float mean = s * (1.f / 64.f); float q = 0.f; \
        _Pragma("unroll") for (int j = 0; j < 8; ++j) { const float d = y[j] - mean; q += d * d; } \
        q += __shfl_xor(q, 1); q += __shfl_xor(q, 2); q += __shfl_xor(q, 4); const float rstd = __builtin_amdgcn_rsqf(q * (1.f / 64.f) + GN_EPS); \
        const LAS unsigned char* vt = lds + (bufsel) * BUFB + 19456 + v8 * 80 + pt_ * 2; \
        _Pragma("unroll") for (int j = 0; j < 8; ++j) { const float vv = __uint_as_float(((unsigned)*(const LAS bf16*)(vt + j * 80)) << 16); o[j] = ((y[j] - mean) * rstd * lgv[j] + lbv[j] + dq * vv) * g[j]; } \
        *(v4u*)(F_MIX + (tb + (size_t)(c) * 32 + pt_) * DMODEL + 640 + cb + v8) = pack8(o); } } while (0)
    if (loader) {
        CS_LOAD(0, st0); CS_WRITE(0, st0); CS_LOAD(1, st1); CS_LOAD(2, st2);
        __syncthreads();
        int bn = 1, bp = 2, bc = 0;
#define CS_LITER(c, STW, LDN) do { const int cur = (c) & 1; \
            if ((c) + 3 < NCH) CS_LOAD((c) + 3, LDN); \
            if ((c) > 0) CS_POST((c) - 1, cur ^ 1, bp); \
            CS_GLOAD(c); \
            if ((c) + 1 < NCH) CS_WRITE(bn, STW); \
            __syncthreads(); { const int t_ = bp; bp = bc; bc = bn; bn = t_; } } while (0)
#pragma unroll 1
        for (int c4 = 0; c4 < NCH; c4 += 4) { CS_LITER(c4, st1, st3); CS_LITER(c4 + 1, st2, st0); CS_LITER(c4 + 2, st3, st1); CS_LITER(c4 + 3, st0, st2); }
        CS_POST(NCH - 1, (NCH - 1) & 1, bp);
#undef CS_LITER
    } else {
        const int lane = F.lane, r32 = lane & 31, h = lane >> 5, vh = F.wave;
        f32x16 Hacc[2]; bf16x8 Hpk[2][2];
#pragma unroll
        for (int kt = 0; kt < 2; ++kt) {
#pragma unroll
            for (int i = 0; i < 16; ++i) Hacc[kt][i] = 0.f;
            Hpk[kt][0] = bf16x8{0, 0, 0, 0, 0, 0, 0, 0}; Hpk[kt][1] = bf16x8{0, 0, 0, 0, 0, 0, 0, 0}; }
        __syncthreads();
        int bc = 0;
#pragma unroll 1
        for (int c = 0; c < NCH; ++c) { cs_consume(lds + bc * BUFB, lds + YOFF + (c & 1) * YB, Hacc, Hpk, r32, h, vh); __syncthreads(); bc = (bc == 2) ? 0 : bc + 1; }
    }
#undef CS_LOAD
#undef CS_WRITE
#undef CS_GLOAD
#undef CS_POST
    __syncthreads();
}

DI void mix_phase(const Frame& F0, int l, char* ldsg) { Frame F = refresh(F0);
#ifndef SKIP_SCAN
    if ((int)blockIdx.x < SCAN_WGS) { cscan_wg(F, (int)blockIdx.x, l); }
    else { const int nw_ = (F.G - SCAN_WGS) * NWAVES, w0_ = ((int)blockIdx.x - SCAN_WGS) * NWAVES + F.wave;
        conv_phase(F, l, w0_, nw_); if (l == 0) prologue(F, 1, w0_, nw_); __syncthreads(); }
#endif
    const float* lq1 = INP(F, 3) + l * 32; const float* lk1 = INP(F, 4) + l * 32; const float* lq2 = INP(F, 5) + l * 32; const float* lk2 = INP(F, 6) + l * 32;
    float d1 = 0.f, d2 = 0.f;
    for (int i = 0; i < 32; ++i) { d1 += lq1[i] * lk1[i]; d2 += lq2[i] * lk2[i]; }
    const float lambda_init = (l == 0) ? 0.2f : 0.35550906759f;
    const float lam = __expf(d1) - __expf(d2) + lambda_init;
    const float* sg = INP(F, 7) + l * 64;
    volatile LAS unsigned* qslot = (volatile LAS unsigned*)(F.lds + MISC_OFF + 64);
    const int myx = (int)(xb_xcc_id() & 7u);
    int qk = 0;
    for (;;) {
        if (F.tid == 0) { unsigned got = 0xffffffffu; int k = qk;
            for (; k < 8; ++k) { const int x = (myx + k) & 7; const unsigned v = atomicAdd(F_ctl + 64 * (1 + 8 * l + x), 1u); if (v < 96u) { got = (unsigned)x * 96u + v; break; } }
            qslot[0] = got; qslot[1] = (unsigned)k; }
        __syncthreads();
        const unsigned idx = (unsigned)__builtin_amdgcn_readfirstlane((int)qslot[0]); qk = __builtin_amdgcn_readfirstlane((int)qslot[1]);
        __syncthreads();
        if (idx == 0xffffffffu) break;
        const int xq = (int)(idx / 96u), iq = (int)(idx % 96u), qb = 15 - (iq & 15), bh = xq * 6 + (iq >> 4), b = bh / 6, h = bh % 6;
        const attn_body::bf16* P = (const attn_body::bf16*)F_PROJ;
#ifndef SKIP_ATT
#pragma unroll 1
        for (int ns = 0; ns < 2; ++ns)
            attn_body::attn_unit<8>(b, h, qb, ns, lam, sg, 1.f - lambda_init, P, P + 384, P + 768, (attn_body::bf16*)F_MIX, ldsg);
#endif
    }
}

__global__ void __launch_bounds__(NWAVES * 64, 2) mega_fwd(Args args) {
    extern __shared__ __attribute__((aligned(16))) unsigned char lds[];
    cg::grid_group grid = cg::this_grid();
    Frame F;
    F.lds = (LAS unsigned char*)lds;
    F.tid = threadIdx.x; F.lane = F.tid & 63; F.wave = __builtin_amdgcn_readfirstlane(F.tid >> 6);
    F.G = gridDim.x; F.gw = (int)blockIdx.x * NWAVES + F.wave; F.NGW = F.G * NWAVES;
    F.in = args.in; F.out = args.out; F.ws = args.ws;
    const int G = F.G;
    if (F.tid < 32) ((LAS unsigned*)(F.lds + MISC_OFF))[F.tid] = 0u;
    __syncthreads();
    XcdBarrier bar = xcd_barrier_post((unsigned*)(args.ws + WS_CTL) + CW_BAR, (volatile LAS unsigned*)(F.lds + MISC_OFF) + 8);

    prologue(F, 0, F.gw, F.NGW);
    x_to_bf16(F, INP(F, 0), F_XB, SSP(4));
    if (args.i0 != 0) grid.sync();
    xcd_barrier(bar);
#pragma unroll 1
    for (int l = 0; l < 2; ++l) {
        {
            pg8::Gemm g{F_XB, F_WIN + (size_t)l * NIN * DMODEL, M, NIN, DMODEL}; pg8::StaticOrder S; int bx = blockIdx.x; asm volatile("" : "+s"(bx)); S.init(M, NIN, G, bx);
            pg8::EpiBf16S<0> E{F_PROJ, NIN, (const float*)SSP(l == 0 ? 4 : 1)};
            GEMMCALL0 pg8::gemm_phase<pg8::EpiBf16S<0>, pg8::StaticOrder, true, true>(F.lds, g, S, E);
            if (PROBE & 1) { __syncthreads(); pg8::gemm_phase<pg8::EpiBf16S<0>, pg8::StaticOrder, true, true>(F.lds, g, S, E); }
        }
        xcd_barrier(bar);
#ifndef SKIP_PREP
        prep_phase(F, l);
#endif
        if (F.NGW == M / 16) {
            asm volatile("s_waitcnt vmcnt(0)" ::: "memory"); __syncthreads(); __builtin_amdgcn_fence(__ATOMIC_ACQUIRE, "agent"); asm volatile("s_waitcnt vmcnt(0)" ::: "memory");
        } else xcd_barrier(bar);
        cprep_phase(F, l);
        seam_arrive((unsigned*)(args.ws + WS_CTL) + 64 * (20 + l));
        if ((int)blockIdx.x < SCAN_WGS) seam_wait((unsigned*)(args.ws + WS_CTL) + 64 * (20 + l), gridDim.x);
        mix_phase(F, l, (char*)lds);
        xcd_barrier(bar);
        {
            pg8::Gemm g{F_MIX, F_WOUT + (size_t)l * DMODEL * DMODEL, M, DMODEL, DMODEL}; pg8::StaticOrder S; int bx = blockIdx.x; asm volatile("" : "+s"(bx)); S.init(M, DMODEL, G, bx);
            float* ssp = SSP(2 * l);
            pg8::EpiResBf16<false> E{nullptr, F_XB, DMODEL, ssp};
            pg8::gemm_phase<pg8::EpiResBf16<false>, pg8::StaticOrder, true, true>(F.lds, g, S, E);
        }
        xcd_barrier(bar);
        {
            pg8::Gemm g{F_XB, F_WUP + (size_t)l * FF * DMODEL, M, FF, DMODEL}; pg8::StaticOrder S; int bx = blockIdx.x; asm volatile("" : "+s"(bx)); S.init(M, FF, G, bx);
            pg8::EpiBf16S<2> E{F_HID, FF, (const float*)SSP(2 * l)};
            GEMMCALL2 pg8::gemm_phase<pg8::EpiBf16S<2>, pg8::StaticOrder, true, true>(F.lds, g, S, E);
            if (PROBE & 1) { __syncthreads(); pg8::gemm_phase<pg8::EpiBf16S<2>, pg8::StaticOrder, true, true>(F.lds, g, S, E); }
        }
        xcd_barrier(bar);
        {
            pg8::Gemm g{F_HID, F_WDN + (size_t)l * DMODEL * FF, M, DMODEL, FF}; pg8::StaticOrder S; int bx = blockIdx.x; asm volatile("" : "+s"(bx)); S.init(M, DMODEL, G, bx);
            pg8::EpiResBf16<false> E{nullptr, F_XB, DMODEL, SSP(2 * l + 1)};
            pg8::gemm_phase<pg8::EpiResBf16<false>, pg8::StaticOrder, true, true>(F.lds, g, S, E);
        }
        xcd_barrier(bar);
    }
    final_norm(F, F_XB, F.out, INP(F, 24));
}

extern "C" void kernel_launch(void* const* d_in, const int* in_sizes, int n_in, void* d_out, int out_size, void* d_ws, size_t ws_size, hipStream_t stream) {
    static int grid = 0;
    if (grid == 0) {
        if (n_in != 25 || in_sizes[0] != M * DMODEL || out_size != M * DMODEL || ws_size < WS_END) {
            fprintf(stderr, "kernel_launch: unexpected problem geometry (n_in %d, in0 %d, out %d, ws %zu)\n", n_in, n_in > 0 ? in_sizes[0] : -1, out_size, ws_size); grid = -1; return; }
        int dev = 0, cus = 0, per_cu = 0;
        if (hipGetDevice(&dev) != hipSuccess || hipDeviceGetAttribute(&cus, hipDeviceAttributeMultiprocessorCount, dev) != hipSuccess) { grid = -1; return; }
        if (hipFuncSetAttribute((const void*)mega_fwd, hipFuncAttributeMaxDynamicSharedMemorySize, LDS_BYTES) != hipSuccess) { fprintf(stderr, "kernel_launch: hipFuncSetAttribute failed\n"); grid = -1; return; }
        if (hipOccupancyMaxActiveBlocksPerMultiprocessor(&per_cu, (const void*)mega_fwd, NWAVES * 64, LDS_BYTES) != hipSuccess || per_cu < 1) { fprintf(stderr, "kernel_launch: occupancy query gave %d\n", per_cu); (void)hipGetLastError(); per_cu = 1; }
        grid = cus * per_cu;
    }
    if (grid < 0) return;
    (void)hipMemsetAsync((char*)d_ws + WS_CTL, 0, CTL_ZERO_BYTES, stream);
    Args a{};
    for (int i = 0; i < 25; ++i) a.in[i] = (const float*)d_in[i];
    a.out = (float*)d_out; a.ws = (unsigned char*)d_ws; a.i0 = 0; a.i1 = 0;
    void* kargs[] = {&a};
    const hipError_t e = hipLaunchCooperativeKernel((const void*)mega_fwd, dim3(grid), dim3(NWAVES * 64), kargs, LDS_BYTES, stream);
    if (e != hipSuccess) fprintf(stderr, "kernel_launch: cooperative launch failed: %s (grid %d)\n", hipGetErrorString(e), grid);
}
```

```cpp
#include <hip/hip_runtime.h>
#include <hip/hip_cooperative_groups.h>
#include <hip/hip_bf16.h>
#include <cstdio>
#include <cstdint>
#include <cmath>
namespace pg8 {
#define PG8_LAS __attribute__((address_space(3)))
typedef unsigned short bf16_t;
typedef short bf16x8 __attribute__((ext_vector_type(8)));
typedef float f32x4 __attribute__((ext_vector_type(4)));
typedef unsigned u32x4 __attribute__((ext_vector_type(4)));
constexpr int BM = 256, BK = 64, HALF = 128, HTB = HALF * BK * 2  , STAGE_BYTES = 8 * HTB, NXCD = 8, WGM = 8;

__host__ __device__ __forceinline__ int lds_byte(int r, int c) { const int st = (r >> 4) * 2 + (c >> 5), rr = r & 15, cc = c & 31, ob = rr * 64 + cc * 2; return st * 1024 + (ob ^ (((ob >> 9) & 1) << 5)); }
__host__ __device__ __forceinline__ void stage_rc(int b, int& R, int& C) { const int st = b / 1024, sb = b % 1024, swz = sb ^ (((sb >> 9) & 1) << 5); R = (st >> 1) * 16 + swz / 64; C = (st & 1) * 32 + (swz % 64) / 2; }
__host__ __device__ __forceinline__ int perm32(int rho) { const int n = rho >> 4, i = rho & 15; return 8 * (i >> 2) + 4 * n + (i & 3); }

struct Unit { int pm, pn; };
struct Gemm { const bf16_t* A; const bf16_t* Bt; int M, N, K; };

struct StaticOrder {
    int nM, nN, nwg, G, c;
    __host__ __device__ void init(int M, int N, int G_, int c_) { nM = M / BM; nN = N / BM; nwg = nM * nN; G = G_; c = c_; }
    __host__ __device__ bool next(int i, Unit& u) const {
        const long L = (long)i * G + c; if (L >= nwg) return false;
        int wgid = (int)L; { const int q = nwg / NXCD, r = nwg % NXCD, xcd = wgid % NXCD, off = wgid / NXCD; wgid = (xcd < r ? xcd * (q + 1) : r * (q + 1) + (xcd - r) * q) + off; }
        const int nig = WGM * nN, gid = wgid / nig, fm = gid * WGM, gsz = (nM - fm) < WGM ? (nM - fm) : WGM;
        u.pm = fm + ((wgid % nig) % gsz); u.pn = (wgid % nig) / gsz; return true;
    }
    __device__ __forceinline__ void a_ready(const Unit&) const {}
    __device__ __forceinline__ void done(const Unit&) const {}
};

__device__ __forceinline__ unsigned cvt_pk_bf16(float lo, float hi) { unsigned r; asm volatile("v_cvt_pk_bf16_f32 %0, %1, %2" : "=v"(r) : "v"(lo), "v"(hi)); return r; }
typedef float f32x2 __attribute__((ext_vector_type(2)));
template <int ACT  > struct EpiBf16S {
    static constexpr bool PERM = true, AFTER_DRAIN = false;
    bf16_t* O; int ldc; const float* ss;
    __device__ __forceinline__ void operator()(const f32x4 (&acc)[2][2][4][2], const Unit& u, int wr, int wc, int fr, int fq) const {
        const int row0 = u.pm * BM + wr * 64 + fr; const int col0 = u.pn * BM + wc * 32 + 8 * fq;
        f32x4 sp[8]; float rs[8];
#pragma unroll
        for (int g = 0; g < 8; ++g) sp[g] = *(const f32x4*)(ss + (size_t)(row0 + (g >> 2) * HALF + (g & 3) * 16) * 16 + fq * 4);
#pragma unroll
        for (int g = 0; g < 8; ++g) { float t = (sp[g].x + sp[g].y) + (sp[g].z + sp[g].w); t += __shfl_xor(t, 16); t += __shfl_xor(t, 32); rs[g] = 1.0f / sqrtf(t * (1.0f / 1024.0f) + 1e-6f); }
#pragma unroll
        for (int ai = 0; ai < 2; ++ai)
#pragma unroll
            for (int m = 0; m < 4; ++m) { bf16_t* rowp = O + (size_t)(row0 + ai * HALF + m * 16) * ldc + col0; const float r_ = rs[ai * 4 + m];
#pragma unroll
                for (int bj = 0; bj < 2; ++bj) { f32x4 v0 = acc[ai][bj][m][0] * r_, v1 = acc[ai][bj][m][1] * r_;
                    if (ACT == 2) {
#pragma unroll
                        for (int e = 0; e < 4; ++e) { float a = v0[e] > 0.f ? v0[e] : 0.f; v0[e] = a * a; float b = v1[e] > 0.f ? v1[e] : 0.f; v1[e] = b * b; } }
                    u32x4 w; w.x = cvt_pk_bf16(v0[0], v0[1]); w.y = cvt_pk_bf16(v0[2], v0[3]); w.z = cvt_pk_bf16(v1[0], v1[1]); w.w = cvt_pk_bf16(v1[2], v1[3]);
                    __builtin_nontemporal_store(w, (u32x4*)(rowp + bj * HALF)); } }
    }
};
template <bool BASE_F32> struct EpiResBf16 {
    static constexpr bool PERM = true, AFTER_DRAIN = false;
    const float* basef; bf16_t* xb; int ldc; float* ss;
    __device__ __forceinline__ void operator()(const f32x4 (&acc)[2][2][4][2], const Unit& u, int wr, int wc, int fr, int fq) const {
        const int col0 = u.pn * BM + wc * 32 + 8 * fq;
        const size_t off0 = (size_t)(u.pm * BM + wr * 64 + fr) * ldc + col0;
        f32x4 cb[4], nb[4];
        auto ld = [&](size_t off, f32x4 (&d)[4]) {
            if (BASE_F32) {
#pragma unroll
                for (int q = 0; q < 4; ++q) d[q] = *(const f32x4*)(basef + off + (q >> 1) * HALF + (q & 1) * 4);
            } else {
#pragma unroll
                for (int bj = 0; bj < 2; ++bj) { const u32x4 w = *(const u32x4*)(xb + off + bj * HALF);
                    d[2 * bj] = (f32x4){__uint_as_float(w.x << 16), __uint_as_float(w.x & 0xffff0000u), __uint_as_float(w.y << 16), __uint_as_float(w.y & 0xffff0000u)};
                    d[2 * bj + 1] = (f32x4){__uint_as_float(w.z << 16), __uint_as_float(w.z & 0xffff0000u), __uint_as_float(w.w << 16), __uint_as_float(w.w & 0xffff0000u)}; }
            }
        };
        ld(off0, cb);
#pragma unroll
        for (int g = 0; g < 8; ++g) { const int ai = g >> 2, m = g & 3; const size_t off = off0 + (size_t)(ai * HALF + m * 16) * ldc; const int r = u.pm * BM + ai * HALF + wr * 64 + m * 16 + fr;
            if (g < 7) ld(off0 + (size_t)(((g + 1) >> 2) * HALF + ((g + 1) & 3) * 16) * ldc, nb);
            float sq = 0.f;
#pragma unroll
            for (int bj = 0; bj < 2; ++bj) { const size_t idx = off + bj * HALF;
                const f32x4 o0 = cb[2 * bj] + acc[ai][bj][m][0], o1 = cb[2 * bj + 1] + acc[ai][bj][m][1];
                sq += ((o0[0] * o0[0] + o0[1] * o0[1]) + (o0[2] * o0[2] + o0[3] * o0[3])) + ((o1[0] * o1[0] + o1[1] * o1[1]) + (o1[2] * o1[2] + o1[3] * o1[3]));
                u32x4 w; w.x = cvt_pk_bf16(o0[0], o0[1]); w.y = cvt_pk_bf16(o0[2], o0[3]); w.z = cvt_pk_bf16(o1[0], o1[1]); w.w = cvt_pk_bf16(o1[2], o1[3]);
                *(u32x4*)(xb + idx) = w; }
            sq += __shfl_xor(sq, 16); sq += __shfl_xor(sq, 32);
            if (fq == 0) ss[(size_t)r * 16 + u.pn * 4 + wc] = sq;
#pragma unroll
            for (int q = 0; q < 4; ++q) cb[q] = nb[q];
            asm volatile("" ::: "memory"); }
    }
};
template <class Epi, class Sched, bool ALIGN_EPI = false, bool SP2 = false>
__device__ __forceinline__ void gemm_phase(PG8_LAS unsigned char* lds, const Gemm g, const Sched& S, const Epi& E) {
    int tid_ = threadIdx.x; asm volatile("" : "+v"(tid_)); const int tid = tid_, wid = __builtin_amdgcn_readfirstlane(tid >> 6), lane = tid & 63, wr = wid >> 2, wc = wid & 3, fr = lane & 15, fq = lane >> 4;
    const int K = g.K, nt = K / BK;
    unsigned voffA[2], voffB[2];
#pragma unroll
    for (int i = 0; i < 2; ++i) { int R, C; stage_rc(tid * 16 + i * 8192, R, C); const int Rb = Epi::PERM ? ((R & ~31) + perm32(R & 31)) : R;
        voffA[i] = (unsigned)(R * K + C) * 2u; voffB[i] = (unsigned)(Rb * K + C) * 2u; }
    const size_t kstep = (size_t)(BK * 2);
    const size_t hstep = (size_t)HALF * K * 2;
    const size_t tstep = 2 * hstep;
    const unsigned ldsw = (unsigned)wid * 1024u;
    const int aoff = lds_byte(wr * 64 + fr, fq * 8), boff = lds_byte(wc * 32 + fr, fq * 8);
#define PG8_SA(b, h) (((b) * 2 + (h)) * HTB)
#define PG8_SB(b, h) ((4 + (b) * 2 + (h)) * HTB)
#define PG8_STAGE(bufoff, gbase, voff) do { _Pragma("unroll") for (int _i = 0; _i < 2; ++_i) \
        __builtin_amdgcn_global_load_lds((const unsigned*)((const char*)(gbase) + (voff)[_i]), (PG8_LAS unsigned*)(lds + (bufoff) + ldsw + _i * 8192), 16, 0, 0); } while (0)
#define PG8_LDA(dst, b, h) do { _Pragma("unroll") for (int m = 0; m < 4; ++m) _Pragma("unroll") for (int k = 0; k < 2; ++k) dst[m][k] = *(const PG8_LAS bf16x8*)(lds + PG8_SA(b, h) + aoff + m * 2048 + k * 1024); } while (0)
#define PG8_LDB(dst, b, h) do { _Pragma("unroll") for (int n = 0; n < 2; ++n) _Pragma("unroll") for (int k = 0; k < 2; ++k) dst[n][k] = *(const PG8_LAS bf16x8*)(lds + PG8_SB(b, h) + boff + n * 2048 + k * 1024); } while (0)
#define PG8_MMA(ai, bj, At, Bt) do { __builtin_amdgcn_s_setprio(1); _Pragma("unroll") for (int m = 0; m < 4; ++m) _Pragma("unroll") for (int n = 0; n < 2; ++n) _Pragma("unroll") for (int k = 0; k < 2; ++k) \
        acc[ai][bj][m][n] = __builtin_amdgcn_mfma_f32_16x16x32_bf16(Bt[n][k], At[m][k], acc[ai][bj][m][n], 0, 0, 0); __builtin_amdgcn_s_setprio(0); } while (0)
#define PG8_WAIT_V(n) asm volatile("s_waitcnt vmcnt(" #n ")" ::: "memory")
#define PG8_WAIT_L(n) asm volatile("s_waitcnt lgkmcnt(" #n ")" ::: "memory")
#define PG8_BAR __builtin_amdgcn_s_barrier()
#define PG8_SCHED __builtin_amdgcn_sched_barrier(0)
    Unit cur, nxt; int ui = 0;
    if (!S.next(0, cur)) return;
    f32x4 acc[2][2][4][2];
#pragma unroll
    for (int a = 0; a < 2; ++a)
#pragma unroll
        for (int b = 0; b < 2; ++b)
#pragma unroll
            for (int m = 0; m < 4; ++m)
#pragma unroll
                for (int n = 0; n < 2; ++n) acc[a][b][m][n] = (f32x4){0.f, 0.f, 0.f, 0.f};
    bf16x8 At[4][2], B0[2][2], B1[2][2];
    const char* cA = (const char*)g.A + (size_t)cur.pm * tstep; const char* cB = (const char*)g.Bt + (size_t)cur.pn * tstep;
    S.a_ready(cur);
    if constexpr (SP2) {
        PG8_STAGE(PG8_SB(0, 0), cB, voffB); PG8_STAGE(PG8_SB(0, 1), cB + hstep, voffB); PG8_STAGE(PG8_SA(0, 0), cA, voffA); PG8_STAGE(PG8_SA(0, 1), cA + hstep, voffA);
        if (wr == 1) PG8_BAR;
        PG8_WAIT_V(2); PG8_BAR;
        PG8_STAGE(PG8_SB(1, 0), cB + kstep, voffB); PG8_STAGE(PG8_SA(1, 0), cA + kstep, voffA); PG8_STAGE(PG8_SB(1, 1), cB + hstep + kstep, voffB);
        PG8_WAIT_V(6); PG8_BAR;
    } else {
        PG8_STAGE(PG8_SB(0, 0), cB, voffB); PG8_STAGE(PG8_SA(0, 0), cA, voffA); PG8_STAGE(PG8_SB(0, 1), cB + hstep, voffB); PG8_STAGE(PG8_SA(0, 1), cA + hstep, voffA);
        if (wr == 1) PG8_BAR;
        PG8_WAIT_V(4); PG8_BAR;
        PG8_STAGE(PG8_SB(1, 0), cB + kstep, voffB); PG8_STAGE(PG8_SA(1, 0), cA + kstep, voffA); PG8_STAGE(PG8_SB(1, 1), cB + hstep + kstep, voffB);
        PG8_WAIT_V(6); PG8_BAR;
    }
    for (;;) {
        const bool has_next = S.next(ui + 1, nxt);
        const char* nA = has_next ? (const char*)g.A + (size_t)nxt.pm * tstep : cA; const char* nB = has_next ? (const char*)g.Bt + (size_t)nxt.pn * tstep : cB;
        for (int t = 0; t < nt; t += 2) {
            const bool last = (t == nt - 2);
            const char* a1 = cA + (size_t)(t + 1) * kstep;
            const char* a2 = last ? nA : cA + (size_t)(t + 2) * kstep; const char* b2 = last ? nB : cB + (size_t)(t + 2) * kstep;
            const char* a3 = a2 + kstep; const char* b3 = b2 + kstep;
            if (last && has_next) S.a_ready(nxt);
            if constexpr (SP2) {
            PG8_LDB(B0, 0, 0); PG8_LDB(B1, 0, 1); PG8_SCHED; PG8_LDA(At, 0, 0); PG8_STAGE(PG8_SA(1, 1), a1 + hstep, voffA);
            PG8_WAIT_V(8); PG8_WAIT_L(0); PG8_BAR; PG8_MMA(0, 0, At, B0); PG8_MMA(0, 1, At, B1); PG8_BAR; PG8_SCHED;
            PG8_LDA(At, 0, 1); PG8_STAGE(PG8_SB(0, 0), b2, voffB); PG8_STAGE(PG8_SB(0, 1), b2 + hstep, voffB); PG8_STAGE(PG8_SA(0, 0), a2, voffA);
            PG8_WAIT_V(8); PG8_WAIT_L(0); PG8_BAR; PG8_MMA(1, 0, At, B0); PG8_MMA(1, 1, At, B1); PG8_BAR; PG8_SCHED;
            PG8_LDB(B0, 1, 0); PG8_LDB(B1, 1, 1); PG8_SCHED; PG8_LDA(At, 1, 0); PG8_STAGE(PG8_SA(0, 1), a2 + hstep, voffA);
            PG8_WAIT_V(8); PG8_WAIT_L(0); PG8_BAR; PG8_MMA(0, 0, At, B0); PG8_MMA(0, 1, At, B1); PG8_BAR; PG8_SCHED;
            PG8_LDA(At, 1, 1); PG8_STAGE(PG8_SB(1, 0), b3, voffB); PG8_STAGE(PG8_SB(1, 1), b3 + hstep, voffB); PG8_STAGE(PG8_SA(1, 0), a3, voffA);
            PG8_WAIT_V(8); PG8_WAIT_L(0); PG8_BAR; PG8_MMA(1, 0, At, B0); PG8_MMA(1, 1, At, B1); PG8_BAR; PG8_SCHED;
            } else {
            PG8_LDB(B0, 0, 0); PG8_SCHED; PG8_LDA(At, 0, 0); PG8_STAGE(PG8_SA(1, 1), a1 + hstep, voffA);
            PG8_WAIT_L(8); PG8_BAR; PG8_WAIT_L(0); PG8_MMA(0, 0, At, B0); PG8_BAR; PG8_SCHED;
            PG8_LDB(B1, 0, 1); PG8_STAGE(PG8_SB(0, 0), b2, voffB);
            PG8_BAR; PG8_WAIT_L(0); PG8_MMA(0, 1, At, B1); PG8_BAR;
            PG8_LDA(At, 0, 1); PG8_STAGE(PG8_SA(0, 0), a2, voffA);
            PG8_BAR; PG8_WAIT_L(0); PG8_MMA(1, 0, At, B0); PG8_BAR; PG8_SCHED;
            PG8_STAGE(PG8_SB(0, 1), b2 + hstep, voffB);
            PG8_WAIT_V(6); PG8_BAR; PG8_MMA(1, 1, At, B1); PG8_BAR;
            PG8_LDB(B0, 1, 0); PG8_SCHED; PG8_LDA(At, 1, 0); PG8_STAGE(PG8_SA(0, 1), a2 + hstep, voffA);
            PG8_WAIT_L(8); PG8_BAR; PG8_WAIT_L(0); PG8_MMA(0, 0, At, B0); PG8_BAR; PG8_SCHED;
            PG8_LDB(B1, 1, 1); PG8_STAGE(PG8_SB(1, 0), b3, voffB);
            PG8_BAR; PG8_WAIT_L(0); PG8_MMA(0, 1, At, B1); PG8_BAR;
            PG8_LDA(At, 1, 1); PG8_STAGE(PG8_SA(1, 0), a3, voffA);
            PG8_BAR; PG8_WAIT_L(0); PG8_MMA(1, 0, At, B0); PG8_BAR; PG8_SCHED;
            PG8_STAGE(PG8_SB(1, 1), b3 + hstep, voffB);
            PG8_WAIT_V(6); PG8_BAR; PG8_MMA(1, 1, At, B1); PG8_BAR;
            }
        }
        if constexpr (ALIGN_EPI) { if (wr == 0) PG8_BAR; }
        if constexpr (!Epi::AFTER_DRAIN) { E(acc, cur, wr, wc, fr, fq); S.done(cur); }
        if (!has_next) break;
#pragma unroll
        for (int a = 0; a < 2; ++a)
#pragma unroll
            for (int b = 0; b < 2; ++b)
#pragma unroll
                for (int m = 0; m < 4; ++m)
#pragma unroll
                    for (int n = 0; n < 2; ++n) acc[a][b][m][n] = (f32x4){0.f, 0.f, 0.f, 0.f};
        cur = nxt; cA = nA; cB = nB; ++ui;
        if constexpr (ALIGN_EPI) { if (wr == 1) PG8_BAR; }
    }
    PG8_WAIT_V(0);
    if constexpr (!ALIGN_EPI) { if (wr == 0) PG8_BAR; }
    PG8_BAR;
    if constexpr (Epi::AFTER_DRAIN) { E.fused(acc, cur, wr, wc, fr, fq, lds, wid, lane); S.done(cur); }
#undef PG8_SA
#undef PG8_SB
#undef PG8_STAGE
#undef PG8_LDA
#undef PG8_LDB
#undef PG8_MMA
#undef PG8_WAIT_V
#undef PG8_WAIT_L
#undef PG8_BAR
#undef PG8_SCHED
}
}

#define PG8_SP2 true
#define PG8_ALIGN true
namespace attn_body {
using bf16=__hip_bfloat16;
using bf16x8=__attribute__((ext_vector_type(8)))short;
using s16x4=__attribute__((ext_vector_type(4)))short;
using f32x16=__attribute__((ext_vector_type(16)))float;
using u32x4=__attribute__((ext_vector_type(4)))unsigned;
constexpr int BATCH=8,NHEAD=6,SEQ=4096,D=64,DM=3328,OPITCH=1024;
constexpr int NW=8,QBLK=32,QB=QBLK*NW,KVBLK=64,NQB=SEQ/QB;
constexpr int ATTN_PITCH=DM, ATTN_UNIT_ROWS=QB;
__device__ __forceinline__ int crow(int r,int hi){return (r&3)+8*(r>>2)+4*hi;}
#define SBAR() __builtin_amdgcn_sched_barrier(0)
__device__ __forceinline__ void cmask(f32x16&p0,f32x16&p1,int jb,int qrel,int hi){
  const float NEG=-INFINITY; int kb=64*jb+4*hi;
  #pragma unroll
  for(int r=0;r<16;++r){int kv=kb+(r&3)+8*(r>>2); if(kv>qrel)p0[r]=NEG; if(kv+32>qrel)p1[r]=NEG;}
}

constexpr int NSLOT=3, SLOTB=8192;
constexpr int LDS_K=0, LDS_V=NSLOT*SLOTB, LDS_WS=2*NSLOT*SLOTB, LDS_OST=LDS_WS+NW*64*4, LDS_OST1=LDS_OST+NW*4096, LDS_BYTES=LDS_OST1+NW*4096;
constexpr float C2=0.17677669529663687f*1.4426950408889634f;
__device__ __forceinline__ void glds16(const void*gsrc,unsigned lds_dst){unsigned keep;
  asm volatile("s_mov_b32 %0, m0\n\ts_mov_b32 m0, %2\n\ts_nop 0\n\tglobal_load_lds_dwordx4 %1, off\n\ts_mov_b32 m0, %0":"=&s"(keep):"v"(gsrc),"s"(lds_dst):"memory");}
__device__ __forceinline__ float max3f(float a,float b,float c){float r;asm("v_max3_f32 %0, %1, %2, %3":"=v"(r):"v"(a),"v"(b),"v"(c));return r;}
__device__ __forceinline__ float max2f(float a,float b){float r;asm("v_max_f32_e32 %0, %1, %2":"=v"(r):"v"(a),"v"(b));return r;}
__device__ __forceinline__ float fadd_s(float a,float b){float r;asm("v_add_f32_e32 %0, %1, %2":"=v"(r):"v"(a),"v"(b));return r;}
__device__ __forceinline__ float fsub_s(float a,float b){float r;asm("v_sub_f32_e32 %0, %1, %2":"=v"(r):"v"(a),"v"(b));return r;}
typedef float f32x2_t __attribute__((ext_vector_type(2))); typedef __bf16 bf16x2_t __attribute__((ext_vector_type(2)));
__device__ __forceinline__ unsigned cvtpk_s(float lo,float hi){f32x2_t v={lo,hi};bf16x2_t b=__builtin_convertvector(v,bf16x2_t);return __builtin_bit_cast(unsigned,b);}
#define WAIT_BAR(N) asm volatile("s_waitcnt vmcnt(" #N ") lgkmcnt(0)\n\ts_barrier":::"memory")

__device__ __forceinline__ void qkt(f32x16&p0,f32x16&p1,const char*Kslot,const bf16x8*qr,const f32x16&negm,int r32,int hi){
  const char*kb=Kslot+hi*1024+r32*16;
  #pragma unroll
  for(int d0=0;d0<4;++d0){
    const bf16x8 b0=*reinterpret_cast<const bf16x8*>(kb+d0*2048);
    const bf16x8 b1=*reinterpret_cast<const bf16x8*>(kb+d0*2048+512);
    if(d0==0){p0=__builtin_amdgcn_mfma_f32_32x32x16_bf16(b0,qr[0],negm,0,0,0);p1=__builtin_amdgcn_mfma_f32_32x32x16_bf16(b1,qr[0],negm,0,0,0);}
    else{p0=__builtin_amdgcn_mfma_f32_32x32x16_bf16(b0,qr[d0],p0,0,0,0);p1=__builtin_amdgcn_mfma_f32_32x32x16_bf16(b1,qr[d0],p1,0,0,0);}}
}
typedef __attribute__((address_space(3))) const char* lds_cptr;
typedef short v4i16_t __attribute__((ext_vector_type(4)));
__device__ __forceinline__ void kload8(bf16x8*kf,lds_cptr kp){
  kf[0]=*(const __attribute__((address_space(3))) bf16x8*)(kp);      kf[1]=*(const __attribute__((address_space(3))) bf16x8*)(kp+512);
  kf[2]=*(const __attribute__((address_space(3))) bf16x8*)(kp+2048); kf[3]=*(const __attribute__((address_space(3))) bf16x8*)(kp+2560);
  kf[4]=*(const __attribute__((address_space(3))) bf16x8*)(kp+4096); kf[5]=*(const __attribute__((address_space(3))) bf16x8*)(kp+4608);
  kf[6]=*(const __attribute__((address_space(3))) bf16x8*)(kp+6144); kf[7]=*(const __attribute__((address_space(3))) bf16x8*)(kp+6656);
}
__device__ __forceinline__ void kload2(bf16x8*kf,lds_cptr kp,int j){ kf[2*j]=*(const __attribute__((address_space(3))) bf16x8*)(kp+j*2048); kf[2*j+1]=*(const __attribute__((address_space(3))) bf16x8*)(kp+j*2048+512); }
__device__ __forceinline__ s16x4 vtr(lds_cptr p){ return __builtin_bit_cast(s16x4,__builtin_amdgcn_ds_read_tr16_b64_v4i16((__attribute__((address_space(3))) v4i16_t*)p)); }
__device__ __forceinline__ float rowmax(const f32x16&p0,const f32x16&p1){
  float a=max3f(p0[0],p0[1],p1[0]),b=max3f(p0[2],p0[3],p1[1]);a=max3f(a,p1[2],p1[3]);
  #pragma unroll
  for(int r=4;r<16;r+=4){a=max3f(a,p0[r],p0[r+1]);b=max3f(b,p0[r+2],p0[r+3]);a=max3f(a,p1[r],p1[r+1]);b=max3f(b,p1[r+2],p1[r+3]);}
  const float m=max2f(a,b);
  auto rr=__builtin_amdgcn_permlane32_swap(__float_as_uint(m),__float_as_uint(m),false,false);
  return max2f(__uint_as_float(rr[0]),__uint_as_float(rr[1]));
}
__device__ __forceinline__ void pv(f32x16*o,int vb,bf16x8 pa0,bf16x8 pa1,bf16x8 pa2,bf16x8 pa3){
  #pragma unroll
  for(int d0=0;d0<2;++d0){s16x4 lo[4],hi[4];
    #pragma unroll
    for(int ks=0;ks<4;++ks){
      asm volatile("ds_read_b64_tr_b16 %0,%1 offset:%c2":"=&v"(lo[ks]):"v"(vb),"i"(d0*4096+ks*1024):"memory");
      asm volatile("ds_read_b64_tr_b16 %0,%1 offset:%c2":"=&v"(hi[ks]):"v"(vb),"i"(d0*4096+ks*1024+512):"memory");}
    asm volatile("s_waitcnt lgkmcnt(0)":::"memory");SBAR();
    #define PK(k) (bf16x8){lo[k][0],lo[k][1],lo[k][2],lo[k][3],hi[k][0],hi[k][1],hi[k][2],hi[k][3]}
    o[d0]=__builtin_amdgcn_mfma_f32_32x32x16_bf16(pa0,PK(0),o[d0],0,0,0);
    o[d0]=__builtin_amdgcn_mfma_f32_32x32x16_bf16(pa1,PK(1),o[d0],0,0,0);
    o[d0]=__builtin_amdgcn_mfma_f32_32x32x16_bf16(pa2,PK(2),o[d0],0,0,0);
    o[d0]=__builtin_amdgcn_mfma_f32_32x32x16_bf16(pa3,PK(3),o[d0],0,0,0);
    #undef PK
  }
}

#ifndef ATTN_STORE16
#define ATTN_STORE16(p,v) __builtin_nontemporal_store((v),(u32x4*)(p))
#endif
template<int THRL> __device__ __forceinline__ void attn_unit(int b,int h,int qb,int nsel,float lam,const float*subg,float omli,const bf16*Q,const bf16*__restrict__ K,const bf16*__restrict__ V,bf16*O,char*shm){
  int tid_=threadIdx.x; asm volatile("":"+v"(tid_)); const int tid=tid_,lane=tid&63,r32=lane&31,hi=lane>>5; const int wid=__builtin_amdgcn_readfirstlane(tid>>6);
  const long rowbase=(long)b*SEQ; const int q0=qb*QB;
  const bf16*Qw=Q+(rowbase+q0+wid*QBLK)*DM+h*D;
  const bf16*Kh=K+rowbase*DM+h*D,*Vh=V+rowbase*DM+h*D;
  const unsigned lds0=(unsigned)(uintptr_t)shm;
  float*wsf=(float*)(shm+LDS_WS)+wid*64;
  const bf16*ksrc=Kh+(long)lane*DM+wid*8;
  const bf16*vsrc=Vh+(long)(16*(wid&3)+(lane>>2))*DM+(wid>>2)*32+(lane&3)*8;
  const unsigned kdst=lds0+LDS_K+wid*1024, vdst=lds0+LDS_V+wid*1024;
  #define DMA_K(t,slot) glds16(ksrc+(long)(t)*KVBLK*DM,(unsigned)__builtin_amdgcn_readfirstlane(kdst+(slot)))
  #define DMA_V(t,slot) glds16(vsrc+(long)(t)*KVBLK*DM,(unsigned)__builtin_amdgcn_readfirstlane(vdst+(slot)))
  const int vb0=(int)(lds0+LDS_V)+((lane>>4)&1)*32+(lane&3)*8+(4*hi+((lane&15)>>2))*64;
  const char*Kbase=shm+LDS_K; bf16x8 kf[8];
  const lds_cptr shm3=(lds_cptr)shm; const lds_cptr kp0=shm3+LDS_K+hi*1024+r32*16; const lds_cptr vp0=shm3+LDS_V+((lane>>4)&1)*32+(lane&3)*8+(4*hi+((lane&15)>>2))*64;
  const int NT=(q0+QB)/KVBLK;
  DMA_K(0,0);DMA_V(0,0);DMA_K(1,SLOTB);
  bf16x8 qr[4];
  #pragma unroll
  for(int d0=0;d0<4;++d0){qr[d0]=*reinterpret_cast<const bf16x8*>(&Qw[(long)r32*DM+d0*16+hi*8]); if((d0>>1)!=nsel)qr[d0]=bf16x8{0,0,0,0,0,0,0,0};}
  float mhat=0.f,l_reg=0.f;f32x16 o[2];o[0]=f32x16{};o[1]=f32x16{};f32x16 negm=f32x16{};asm volatile("":"+v"(negm));
  const int qrel=wid*QBLK+r32;
  #define CMASK(P0,P1,t) do{int jb_=(t)-(NT-4); if(jb_>=0)cmask(P0,P1,jb_,qrel,hi);}while(0)
  bool resc=false;
  #define START(P0,P1) do{ const float rm=rowmax(P0,P1); resc=false; \
    { const float dl=rm; mhat=fadd_s(mhat,dl); \
      _Pragma("unroll") for(int r=0;r<16;++r){P0[r]=fsub_s(P0[r],dl);P1[r]=fsub_s(P1[r],dl);} \
      _Pragma("unroll") for(int r=0;r<16;++r)negm[r]=-mhat; asm volatile("":"+v"(negm)); } \
    _Pragma("unroll") for(int r=0;r<16;++r)P0[r]=__builtin_amdgcn_exp2f(P0[r]); }while(0)
  #define RESC() do{ if(resc){ asm volatile("s_waitcnt lgkmcnt(0)":::"memory"); \
      _Pragma("unroll") for(int d_=0;d_<2;++d_) _Pragma("unroll") for(int r=0;r<16;++r)o[d_][r]*=wsf[crow(r,hi)]; } }while(0)
  f32x16 pA0,pA1,pB0,pB1;
  int sl_prev=0,sl_cur=0,sl_next=SLOTB;
  #define ROT() do{sl_prev=sl_cur;sl_cur=sl_next;sl_next=(sl_next==(NSLOT-1)*SLOTB)?0:sl_next+SLOTB;}while(0)
  DMA_K(2,2*SLOTB);
  WAIT_BAR(3);
  qkt(pA0,pA1,Kbase,qr,negm,r32,hi);asm volatile("s_nop 15\n\ts_nop 7":"+v"(pA0),"+v"(pA1));CMASK(pA0,pA1,0);
  START(pA0,pA1);
  _Pragma("unroll") for(int r=0;r<16;++r)pA1[r]=__builtin_amdgcn_exp2f(pA1[r]);
  WAIT_BAR(0);
  DMA_K(3,0);DMA_V(1,SLOTB);
  ROT();
  kload8(kf,kp0+sl_cur);
  WAIT_BAR(2);
  s16x4 vlo[8],vhi[8]; u32x4 pw0,pw1,pw2,pw3;
  #define PKW(P,B) cvtpk_s(P[B],P[B+1])
  #define PAF(k) __builtin_bit_cast(bf16x8,pw##k)
  #define VFR(i) (bf16x8){vlo[i][0],vlo[i][1],vlo[i][2],vlo[i][3],vhi[i][0],vhi[i][1],vhi[i][2],vhi[i][3]}
  #define PIN(x) asm volatile("":"+v"(x))
  #define MX3(a,b,c) __builtin_fmaxf(__builtin_fmaxf((a),(b)),(c))
  #define GAPA(MF,A0,A1,A2,A3,W0,W1,PW) do{ MF; sacc+=A0; sacc+=A1; sacc+=A2; sacc+=A3; PIN(sacc); W0; W1; PIN(PW); SBAR(); }while(0)
  #define EX(v) __builtin_amdgcn_exp2f(v)
  #define GAPB(MF,X,B) do{ MF; X[B]=EX(X[B]); X[B+1]=EX(X[B+1]); X[B+2]=EX(X[B+2]); X[B+3]=EX(X[B+3]); PIN(X); SBAR(); }while(0)
  #define VRD(i) do{ vlo[i]=vtr(vp_+(((i)>>2)*4096+((i)&3)*1024)); vhi[i]=vtr(vp_+(((i)>>2)*4096+((i)&3)*1024+512)); }while(0)
  #define KRD(G,j) do{ if(G){ kload2(kf,kp0+sl_next,j); SBAR(); } }while(0)
  #define STEP(C0,C1,P0,P1,t,GK,GV,GL) do{ SBAR(); \
    const lds_cptr vp_=vp0+sl_prev; \
    VRD(0); SBAR(); float sacc=(P0[0]+P0[1]); \
    GAPA(C0=__builtin_amdgcn_mfma_f32_32x32x16_bf16(kf[0],qr[0],negm,0,0,0), P0[2],P0[3],P0[4],P0[5],     pw0[0]=PKW(P0,0), pw0[1]=PKW(P0,2), pw0); \
    VRD(4); SBAR(); GAPA(C1=__builtin_amdgcn_mfma_f32_32x32x16_bf16(kf[1],qr[0],negm,0,0,0), P0[6],P0[7],P0[8],P0[9],     pw0[2]=PKW(P0,4), pw0[3]=PKW(P0,6), pw0); \
    VRD(1); SBAR(); GAPA(C0=__builtin_amdgcn_mfma_f32_32x32x16_bf16(kf[2],qr[1],C0,0,0,0),   P0[10],P0[11],P0[12],P0[13], pw1[0]=PKW(P0,8), pw1[1]=PKW(P0,10), pw1); \
    VRD(5); SBAR(); GAPA(C1=__builtin_amdgcn_mfma_f32_32x32x16_bf16(kf[3],qr[1],C1,0,0,0),   P0[14],P0[15],P1[0],P1[1],   pw1[2]=PKW(P0,12),pw1[3]=PKW(P0,14), pw1); \
    VRD(2); SBAR(); GAPA(C0=__builtin_amdgcn_mfma_f32_32x32x16_bf16(kf[4],qr[2],C0,0,0,0),   P1[2],P1[3],P1[4],P1[5],     pw2[0]=PKW(P1,0), pw2[1]=PKW(P1,2), pw2); \
    VRD(6); SBAR(); GAPA(C1=__builtin_amdgcn_mfma_f32_32x32x16_bf16(kf[5],qr[2],C1,0,0,0),   P1[6],P1[7],P1[8],P1[9],     pw2[2]=PKW(P1,4), pw2[3]=PKW(P1,6), pw2); \
    VRD(3); SBAR(); GAPA(C0=__builtin_amdgcn_mfma_f32_32x32x16_bf16(kf[6],qr[3],C0,0,0,0),   P1[10],P1[11],P1[12],P1[13], pw3[0]=PKW(P1,8), pw3[1]=PKW(P1,10), pw3); \
    VRD(7); SBAR(); GAPA(C1=__builtin_amdgcn_mfma_f32_32x32x16_bf16(kf[7],qr[3],C1,0,0,0),   P1[14],P1[15],0.f,0.f,       pw3[2]=PKW(P1,12),pw3[3]=PKW(P1,14), pw3); \
    l_reg+=sacc; \
    if(GK){DMA_K((t)+3,sl_cur);} if(GV){DMA_V((t)+1,sl_next);} \
    CMASK(C0,C1,t); \
    { float a=MX3(C0[0],C0[1],C1[0]),b=MX3(C0[2],C0[3],C1[1]); a=MX3(a,C1[2],C1[3]); \
      _Pragma("unroll") for(int r=4;r<16;r+=4){a=MX3(a,C0[r],C0[r+1]);b=MX3(b,C0[r+2],C0[r+3]);a=MX3(a,C1[r],C1[r+1]);b=MX3(b,C1[r+2],C1[r+3]);} \
      float rm=__builtin_fmaxf(a,b); { auto rr=__builtin_amdgcn_permlane32_swap(__float_as_uint(rm),__float_as_uint(rm),false,false); rm=__builtin_fmaxf(__uint_as_float(rr[0]),__uint_as_float(rr[1])); } \
      resc=false; \
      if(__builtin_expect(__any(rm>(float)THRL),0)){ const float dl=__builtin_fmaxf(rm,0.f); mhat+=dl; \
        _Pragma("unroll") for(int r=0;r<16;++r){C0[r]-=dl;C1[r]-=dl;} \
        _Pragma("unroll") for(int r=0;r<16;++r)negm[r]=-mhat; asm volatile("":"+v"(negm)); \
        const float f=__builtin_amdgcn_exp2f(-dl); l_reg*=f; if(hi==0)wsf[r32]=f; resc=true; } } \
    SBAR(); \
    GAPB(o[0]=__builtin_amdgcn_mfma_f32_32x32x16_bf16(PAF(0),VFR(0),o[0],0,0,0), C0,0); \
    GAPB(o[1]=__builtin_amdgcn_mfma_f32_32x32x16_bf16(PAF(0),VFR(4),o[1],0,0,0), C0,4); \
    KRD(GL,0); GAPB(o[0]=__builtin_amdgcn_mfma_f32_32x32x16_bf16(PAF(1),VFR(1),o[0],0,0,0), C0,8); \
    KRD(GL,1); GAPB(o[1]=__builtin_amdgcn_mfma_f32_32x32x16_bf16(PAF(1),VFR(5),o[1],0,0,0), C0,12); \
    KRD(GL,2); GAPB(o[0]=__builtin_amdgcn_mfma_f32_32x32x16_bf16(PAF(2),VFR(2),o[0],0,0,0), C1,0); \
    KRD(GL,3); GAPB(o[1]=__builtin_amdgcn_mfma_f32_32x32x16_bf16(PAF(2),VFR(6),o[1],0,0,0), C1,4); \
    GAPB(o[0]=__builtin_amdgcn_mfma_f32_32x32x16_bf16(PAF(3),VFR(3),o[0],0,0,0), C1,8); \
    GAPB(o[1]=__builtin_amdgcn_mfma_f32_32x32x16_bf16(PAF(3),VFR(7),o[1],0,0,0), C1,12); \
    }while(0)
  int t=1;
  #undef CMASK
  #define CMASK(P0,P1,t) do{}while(0)
  for(;t+5<NT;t+=2){
    STEP(pB0,pB1,pA0,pA1,t,true,true,true);     WAIT_BAR(2); RESC(); ROT();
    STEP(pA0,pA1,pB0,pB1,t+1,true,true,true);   WAIT_BAR(2); RESC(); ROT();
  }
  #undef CMASK
  #define CMASK(P0,P1,t) do{int jb_=(t)-(NT-4); if(jb_>=0)cmask(P0,P1,jb_,qrel,hi);}while(0)
  #define ENDW(tt) do{ if((tt)+3<NT){WAIT_BAR(2);} else if((tt)+2<NT){WAIT_BAR(1);} else {WAIT_BAR(0);} }while(0)
  for(;t+1<NT;t+=2){
    STEP(pB0,pB1,pA0,pA1,t,(t+3<NT),(t+1<NT),(t+1<NT));       ENDW(t);   RESC(); ROT();
    STEP(pA0,pA1,pB0,pB1,t+1,(t+4<NT),(t+2<NT),(t+2<NT));     ENDW(t+1); RESC(); ROT();
  }
  STEP(pB0,pB1,pA0,pA1,NT-1,false,false,false); RESC();
  { float sacc=pB0[0]+pB0[1]; _Pragma("unroll") for(int r=2;r<16;++r)sacc+=pB0[r]; _Pragma("unroll") for(int r=0;r<16;++r)sacc+=pB1[r]; l_reg+=sacc;
    pw0=(u32x4){PKW(pB0,0),PKW(pB0,2),PKW(pB0,4),PKW(pB0,6)};pw1=(u32x4){PKW(pB0,8),PKW(pB0,10),PKW(pB0,12),PKW(pB0,14)};pw2=(u32x4){PKW(pB1,0),PKW(pB1,2),PKW(pB1,4),PKW(pB1,6)};pw3=(u32x4){PKW(pB1,8),PKW(pB1,10),PKW(pB1,12),PKW(pB1,14)};
    SBAR(); pv(o,vb0+sl_cur,PAF(0),PAF(1),PAF(2),PAF(3)); }
  #undef PKW
  #undef PAF
  #undef VFR
  #undef PIN
  #undef MX3
  #undef GAPA
  #undef GAPB
  #undef EX
  #undef VRD
  #undef KRD
  #undef STEP
  #undef ENDW
  {auto rr=__builtin_amdgcn_permlane32_swap(__float_as_uint(l_reg),__float_as_uint(l_reg),false,false);l_reg=__uint_as_float(rr[0])+__uint_as_float(rr[1]);}
  if(hi==0)wsf[32+r32]=l_reg;asm volatile("s_waitcnt lgkmcnt(0)":::"memory");
  float rli[16];
  #pragma unroll
  for(int r=0;r<16;++r)rli[r]=__builtin_amdgcn_rcpf(wsf[32+crow(r,hi)]);
  bf16*Ow=O+(rowbase+q0+wid*QBLK)*OPITCH+h*D;
  { bf16*stg=(bf16*)(shm+(nsel==0?LDS_OST1:LDS_OST))+wid*2048;
    #pragma unroll
    for(int r=0;r<16;++r){const int orow=crow(r,hi);
      #pragma unroll
      for(int d0=0;d0<2;++d0)stg[orow*64+d0*32+r32]=__float2bfloat16(o[d0][r]*rli[r]);}
    asm volatile("s_waitcnt lgkmcnt(0)":::"memory");
    if(nsel==1){ const bf16*stg1=(const bf16*)(shm+LDS_OST1)+wid*2048;
      #pragma unroll
      for(int i=0;i<4;++i){const int row=i*8+(lane>>3),ch=lane&7; const u32x4 v2=*(const u32x4*)(stg+row*64+ch*8); const u32x4 v1=*(const u32x4*)(stg1+row*64+ch*8);
        float dd[8]; float ss=0.f;
        #pragma unroll
        for(int j=0;j<4;++j){ const float a0=__uint_as_float(v1[j]<<16),a1=__uint_as_float(v1[j]&0xffff0000u),b0=__uint_as_float(v2[j]<<16),b1=__uint_as_float(v2[j]&0xffff0000u);
          dd[2*j]=a0-lam*b0; dd[2*j+1]=a1-lam*b1; ss+=dd[2*j]*dd[2*j]+dd[2*j+1]*dd[2*j+1]; }
        ss+=__shfl_xor(ss,1); ss+=__shfl_xor(ss,2); ss+=__shfl_xor(ss,4);
        const float rs=omli/sqrtf(ss*(1.0f/64.0f)+1e-6f);
        u32x4 w;
        #pragma unroll
        for(int j=0;j<4;++j) w[j]=cvtpk_s(dd[2*j]*rs*subg[ch*8+2*j],dd[2*j+1]*rs*subg[ch*8+2*j+1]);
        ATTN_STORE16(Ow+(long)row*OPITCH+ch*8,w);} } }
  asm volatile("s_waitcnt lgkmcnt(0)\n\ts_barrier":::"memory");
  #undef DMA_K
  #undef DMA_V
  #undef CMASK
  #undef START
  #undef RESC
  #undef ROT

}
#undef SBAR
#undef WAIT_BAR
}
#ifndef GOFF
#define GOFF 0
#endif
#define GEMMCALL0 if (!((GOFF) & 1))
#define GEMMCALL1 if (!((GOFF) & 2))
#define GEMMCALL2 if (!((GOFF) & 4))
#define GEMMCALL3 if (!((GOFF) & 8))
namespace cg = cooperative_groups;
#define GAS __attribute__((address_space(1)))
#define LAS __attribute__((address_space(3)))
#define DI __device__ __forceinline__
typedef unsigned short bf16;
typedef unsigned v4u __attribute__((ext_vector_type(4)));
typedef unsigned v2u __attribute__((ext_vector_type(2)));
typedef float f32x4 __attribute__((ext_vector_type(4)));
typedef short bf16x8 __attribute__((ext_vector_type(8)));

constexpr int NWAVES = 8;
constexpr int DMODEL = 1024, SEQ = 4096, M = 32768, NIN = 3328, FF = 4096;
constexpr int RW = 384, RCOLS = 1408, ROFF = 1920, COFF = 1152;
constexpr float NORM_EPS = 1e-6f, GN_EPS = 64e-5f;
constexpr size_t MiB = 1u << 20;
constexpr size_t WS_CTL = 0, CTL_ZERO_BYTES = 65536;
constexpr int CW_BAR = 4096;
constexpr size_t WS_SS = 128 * 1024;
constexpr size_t WS_WIN = 1 * MiB, WS_WOUT = 14 * MiB, WS_WUP = 18 * MiB, WS_WDN = 34 * MiB, WS_LORA = 50 * MiB;
constexpr size_t WS_XB = 51 * MiB, WS_PROJ = 115 * MiB, WS_MIX = 323 * MiB, WS_S = 387 * MiB, WS_END = 507 * MiB;
constexpr size_t WS_HID = 115 * MiB;
constexpr size_t WS_AUX = 48 * MiB;
constexpr size_t WS_PT = WS_AUX + 12 * MiB, WS_DOTS = WS_PT + 2 * MiB;
constexpr int NITEMS = 48 * 128;
constexpr size_t SARR = (size_t)M * RW;
constexpr int LORA_L = 384 * 64 * 2 + 384 * 128;
constexpr int LDS_BYTES = 147456, MISC_OFF = 131072;
constexpr int SCAN_WGS = 48, ATT_ITEMS = 768;

#ifndef STAG1
#define STAG1 2000u
#endif
#ifndef STAG3
#define STAG3 3000u
#endif
#ifndef PROBE
#define PROBE 0
#endif
struct Args { const float* in[25]; float* out; unsigned char* ws; int i0, i1; };

DI float wave_sum(float v) {
#pragma unroll
    for (int o = 1; o < 64; o <<= 1) v += __shfl_xor(v, o);
    return v;
}
typedef float f32x2h __attribute__((ext_vector_type(2))); typedef __bf16 bf16x2h __attribute__((ext_vector_type(2)));
DI unsigned pk2(float lo, float hi) { f32x2h v = {lo, hi}; bf16x2h b = __builtin_convertvector(v, bf16x2h); return __builtin_bit_cast(unsigned, b); }
DI unsigned f2bf(float f) { return pk2(f, 0.f) & 0xffffu; }
DI float bflo(unsigned w) { return __uint_as_float(w << 16); }
DI float bfhi(unsigned w) { return __uint_as_float(w & 0xffff0000u); }
DI float bf1(const bf16* p) { return __uint_as_float(((unsigned)*p) << 16); }
DI void unpack8(v4u w, float* f) { f[0] = bflo(w.x); f[1] = bfhi(w.x); f[2] = bflo(w.y); f[3] = bfhi(w.y); f[4] = bflo(w.z); f[5] = bfhi(w.z); f[6] = bflo(w.w); f[7] = bfhi(w.w); }
DI v4u pack8(const float* f) { v4u o; o.x = pk2(f[0], f[1]); o.y = pk2(f[2], f[3]); o.z = pk2(f[4], f[5]); o.w = pk2(f[6], f[7]); return o; }
DI float sigmoidf_(float x) { return __builtin_amdgcn_rcpf(1.f + __expf(-x)); }
DI float tanhf_(float x) { const float e = __expf(2.f * x); return 1.f - 2.f * __builtin_amdgcn_rcpf(e + 1.f); }
template <int CTRL> DI float dpp_add(float x) { return x + __int_as_float(__builtin_amdgcn_update_dpp(0, __float_as_int(x), CTRL, 0xf, 0xf, true)); }
DI float red16(float x) { x = dpp_add<0xB1>(x); x = dpp_add<0x4E>(x); x = dpp_add<0x141>(x); x = dpp_add<0x140>(x); return x; }

#define XB_TMO      128
#define XB_XCNT(j)  (256  + 64 * (j))
#define XB_XSUB(j)  (1280 + 64 * (j))
#define XB_XGEN(j)  (2304 + 64 * (j))
#define XB_TOP      3328
#define XB_TOPGEN   3392
#define XCD_BAR_WORDS 3456
#define XB_SPIN_CAP (1u << 18)

__device__ __forceinline__ unsigned xb_ld(unsigned* p)              { return __hip_atomic_load(p, __ATOMIC_RELAXED, __HIP_MEMORY_SCOPE_AGENT); }
__device__ __forceinline__ unsigned xb_add(unsigned* p, unsigned v) { return __hip_atomic_fetch_add(p, v, __ATOMIC_RELAXED, __HIP_MEMORY_SCOPE_AGENT); }
__device__ __forceinline__ unsigned xb_xcc_id() { return (unsigned)__builtin_amdgcn_s_getreg((3 << 11) | 20) & 0xFu; }
#define XB_SPIN(cond, bar) do { unsigned _sp = 0; while (cond) { __builtin_amdgcn_s_sleep(1); \
    if ((++_sp & 255u) == 0u) { if (xb_ld(&(bar)[XB_TMO])) break; if (_sp > XB_SPIN_CAP) { atomicAdd(&(bar)[XB_TMO], 1u); break; } } } } while (0)

struct XcdBarrier {
    unsigned* bar; unsigned x;
    volatile LAS unsigned* st;
};

__device__ __forceinline__ XcdBarrier xcd_barrier_post(unsigned* bar, volatile LAS unsigned* st) {
    XcdBarrier b; b.bar = bar; b.x = xb_xcc_id(); b.st = st;
    if (threadIdx.x == 0) (void)xb_add(&bar[XB_XCNT(b.x)], 1u);
    return b;
}
__device__ __forceinline__ void xcd_barrier_complete(unsigned* bar, unsigned x, unsigned& nloc, unsigned& nx) {
    const unsigned G = gridDim.x * gridDim.y * gridDim.z;
    unsigned sum, cnt, mine, sp = 0u;
    for (;;) {
        sum = 0u; cnt = 0u; mine = 0u;
#pragma unroll
        for (unsigned j = 0; j < 16; ++j) { const unsigned c = xb_ld(&bar[XB_XCNT(j)]); sum += c; cnt += (c > 0u) ? 1u : 0u; mine = (j == x) ? c : mine; }
        if (sum == G) break;
        __builtin_amdgcn_s_sleep(1);
        if ((++sp & 255u) == 0u) { if (xb_ld(&bar[XB_TMO])) break; if (sp > XB_SPIN_CAP) { atomicAdd(&bar[XB_TMO], 1u); break; } }
    }
    nloc = mine > 0u ? mine : 1u; nx = cnt > 0u ? cnt : 1u;
}

__device__ __forceinline__ void xcd_barrier(const XcdBarrier& b) {
    asm volatile("s_waitcnt vmcnt(0)" ::: "memory");
    __syncthreads();
    if (threadIdx.x == 0) {
        unsigned* bar = b.bar; unsigned bx_ = xb_xcc_id(); asm volatile("" : "+s"(bx_));
        __builtin_amdgcn_s_waitcnt(0);
        unsigned nloc = b.st[0], nx = b.st[1];
        if (nloc == 0u) { xcd_barrier_complete(bar, bx_, nloc, nx); b.st[0] = nloc; b.st[1] = nx; }
        const unsigned old = xb_add(&bar[XB_XSUB(bx_)], 1u);
        const unsigned gen = old / nloc;
        if (old + 1u == (gen + 1u) * nloc) {
            __builtin_amdgcn_fence(__ATOMIC_RELEASE, "agent");
            asm volatile("s_waitcnt vmcnt(0)" ::: "memory");
            const unsigned og = xb_add(&bar[XB_TOP], 1u);
            const unsigned tg = og / nx;
            if (og + 1u == (tg + 1u) * nx) xb_add(&bar[XB_TOPGEN], 1u);
            else XB_SPIN(xb_ld(&bar[XB_TOPGEN]) == tg, bar);
            __builtin_amdgcn_fence(__ATOMIC_ACQUIRE, "agent");
            xb_add(&bar[XB_XGEN(bx_)], 1u);
            asm volatile("s_waitcnt vmcnt(0)" ::: "memory");
        } else {
            XB_SPIN(xb_ld(&bar[XB_XGEN(bx_)]) == gen, bar);
            __builtin_amdgcn_fence(__ATOMIC_ACQUIRE, "agent");
            asm volatile("s_waitcnt vmcnt(0)" ::: "memory");
        }
    }
    __syncthreads();
}


DI void seam_arrive(unsigned* w) { asm volatile("s_waitcnt vmcnt(0)" ::: "memory"); __syncthreads();
    if (threadIdx.x == 0) { __builtin_amdgcn_fence(__ATOMIC_RELEASE, "agent"); asm volatile("s_waitcnt vmcnt(0)" ::: "memory"); (void)__hip_atomic_fetch_add(w, 1u, __ATOMIC_RELAXED, __HIP_MEMORY_SCOPE_AGENT); } }
DI void seam_wait(unsigned* w, unsigned need) {
    if (threadIdx.x == 0) { unsigned sp = 0u; while (__hip_atomic_load(w, __ATOMIC_RELAXED, __HIP_MEMORY_SCOPE_AGENT) < need) { __builtin_amdgcn_s_sleep(1); if (++sp > (1u << 22)) break; }
        __builtin_amdgcn_fence(__ATOMIC_ACQUIRE, "agent"); asm volatile("s_waitcnt vmcnt(0)" ::: "memory"); }
    __syncthreads(); }
struct Frame {
    LAS unsigned char* lds;
    int tid, lane, wave, G, gw, NGW;
    const float* const* in;
    float* out; unsigned char* ws;
};
DI const float* INP(const Frame& F, int k) { asm volatile("" : "+s"(k)); return F.in[k]; }
#define SSP(k) ((float*)((unsigned char*)F.out + 64 * MiB) + (size_t)(k) * M * 16)
#define F_WIN  ((bf16*)(F.ws + WS_WIN))
#define F_WOUT ((bf16*)(F.ws + WS_WOUT))
#define F_WUP  ((bf16*)(F.ws + WS_WUP))
#define F_WDN  ((bf16*)(F.ws + WS_WDN))
#define F_LORA ((bf16*)(F.ws + WS_LORA))
#define F_XB   ((bf16*)(F.ws + WS_XB))
#define F_PROJ ((bf16*)(F.ws + WS_PROJ))
#define F_MIX  ((bf16*)(F.ws + WS_MIX))
#define F_HID  ((bf16*)(F.ws + WS_HID))
#define F_S_r  ((bf16*)F.out)
#define F_S_ld ((bf16*)F.out + SARR)
#define F_S_k  ((bf16*)(F.ws + WS_S))
#define F_S_v  ((bf16*)(F.ws + WS_S) + SARR)
#define F_S_n  ((bf16*)(F.ws + WS_S) + 2 * SARR)
#define F_S_b  ((bf16*)(F.ws + WS_S) + 3 * SARR)
#define F_S_g  ((bf16*)(F.ws + WS_S) + 4 * SARR)
#define F_ctl  ((unsigned*)(F.ws + WS_CTL))

DI void transpose_item(const float* W, int K, int N, bf16* WT, LAS float* scr, int item, int lane, const float* gk, float cs, int csn) {
    const int nblk = N / 32, kb = item / nblk, nb = item % nblk, k0 = 64 * kb, n0 = 32 * nb;
    const float colscale = (n0 + (lane & 31) < csn) ? cs : 1.f;
#pragma unroll 8
    for (int i = 0; i < 32; ++i) { const int kk = 2 * i + (lane >> 5); float v = __builtin_nontemporal_load(&W[(size_t)(k0 + kk) * N + n0 + (lane & 31)]); if (gk) v *= gk[k0 + kk]; scr[kk * 33 + (lane & 31)] = v * colscale; }
    asm volatile("s_waitcnt lgkmcnt(0)" ::: "memory");
    const int c = lane & 7;
#pragma unroll
    for (int j = 0; j < 4; ++j) { const int n = (lane >> 3) + 8 * j; const LAS float* s = scr + (8 * c) * 33 + n;
        v4u o; o.x = pk2(s[0 * 33], s[1 * 33]); o.y = pk2(s[2 * 33], s[3 * 33]); o.z = pk2(s[4 * 33], s[5 * 33]); o.w = pk2(s[6 * 33], s[7 * 33]);
        *(v4u*)(WT + (size_t)(n0 + n) * K + k0 + 8 * c) = o; }
    asm volatile("s_waitcnt lgkmcnt(0)" ::: "memory");
}
DI Frame refresh(const Frame& F0) { Frame F = F0; int t = threadIdx.x; asm volatile("" : "+v"(t)); int bxx = blockIdx.x; asm volatile("" : "+s"(bxx)); F.tid = t; F.lane = t & 63; F.wave = __builtin_amdgcn_readfirstlane(t >> 6); F.gw = bxx * NWAVES + F.wave; return F; }
DI void stagger(unsigned ticks) { if ((blockIdx.x >> 3) & 1) { const unsigned long long t0 = __builtin_amdgcn_s_memrealtime(); while (__builtin_amdgcn_s_memrealtime() - t0 < ticks) __builtin_amdgcn_s_sleep(8); } }
DI void prologue(const Frame& F0, int l, int w0, int nw) { Frame F = refresh(F0);
    LAS float* scr = (LAS float*)(F.lds + F.wave * 16384);
    constexpr int I_IN = 16 * 104, I_OUT = 16 * 32, I_UP = 16 * 128, I_DN = 64 * 32, I_LW = 12, I_LG = 24;
    constexpr int PER = I_IN + I_OUT + I_UP + I_DN + 2 * I_LW + I_LG;
    constexpr float C2 = 0.17677669529663687f * 1.4426950408889634f;
    for (int it = w0; it < PER; it += nw) {
        int r = it;
        if (r < I_IN) { transpose_item(INP(F, 2) + (size_t)l * DMODEL * NIN, DMODEL, NIN, F_WIN + (size_t)l * NIN * DMODEL, scr, r, F.lane, INP(F, 1) + l * DMODEL, C2, 384); continue; } r -= I_IN;
        if (r < I_OUT) { transpose_item(INP(F, 20) + (size_t)l * DMODEL * DMODEL, DMODEL, DMODEL, F_WOUT + (size_t)l * DMODEL * DMODEL, scr, r, F.lane, nullptr, 1.f, 0); continue; } r -= I_OUT;
        if (r < I_UP) { transpose_item(INP(F, 22) + (size_t)l * DMODEL * FF, DMODEL, FF, F_WUP + (size_t)l * FF * DMODEL, scr, r, F.lane, INP(F, 21) + l * DMODEL, 1.f, 0); continue; } r -= I_UP;
        if (r < I_DN) { transpose_item(INP(F, 23) + (size_t)l * FF * DMODEL, FF, DMODEL, F_WDN + (size_t)l * DMODEL * FF, scr, r, F.lane, nullptr, 1.f, 0); continue; } r -= I_DN;
        bf16* L = F_LORA + (size_t)l * LORA_L;
        if (r < I_LW) { transpose_item(INP(F, 11) + (size_t)l * 64 * RW, 64, RW, L, scr, r, F.lane, nullptr, 1.f, 0); continue; } r -= I_LW;
        if (r < I_LW) { transpose_item(INP(F, 13) + (size_t)l * 64 * RW, 64, RW, L + RW * 64, scr, r, F.lane, nullptr, 1.f, 0); continue; } r -= I_LW;
        transpose_item(INP(F, 14) + (size_t)l * 128 * RW, 128, RW, L + 2 * RW * 64, scr, r, F.lane, nullptr, 1.f, 0);
    }
}
DI void x_to_bf16(const Frame& F0, const float* src, bf16* dst, float* ss) { Frame F = refresh(F0);
    for (int m0 = F.gw; m0 < M; m0 += 4 * F.NGW) {
        f32x4 v[4][4];
#pragma unroll
        for (int q = 0; q < 4; ++q) { const int m = m0 + q * F.NGW; if (m < M) { const f32x4* xr = (const f32x4*)(src + (size_t)m * DMODEL) + F.lane;
#pragma unroll
            for (int j = 0; j < 4; ++j) v[q][j] = __builtin_nontemporal_load(&xr[64 * j]); } }
#pragma unroll
        for (int q = 0; q < 4; ++q) { const int m = m0 + q * F.NGW; if (m < M) { float s2 = 0.f;
#pragma unroll
            for (int j = 0; j < 4; ++j) s2 += (v[q][j].x * v[q][j].x + v[q][j].y * v[q][j].y) + (v[q][j].z * v[q][j].z + v[q][j].w * v[q][j].w);
            s2 = wave_sum(s2); if (F.lane < 16) ss[(size_t)m * 16 + F.lane] = (F.lane == 0) ? s2 : 0.f;
            v2u* o8 = (v2u*)(dst + (size_t)m * DMODEL) + F.lane;
#pragma unroll
            for (int j = 0; j < 4; ++j) { v2u w; w.x = pk2(v[q][j].x, v[q][j].y); w.y = pk2(v[q][j].z, v[q][j].w); o8[64 * j] = w; } } }
    }
}
DI void final_norm(const Frame& F0, const bf16* xb, float* out, const float* g) { Frame F = refresh(F0);
    const f32x4* gr = (const f32x4*)g + F.lane; f32x4 gv[4];
#pragma unroll
    for (int j = 0; j < 4; ++j) gv[j] = gr[64 * j];
    for (int m0 = F.gw; m0 < M; m0 += 4 * F.NGW) {
        v2u w[4][4];
#pragma unroll
        for (int q = 0; q < 4; ++q) { const int m = m0 + q * F.NGW; if (m < M) { const v2u* xr = (const v2u*)(xb + (size_t)m * DMODEL) + F.lane;
#pragma unroll
            for (int j = 0; j < 4; ++j) w[q][j] = __builtin_nontemporal_load(&xr[64 * j]); } }
#pragma unroll
        for (int q = 0; q < 4; ++q) { const int m = m0 + q * F.NGW; if (m < M) { f32x4 v[4]; float s2 = 0.f;
#pragma unroll
            for (int j = 0; j < 4; ++j) { v[j] = (f32x4){bflo(w[q][j].x), bfhi(w[q][j].x), bflo(w[q][j].y), bfhi(w[q][j].y)}; s2 += (v[j].x * v[j].x + v[j].y * v[j].y) + (v[j].z * v[j].z + v[j].w * v[j].w); }
            const float rstd = 1.f / sqrtf(wave_sum(s2) * (1.f / DMODEL) + NORM_EPS);
            f32x4* orow = (f32x4*)(out + (size_t)m * DMODEL) + F.lane;
#pragma unroll
            for (int j = 0; j < 4; ++j) __builtin_nontemporal_store(v[j] * rstd * gv[j], &orow[64 * j]); } }
    }
}

DI void loadz8(const bf16* prow, bool first, const float* mu, int col, float* z) {
    const v4u p = *(const v4u*)(prow + col); v4u q = (v4u){0u, 0u, 0u, 0u}; if (!first) q = *(const v4u*)(prow - NIN + col);
    const f32x4 m0 = *(const f32x4*)(mu + col), m1 = *(const f32x4*)(mu + col + 4);
    float pf[8], qf[8]; unpack8(p, pf); unpack8(q, qf);
#pragma unroll
    for (int j = 0; j < 4; ++j) { z[j] = pf[j] + m0[j] * (qf[j] - pf[j]); z[4 + j] = pf[4 + j] + m1[j] * (qf[4 + j] - pf[4 + j]); }
}
DI void loadz8L(const bf16* prow, bool first, const LAS float* mu, int col, float* z) {
    const v4u p = *(const v4u*)(prow + col); v4u q = (v4u){0u, 0u, 0u, 0u}; if (!first) q = *(const v4u*)(prow - NIN + col);
    const f32x4 m0 = *(const LAS f32x4*)(mu + col), m1 = *(const LAS f32x4*)(mu + col + 4);
    float pf[8], qf[8]; unpack8(p, pf); unpack8(q, qf);
#pragma unroll
    for (int j = 0; j < 4; ++j) { z[j] = pf[j] + m0[j] * (qf[j] - pf[j]); z[4 + j] = pf[4 + j] + m1[j] * (qf[4 + j] - pf[4 + j]); }
}
DI float loadz1(const bf16* prow, bool first, float mu, int col) { const float p = bf1(prow + col); const float q = first ? 0.f : bf1(prow - NIN + col); return p + mu * (q - p); }

DI void prep_phase(const Frame& F0, int l) { Frame F = refresh(F0);
    LAS float* PT = (LAS float*)(F.lds + MISC_OFF + 256);
    {   const float* srcs[6] = {INP(F, 10) + l * RW, INP(F, 12) + l * RW, INP(F, 15) + l * RW, INP(F, 16) + l * RW, INP(F, 17) + l * RW, INP(F, 9) + l * RCOLS};
        for (int i = F.tid; i < 5 * RW + RCOLS; i += NWAVES * 64) { const int a = i < 5 * RW ? i / RW : 5; PT[i] = srcs[a][i - a * RW]; }
        __syncthreads(); }
    const LAS float* w0 = PT; const LAS float* a0 = PT + RW; const LAS float* kkw = PT + 2 * RW; const LAS float* kaw = PT + 3 * RW; const LAS float* rkp = PT + 4 * RW; const LAS float* mu = PT + 5 * RW;
    const bf16* WUT = F_LORA + (size_t)l * LORA_L; const bf16* AUT = WUT + RW * 64; const bf16* GUT = AUT + RW * 64;
    const int row = F.lane & 15, kq = F.lane >> 4, tok = F.lane >> 2, cq = (F.lane & 3) * 16;
    LAS float* LW = (LAS float*)(F.lds + F.wave * 16384);
    for (int tile = F.gw; tile < M / 16; tile += F.NGW) {
        const int t0 = tile * 16;
        bf16x8 Aw[2], Aa[2], Ag[4];
        { const int t = t0 + row; const bool first = (t % SEQ) == 0; const bf16* prow = F_PROJ + (size_t)t * NIN + ROFF; float z[8];
#pragma unroll
          for (int ks = 0; ks < 2; ++ks) { loadz8L(prow, first, mu, 1152 + ks * 32 + kq * 8, z);
#pragma unroll
              for (int j = 0; j < 8; ++j) z[j] = tanhf_(z[j]);
              Aw[ks] = __builtin_bit_cast(bf16x8, pack8(z)); }
#pragma unroll
          for (int ks = 0; ks < 2; ++ks) { loadz8L(prow, first, mu, 1216 + ks * 32 + kq * 8, z); Aa[ks] = __builtin_bit_cast(bf16x8, pack8(z)); }
#pragma unroll
          for (int ks = 0; ks < 4; ++ks) { loadz8L(prow, first, mu, 1280 + ks * 32 + kq * 8, z);
#pragma unroll
              for (int j = 0; j < 8; ++j) z[j] = sigmoidf_(z[j]);
              Ag[ks] = __builtin_bit_cast(bf16x8, pack8(z)); } }
#pragma unroll 1
        for (int hq = 0; hq < 6; ++hq) { const int hd_ = hq + F.wave + (int)(blockIdx.x >> 3); const int hd = hd_ % 6;
            const int t = t0 + tok; const bool first = (t % SEQ) == 0; const bf16* prow = F_PROJ + (size_t)t * NIN + ROFF; const int ch0 = hd * 64 + cq;
            float zr2[2][8], zk2[2][8], zv2[2][8];
#pragma unroll
            for (int sub = 0; sub < 2; ++sub) { loadz8L(prow, first, mu, ch0 + sub * 8, zr2[sub]); loadz8L(prow, first, mu, RW + ch0 + sub * 8, zk2[sub]); loadz8L(prow, first, mu, 2 * RW + ch0 + sub * 8, zv2[sub]); }
#pragma unroll
            for (int cgi = 0; cgi < 4; ++cgi) {
                const int ch = hd * 64 + cgi * 16 + row;
                f32x4 cw = (f32x4){0.f, 0.f, 0.f, 0.f}, ca = cw, cgt = cw;
#pragma unroll
                for (int ks = 0; ks < 2; ++ks) {
                    const bf16x8 bw = *(const bf16x8*)(WUT + (size_t)ch * 64 + ks * 32 + kq * 8); cw = __builtin_amdgcn_mfma_f32_16x16x32_bf16(Aw[ks], bw, cw, 0, 0, 0);
                    const bf16x8 ba = *(const bf16x8*)(AUT + (size_t)ch * 64 + ks * 32 + kq * 8); ca = __builtin_amdgcn_mfma_f32_16x16x32_bf16(Aa[ks], ba, ca, 0, 0, 0); }
#pragma unroll
                for (int ks = 0; ks < 4; ++ks) { const bf16x8 bg = *(const bf16x8*)(GUT + (size_t)ch * 128 + ks * 32 + kq * 8); cgt = __builtin_amdgcn_mfma_f32_16x16x32_bf16(Ag[ks], bg, cgt, 0, 0, 0); }
#pragma unroll
                for (int j = 0; j < 4; ++j) { LAS float* d = LW + (kq * 4 + j) * 68 + cgi * 16 + row; d[0] = cw[j]; d[16 * 68] = ca[j]; d[32 * 68] = cgt[j]; }
            }
            asm volatile("s_waitcnt lgkmcnt(0)" ::: "memory");
            float kkq[16], aq[16]; float ss = 0.f, dotp = 0.f;
#pragma unroll
            for (int sub = 0; sub < 2; ++sub) {
                const int ch = ch0 + sub * 8; const size_t idx = (size_t)t * RW + ch;
                float (&zr)[8] = zr2[sub]; float (&zk)[8] = zk2[sub]; float (&zv)[8] = zv2[sub];
                float gl[8], ldv[8], kpv[8];
                const LAS float* lw = LW + tok * 68 + cq + sub * 8;
#pragma unroll
                for (int hh = 0; hh < 2; ++hh) { const f32x4 x0 = *(const LAS f32x4*)(lw + 4 * hh), x1 = *(const LAS f32x4*)(lw + 16 * 68 + 4 * hh), x2 = *(const LAS f32x4*)(lw + 32 * 68 + 4 * hh);
                    const f32x4 p0 = *(const LAS f32x4*)(w0 + ch + 4 * hh), p1 = *(const LAS f32x4*)(a0 + ch + 4 * hh), p2 = *(const LAS f32x4*)(kkw + ch + 4 * hh), p3 = *(const LAS f32x4*)(kaw + ch + 4 * hh), p4 = *(const LAS f32x4*)(rkp + ch + 4 * hh);
#pragma unroll
                    for (int e = 0; e < 4; ++e) { const int j = 4 * hh + e;
                        gl[j] = x2[e];
                        const float xs = -(p0[e] + x0[e]); const float sp = fmaxf(xs, 0.f) + __logf(1.f + __expf(-fabsf(xs)));
                        ldv[j] = -__expf(-sp - 0.5f);
                        const float a = sigmoidf_(p1[e] + x1[e]);
                        const float kk = zk[j] * p2[e]; kpv[j] = zk[j] * (1.f + (a - 1.f) * p3[e]);
                        kkq[sub * 8 + j] = kk; aq[sub * 8 + j] = a; ss += kk * kk; dotp += zr[j] * kpv[j] * p4[e];
                    } }
                *(v4u*)(F_S_ld + idx) = pack8(ldv); *(v4u*)(F_S_k + idx) = pack8(kpv); *(v4u*)(F_S_g + idx) = pack8(gl);
            }
            ss += __shfl_xor(ss, 1); ss += __shfl_xor(ss, 2);
            dotp += __shfl_xor(dotp, 1); dotp += __shfl_xor(dotp, 2);
            if ((F.lane & 3) == 0) ((float*)((unsigned char*)F.out + WS_DOTS))[(size_t)t * 6 + hd] = dotp;
            const float inv = __builtin_amdgcn_rsqf(fmaxf(ss, 1e-24f));
#pragma unroll
            for (int sub = 0; sub < 2; ++sub) { float nn[8], bbv[8];
#pragma unroll
                for (int j = 0; j < 8; ++j) { const float kn = kkq[sub * 8 + j] * inv; nn[j] = -kn; bbv[j] = kn * aq[sub * 8 + j]; }
                const size_t idx = (size_t)t * RW + ch0 + sub * 8; *(v4u*)(F_S_n + idx) = pack8(nn); *(v4u*)(F_S_b + idx) = pack8(bbv); }
            asm volatile("s_waitcnt lgkmcnt(0)" ::: "memory");
        }
    }
}

DI void conv_phase(const Frame& F0, int l, int w0, int nw) { Frame F = refresh(F0);
    const float* cw_ = INP(F, 8) + l * 3 * 256;
    for (int it = w0; it < M / 2; it += nw) {
        const int t = it * 2 + (F.lane >> 5), c8 = (F.lane & 31) * 8, pos = t % SEQ;
        const bf16* base = F_PROJ + (size_t)t * NIN + COFF + c8;
        float b8[8], g8[8], u8[8], acc[8], w8[8];
        unpack8(*(const v4u*)base, b8);
#pragma unroll
        for (int j = 0; j < 8; ++j) acc[j] = 0.f;
#pragma unroll
        for (int d = 0; d < 3; ++d) {
            const int back = 2 - d;
            if (pos >= back) {
                const bf16* pb = base - (size_t)back * NIN;
                unpack8(*(const v4u*)(pb + 256), g8); unpack8(*(const v4u*)(pb + 512), u8);
                const f32x4 wa = *(const f32x4*)(cw_ + d * 256 + c8), wb = *(const f32x4*)(cw_ + d * 256 + c8 + 4);
                w8[0] = wa.x; w8[1] = wa.y; w8[2] = wa.z; w8[3] = wa.w; w8[4] = wb.x; w8[5] = wb.y; w8[6] = wb.z; w8[7] = wb.w;
#pragma unroll
                for (int j = 0; j < 8; ++j) acc[j] += w8[j] * (g8[j] * u8[j]);
            }
        }
#pragma unroll
        for (int j = 0; j < 8; ++j) acc[j] *= b8[j];
        __builtin_nontemporal_store(pack8(acc), (v4u*)(F_MIX + (size_t)t * DMODEL + 384 + c8));
    }
}

DI void post_phase(const Frame& F0, int l) { Frame F = refresh(F0);
    const float* lg = INP(F, 18) + l * RW; const float* lb = INP(F, 19) + l * RW; const float* mu = INP(F, 9) + l * RCOLS;
    for (int it = F.gw; it < M * 6 / 8; it += F.NGW) {
        const int pair = it * 8 + (F.lane >> 3), t = pair / 6, hd = pair % 6, ch = hd * 64 + (F.lane & 7) * 8;
        bf16* yp = F_MIX + (size_t)t * DMODEL + 640 + ch; const size_t idx = (size_t)t * RW + ch;
        float y[8], v[8], g[8], o[8];
        unpack8(*(const v4u*)yp, y); unpack8(*(const v4u*)(F_S_g + idx), g);
        loadz8(F_PROJ + (size_t)t * NIN + ROFF, (t % SEQ) == 0, mu, 2 * RW + ch, v);
        const float dot = ((const float*)((unsigned char*)F.out + WS_DOTS))[(size_t)t * 6 + hd];
        float s = 0.f;
#pragma unroll
        for (int j = 0; j < 8; ++j) s += y[j];
        s += __shfl_xor(s, 1); s += __shfl_xor(s, 2); s += __shfl_xor(s, 4);
        const float mean = s * (1.f / 64.f); float q = 0.f;
#pragma unroll
        for (int j = 0; j < 8; ++j) { const float d = y[j] - mean; q += d * d; }
        q += __shfl_xor(q, 1); q += __shfl_xor(q, 2); q += __shfl_xor(q, 4);
        const float rstd = 1.f / sqrtf(q * (1.f / 64.f) + GN_EPS);
#pragma unroll
        for (int j = 0; j < 8; ++j) o[j] = ((y[j] - mean) * rstd * lg[ch + j] + lb[ch + j] + dot * v[j]) * g[j];
        *(v4u*)yp = pack8(o);
    }
}


DI void scan_wg(const Frame& F0, int sw) { Frame F = refresh(F0);
    const int bh = sw >> 1, half = sw & 1, b = bh / 6, hd = bh % 6;
    const size_t tb = (size_t)b * SEQ; const int cb = hd * 64;
    LAS unsigned char* const lds = F.lds;
    constexpr int BUFB = 6 * 8192, YOFF = 2 * BUFB;
    const bool loader = F.wave >= 4; const int ltid = F.tid - 256;
#define SCAN_STAGE(c, bufsel, P0, NP, STRIDE) do { _Pragma("unroll") for (int i = 0; i < (NP); ++i) { const int p = (P0) + (STRIDE) * i, a = p >> 8, tt = (p & 255) >> 3, c8 = (p & 7) * 8; \
        const bf16* src = (a == 0 ? F_S_r : a == 1 ? F_S_ld : a == 2 ? F_S_k : a == 3 ? F_S_v : a == 4 ? F_S_n : F_S_b); \
        const v4u raw = *(const v4u*)(src + (tb + (size_t)(c) * 32 + tt) * RW + cb + c8); \
        float f[8]; unpack8(raw, f); if (a == 1) { _Pragma("unroll") for (int j = 0; j < 8; ++j) f[j] = __expf(f[j]); } \
        LAS f32x4* d = (LAS f32x4*)(lds + (bufsel) * BUFB + a * 8192 + tt * 256 + c8 * 4); d[0] = (f32x4){f[0], f[1], f[2], f[3]}; d[1] = (f32x4){f[4], f[5], f[6], f[7]}; } } while (0)
#define SCAN_YOUT(c, bufsel) do { _Pragma("unroll") for (int i = 0; i < 2; ++i) { const int e = ltid + 256 * i, tt = e >> 4, r2 = (e & 15) * 2; \
        const LAS float* ys = (const LAS float*)(lds + YOFF + (bufsel) * 4096) + tt * 32 + r2; \
        *(unsigned*)(F_MIX + (tb + (size_t)(c) * 32 + tt) * DMODEL + 640 + cb + half * 32 + r2) = pk2(ys[0], ys[1]); } } while (0)
    SCAN_STAGE(0, 0, F.tid, 3, 512);
    __syncthreads();
    typedef float f32x2v __attribute__((ext_vector_type(2)));
    const int rp = F.wave * 8 + (F.lane >> 4) * 2, kp = F.lane & 15;
    f32x4 s0 = (f32x4){0.f, 0.f, 0.f, 0.f}, s1 = s0;
#pragma unroll 1
    for (int c = 0; c < SEQ / 32; ++c) {
        const int cur = c & 1;
        if (loader) {
            if (c + 1 < SEQ / 32) SCAN_STAGE(c + 1, cur ^ 1, ltid, 6, 256);
            if (c > 0) SCAN_YOUT(c - 1, cur ^ 1);
        } else {
            const LAS unsigned char* bb = lds + cur * BUFB + kp * 16;
            const LAS unsigned char* vb = lds + cur * BUFB + 3 * 8192 + (half * 32 + rp) * 4;
            LAS f32x2v* yb = (LAS f32x2v*)(lds + YOFF + cur * 4096 + rp * 4);
            f32x4 rv = *(const LAS f32x4*)(bb + 0 * 8192), wv = *(const LAS f32x4*)(bb + 1 * 8192), kv = *(const LAS f32x4*)(bb + 2 * 8192);
            f32x4 nv = *(const LAS f32x4*)(bb + 4 * 8192), bv = *(const LAS f32x4*)(bb + 5 * 8192);
            f32x2v vv = *(const LAS f32x2v*)(vb);
#pragma unroll 8
            for (int tt = 0; tt < 32; ++tt) {
                const int tn = (tt + 1) & 31;
                const f32x4 rv2 = *(const LAS f32x4*)(bb + 0 * 8192 + tn * 256), wv2 = *(const LAS f32x4*)(bb + 1 * 8192 + tn * 256), kv2 = *(const LAS f32x4*)(bb + 2 * 8192 + tn * 256);
                const f32x4 nv2 = *(const LAS f32x4*)(bb + 4 * 8192 + tn * 256), bv2 = *(const LAS f32x4*)(bb + 5 * 8192 + tn * 256);
                const f32x2v vv2 = *(const LAS f32x2v*)(vb + tn * 256);
                f32x2v d0 = (f32x2v){s0.x, s0.y} * (f32x2v){nv.x, nv.y}; d0 = (f32x2v){s0.z, s0.w} * (f32x2v){nv.z, nv.w} + d0;
                f32x2v d1 = (f32x2v){s1.x, s1.y} * (f32x2v){nv.x, nv.y}; d1 = (f32x2v){s1.z, s1.w} * (f32x2v){nv.z, nv.w} + d1;
                const float sa0 = red16(d0.x + d0.y), sa1 = red16(d1.x + d1.y);
                const f32x4 q0 = s0 * wv + kv * vv.x, q1 = s1 * wv + kv * vv.y;
                s0 = bv * sa0 + q0; s1 = bv * sa1 + q1;
                f32x2v y0 = (f32x2v){s0.x, s0.y} * (f32x2v){rv.x, rv.y}; y0 = (f32x2v){s0.z, s0.w} * (f32x2v){rv.z, rv.w} + y0;
                f32x2v y1 = (f32x2v){s1.x, s1.y} * (f32x2v){rv.x, rv.y}; y1 = (f32x2v){s1.z, s1.w} * (f32x2v){rv.z, rv.w} + y1;
                const float ya = red16(y0.x + y0.y), yc = red16(y1.x + y1.y);
                yb[tt * 16] = (f32x2v){ya, yc};
                rv = rv2; wv = wv2; kv = kv2; nv = nv2; bv = bv2; vv = vv2;
            }
        }
        __syncthreads();
    }
    if (loader) SCAN_YOUT(SEQ / 32 - 1, (SEQ / 32 - 1) & 1);
#undef SCAN_STAGE
#undef SCAN_YOUT
    __syncthreads();
}

typedef float f32x16 __attribute__((ext_vector_type(16)));
typedef short s16x4 __attribute__((ext_vector_type(4)));
DI int crow_(int r, int h) { return (r & 3) + 8 * (r >> 2) + 4 * h; }
typedef float f32x2c __attribute__((ext_vector_type(2))); typedef __bf16 bf16x2c __attribute__((ext_vector_type(2)));
DI unsigned cvtpk(float lo, float hi) { f32x2c v = {lo, hi}; bf16x2c b = __builtin_convertvector(v, bf16x2c); return __builtin_bit_cast(unsigned, b); }
DI bf16x8 packregs(const f32x16& x, int s) {
    v4u p; p.x = cvtpk(x[8 * s + 0], x[8 * s + 1]); p.y = cvtpk(x[8 * s + 2], x[8 * s + 3]); p.z = cvtpk(x[8 * s + 4], x[8 * s + 5]); p.w = cvtpk(x[8 * s + 6], x[8 * s + 7]);
    return __builtin_bit_cast(bf16x8, p);
}
DI bf16x8 cat44(s16x4 lo, s16x4 hi) { return __builtin_shufflevector(lo, hi, 0, 1, 2, 3, 4, 5, 6, 7); }
#define MFMA32(a, b, c) __builtin_amdgcn_mfma_f32_32x32x16_bf16((a), (b), (c), 0, 0, 0)

DI void cprep_phase(const Frame& F0, int l) { Frame F = refresh(F0);
    const float* mu_ = INP(F, 9) + l * RCOLS;
    LAS unsigned char* const W = F.lds + F.wave * 16384;
    const int lane = F.lane, r32 = lane & 31, h = lane >> 5;
    const bool local = (F.NGW == M / 16);
    for (int it_ = 0; it_ < (local ? 3 : (NITEMS + F.NGW - 1) / F.NGW); ++it_) {
        int item;
        if (local) { const int li = F.wave * 3 + it_, cg_ = 4 * (int)blockIdx.x + li / 6; item = ((cg_ >> 7) * 6 + li % 6) * 128 + (cg_ & 127); }
        else { item = F.gw + it_ * F.NGW; if (item >= NITEMS) break; }
        const int bh = item >> 7, c = item & 127, b = bh / 6, hd = bh % 6;
        const size_t row0 = (size_t)b * SEQ + (size_t)c * 32;
        const size_t sbase = row0 * RW + hd * 64;
        {
            float lp = 0.f, Pcur = 1.f; unsigned btp[16], ktp[16], vtp[16]; float bprev = 0.f, kprev = 0.f, vprev = 0.f;
            const bf16* pj = F_PROJ + row0 * NIN + ROFF + hd * 64 + lane;
            const float mur = mu_[hd * 64 + lane], muv = mu_[2 * RW + hd * 64 + lane];
            float pr_prev = 0.f, pv_prev = 0.f; if (c != 0) { pr_prev = bf1(pj - NIN); pv_prev = bf1(pj - NIN + 2 * RW); }
#pragma unroll
            for (int hf = 0; hf < 4; ++hf) {
                unsigned short raw[8][6];
#pragma unroll
                for (int tq = 0; tq < 8; ++tq) { const size_t e = sbase + (size_t)(8 * hf + tq) * RW + lane; raw[tq][0] = F_S_ld[e]; raw[tq][1] = pj[(size_t)(8 * hf + tq) * NIN]; raw[tq][2] = F_S_n[e]; raw[tq][3] = F_S_b[e]; raw[tq][4] = F_S_k[e]; raw[tq][5] = pj[(size_t)(8 * hf + tq) * NIN + 2 * RW]; }
#pragma unroll
                for (int tq = 0; tq < 8; ++tq) { const int t = 8 * hf + tq;
                    const float ldv = __uint_as_float((unsigned)raw[tq][0] << 16), prw = __uint_as_float((unsigned)raw[tq][1] << 16), nn = __uint_as_float((unsigned)raw[tq][2] << 16), bb = __uint_as_float((unsigned)raw[tq][3] << 16), kk = __uint_as_float((unsigned)raw[tq][4] << 16), pvw = __uint_as_float((unsigned)raw[tq][5] << 16);
                    const float rr = prw + mur * (pr_prev - prw), vv = pvw + muv * (pv_prev - pvw); pr_prev = prw; pv_prev = pvw;
                    lp += ldv;
                    const float Pp = Pcur; const float P = __expf(lp), iP = __builtin_amdgcn_rcpf(P); Pcur = P;
                    const float rt = rr * P, nt = nn * Pp, bt = bb * iP, kt = kk * iP;
                    const int sw = (((lane >> 3) ^ (t & 7)) << 4) + (lane & 7) * 2 + t * 128;
                    *(LAS bf16*)(W + sw) = (bf16)f2bf(rt); *(LAS bf16*)(W + 4096 + sw) = (bf16)f2bf(nt); *(LAS bf16*)(W + 8192 + sw) = (bf16)f2bf(bt); *(LAS bf16*)(W + 12288 + sw) = (bf16)f2bf(kt);
                    if (t & 1) { btp[t >> 1] = pk2(bprev, bt); ktp[t >> 1] = pk2(kprev, kt); vtp[t >> 1] = pk2(vprev, vv); } else { bprev = bt; kprev = kt; vprev = vv; }
                }
            }
            ((float*)((unsigned char*)F.out + WS_PT))[(size_t)item * 64 + lane] = Pcur;
            const size_t te = sbase + (size_t)(lane >> 1) * RW + (lane & 1) * 32;
#pragma unroll
            for (int q = 0; q < 4; ++q) {
                *(v4u*)(F_S_b + te + q * 8) = (v4u){btp[4 * q], btp[4 * q + 1], btp[4 * q + 2], btp[4 * q + 3]};
                *(v4u*)(F_S_k + te + q * 8) = (v4u){ktp[4 * q], ktp[4 * q + 1], ktp[4 * q + 2], ktp[4 * q + 3]};
                *(v4u*)(F_S_ld + te + q * 8) = (v4u){vtp[4 * q], vtp[4 * q + 1], vtp[4 * q + 2], vtp[4 * q + 3]};
            }
        }
        asm volatile("s_waitcnt lgkmcnt(0)" ::: "memory");
        f32x16 Cnb, Cnk, Crb, Crk;
#pragma unroll
        for (int i = 0; i < 16; ++i) { Cnb[i] = 0.f; Cnk[i] = 0.f; Crb[i] = 0.f; Crk[i] = 0.f; }
#pragma unroll
        for (int s4 = 0; s4 < 4; ++s4) {
            const int fo = r32 * 128 + (((2 * s4 + h) ^ (r32 & 7)) << 4);
            const bf16x8 aR = *(const LAS bf16x8*)(W + fo), aN = *(const LAS bf16x8*)(W + 4096 + fo), bB = *(const LAS bf16x8*)(W + 8192 + fo), bK = *(const LAS bf16x8*)(W + 12288 + fo);
            Cnb = MFMA32(aN, bB, Cnb); Cnk = MFMA32(aN, bK, Cnk); Crb = MFMA32(aR, bB, Crb); Crk = MFMA32(aR, bK, Crk);
        }
#pragma unroll
        for (int i = 0; i < 16; ++i) { const int t = crow_(i, h); if (!(r32 < t)) { Cnb[i] = 0.f; Cnk[i] = 0.f; } if (!(r32 <= t)) { Crb[i] = 0.f; Crk[i] = 0.f; } }
        asm volatile("s_waitcnt lgkmcnt(0)" ::: "memory");
#pragma unroll
        for (int q = 0; q < 4; ++q) { const int p = lane + 64 * q, rr_ = p >> 3, cc = p & 7;
            *(v4u*)(F_S_r + sbase + (size_t)rr_ * RW + cc * 8) = *(const LAS v4u*)(W + rr_ * 128 + ((cc ^ (rr_ & 7)) << 4)); }
#pragma unroll
        for (int i = 0; i < 16; ++i) *(LAS float*)(W + 8192 + crow_(i, h) * 144 + r32 * 4) = Cnb[i];
        asm volatile("s_waitcnt lgkmcnt(0)" ::: "memory");
        {
            float X[32];
#pragma unroll
            for (int t = 0; t < 32; ++t) {
                float a0 = (t == r32) ? 1.f : 0.f, a1 = 0.f;
#pragma unroll
                for (int i4 = 0; i4 < (t + 3) / 4; ++i4) {
                    const f32x4 Lr = *(const LAS f32x4*)(W + 8192 + t * 144 + i4 * 16);
#pragma unroll
                    for (int e = 0; e < 4; ++e) { const int i = 4 * i4 + e; if (i < t) { if (e & 1) a1 += Lr[e] * X[i]; else a0 += Lr[e] * X[i]; } }
                }
                X[t] = a0 + a1;
            }
            asm volatile("s_waitcnt lgkmcnt(0)" ::: "memory");
#pragma unroll
            for (int t = 0; t < 32; ++t) *(LAS bf16*)(W + 12800 + t * 64 + r32 * 2) = (bf16)f2bf(X[t]);
        }
        asm volatile("s_waitcnt lgkmcnt(0)" ::: "memory");
        f32x16 Cw[2];
#pragma unroll
        for (int nt = 0; nt < 2; ++nt) {
#pragma unroll
            for (int i = 0; i < 16; ++i) Cw[nt][i] = 0.f;
#pragma unroll
            for (int s = 0; s < 2; ++s) {
                const bf16x8 a = *(const LAS bf16x8*)(W + 12800 + r32 * 64 + (2 * s + h) * 16);
                const int ch = 32 * nt + r32; unsigned short e[8];
#pragma unroll
                for (int j = 0; j < 8; ++j) { const int i = 16 * s + 8 * h + j; e[j] = *(const LAS bf16*)(W + 4096 + i * 128 + (((ch >> 3) ^ (i & 7)) << 4) + (ch & 7) * 2); }
                v4u bw; bw.x = e[0] | ((unsigned)e[1] << 16); bw.y = e[2] | ((unsigned)e[3] << 16); bw.z = e[4] | ((unsigned)e[5] << 16); bw.w = e[6] | ((unsigned)e[7] << 16);
                Cw[nt] = MFMA32(a, __builtin_bit_cast(bf16x8, bw), Cw[nt]);
            }
        }
        f32x16 Cm;
#pragma unroll
        for (int i = 0; i < 16; ++i) Cm[i] = 0.f;
#pragma unroll
        for (int s = 0; s < 2; ++s) {
            const s16x4 lo = *(const LAS s16x4*)(W + 12800 + r32 * 64 + (16 * s + 4 * h) * 2), hi = *(const LAS s16x4*)(W + 12800 + r32 * 64 + (16 * s + 8 + 4 * h) * 2);
            Cm = MFMA32(cat44(lo, hi), packregs(Cnk, s), Cm);
        }
        asm volatile("s_waitcnt lgkmcnt(0)" ::: "memory");
#pragma unroll
        for (int nt = 0; nt < 2; ++nt)
#pragma unroll
            for (int i = 0; i < 16; ++i) *(LAS bf16*)(W + crow_(i, h) * 128 + (32 * nt + r32) * 2) = (bf16)f2bf(Cw[nt][i]);
#pragma unroll
        for (int i = 0; i < 16; ++i) { const int o = crow_(i, h) * 64 + r32 * 2;
            *(LAS bf16*)(W + 4096 + o) = (bf16)f2bf(Crb[i]); *(LAS bf16*)(W + 6144 + o) = (bf16)f2bf(Cm[i]); *(LAS bf16*)(W + 8192 + o) = (bf16)f2bf(Crk[i]); }
        asm volatile("s_waitcnt lgkmcnt(0)" ::: "memory");
#pragma unroll
        for (int q = 0; q < 4; ++q) { const int p = lane + 64 * q, rr = p >> 3, cc = p & 7;
            *(v4u*)(F_S_n + sbase + (size_t)rr * RW + cc * 8) = *(const LAS v4u*)(W + rr * 128 + cc * 16); }
#pragma unroll
        for (int q = 0; q < 2; ++q) { const int p = lane + 64 * q, mr = p >> 2, cc = p & 3;
            *(v4u*)(F_S_v + sbase + (size_t)(mr >> 1) * RW + (mr & 1) * 32 + cc * 8) = *(const LAS v4u*)(W + 4096 + mr * 64 + cc * 16);
            *(v4u*)(F_S_v + sbase + (size_t)(16 + (mr >> 1)) * RW + (mr & 1) * 32 + cc * 8) = *(const LAS v4u*)(W + 6144 + mr * 64 + cc * 16);
            *(v4u*)((bf16*)((unsigned char*)F.out + WS_AUX) + (size_t)item * 1024 + mr * 32 + cc * 8) = *(const LAS v4u*)(W + 8192 + mr * 64 + cc * 16); }
        asm volatile("s_waitcnt vmcnt(0) lgkmcnt(0)" ::: "memory");
    }
}

DI void cs_consume(const LAS unsigned char* B, LAS unsigned char* ybuf, f32x16 (&Hacc)[2], bf16x8 (&Hpk)[2][2], int r32, int h, int vh) {
    bf16x8 Vf[2];
#pragma unroll
    for (int s = 0; s < 2; ++s) Vf[s] = *(const LAS bf16x8*)(B + 19456 + (32 * vh + r32) * 80 + (2 * s + h) * 16);
    f32x16 U;
#pragma unroll
    for (int i = 0; i < 16; ++i) U[i] = 0.f;
#pragma unroll
    for (int kt = 0; kt < 2; ++kt)
#pragma unroll
        for (int s = 0; s < 2; ++s) { const LAS unsigned char* ap = B + r32 * 144 + (32 * kt + 16 * s + 4 * h) * 2;
            U = MFMA32(cat44(*(const LAS s16x4*)ap, *(const LAS s16x4*)(ap + 16)), Hpk[kt][s], U); }
#pragma unroll
    for (int s = 0; s < 2; ++s) U = MFMA32(*(const LAS bf16x8*)(B + 27136 + r32 * 80 + (2 * s + h) * 16), Vf[s], U);
    bf16x8 Upk[2]; Upk[0] = packregs(U, 0); Upk[1] = packregs(U, 1);
    f32x16 Y;
#pragma unroll
    for (int i = 0; i < 16; ++i) Y[i] = 0.f;
#pragma unroll
    for (int kt = 0; kt < 2; ++kt)
#pragma unroll
        for (int s = 0; s < 2; ++s) { const LAS unsigned char* ap = B + 4608 + r32 * 144 + (32 * kt + 16 * s + 4 * h) * 2;
            Y = MFMA32(cat44(*(const LAS s16x4*)ap, *(const LAS s16x4*)(ap + 16)), Hpk[kt][s], Y); }
#pragma unroll
    for (int s = 0; s < 2; ++s) { const LAS unsigned char* ap = B + 24576 + r32 * 80 + (16 * s + 4 * h) * 2;
        Y = MFMA32(cat44(*(const LAS s16x4*)ap, *(const LAS s16x4*)(ap + 16)), Upk[s], Y);
        Y = MFMA32(*(const LAS bf16x8*)(B + 29696 + r32 * 80 + (2 * s + h) * 16), Vf[s], Y); }
    {   LAS float* yb = (LAS float*)ybuf + 32 * vh + r32;
#pragma unroll
        for (int i = 0; i < 16; ++i) yb[crow_(i, h) * 64] = Y[i]; }
#pragma unroll
    for (int kt = 0; kt < 2; ++kt) {
        f32x16 acc = Hacc[kt];
#pragma unroll
        for (int s = 0; s < 2; ++s) { const LAS unsigned char* ap = B + 9216 + (32 * kt + r32) * 80 + (16 * s + 4 * h) * 2;
            acc = MFMA32(cat44(*(const LAS s16x4*)ap, *(const LAS s16x4*)(ap + 16)), Upk[s], acc);
            acc = MFMA32(*(const LAS bf16x8*)(B + 14336 + (32 * kt + r32) * 80 + (2 * s + h) * 16), Vf[s], acc); }
#pragma unroll
        for (int g = 0; g < 4; ++g) { const f32x4 pt = *(const LAS f32x4*)(B + 32256 + (32 * kt + 8 * g + 4 * h) * 4);
            acc[4 * g] *= pt.x; acc[4 * g + 1] *= pt.y; acc[4 * g + 2] *= pt.z; acc[4 * g + 3] *= pt.w; }
        Hacc[kt] = acc; Hpk[kt][0] = packregs(acc, 0); Hpk[kt][1] = packregs(acc, 1);
    }
}

DI void cscan_wg(const Frame& F0, int bh, int l) { Frame F = refresh(F0);
    const int b = bh / 6, hd = bh % 6; const size_t tb = (size_t)b * SEQ; const int cb = hd * 64;
    LAS unsigned char* const lds = F.lds;
    constexpr int BUFB = 32512, YOFF = 3 * BUFB, YB = 8192, NCH = SEQ / 32;
    const int ltid = F.tid - 128;
    const bool loader = F.wave >= 2;
    v4u st0[5], st1[5], st2[5], st3[5];
#define CS_LOAD(c, ST) do { const size_t sb_ = (tb + (size_t)(c) * 32) * RW + cb; const int item_ = bh * 128 + (c); \
        _Pragma("unroll") for (int i = 0; i < 5; ++i) { const int p = ltid + 384 * i; \
            if (p < 1536) { const int a = p >> 8, sr = (p >> 3) & 31, cc = p & 7;              \
                const bf16* src = (a == 0 ? F_S_n : a == 1 ? F_S_r : a == 2 ? F_S_b : a == 3 ? F_S_k : a == 4 ? F_S_ld : F_S_v); \
                ST[i] = __builtin_nontemporal_load((const v4u*)(src + sb_ + (size_t)sr * RW + cc * 8)); } \
            else if (p < 1664) { const int q = p - 1536, mr = q >> 2, cc = q & 3; ST[i] = __builtin_nontemporal_load((const v4u*)((const bf16*)((unsigned char*)F.out + WS_AUX) + (size_t)item_ * 1024 + mr * 32 + cc * 8)); } \
            else if (p < 1680) { const int q = p - 1664; ST[i] = __builtin_nontemporal_load((const v4u*)((const float*)((unsigned char*)F.out + WS_PT) + (size_t)item_ * 64 + q * 4)); } } } while (0)
#define CS_WRITE(bufsel, ST) do { LAS unsigned char* B_ = lds + (bufsel) * BUFB; \
        _Pragma("unroll") for (int i = 0; i < 5; ++i) { const int p = ltid + 384 * i; \
            if (p < 1536) { const int a = p >> 8, sr = (p >> 3) & 31, cc = p & 7; \
                int dst; if (a < 2) dst = a * 4608 + sr * 144 + cc * 16; else if (a < 5) dst = 9216 + (a - 2) * 5120 + (2 * sr + (cc >> 2)) * 80 + (cc & 3) * 16; \
                else dst = 24576 + (sr >> 4) * 2560 + ((2 * sr + (cc >> 2)) & 31) * 80 + (cc & 3) * 16; \
                *(LAS v4u*)(B_ + dst) = ST[i]; } \
            else if (p < 1664) { const int q = p - 1536, mr = q >> 2, cc = q & 3; *(LAS v4u*)(B_ + 29696 + mr * 80 + cc * 16) = ST[i]; } \
            else if (p < 1680) { const int q = p - 1664; *(LAS v4u*)(B_ + 32256 + q * 16) = ST[i]; } } } while (0)
    const int pt_ = (ltid >> 3) & 31, v8 = (ltid & 7) * 8;
    float lgv[8], lbv[8]; v4u gq = (v4u){0u, 0u, 0u, 0u}; float dq = 0.f;
    if (loader) { const float* lg = INP(F, 18) + l * RW + cb + v8; const float* lb = INP(F, 19) + l * RW + cb + v8;
#pragma unroll
        for (int j = 0; j < 8; ++j) { lgv[j] = lg[j]; lbv[j] = lb[j]; } }
#define CS_GLOAD(c) do { if (ltid < 256) { const size_t row_ = tb + (size_t)(c) * 32 + pt_; gq = *(const v4u*)(F_S_g + row_ * RW + cb + v8); dq = ((const float*)((unsigned char*)F.out + WS_DOTS))[row_ * 6 + hd]; } } while (0)
#define CS_POST(c, ybsel, bufsel) do { if (ltid < 256) { const LAS float* ys = (const LAS float*)(lds + YOFF + (ybsel) * YB) + pt_ * 64 + v8; \
        float y[8], g[8], o[8]; const f32x4 y0 = *(const LAS f32x4*)ys, y1 = *(const LAS f32x4*)(ys + 4); y[0] = y0.x; y[1] = y0.y; y[2] = y0.z; y[3] = y0.w; y[4] = y1.x; y[5] = y1.y; y[6] = y1.z; y[7] = y1.w; \
        unpack8(gq, g); float s = 0.f; _Pragma("unroll") for (int j = 0; j < 8; ++j) s += y[j]; \
        s += __shfl_xor(s, 1); s += __shfl_xor(s, 2); s += __shfl_xor(s, 4); const float mean = s * (1.f / 64.f); float q = 0.f; \
        _Pragma("unroll") for (int j = 0; j < 8; ++j) { const float d = y[j] - mean; q += d * d; } \
        q += __shfl_xor(q, 1); q += __shfl_xor(q, 2); q += __shfl_xor(q, 4); const float rstd = __builtin_amdgcn_rsqf(q * (1.f / 64.f) + GN_EPS); \
        const LAS unsigned char* vt = lds + (bufsel) * BUFB + 19456 + v8 * 80 + pt_ * 2; \
        _Pragma("unroll") for (int j = 0; j < 8; ++j) { const float vv = __uint_as_float(((unsigned)*(const LAS bf16*)(vt + j * 80)) << 16); o[j] = ((y[j] - mean) * rstd * lgv[j] + lbv[j] + dq * vv) * g[j]; } \
        __builtin_nontemporal_store(pack8(o), (v4u*)(F_MIX + (tb + (size_t)(c) * 32 + pt_) * DMODEL + 640 + cb + v8)); } } while (0)
    if (loader) {
        CS_LOAD(0, st0); CS_WRITE(0, st0); CS_LOAD(1, st1); CS_LOAD(2, st2);
        __syncthreads();
        int bn = 1, bp = 2, bc = 0;
#define CS_LITER(c, STW, LDN) do { const int cur = (c) & 1; \
            if ((c) + 3 < NCH) CS_LOAD((c) + 3, LDN); \
            if ((c) > 0) CS_POST((c) - 1, cur ^ 1, bp); \
            CS_GLOAD(c); \
            if ((c) + 1 < NCH) CS_WRITE(bn, STW); \
            __syncthreads(); { const int t_ = bp; bp = bc; bc = bn; bn = t_; } } while (0)
#pragma unroll 1
        for (int c4 = 0; c4 < NCH; c4 += 4) { CS_LITER(c4, st1, st3); CS_LITER(c4 + 1, st2, st0); CS_LITER(c4 + 2, st3, st1); CS_LITER(c4 + 3, st0, st2); }
        CS_POST(NCH - 1, (NCH - 1) & 1, bp);
#undef CS_LITER
    } else {
        const int lane = F.lane, r32 = lane & 31, h = lane >> 5, vh = F.wave;
        f32x16 Hacc[2]; bf16x8 Hpk[2][2];
#pragma unroll
        for (int kt = 0; kt < 2; ++kt) {
#pragma unroll
            for (int i = 0; i < 16; ++i) Hacc[kt][i] = 0.f;
            Hpk[kt][0] = bf16x8{0, 0, 0, 0, 0, 0, 0, 0}; Hpk[kt][1] = bf16x8{0, 0, 0, 0, 0, 0, 0, 0}; }
        __syncthreads();
        int bc = 0;
#pragma unroll 1
        for (int c = 0; c < NCH; ++c) { cs_consume(lds + bc * BUFB, lds + YOFF + (c & 1) * YB, Hacc, Hpk, r32, h, vh); __syncthreads(); bc = (bc == 2) ? 0 : bc + 1; }
    }
#undef CS_LOAD
#undef CS_WRITE
#undef CS_GLOAD
#undef CS_POST
    __syncthreads();
}

DI void mix_phase(const Frame& F0, int l, char* ldsg) { Frame F = refresh(F0);
#ifndef SKIP_SCAN
    if ((int)blockIdx.x < SCAN_WGS) { cscan_wg(F, (int)blockIdx.x, l); }
    else { const int nw_ = (F.G - SCAN_WGS) * NWAVES, w0_ = ((int)blockIdx.x - SCAN_WGS) * NWAVES + F.wave;
        conv_phase(F, l, w0_, nw_); if (l == 0) prologue(F, 1, w0_, nw_); __syncthreads(); }
#endif
    const float* lq1 = INP(F, 3) + l * 32; const float* lk1 = INP(F, 4) + l * 32; const float* lq2 = INP(F, 5) + l * 32; const float* lk2 = INP(F, 6) + l * 32;
    float d1 = 0.f, d2 = 0.f;
    for (int i = 0; i < 32; ++i) { d1 += lq1[i] * lk1[i]; d2 += lq2[i] * lk2[i]; }
    const float lambda_init = (l == 0) ? 0.2f : 0.35550906759f;
    const float lam = __expf(d1) - __expf(d2) + lambda_init;
    const float* sg = INP(F, 7) + l * 64;
    volatile LAS unsigned* qslot = (volatile LAS unsigned*)(F.lds + MISC_OFF + 64);
    const int myx = (int)(xb_xcc_id() & 7u);
    int qk = 0;
    for (;;) {
        if (F.tid == 0) { unsigned got = 0xffffffffu; int k = qk;
            for (; k < 8; ++k) { const int x = (myx + k) & 7; const unsigned v = atomicAdd(F_ctl + 64 * (1 + 8 * l + x), 1u); if (v < 96u) { got = (unsigned)x * 96u + v; break; } }
            qslot[0] = got; qslot[1] = (unsigned)k; }
        __syncthreads();
        const unsigned idx = (unsigned)__builtin_amdgcn_readfirstlane((int)qslot[0]); qk = __builtin_amdgcn_readfirstlane((int)qslot[1]);
        __syncthreads();
        if (idx == 0xffffffffu) break;
        const int xq = (int)(idx / 96u), iq = (int)(idx % 96u), qb = 15 - (iq & 15), bh = xq * 6 + (iq >> 4), b = bh / 6, h = bh % 6;
        const attn_body::bf16* P = (const attn_body::bf16*)F_PROJ;
#ifndef SKIP_ATT
#pragma unroll 1
        for (int ns = 0; ns < 2; ++ns)
            attn_body::attn_unit<8>(b, h, qb, ns, lam, sg, 1.f - lambda_init, P, P + 384, P + 768, (attn_body::bf16*)F_MIX, ldsg);
#endif
    }
}

__global__ void __launch_bounds__(NWAVES * 64, 2) mega_fwd(Args args) {
    extern __shared__ __attribute__((aligned(16))) unsigned char lds[];
    cg::grid_group grid = cg::this_grid();
    Frame F;
    F.lds = (LAS unsigned char*)lds;
    F.tid = threadIdx.x; F.lane = F.tid & 63; F.wave = __builtin_amdgcn_readfirstlane(F.tid >> 6);
    F.G = gridDim.x; F.gw = (int)blockIdx.x * NWAVES + F.wave; F.NGW = F.G * NWAVES;
    F.in = args.in; F.out = args.out; F.ws = args.ws;
    const int G = F.G;
    if (F.tid < 32) ((LAS unsigned*)(F.lds + MISC_OFF))[F.tid] = 0u;
    __syncthreads();
    XcdBarrier bar = xcd_barrier_post((unsigned*)(args.ws + WS_CTL) + CW_BAR, (volatile LAS unsigned*)(F.lds + MISC_OFF) + 8);

    prologue(F, 0, F.gw, F.NGW);
    x_to_bf16(F, INP(F, 0), F_XB, SSP(4));
    if (args.i0 != 0) grid.sync();
    xcd_barrier(bar);
#pragma unroll 1
    for (int l = 0; l < 2; ++l) {
        {
            pg8::Gemm g{F_XB, F_WIN + (size_t)l * NIN * DMODEL, M, NIN, DMODEL}; pg8::StaticOrder S; int bx = blockIdx.x; asm volatile("" : "+s"(bx)); S.init(M, NIN, G, bx);
            pg8::EpiBf16S<0> E{F_PROJ, NIN, (const float*)SSP(l == 0 ? 4 : 1)};
            GEMMCALL0 pg8::gemm_phase<pg8::EpiBf16S<0>, pg8::StaticOrder, true, true>(F.lds, g, S, E);
            if (PROBE & 1) { __syncthreads(); pg8::gemm_phase<pg8::EpiBf16S<0>, pg8::StaticOrder, true, true>(F.lds, g, S, E); }
        }
        xcd_barrier(bar);
#ifndef SKIP_PREP
        prep_phase(F, l);
#endif
        if (F.NGW == M / 16) {
            asm volatile("s_waitcnt vmcnt(0)" ::: "memory"); __syncthreads(); __builtin_amdgcn_fence(__ATOMIC_ACQUIRE, "agent"); asm volatile("s_waitcnt vmcnt(0)" ::: "memory");
        } else xcd_barrier(bar);
        cprep_phase(F, l);
        seam_arrive((unsigned*)(args.ws + WS_CTL) + 64 * (20 + l));
        if ((int)blockIdx.x < SCAN_WGS) seam_wait((unsigned*)(args.ws + WS_CTL) + 64 * (20 + l), gridDim.x);
        mix_phase(F, l, (char*)lds);
        xcd_barrier(bar);
        {
            pg8::Gemm g{F_MIX, F_WOUT + (size_t)l * DMODEL * DMODEL, M, DMODEL, DMODEL}; pg8::StaticOrder S; int bx = blockIdx.x; asm volatile("" : "+s"(bx)); S.init(M, DMODEL, G, bx);
            float* ssp = SSP(2 * l);
            pg8::EpiResBf16<false> E{nullptr, F_XB, DMODEL, ssp};
            pg8::gemm_phase<pg8::EpiResBf16<false>, pg8::StaticOrder, true, true>(F.lds, g, S, E);
        }
        xcd_barrier(bar);
        {
            pg8::Gemm g{F_XB, F_WUP + (size_t)l * FF * DMODEL, M, FF, DMODEL}; pg8::StaticOrder S; int bx = blockIdx.x; asm volatile("" : "+s"(bx)); S.init(M, FF, G, bx);
            pg8::EpiBf16S<2> E{F_HID, FF, (const float*)SSP(2 * l)};
            GEMMCALL2 pg8::gemm_phase<pg8::EpiBf16S<2>, pg8::StaticOrder, true, true>(F.lds, g, S, E);
            if (PROBE & 1) { __syncthreads(); pg8::gemm_phase<pg8::EpiBf16S<2>, pg8::StaticOrder, true, true>(F.lds, g, S, E); }
        }
        xcd_barrier(bar);
        {
            pg8::Gemm g{F_HID, F_WDN + (size_t)l * DMODEL * FF, M, DMODEL, FF}; pg8::StaticOrder S; int bx = blockIdx.x; asm volatile("" : "+s"(bx)); S.init(M, DMODEL, G, bx);
            pg8::EpiResBf16<false> E{nullptr, F_XB, DMODEL, SSP(2 * l + 1)};
            pg8::gemm_phase<pg8::EpiResBf16<false>, pg8::StaticOrder, true, true>(F.lds, g, S, E);
        }
        xcd_barrier(bar);
    }
    final_norm(F, F_XB, F.out, INP(F, 24));
}

extern "C" void kernel_launch(void* const* d_in, const int* in_sizes, int n_in, void* d_out, int out_size, void* d_ws, size_t ws_size, hipStream_t stream) {
    static int grid = 0;
    if (grid == 0) {
        if (n_in != 25 || in_sizes[0] != M * DMODEL || out_size != M * DMODEL || ws_size < WS_END) {
            fprintf(stderr, "kernel_launch: unexpected problem geometry (n_in %d, in0 %d, out %d, ws %zu)\n", n_in, n_in > 0 ? in_sizes[0] : -1, out_size, ws_size); grid = -1; return; }
        int dev = 0, cus = 0, per_cu = 0;
        if (hipGetDevice(&dev) != hipSuccess || hipDeviceGetAttribute(&cus, hipDeviceAttributeMultiprocessorCount, dev) != hipSuccess) { grid = -1; return; }
        if (hipFuncSetAttribute((const void*)mega_fwd, hipFuncAttributeMaxDynamicSharedMemorySize, LDS_BYTES) != hipSuccess) { fprintf(stderr, "kernel_launch: hipFuncSetAttribute failed\n"); grid = -1; return; }
        if (hipOccupancyMaxActiveBlocksPerMultiprocessor(&per_cu, (const void*)mega_fwd, NWAVES * 64, LDS_BYTES) != hipSuccess || per_cu < 1) { fprintf(stderr, "kernel_launch: occupancy query gave %d\n", per_cu); (void)hipGetLastError(); per_cu = 1; }
        grid = cus * per_cu;
    }
    if (grid < 0) return;
    (void)hipMemsetAsync((char*)d_ws + WS_CTL, 0, CTL_ZERO_BYTES, stream);
    Args a{};
    for (int i = 0; i < 25; ++i) a.in[i] = (const float*)d_in[i];
    a.out = (float*)d_out; a.ws = (unsigned char*)d_ws; a.i0 = 0; a.i1 = 0;
    void* kargs[] = {&a};
    const hipError_t e = hipLaunchCooperativeKernel((const void*)mega_fwd, dim3(grid), dim3(NWAVES * 64), kargs, LDS_BYTES, stream);
    if (e != hipSuccess) fprintf(stderr, "kernel_launch: cooperative launch failed: %s (grid %d)\n", hipGetErrorString(e), grid);
}
```

```cpp
#include <hip/hip_runtime.h>
#include <hip/hip_cooperative_groups.h>
#include <hip/hip_bf16.h>
#include <cstdio>
#include <cstdint>
#include <cmath>
namespace pg8 {
#define PG8_LAS __attribute__((address_space(3)))
typedef unsigned short bf16_t;
typedef short bf16x8 __attribute__((ext_vector_type(8)));
typedef float f32x4 __attribute__((ext_vector_type(4)));
typedef unsigned u32x4 __attribute__((ext_vector_type(4)));
constexpr int BM = 256, BK = 64, HALF = 128, HTB = HALF * BK * 2  , STAGE_BYTES = 8 * HTB, NXCD = 8, WGM = 8;

__host__ __device__ __forceinline__ int lds_byte(int r, int c) { const int st = (r >> 4) * 2 + (c >> 5), rr = r & 15, cc = c & 31, ob = rr * 64 + cc * 2; return st * 1024 + (ob ^ (((ob >> 9) & 1) << 5)); }
__host__ __device__ __forceinline__ void stage_rc(int b, int& R, int& C) { const int st = b / 1024, sb = b % 1024, swz = sb ^ (((sb >> 9) & 1) << 5); R = (st >> 1) * 16 + swz / 64; C = (st & 1) * 32 + (swz % 64) / 2; }
__host__ __device__ __forceinline__ int perm32(int rho) { const int n = rho >> 4, i = rho & 15; return 8 * (i >> 2) + 4 * n + (i & 3); }

struct Unit { int pm, pn; };
struct Gemm { const bf16_t* A; const bf16_t* Bt; int M, N, K; };

struct StaticOrder {
    int nM, nN, nwg, G, c;
    __host__ __device__ void init(int M, int N, int G_, int c_) { nM = M / BM; nN = N / BM; nwg = nM * nN; G = G_; c = c_; }
    __host__ __device__ bool next(int i, Unit& u) const {
        const long L = (long)i * G + c; if (L >= nwg) return false;
        int wgid = (int)L; { const int q = nwg / NXCD, r = nwg % NXCD, xcd = wgid % NXCD, off = wgid / NXCD; wgid = (xcd < r ? xcd * (q + 1) : r * (q + 1) + (xcd - r) * q) + off; }
        const int nig = WGM * nN, gid = wgid / nig, fm = gid * WGM, gsz = (nM - fm) < WGM ? (nM - fm) : WGM;
        u.pm = fm + ((wgid % nig) % gsz); u.pn = (wgid % nig) / gsz; return true;
    }
    __device__ __forceinline__ void a_ready(const Unit&) const {}
    __device__ __forceinline__ void done(const Unit&) const {}
};

__device__ __forceinline__ unsigned cvt_pk_bf16(float lo, float hi) { unsigned r; asm volatile("v_cvt_pk_bf16_f32 %0, %1, %2" : "=v"(r) : "v"(lo), "v"(hi)); return r; }
typedef float f32x2 __attribute__((ext_vector_type(2)));
template <int ACT  > struct EpiBf16S {
    static constexpr bool PERM = true, AFTER_DRAIN = false;
    bf16_t* O; int ldc; const float* ss;
    __device__ __forceinline__ void operator()(const f32x4 (&acc)[2][2][4][2], const Unit& u, int wr, int wc, int fr, int fq) const {
        const int row0 = u.pm * BM + wr * 64 + fr; const int col0 = u.pn * BM + wc * 32 + 8 * fq;
        f32x4 sp[8]; float rs[8];
#pragma unroll
        for (int g = 0; g < 8; ++g) sp[g] = *(const f32x4*)(ss + (size_t)(row0 + (g >> 2) * HALF + (g & 3) * 16) * 16 + fq * 4);
#pragma unroll
        for (int g = 0; g < 8; ++g) { float t = (sp[g].x + sp[g].y) + (sp[g].z + sp[g].w); t += __shfl_xor(t, 16); t += __shfl_xor(t, 32); rs[g] = 1.0f / sqrtf(t * (1.0f / 1024.0f) + 1e-6f); }
#pragma unroll
        for (int ai = 0; ai < 2; ++ai)
#pragma unroll
            for (int m = 0; m < 4; ++m) { bf16_t* rowp = O + (size_t)(row0 + ai * HALF + m * 16) * ldc + col0; const float r_ = rs[ai * 4 + m];
#pragma unroll
                for (int bj = 0; bj < 2; ++bj) { f32x4 v0 = acc[ai][bj][m][0] * r_, v1 = acc[ai][bj][m][1] * r_;
                    if (ACT == 2) {
#pragma unroll
                        for (int e = 0; e < 4; ++e) { float a = v0[e] > 0.f ? v0[e] : 0.f; v0[e] = a * a; float b = v1[e] > 0.f ? v1[e] : 0.f; v1[e] = b * b; } }
                    u32x4 w; w.x = cvt_pk_bf16(v0[0], v0[1]); w.y = cvt_pk_bf16(v0[2], v0[3]); w.z = cvt_pk_bf16(v1[0], v1[1]); w.w = cvt_pk_bf16(v1[2], v1[3]);
                    __builtin_nontemporal_store(w, (u32x4*)(rowp + bj * HALF)); } }
    }
};
template <bool BASE_F32> struct EpiResBf16 {
    static constexpr bool PERM = true, AFTER_DRAIN = false;
    const float* basef; bf16_t* xb; int ldc; float* ss;
    __device__ __forceinline__ void operator()(const f32x4 (&acc)[2][2][4][2], const Unit& u, int wr, int wc, int fr, int fq) const {
        const int col0 = u.pn * BM + wc * 32 + 8 * fq;
        const size_t off0 = (size_t)(u.pm * BM + wr * 64 + fr) * ldc + col0;
        f32x4 cb[4], nb[4];
        auto ld = [&](size_t off, f32x4 (&d)[4]) {
            if (BASE_F32) {
#pragma unroll
                for (int q = 0; q < 4; ++q) d[q] = *(const f32x4*)(basef + off + (q >> 1) * HALF + (q & 1) * 4);
            } else {
#pragma unroll
                for (int bj = 0; bj < 2; ++bj) { const u32x4 w = *(const u32x4*)(xb + off + bj * HALF);
                    d[2 * bj] = (f32x4){__uint_as_float(w.x << 16), __uint_as_float(w.x & 0xffff0000u), __uint_as_float(w.y << 16), __uint_as_float(w.y & 0xffff0000u)};
                    d[2 * bj + 1] = (f32x4){__uint_as_float(w.z << 16), __uint_as_float(w.z & 0xffff0000u), __uint_as_float(w.w << 16), __uint_as_float(w.w & 0xffff0000u)}; }
            }
        };
        ld(off0, cb);
#pragma unroll
        for (int g = 0; g < 8; ++g) { const int ai = g >> 2, m = g & 3; const size_t off = off0 + (size_t)(ai * HALF + m * 16) * ldc; const int r = u.pm * BM + ai * HALF + wr * 64 + m * 16 + fr;
            if (g < 7) ld(off0 + (size_t)(((g + 1) >> 2) * HALF + ((g + 1) & 3) * 16) * ldc, nb);
            float sq = 0.f;
#pragma unroll
            for (int bj = 0; bj < 2; ++bj) { const size_t idx = off + bj * HALF;
                const f32x4 o0 = cb[2 * bj] + acc[ai][bj][m][0], o1 = cb[2 * bj + 1] + acc[ai][bj][m][1];
                sq += ((o0[0] * o0[0] + o0[1] * o0[1]) + (o0[2] * o0[2] + o0[3] * o0[3])) + ((o1[0] * o1[0] + o1[1] * o1[1]) + (o1[2] * o1[2] + o1[3] * o1[3]));
                u32x4 w; w.x = cvt_pk_bf16(o0[0], o0[1]); w.y = cvt_pk_bf16(o0[2], o0[3]); w.z = cvt_pk_bf16(o1[0], o1[1]); w.w = cvt_pk_bf16(o1[2], o1[3]);
                *(u32x4*)(xb + idx) = w; }
            sq += __shfl_xor(sq, 16); sq += __shfl_xor(sq, 32);
            if (fq == 0) ss[(size_t)r * 16 + u.pn * 4 + wc] = sq;
#pragma unroll
            for (int q = 0; q < 4; ++q) cb[q] = nb[q];
            asm volatile("" ::: "memory"); }
    }
};
template <class Epi, class Sched, bool ALIGN_EPI = false, bool SP2 = false>
__device__ __forceinline__ void gemm_phase(PG8_LAS unsigned char* lds, const Gemm g, const Sched& S, const Epi& E) {
    int tid_ = threadIdx.x; asm volatile("" : "+v"(tid_)); const int tid = tid_, wid = __builtin_amdgcn_readfirstlane(tid >> 6), lane = tid & 63, wr = wid >> 2, wc = wid & 3, fr = lane & 15, fq = lane >> 4;
    const int K = g.K, nt = K / BK;
    unsigned voffA[2], voffB[2];
#pragma unroll
    for (int i = 0; i < 2; ++i) { int R, C; stage_rc(tid * 16 + i * 8192, R, C); const int Rb = Epi::PERM ? ((R & ~31) + perm32(R & 31)) : R;
        voffA[i] = (unsigned)(R * K + C) * 2u; voffB[i] = (unsigned)(Rb * K + C) * 2u; }
    const size_t kstep = (size_t)(BK * 2);
    const size_t hstep = (size_t)HALF * K * 2;
    const size_t tstep = 2 * hstep;
    const unsigned ldsw = (unsigned)wid * 1024u;
    const int aoff = lds_byte(wr * 64 + fr, fq * 8), boff = lds_byte(wc * 32 + fr, fq * 8);
#define PG8_SA(b, h) (((b) * 2 + (h)) * HTB)
#define PG8_SB(b, h) ((4 + (b) * 2 + (h)) * HTB)
#define PG8_STAGE(bufoff, gbase, voff) do { _Pragma("unroll") for (int _i = 0; _i < 2; ++_i) \
        __builtin_amdgcn_global_load_lds((const unsigned*)((const char*)(gbase) + (voff)[_i]), (PG8_LAS unsigned*)(lds + (bufoff) + ldsw + _i * 8192), 16, 0, 0); } while (0)
#define PG8_LDA(dst, b, h) do { _Pragma("unroll") for (int m = 0; m < 4; ++m) _Pragma("unroll") for (int k = 0; k < 2; ++k) dst[m][k] = *(const PG8_LAS bf16x8*)(lds + PG8_SA(b, h) + aoff + m * 2048 + k * 1024); } while (0)
#define PG8_LDB(dst, b, h) do { _Pragma("unroll") for (int n = 0; n < 2; ++n) _Pragma("unroll") for (int k = 0; k < 2; ++k) dst[n][k] = *(const PG8_LAS bf16x8*)(lds + PG8_SB(b, h) + boff + n * 2048 + k * 1024); } while (0)
#define PG8_MMA(ai, bj, At, Bt) do { __builtin_amdgcn_s_setprio(1); _Pragma("unroll") for (int m = 0; m < 4; ++m) _Pragma("unroll") for (int n = 0; n < 2; ++n) _Pragma("unroll") for (int k = 0; k < 2; ++k) \
        acc[ai][bj][m][n] = __builtin_amdgcn_mfma_f32_16x16x32_bf16(Bt[n][k], At[m][k], acc[ai][bj][m][n], 0, 0, 0); __builtin_amdgcn_s_setprio(0); } while (0)
#define PG8_WAIT_V(n) asm volatile("s_waitcnt vmcnt(" #n ")" ::: "memory")
#define PG8_WAIT_L(n) asm volatile("s_waitcnt lgkmcnt(" #n ")" ::: "memory")
#define PG8_BAR __builtin_amdgcn_s_barrier()
#define PG8_SCHED __builtin_amdgcn_sched_barrier(0)
    Unit cur, nxt; int ui = 0;
    if (!S.next(0, cur)) return;
    f32x4 acc[2][2][4][2];
#pragma unroll
    for (int a = 0; a < 2; ++a)
#pragma unroll
        for (int b = 0; b < 2; ++b)
#pragma unroll
            for (int m = 0; m < 4; ++m)
#pragma unroll
                for (int n = 0; n < 2; ++n) acc[a][b][m][n] = (f32x4){0.f, 0.f, 0.f, 0.f};
    bf16x8 At[4][2], B0[2][2], B1[2][2];
    const char* cA = (const char*)g.A + (size_t)cur.pm * tstep; const char* cB = (const char*)g.Bt + (size_t)cur.pn * tstep;
    S.a_ready(cur);
    if constexpr (SP2) {
        PG8_STAGE(PG8_SB(0, 0), cB, voffB); PG8_STAGE(PG8_SB(0, 1), cB + hstep, voffB); PG8_STAGE(PG8_SA(0, 0), cA, voffA); PG8_STAGE(PG8_SA(0, 1), cA + hstep, voffA);
        if (wr == 1) PG8_BAR;
        PG8_WAIT_V(2); PG8_BAR;
        PG8_STAGE(PG8_SB(1, 0), cB + kstep, voffB); PG8_STAGE(PG8_SA(1, 0), cA + kstep, voffA); PG8_STAGE(PG8_SB(1, 1), cB + hstep + kstep, voffB);
        PG8_WAIT_V(6); PG8_BAR;
    } else {
        PG8_STAGE(PG8_SB(0, 0), cB, voffB); PG8_STAGE(PG8_SA(0, 0), cA, voffA); PG8_STAGE(PG8_SB(0, 1), cB + hstep, voffB); PG8_STAGE(PG8_SA(0, 1), cA + hstep, voffA);
        if (wr == 1) PG8_BAR;
        PG8_WAIT_V(4); PG8_BAR;
        PG8_STAGE(PG8_SB(1, 0), cB + kstep, voffB); PG8_STAGE(PG8_SA(1, 0), cA + kstep, voffA); PG8_STAGE(PG8_SB(1, 1), cB + hstep + kstep, voffB);
        PG8_WAIT_V(6); PG8_BAR;
    }
    for (;;) {
        const bool has_next = S.next(ui + 1, nxt);
        const char* nA = has_next ? (const char*)g.A + (size_t)nxt.pm * tstep : cA; const char* nB = has_next ? (const char*)g.Bt + (size_t)nxt.pn * tstep : cB;
        for (int t = 0; t < nt; t += 2) {
            const bool last = (t == nt - 2);
            const char* a1 = cA + (size_t)(t + 1) * kstep;
            const char* a2 = last ? nA : cA + (size_t)(t + 2) * kstep; const char* b2 = last ? nB : cB + (size_t)(t + 2) * kstep;
            const char* a3 = a2 + kstep; const char* b3 = b2 + kstep;
            if (last && has_next) S.a_ready(nxt);
            if constexpr (SP2) {
            PG8_LDB(B0, 0, 0); PG8_LDB(B1, 0, 1); PG8_SCHED; PG8_LDA(At, 0, 0); PG8_STAGE(PG8_SA(1, 1), a1 + hstep, voffA);
            PG8_WAIT_V(8); PG8_WAIT_L(0); PG8_BAR; PG8_MMA(0, 0, At, B0); PG8_MMA(0, 1, At, B1); PG8_BAR; PG8_SCHED;
            PG8_LDA(At, 0, 1); PG8_STAGE(PG8_SB(0, 0), b2, voffB); PG8_STAGE(PG8_SB(0, 1), b2 + hstep, voffB); PG8_STAGE(PG8_SA(0, 0), a2, voffA);
            PG8_WAIT_V(8); PG8_WAIT_L(0); PG8_BAR; PG8_MMA(1, 0, At, B0); PG8_MMA(1, 1, At, B1); PG8_BAR; PG8_SCHED;
            PG8_LDB(B0, 1, 0); PG8_LDB(B1, 1, 1); PG8_SCHED; PG8_LDA(At, 1, 0); PG8_STAGE(PG8_SA(0, 1), a2 + hstep, voffA);
            PG8_WAIT_V(8); PG8_WAIT_L(0); PG8_BAR; PG8_MMA(0, 0, At, B0); PG8_MMA(0, 1, At, B1); PG8_BAR; PG8_SCHED;
            PG8_LDA(At, 1, 1); PG8_STAGE(PG8_SB(1, 0), b3, voffB); PG8_STAGE(PG8_SB(1, 1), b3 + hstep, voffB); PG8_STAGE(PG8_SA(1, 0), a3, voffA);
            PG8_WAIT_V(8); PG8_WAIT_L(0); PG8_BAR; PG8_MMA(1, 0, At, B0); PG8_MMA(1, 1, At, B1); PG8_BAR; PG8_SCHED;
            } else {
            PG8_LDB(B0, 0, 0); PG8_SCHED; PG8_LDA(At, 0, 0); PG8_STAGE(PG8_SA(1, 1), a1 + hstep, voffA);
            PG8_WAIT_L(8); PG8_BAR; PG8_WAIT_L(0); PG8_MMA(0, 0, At, B0); PG8_BAR; PG8_SCHED;
            PG8_LDB(B1, 0, 1); PG8_STAGE(PG8_SB(0, 0), b2, voffB);
            PG8_BAR; PG8_WAIT_L(0); PG8_MMA(0, 1, At, B1); PG8_BAR;
            PG8_LDA(At, 0, 1); PG8_STAGE(PG8_SA(0, 0), a2, voffA);
            PG8_BAR; PG8_WAIT_L(0); PG8_MMA(1, 0, At, B0); PG8_BAR; PG8_SCHED;
            PG8_STAGE(PG8_SB(0, 1), b2 + hstep, voffB);
            PG8_WAIT_V(6); PG8_BAR; PG8_MMA(1, 1, At, B1); PG8_BAR;
            PG8_LDB(B0, 1, 0); PG8_SCHED; PG8_LDA(At, 1, 0); PG8_STAGE(PG8_SA(0, 1), a2 + hstep, voffA);
            PG8_WAIT_L(8); PG8_BAR; PG8_WAIT_L(0); PG8_MMA(0, 0, At, B0); PG8_BAR; PG8_SCHED;
            PG8_LDB(B1, 1, 1); PG8_STAGE(PG8_SB(1, 0), b3, voffB);
            PG8_BAR; PG8_WAIT_L(0); PG8_MMA(0, 1, At, B1); PG8_BAR;
            PG8_LDA(At, 1, 1); PG8_STAGE(PG8_SA(1, 0), a3, voffA);
            PG8_BAR; PG8_WAIT_L(0); PG8_MMA(1, 0, At, B0); PG8_BAR; PG8_SCHED;
            PG8_STAGE(PG8_SB(1, 1), b3 + hstep, voffB);
            PG8_WAIT_V(6); PG8_BAR; PG8_MMA(1, 1, At, B1); PG8_BAR;
            }
        }
        if constexpr (ALIGN_EPI) { if (wr == 0) PG8_BAR; }
        if constexpr (!Epi::AFTER_DRAIN) { E(acc, cur, wr, wc, fr, fq); S.done(cur); }
        if (!has_next) break;
#pragma unroll
        for (int a = 0; a < 2; ++a)
#pragma unroll
            for (int b = 0; b < 2; ++b)
#pragma unroll
                for (int m = 0; m < 4; ++m)
#pragma unroll
                    for (int n = 0; n < 2; ++n) acc[a][b][m][n] = (f32x4){0.f, 0.f, 0.f, 0.f};
        cur = nxt; cA = nA; cB = nB; ++ui;
        if constexpr (ALIGN_EPI) { if (wr == 1) PG8_BAR; }
    }
    PG8_WAIT_V(0);
    if constexpr (!ALIGN_EPI) { if (wr == 0) PG8_BAR; }
    PG8_BAR;
    if constexpr (Epi::AFTER_DRAIN) { E.fused(acc, cur, wr, wc, fr, fq, lds, wid, lane); S.done(cur); }
#undef PG8_SA
#undef PG8_SB
#undef PG8_STAGE
#undef PG8_LDA
#undef PG8_LDB
#undef PG8_MMA
#undef PG8_WAIT_V
#undef PG8_WAIT_L
#undef PG8_BAR
#undef PG8_SCHED
}
}

#define PG8_SP2 true
#define PG8_ALIGN true
namespace attn_body {
using bf16=__hip_bfloat16;
using bf16x8=__attribute__((ext_vector_type(8)))short;
using s16x4=__attribute__((ext_vector_type(4)))short;
using f32x16=__attribute__((ext_vector_type(16)))float;
using u32x4=__attribute__((ext_vector_type(4)))unsigned;
constexpr int BATCH=8,NHEAD=6,SEQ=4096,D=64,DM=3328,OPITCH=1024;
constexpr int NW=8,QBLK=32,QB=QBLK*NW,KVBLK=64,NQB=SEQ/QB;
constexpr int ATTN_PITCH=DM, ATTN_UNIT_ROWS=QB;
__device__ __forceinline__ int crow(int r,int hi){return (r&3)+8*(r>>2)+4*hi;}
#define SBAR() __builtin_amdgcn_sched_barrier(0)
__device__ __forceinline__ void cmask(f32x16&p0,f32x16&p1,int jb,int qrel,int hi){
  const float NEG=-INFINITY; int kb=64*jb+4*hi;
  #pragma unroll
  for(int r=0;r<16;++r){int kv=kb+(r&3)+8*(r>>2); if(kv>qrel)p0[r]=NEG; if(kv+32>qrel)p1[r]=NEG;}
}

constexpr int NSLOT=3, SLOTB=8192;
constexpr int LDS_K=0, LDS_V=NSLOT*SLOTB, LDS_WS=2*NSLOT*SLOTB, LDS_OST=LDS_WS+NW*64*4, LDS_OST1=LDS_OST+NW*4096, LDS_BYTES=LDS_OST1+NW*4096;
constexpr float C2=0.17677669529663687f*1.4426950408889634f;
__device__ __forceinline__ void glds16(const void*gsrc,unsigned lds_dst){unsigned keep;
  asm volatile("s_mov_b32 %0, m0\n\ts_mov_b32 m0, %2\n\ts_nop 0\n\tglobal_load_lds_dwordx4 %1, off\n\ts_mov_b32 m0, %0":"=&s"(keep):"v"(gsrc),"s"(lds_dst):"memory");}
__device__ __forceinline__ float max3f(float a,float b,float c){float r;asm("v_max3_f32 %0, %1, %2, %3":"=v"(r):"v"(a),"v"(b),"v"(c));return r;}
__device__ __forceinline__ float max2f(float a,float b){float r;asm("v_max_f32_e32 %0, %1, %2":"=v"(r):"v"(a),"v"(b));return r;}
__device__ __forceinline__ float fadd_s(float a,float b){float r;asm("v_add_f32_e32 %0, %1, %2":"=v"(r):"v"(a),"v"(b));return r;}
__device__ __forceinline__ float fsub_s(float a,float b){float r;asm("v_sub_f32_e32 %0, %1, %2":"=v"(r):"v"(a),"v"(b));return r;}
typedef float f32x2_t __attribute__((ext_vector_type(2))); typedef __bf16 bf16x2_t __attribute__((ext_vector_type(2)));
__device__ __forceinline__ unsigned cvtpk_s(float lo,float hi){f32x2_t v={lo,hi};bf16x2_t b=__builtin_convertvector(v,bf16x2_t);return __builtin_bit_cast(unsigned,b);}
#define WAIT_BAR(N) asm volatile("s_waitcnt vmcnt(" #N ") lgkmcnt(0)\n\ts_barrier":::"memory")

__device__ __forceinline__ void qkt(f32x16&p0,f32x16&p1,const char*Kslot,const bf16x8*qr,const f32x16&negm,int r32,int hi){
  const char*kb=Kslot+hi*1024+r32*16;
  #pragma unroll
  for(int d0=0;d0<4;++d0){
    const bf16x8 b0=*reinterpret_cast<const bf16x8*>(kb+d0*2048);
    const bf16x8 b1=*reinterpret_cast<const bf16x8*>(kb+d0*2048+512);
    if(d0==0){p0=__builtin_amdgcn_mfma_f32_32x32x16_bf16(b0,qr[0],negm,0,0,0);p1=__builtin_amdgcn_mfma_f32_32x32x16_bf16(b1,qr[0],negm,0,0,0);}
    else{p0=__builtin_amdgcn_mfma_f32_32x32x16_bf16(b0,qr[d0],p0,0,0,0);p1=__builtin_amdgcn_mfma_f32_32x32x16_bf16(b1,qr[d0],p1,0,0,0);}}
}
typedef __attribute__((address_space(3))) const char* lds_cptr;
typedef short v4i16_t __attribute__((ext_vector_type(4)));
__device__ __forceinline__ void kload8(bf16x8*kf,lds_cptr kp){
  kf[0]=*(const __attribute__((address_space(3))) bf16x8*)(kp);      kf[1]=*(const __attribute__((address_space(3))) bf16x8*)(kp+512);
  kf[2]=*(const __attribute__((address_space(3))) bf16x8*)(kp+2048); kf[3]=*(const __attribute__((address_space(3))) bf16x8*)(kp+2560);
  kf[4]=*(const __attribute__((address_space(3))) bf16x8*)(kp+4096); kf[5]=*(const __attribute__((address_space(3))) bf16x8*)(kp+4608);
  kf[6]=*(const __attribute__((address_space(3))) bf16x8*)(kp+6144); kf[7]=*(const __attribute__((address_space(3))) bf16x8*)(kp+6656);
}
__device__ __forceinline__ void kload2(bf16x8*kf,lds_cptr kp,int j){ kf[2*j]=*(const __attribute__((address_space(3))) bf16x8*)(kp+j*2048); kf[2*j+1]=*(const __attribute__((address_space(3))) bf16x8*)(kp+j*2048+512); }
__device__ __forceinline__ s16x4 vtr(lds_cptr p){ return __builtin_bit_cast(s16x4,__builtin_amdgcn_ds_read_tr16_b64_v4i16((__attribute__((address_space(3))) v4i16_t*)p)); }
__device__ __forceinline__ float rowmax(const f32x16&p0,const f32x16&p1){
  float a=max3f(p0[0],p0[1],p1[0]),b=max3f(p0[2],p0[3],p1[1]);a=max3f(a,p1[2],p1[3]);
  #pragma unroll
  for(int r=4;r<16;r+=4){a=max3f(a,p0[r],p0[r+1]);b=max3f(b,p0[r+2],p0[r+3]);a=max3f(a,p1[r],p1[r+1]);b=max3f(b,p1[r+2],p1[r+3]);}
  const float m=max2f(a,b);
  auto rr=__builtin_amdgcn_permlane32_swap(__float_as_uint(m),__float_as_uint(m),false,false);
  return max2f(__uint_as_float(rr[0]),__uint_as_float(rr[1]));
}
__device__ __forceinline__ void pv(f32x16*o,int vb,bf16x8 pa0,bf16x8 pa1,bf16x8 pa2,bf16x8 pa3){
  #pragma unroll
  for(int d0=0;d0<2;++d0){s16x4 lo[4],hi[4];
    #pragma unroll
    for(int ks=0;ks<4;++ks){
      asm volatile("ds_read_b64_tr_b16 %0,%1 offset:%c2":"=&v"(lo[ks]):"v"(vb),"i"(d0*4096+ks*1024):"memory");
      asm volatile("ds_read_b64_tr_b16 %0,%1 offset:%c2":"=&v"(hi[ks]):"v"(vb),"i"(d0*4096+ks*1024+512):"memory");}
    asm volatile("s_waitcnt lgkmcnt(0)":::"memory");SBAR();
    #define PK(k) (bf16x8){lo[k][0],lo[k][1],lo[k][2],lo[k][3],hi[k][0],hi[k][1],hi[k][2],hi[k][3]}
    o[d0]=__builtin_amdgcn_mfma_f32_32x32x16_bf16(pa0,PK(0),o[d0],0,0,0);
    o[d0]=__builtin_amdgcn_mfma_f32_32x32x16_bf16(pa1,PK(1),o[d0],0,0,0);
    o[d0]=__builtin_amdgcn_mfma_f32_32x32x16_bf16(pa2,PK(2),o[d0],0,0,0);
    o[d0]=__builtin_amdgcn_mfma_f32_32x32x16_bf16(pa3,PK(3),o[d0],0,0,0);
    #undef PK
  }
}

#ifndef ATTN_STORE16
#define ATTN_STORE16(p,v) __builtin_nontemporal_store((v),(u32x4*)(p))
#endif
template<int THRL> __device__ __forceinline__ void attn_unit(int b,int h,int qb,int nsel,float lam,const float*subg,float omli,const bf16*Q,const bf16*__restrict__ K,const bf16*__restrict__ V,bf16*O,char*shm){
  int tid_=threadIdx.x; asm volatile("":"+v"(tid_)); const int tid=tid_,lane=tid&63,r32=lane&31,hi=lane>>5; const int wid=__builtin_amdgcn_readfirstlane(tid>>6);
  const long rowbase=(long)b*SEQ; const int q0=qb*QB;
  const bf16*Qw=Q+(rowbase+q0+wid*QBLK)*DM+h*D;
  const bf16*Kh=K+rowbase*DM+h*D,*Vh=V+rowbase*DM+h*D;
  const unsigned lds0=(unsigned)(uintptr_t)shm;
  float*wsf=(float*)(shm+LDS_WS)+wid*64;
  const bf16*ksrc=Kh+(long)lane*DM+wid*8;
  const bf16*vsrc=Vh+(long)(16*(wid&3)+(lane>>2))*DM+(wid>>2)*32+(lane&3)*8;
  const unsigned kdst=lds0+LDS_K+wid*1024, vdst=lds0+LDS_V+wid*1024;
  #define DMA_K(t,slot) glds16(ksrc+(long)(t)*KVBLK*DM,(unsigned)__builtin_amdgcn_readfirstlane(kdst+(slot)))
  #define DMA_V(t,slot) glds16(vsrc+(long)(t)*KVBLK*DM,(unsigned)__builtin_amdgcn_readfirstlane(vdst+(slot)))
  const int vb0=(int)(lds0+LDS_V)+((lane>>4)&1)*32+(lane&3)*8+(4*hi+((lane&15)>>2))*64;
  const char*Kbase=shm+LDS_K; bf16x8 kf[8];
  const lds_cptr shm3=(lds_cptr)shm; const lds_cptr kp0=shm3+LDS_K+hi*1024+r32*16; const lds_cptr vp0=shm3+LDS_V+((lane>>4)&1)*32+(lane&3)*8+(4*hi+((lane&15)>>2))*64;
  const int NT=(q0+QB)/KVBLK;
  DMA_K(0,0);DMA_V(0,0);DMA_K(1,SLOTB);
  bf16x8 qr[4];
  #pragma unroll
  for(int d0=0;d0<4;++d0){qr[d0]=*reinterpret_cast<const bf16x8*>(&Qw[(long)r32*DM+d0*16+hi*8]); if((d0>>1)!=nsel)qr[d0]=bf16x8{0,0,0,0,0,0,0,0};}
  float mhat=0.f,l_reg=0.f;f32x16 o[2];o[0]=f32x16{};o[1]=f32x16{};f32x16 negm=f32x16{};asm volatile("":"+v"(negm));
  const int qrel=wid*QBLK+r32;
  #define CMASK(P0,P1,t) do{int jb_=(t)-(NT-4); if(jb_>=0)cmask(P0,P1,jb_,qrel,hi);}while(0)
  bool resc=false;
  #define START(P0,P1) do{ const float rm=rowmax(P0,P1); resc=false; \
    { const float dl=rm; mhat=fadd_s(mhat,dl); \
      _Pragma("unroll") for(int r=0;r<16;++r){P0[r]=fsub_s(P0[r],dl);P1[r]=fsub_s(P1[r],dl);} \
      _Pragma("unroll") for(int r=0;r<16;++r)negm[r]=-mhat; asm volatile("":"+v"(negm)); } \
    _Pragma("unroll") for(int r=0;r<16;++r)P0[r]=__builtin_amdgcn_exp2f(P0[r]); }while(0)
  #define RESC() do{ if(resc){ asm volatile("s_waitcnt lgkmcnt(0)":::"memory"); \
      _Pragma("unroll") for(int d_=0;d_<2;++d_) _Pragma("unroll") for(int r=0;r<16;++r)o[d_][r]*=wsf[crow(r,hi)]; } }while(0)
  f32x16 pA0,pA1,pB0,pB1;
  int sl_prev=0,sl_cur=0,sl_next=SLOTB;
  #define ROT() do{sl_prev=sl_cur;sl_cur=sl_next;sl_next=(sl_next==(NSLOT-1)*SLOTB)?0:sl_next+SLOTB;}while(0)
  DMA_K(2,2*SLOTB);
  WAIT_BAR(3);
  qkt(pA0,pA1,Kbase,qr,negm,r32,hi);asm volatile("s_nop 15\n\ts_nop 7":"+v"(pA0),"+v"(pA1));CMASK(pA0,pA1,0);
  START(pA0,pA1);
  _Pragma("unroll") for(int r=0;r<16;++r)pA1[r]=__builtin_amdgcn_exp2f(pA1[r]);
  WAIT_BAR(0);
  DMA_K(3,0);DMA_V(1,SLOTB);
  ROT();
  kload8(kf,kp0+sl_cur);
  WAIT_BAR(2);
  s16x4 vlo[8],vhi[8]; u32x4 pw0,pw1,pw2,pw3;
  #define PKW(P,B) cvtpk_s(P[B],P[B+1])
  #define PAF(k) __builtin_bit_cast(bf16x8,pw##k)
  #define VFR(i) (bf16x8){vlo[i][0],vlo[i][1],vlo[i][2],vlo[i][3],vhi[i][0],vhi[i][1],vhi[i][2],vhi[i][3]}
  #define PIN(x) asm volatile("":"+v"(x))
  #define MX3(a,b,c) __builtin_fmaxf(__builtin_fmaxf((a),(b)),(c))
  #define GAPA(MF,A0,A1,A2,A3,W0,W1,PW) do{ MF; sacc+=A0; sacc+=A1; sacc+=A2; sacc+=A3; PIN(sacc); W0; W1; PIN(PW); SBAR(); }while(0)
  #define EX(v) __builtin_amdgcn_exp2f(v)
  #define GAPB(MF,X,B) do{ MF; X[B]=EX(X[B]); X[B+1]=EX(X[B+1]); X[B+2]=EX(X[B+2]); X[B+3]=EX(X[B+3]); PIN(X); SBAR(); }while(0)
  #define VRD(i) do{ vlo[i]=vtr(vp_+(((i)>>2)*4096+((i)&3)*1024)); vhi[i]=vtr(vp_+(((i)>>2)*4096+((i)&3)*1024+512)); }while(0)
  #define KRD(G,j) do{ if(G){ kload2(kf,kp0+sl_next,j); SBAR(); } }while(0)
  #define STEP(C0,C1,P0,P1,t,GK,GV,GL) do{ SBAR(); \
    const lds_cptr vp_=vp0+sl_prev; \
    VRD(0); SBAR(); float sacc=(P0[0]+P0[1]); \
    GAPA(C0=__builtin_amdgcn_mfma_f32_32x32x16_bf16(kf[0],qr[0],negm,0,0,0), P0[2],P0[3],P0[4],P0[5],     pw0[0]=PKW(P0,0), pw0[1]=PKW(P0,2), pw0); \
    VRD(4); SBAR(); GAPA(C1=__builtin_amdgcn_mfma_f32_32x32x16_bf16(kf[1],qr[0],negm,0,0,0), P0[6],P0[7],P0[8],P0[9],     pw0[2]=PKW(P0,4), pw0[3]=PKW(P0,6), pw0); \
    VRD(1); SBAR(); GAPA(C0=__builtin_amdgcn_mfma_f32_32x32x16_bf16(kf[2],qr[1],C0,0,0,0),   P0[10],P0[11],P0[12],P0[13], pw1[0]=PKW(P0,8), pw1[1]=PKW(P0,10), pw1); \
    VRD(5); SBAR(); GAPA(C1=__builtin_amdgcn_mfma_f32_32x32x16_bf16(kf[3],qr[1],C1,0,0,0),   P0[14],P0[15],P1[0],P1[1],   pw1[2]=PKW(P0,12),pw1[3]=PKW(P0,14), pw1); \
    VRD(2); SBAR(); GAPA(C0=__builtin_amdgcn_mfma_f32_32x32x16_bf16(kf[4],qr[2],C0,0,0,0),   P1[2],P1[3],P1[4],P1[5],     pw2[0]=PKW(P1,0), pw2[1]=PKW(P1,2), pw2); \
    VRD(6); SBAR(); GAPA(C1=__builtin_amdgcn_mfma_f32_32x32x16_bf16(kf[5],qr[2],C1,0,0,0),   P1[6],P1[7],P1[8],P1[9],     pw2[2]=PKW(P1,4), pw2[3]=PKW(P1,6), pw2); \
    VRD(3); SBAR(); GAPA(C0=__builtin_amdgcn_mfma_f32_32x32x16_bf16(kf[6],qr[3],C0,0,0,0),   P1[10],P1[11],P1[12],P1[13], pw3[0]=PKW(P1,8), pw3[1]=PKW(P1,10), pw3); \
    VRD(7); SBAR(); GAPA(C1=__builtin_amdgcn_mfma_f32_32x32x16_bf16(kf[7],qr[3],C1,0,0,0),   P1[14],P1[15],0.f,0.f,       pw3[2]=PKW(P1,12),pw3[3]=PKW(P1,14), pw3); \
    l_reg+=sacc; \
    if(GK){DMA_K((t)+3,sl_cur);} if(GV){DMA_V((t)+1,sl_next);} \
    CMASK(C0,C1,t); \
    { float a=MX3(C0[0],C0[1],C1[0]),b=MX3(C0[2],C0[3],C1[1]); a=MX3(a,C1[2],C1[3]); \
      _Pragma("unroll") for(int r=4;r<16;r+=4){a=MX3(a,C0[r],C0[r+1]);b=MX3(b,C0[r+2],C0[r+3]);a=MX3(a,C1[r],C1[r+1]);b=MX3(b,C1[r+2],C1[r+3]);} \
      float rm=__builtin_fmaxf(a,b); { auto rr=__builtin_amdgcn_permlane32_swap(__float_as_uint(rm),__float_as_uint(rm),false,false); rm=__builtin_fmaxf(__uint_as_float(rr[0]),__uint_as_float(rr[1])); } \
      resc=false; \
      if(__builtin_expect(__any(rm>(float)THRL),0)){ const float dl=__builtin_fmaxf(rm,0.f); mhat+=dl; \
        _Pragma("unroll") for(int r=0;r<16;++r){C0[r]-=dl;C1[r]-=dl;} \
        _Pragma("unroll") for(int r=0;r<16;++r)negm[r]=-mhat; asm volatile("":"+v"(negm)); \
        const float f=__builtin_amdgcn_exp2f(-dl); l_reg*=f; if(hi==0)wsf[r32]=f; resc=true; } } \
    SBAR(); \
    GAPB(o[0]=__builtin_amdgcn_mfma_f32_32x32x16_bf16(PAF(0),VFR(0),o[0],0,0,0), C0,0); \
    GAPB(o[1]=__builtin_amdgcn_mfma_f32_32x32x16_bf16(PAF(0),VFR(4),o[1],0,0,0), C0,4); \
    KRD(GL,0); GAPB(o[0]=__builtin_amdgcn_mfma_f32_32x32x16_bf16(PAF(1),VFR(1),o[0],0,0,0), C0,8); \
    KRD(GL,1); GAPB(o[1]=__builtin_amdgcn_mfma_f32_32x32x16_bf16(PAF(1),VFR(5),o[1],0,0,0), C0,12); \
    KRD(GL,2); GAPB(o[0]=__builtin_amdgcn_mfma_f32_32x32x16_bf16(PAF(2),VFR(2),o[0],0,0,0), C1,0); \
    KRD(GL,3); GAPB(o[1]=__builtin_amdgcn_mfma_f32_32x32x16_bf16(PAF(2),VFR(6),o[1],0,0,0), C1,4); \
    GAPB(o[0]=__builtin_amdgcn_mfma_f32_32x32x16_bf16(PAF(3),VFR(3),o[0],0,0,0), C1,8); \
    GAPB(o[1]=__builtin_amdgcn_mfma_f32_32x32x16_bf16(PAF(3),VFR(7),o[1],0,0,0), C1,12); \
    }while(0)
  int t=1;
  #undef CMASK
  #define CMASK(P0,P1,t) do{}while(0)
  for(;t+5<NT;t+=2){
    STEP(pB0,pB1,pA0,pA1,t,true,true,true);     WAIT_BAR(2); RESC(); ROT();
    STEP(pA0,pA1,pB0,pB1,t+1,true,true,true);   WAIT_BAR(2); RESC(); ROT();
  }
  #undef CMASK
  #define CMASK(P0,P1,t) do{int jb_=(t)-(NT-4); if(jb_>=0)cmask(P0,P1,jb_,qrel,hi);}while(0)
  #define ENDW(tt) do{ if((tt)+3<NT){WAIT_BAR(2);} else if((tt)+2<NT){WAIT_BAR(1);} else {WAIT_BAR(0);} }while(0)
  for(;t+1<NT;t+=2){
    STEP(pB0,pB1,pA0,pA1,t,(t+3<NT),(t+1<NT),(t+1<NT));       ENDW(t);   RESC(); ROT();
    STEP(pA0,pA1,pB0,pB1,t+1,(t+4<NT),(t+2<NT),(t+2<NT));     ENDW(t+1); RESC(); ROT();
  }
  STEP(pB0,pB1,pA0,pA1,NT-1,false,false,false); RESC();
  { float sacc=pB0[0]+pB0[1]; _Pragma("unroll") for(int r=2;r<16;++r)sacc+=pB0[r]; _Pragma("unroll") for(int r=0;r<16;++r)sacc+=pB1[r]; l_reg+=sacc;
    pw0=(u32x4){PKW(pB0,0),PKW(pB0,2),PKW(pB0,4),PKW(pB0,6)};pw1=(u32x4){PKW(pB0,8),PKW(pB0,10),PKW(pB0,12),PKW(pB0,14)};pw2=(u32x4){PKW(pB1,0),PKW(pB1,2),PKW(pB1,4),PKW(pB1,6)};pw3=(u32x4){PKW(pB1,8),PKW(pB1,10),PKW(pB1,12),PKW(pB1,14)};
    SBAR(); pv(o,vb0+sl_cur,PAF(0),PAF(1),PAF(2),PAF(3)); }
  #undef PKW
  #undef PAF
  #undef VFR
  #undef PIN
  #undef MX3
  #undef GAPA
  #undef GAPB
  #undef EX
  #undef VRD
  #undef KRD
  #undef STEP
  #undef ENDW
  {auto rr=__builtin_amdgcn_permlane32_swap(__float_as_uint(l_reg),__float_as_uint(l_reg),false,false);l_reg=__uint_as_float(rr[0])+__uint_as_float(rr[1]);}
  if(hi==0)wsf[32+r32]=l_reg;asm volatile("s_waitcnt lgkmcnt(0)":::"memory");
  float rli[16];
  #pragma unroll
  for(int r=0;r<16;++r)rli[r]=__builtin_amdgcn_rcpf(wsf[32+crow(r,hi)]);
  bf16*Ow=O+(rowbase+q0+wid*QBLK)*OPITCH+h*D;
  { bf16*stg=(bf16*)(shm+(nsel==0?LDS_OST1:LDS_OST))+wid*2048;
    #pragma unroll
    for(int r=0;r<16;++r){const int orow=crow(r,hi);
      #pragma unroll
      for(int d0=0;d0<2;++d0)stg[orow*64+d0*32+r32]=__float2bfloat16(o[d0][r]*rli[r]);}
    asm volatile("s_waitcnt lgkmcnt(0)":::"memory");
    if(nsel==1){ const bf16*stg1=(const bf16*)(shm+LDS_OST1)+wid*2048;
      #pragma unroll
      for(int i=0;i<4;++i){const int row=i*8+(lane>>3),ch=lane&7; const u32x4 v2=*(const u32x4*)(stg+row*64+ch*8); const u32x4 v1=*(const u32x4*)(stg1+row*64+ch*8);
        float dd[8]; float ss=0.f;
        #pragma unroll
        for(int j=0;j<4;++j){ const float a0=__uint_as_float(v1[j]<<16),a1=__uint_as_float(v1[j]&0xffff0000u),b0=__uint_as_float(v2[j]<<16),b1=__uint_as_float(v2[j]&0xffff0000u);
          dd[2*j]=a0-lam*b0; dd[2*j+1]=a1-lam*b1; ss+=dd[2*j]*dd[2*j]+dd[2*j+1]*dd[2*j+1]; }
        ss+=__shfl_xor(ss,1); ss+=__shfl_xor(ss,2); ss+=__shfl_xor(ss,4);
        const float rs=omli/sqrtf(ss*(1.0f/64.0f)+1e-6f);
        u32x4 w;
        #pragma unroll
        for(int j=0;j<4;++j) w[j]=cvtpk_s(dd[2*j]*rs*subg[ch*8+2*j],dd[2*j+1]*rs*subg[ch*8+2*j+1]);
        ATTN_STORE16(Ow+(long)row*OPITCH+ch*8,w);} } }
  asm volatile("s_waitcnt lgkmcnt(0)\n\ts_barrier":::"memory");
  #undef DMA_K
  #undef DMA_V
  #undef CMASK
  #undef START
  #undef RESC
  #undef ROT

}
#undef SBAR
#undef WAIT_BAR
}
#ifndef GOFF
#define GOFF 0
#endif
#define GEMMCALL0 if (!((GOFF) & 1))
#define GEMMCALL1 if (!((GOFF) & 2))
#define GEMMCALL2 if (!((GOFF) & 4))
#define GEMMCALL3 if (!((GOFF) & 8))
namespace cg = cooperative_groups;
#define GAS __attribute__((address_space(1)))
#define LAS __attribute__((address_space(3)))
#define DI __device__ __forceinline__
typedef unsigned short bf16;
typedef unsigned v4u __attribute__((ext_vector_type(4)));
typedef unsigned v2u __attribute__((ext_vector_type(2)));
typedef float f32x4 __attribute__((ext_vector_type(4)));
typedef short bf16x8 __attribute__((ext_vector_type(8)));

constexpr int NWAVES = 8;
constexpr int DMODEL = 1024, SEQ = 4096, M = 32768, NIN = 3328, FF = 4096;
constexpr int RW = 384, RCOLS = 1408, ROFF = 1920, COFF = 1152;
constexpr float NORM_EPS = 1e-6f, GN_EPS = 64e-5f;
constexpr size_t MiB = 1u << 20;
constexpr size_t WS_CTL = 0, CTL_ZERO_BYTES = 65536;
constexpr int CW_BAR = 4096;
constexpr size_t WS_SS = 128 * 1024;
constexpr size_t WS_WIN = 1 * MiB, WS_WOUT = 14 * MiB, WS_WUP = 18 * MiB, WS_WDN = 34 * MiB, WS_LORA = 50 * MiB;
constexpr size_t WS_XB = 51 * MiB, WS_PROJ = 115 * MiB, WS_MIX = 323 * MiB, WS_S = 387 * MiB, WS_END = 507 * MiB;
constexpr size_t WS_HID = 115 * MiB;
constexpr size_t WS_AUX = 48 * MiB;
constexpr size_t WS_PT = WS_AUX + 12 * MiB, WS_DOTS = WS_PT + 2 * MiB;
constexpr int NITEMS = 48 * 128;
constexpr size_t SARR = (size_t)M * RW;
constexpr int LORA_L = 384 * 64 * 2 + 384 * 128;
constexpr int LDS_BYTES = 147456, MISC_OFF = 131072;
constexpr int SCAN_WGS = 48, ATT_ITEMS = 768;

#ifndef STAG1
#define STAG1 2000u
#endif
#ifndef STAG3
#define STAG3 3000u
#endif
#ifndef PROBE
#define PROBE 0
#endif
struct Args { const float* in[25]; float* out; unsigned char* ws; int i0, i1; };

DI float wave_sum(float v) {
#pragma unroll
    for (int o = 1; o < 64; o <<= 1) v += __shfl_xor(v, o);
    return v;
}
typedef float f32x2h __attribute__((ext_vector_type(2))); typedef __bf16 bf16x2h __attribute__((ext_vector_type(2)));
DI unsigned pk2(float lo, float hi) { f32x2h v = {lo, hi}; bf16x2h b = __builtin_convertvector(v, bf16x2h); return __builtin_bit_cast(unsigned, b); }
DI unsigned f2bf(float f) { return pk2(f, 0.f) & 0xffffu; }
DI float bflo(unsigned w) { return __uint_as_float(w << 16); }
DI float bfhi(unsigned w) { return __uint_as_float(w & 0xffff0000u); }
DI float bf1(const bf16* p) { return __uint_as_float(((unsigned)*p) << 16); }
DI void unpack8(v4u w, float* f) { f[0] = bflo(w.x); f[1] = bfhi(w.x); f[2] = bflo(w.y); f[3] = bfhi(w.y); f[4] = bflo(w.z); f[5] = bfhi(w.z); f[6] = bflo(w.w); f[7] = bfhi(w.w); }
DI v4u pack8(const float* f) { v4u o; o.x = pk2(f[0], f[1]); o.y = pk2(f[2], f[3]); o.z = pk2(f[4], f[5]); o.w = pk2(f[6], f[7]); return o; }
DI float sigmoidf_(float x) { return __builtin_amdgcn_rcpf(1.f + __expf(-x)); }
DI float tanhf_(float x) { const float e = __expf(2.f * x); return 1.f - 2.f * __builtin_amdgcn_rcpf(e + 1.f); }
template <int CTRL> DI float dpp_add(float x) { return x + __int_as_float(__builtin_amdgcn_update_dpp(0, __float_as_int(x), CTRL, 0xf, 0xf, true)); }
DI float red16(float x) { x = dpp_add<0xB1>(x); x = dpp_add<0x4E>(x); x = dpp_add<0x141>(x); x = dpp_add<0x140>(x); return x; }

#define XB_TMO      128
#define XB_XCNT(j)  (256  + 64 * (j))
#define XB_XSUB(j)  (1280 + 64 * (j))
#define XB_XGEN(j)  (2304 + 64 * (j))
#define XB_TOP      3328
#define XB_TOPGEN   3392
#define XCD_BAR_WORDS 3456
#define XB_SPIN_CAP (1u << 18)

__device__ __forceinline__ unsigned xb_ld(unsigned* p)              { return __hip_atomic_load(p, __ATOMIC_RELAXED, __HIP_MEMORY_SCOPE_AGENT); }
__device__ __forceinline__ unsigned xb_add(unsigned* p, unsigned v) { return __hip_atomic_fetch_add(p, v, __ATOMIC_RELAXED, __HIP_MEMORY_SCOPE_AGENT); }
__device__ __forceinline__ unsigned xb_xcc_id() { return (unsigned)__builtin_amdgcn_s_getreg((3 << 11) | 20) & 0xFu; }
#define XB_SPIN(cond, bar) do { unsigned _sp = 0; while (cond) { __builtin_amdgcn_s_sleep(1); \
    if ((++_sp & 255u) == 0u) { if (xb_ld(&(bar)[XB_TMO])) break; if (_sp > XB_SPIN_CAP) { atomicAdd(&(bar)[XB_TMO], 1u); break; } } } } while (0)

struct XcdBarrier {
    unsigned* bar; unsigned x;
    volatile LAS unsigned* st;
};

__device__ __forceinline__ XcdBarrier xcd_barrier_post(unsigned* bar, volatile LAS unsigned* st) {
    XcdBarrier b; b.bar = bar; b.x = xb_xcc_id(); b.st = st;
    if (threadIdx.x == 0) (void)xb_add(&bar[XB_XCNT(b.x)], 1u);
    return b;
}
__device__ __forceinline__ void xcd_barrier_complete(unsigned* bar, unsigned x, unsigned& nloc, unsigned& nx) {
    const unsigned G = gridDim.x * gridDim.y * gridDim.z;
    unsigned sum, cnt, mine, sp = 0u;
    for (;;) {
        sum = 0u; cnt = 0u; mine = 0u;
#pragma unroll
        for (unsigned j = 0; j < 16; ++j) { const unsigned c = xb_ld(&bar[XB_XCNT(j)]); sum += c; cnt += (c > 0u) ? 1u : 0u; mine = (j == x) ? c : mine; }
        if (sum == G) break;
        __builtin_amdgcn_s_sleep(1);
        if ((++sp & 255u) == 0u) { if (xb_ld(&bar[XB_TMO])) break; if (sp > XB_SPIN_CAP) { atomicAdd(&bar[XB_TMO], 1u); break; } }
    }
    nloc = mine > 0u ? mine : 1u; nx = cnt > 0u ? cnt : 1u;
}

__device__ __forceinline__ void xcd_barrier(const XcdBarrier& b) {
    asm volatile("s_waitcnt vmcnt(0)" ::: "memory");
    __syncthreads();
    if (threadIdx.x == 0) {
        unsigned* bar = b.bar; unsigned bx_ = xb_xcc_id(); asm volatile("" : "+s"(bx_));
        __builtin_amdgcn_s_waitcnt(0);
        unsigned nloc = b.st[0], nx = b.st[1];
        if (nloc == 0u) { xcd_barrier_complete(bar, bx_, nloc, nx); b.st[0] = nloc; b.st[1] = nx; }
        const unsigned old = xb_add(&bar[XB_XSUB(bx_)], 1u);
        const unsigned gen = old / nloc;
        if (old + 1u == (gen + 1u) * nloc) {
            __builtin_amdgcn_fence(__ATOMIC_RELEASE, "agent");
            asm volatile("s_waitcnt vmcnt(0)" ::: "memory");
            const unsigned og = xb_add(&bar[XB_TOP], 1u);
            const unsigned tg = og / nx;
            if (og + 1u == (tg + 1u) * nx) xb_add(&bar[XB_TOPGEN], 1u);
            else XB_SPIN(xb_ld(&bar[XB_TOPGEN]) == tg, bar);
            __builtin_amdgcn_fence(__ATOMIC_ACQUIRE, "agent");
            xb_add(&bar[XB_XGEN(bx_)], 1u);
            asm volatile("s_waitcnt vmcnt(0)" ::: "memory");
        } else {
            XB_SPIN(xb_ld(&bar[XB_XGEN(bx_)]) == gen, bar);
            __builtin_amdgcn_fence(__ATOMIC_ACQUIRE, "agent");
            asm volatile("s_waitcnt vmcnt(0)" ::: "memory");
        }
    }
    __syncthreads();
}


DI void seam_arrive(unsigned* w) { asm volatile("s_waitcnt vmcnt(0)" ::: "memory"); __syncthreads();
    if (threadIdx.x == 0) { __builtin_amdgcn_fence(__ATOMIC_RELEASE, "agent"); asm volatile("s_waitcnt vmcnt(0)" ::: "memory"); (void)__hip_atomic_fetch_add(w, 1u, __ATOMIC_RELAXED, __HIP_MEMORY_SCOPE_AGENT); } }
DI void seam_wait(unsigned* w, unsigned need) {
    if (threadIdx.x == 0) { unsigned sp = 0u; while (__hip_atomic_load(w, __ATOMIC_RELAXED, __HIP_MEMORY_SCOPE_AGENT) < need) { __builtin_amdgcn_s_sleep(1); if (++sp > (1u << 22)) break; }
        __builtin_amdgcn_fence(__ATOMIC_ACQUIRE, "agent"); asm volatile("s_waitcnt vmcnt(0)" ::: "memory"); }
    __syncthreads(); }
struct Frame {
    LAS unsigned char* lds;
    int tid, lane, wave, G, gw, NGW;
    const float* const* in;
    float* out; unsigned char* ws;
};
DI const float* INP(const Frame& F, int k) { asm volatile("" : "+s"(k)); return F.in[k]; }
#define SSP(k) ((float*)((unsigned char*)F.out + 64 * MiB) + (size_t)(k) * M * 16)
#define F_WIN  ((bf16*)(F.ws + WS_WIN))
#define F_WOUT ((bf16*)(F.ws + WS_WOUT))
#define F_WUP  ((bf16*)(F.ws + WS_WUP))
#define F_WDN  ((bf16*)(F.ws + WS_WDN))
#define F_LORA ((bf16*)(F.ws + WS_LORA))
#define F_XB   ((bf16*)(F.ws + WS_XB))
#define F_PROJ ((bf16*)(F.ws + WS_PROJ))
#define F_MIX  ((bf16*)(F.ws + WS_MIX))
#define F_HID  ((bf16*)(F.ws + WS_HID))
#define F_S_r  ((bf16*)F.out)
#define F_S_ld ((bf16*)F.out + SARR)
#define F_S_k  ((bf16*)(F.ws + WS_S))
#define F_S_v  ((bf16*)(F.ws + WS_S) + SARR)
#define F_S_n  ((bf16*)(F.ws + WS_S) + 2 * SARR)
#define F_S_b  ((bf16*)(F.ws + WS_S) + 3 * SARR)
#define F_S_g  ((bf16*)(F.ws + WS_S) + 4 * SARR)
#define F_ctl  ((unsigned*)(F.ws + WS_CTL))

template <bool STREAM> DI void transpose_item(const float* W, int K, int N, bf16* WT, LAS float* scr, int item, int lane, const float* gk, float cs, int csn) {
    const int nblk = N / 32, kb = item / nblk, nb = item % nblk, k0 = 64 * kb, n0 = 32 * nb;
    const float colscale = (n0 + (lane & 31) < csn) ? cs : 1.f;
#pragma unroll 8
    for (int i = 0; i < 32; ++i) { const int kk = 2 * i + (lane >> 5); float v = __builtin_nontemporal_load(&W[(size_t)(k0 + kk) * N + n0 + (lane & 31)]); if (gk) v *= gk[k0 + kk]; scr[kk * 33 + (lane & 31)] = v * colscale; }
    asm volatile("s_waitcnt lgkmcnt(0)" ::: "memory");
    const int c = lane & 7;
#pragma unroll
    for (int j = 0; j < 4; ++j) { const int n = (lane >> 3) + 8 * j; const LAS float* s = scr + (8 * c) * 33 + n;
        v4u o; o.x = pk2(s[0 * 33], s[1 * 33]); o.y = pk2(s[2 * 33], s[3 * 33]); o.z = pk2(s[4 * 33], s[5 * 33]); o.w = pk2(s[6 * 33], s[7 * 33]);
        if (STREAM) __builtin_nontemporal_store(o, (v4u*)(WT + (size_t)(n0 + n) * K + k0 + 8 * c)); else *(v4u*)(WT + (size_t)(n0 + n) * K + k0 + 8 * c) = o; }
    asm volatile("s_waitcnt lgkmcnt(0)" ::: "memory");
}
DI Frame refresh(const Frame& F0) { Frame F = F0; int t = threadIdx.x; asm volatile("" : "+v"(t)); int bxx = blockIdx.x; asm volatile("" : "+s"(bxx)); F.tid = t; F.lane = t & 63; F.wave = __builtin_amdgcn_readfirstlane(t >> 6); F.gw = bxx * NWAVES + F.wave; return F; }
DI void stagger(unsigned ticks) { if ((blockIdx.x >> 3) & 1) { const unsigned long long t0 = __builtin_amdgcn_s_memrealtime(); while (__builtin_amdgcn_s_memrealtime() - t0 < ticks) __builtin_amdgcn_s_sleep(8); } }
template <bool STREAM> DI void prologue(const Frame& F0, int l, int w0, int nw) { Frame F = refresh(F0);
    LAS float* scr = (LAS float*)(F.lds + F.wave * 16384);
    constexpr int I_IN = 16 * 104, I_OUT = 16 * 32, I_UP = 16 * 128, I_DN = 64 * 32, I_LW = 12, I_LG = 24;
    constexpr int PER = I_IN + I_OUT + I_UP + I_DN + 2 * I_LW + I_LG;
    constexpr float C2 = 0.17677669529663687f * 1.4426950408889634f;
    for (int it = w0; it < PER; it += nw) {
        int r = it;
        if (r < I_IN) { transpose_item<STREAM>(INP(F, 2) + (size_t)l * DMODEL * NIN, DMODEL, NIN, F_WIN + (size_t)l * NIN * DMODEL, scr, r, F.lane, INP(F, 1) + l * DMODEL, C2, 384); continue; } r -= I_IN;
        if (r < I_OUT) { transpose_item<STREAM>(INP(F, 20) + (size_t)l * DMODEL * DMODEL, DMODEL, DMODEL, F_WOUT + (size_t)l * DMODEL * DMODEL, scr, r, F.lane, nullptr, 1.f, 0); continue; } r -= I_OUT;
        if (r < I_UP) { transpose_item<STREAM>(INP(F, 22) + (size_t)l * DMODEL * FF, DMODEL, FF, F_WUP + (size_t)l * FF * DMODEL, scr, r, F.lane, INP(F, 21) + l * DMODEL, 1.f, 0); continue; } r -= I_UP;
        if (r < I_DN) { transpose_item<STREAM>(INP(F, 23) + (size_t)l * FF * DMODEL, FF, DMODEL, F_WDN + (size_t)l * DMODEL * FF, scr, r, F.lane, nullptr, 1.f, 0); continue; } r -= I_DN;
        bf16* L = F_LORA + (size_t)l * LORA_L;
        if (r < I_LW) { transpose_item<STREAM>(INP(F, 11) + (size_t)l * 64 * RW, 64, RW, L, scr, r, F.lane, nullptr, 1.f, 0); continue; } r -= I_LW;
        if (r < I_LW) { transpose_item<STREAM>(INP(F, 13) + (size_t)l * 64 * RW, 64, RW, L + RW * 64, scr, r, F.lane, nullptr, 1.f, 0); continue; } r -= I_LW;
        transpose_item<STREAM>(INP(F, 14) + (size_t)l * 128 * RW, 128, RW, L + 2 * RW * 64, scr, r, F.lane, nullptr, 1.f, 0);
    }
}
DI void x_to_bf16(const Frame& F0, const float* src, bf16* dst, float* ss) { Frame F = refresh(F0);
    for (int m0 = F.gw; m0 < M; m0 += 4 * F.NGW) {
        f32x4 v[4][4];
#pragma unroll
        for (int q = 0; q < 4; ++q) { const int m = m0 + q * F.NGW; if (m < M) { const f32x4* xr = (const f32x4*)(src + (size_t)m * DMODEL) + F.lane;
#pragma unroll
            for (int j = 0; j < 4; ++j) v[q][j] = __builtin_nontemporal_load(&xr[64 * j]); } }
#pragma unroll
        for (int q = 0; q < 4; ++q) { const int m = m0 + q * F.NGW; if (m < M) { float s2 = 0.f;
#pragma unroll
            for (int j = 0; j < 4; ++j) s2 += (v[q][j].x * v[q][j].x + v[q][j].y * v[q][j].y) + (v[q][j].z * v[q][j].z + v[q][j].w * v[q][j].w);
            s2 = wave_sum(s2); if (F.lane < 16) ss[(size_t)m * 16 + F.lane] = (F.lane == 0) ? s2 : 0.f;
            v2u* o8 = (v2u*)(dst + (size_t)m * DMODEL) + F.lane;
#pragma unroll
            for (int j = 0; j < 4; ++j) { v2u w; w.x = pk2(v[q][j].x, v[q][j].y); w.y = pk2(v[q][j].z, v[q][j].w); o8[64 * j] = w; } } }
    }
}
DI void final_norm(const Frame& F0, const bf16* xb, float* out, const float* g) { Frame F = refresh(F0);
    const f32x4* gr = (const f32x4*)g + F.lane; f32x4 gv[4];
#pragma unroll
    for (int j = 0; j < 4; ++j) gv[j] = gr[64 * j];
    for (int m0 = F.gw; m0 < M; m0 += 4 * F.NGW) {
        v2u w[4][4];
#pragma unroll
        for (int q = 0; q < 4; ++q) { const int m = m0 + q * F.NGW; if (m < M) { const v2u* xr = (const v2u*)(xb + (size_t)m * DMODEL) + F.lane;
#pragma unroll
            for (int j = 0; j < 4; ++j) w[q][j] = __builtin_nontemporal_load(&xr[64 * j]); } }
#pragma unroll
        for (int q = 0; q < 4; ++q) { const int m = m0 + q * F.NGW; if (m < M) { f32x4 v[4]; float s2 = 0.f;
#pragma unroll
            for (int j = 0; j < 4; ++j) { v[j] = (f32x4){bflo(w[q][j].x), bfhi(w[q][j].x), bflo(w[q][j].y), bfhi(w[q][j].y)}; s2 += (v[j].x * v[j].x + v[j].y * v[j].y) + (v[j].z * v[j].z + v[j].w * v[j].w); }
            const float rstd = 1.f / sqrtf(wave_sum(s2) * (1.f / DMODEL) + NORM_EPS);
            f32x4* orow = (f32x4*)(out + (size_t)m * DMODEL) + F.lane;
#pragma unroll
            for (int j = 0; j < 4; ++j) __builtin_nontemporal_store(v[j] * rstd * gv[j], &orow[64 * j]); } }
    }
}

DI void loadz8(const bf16* prow, bool first, const float* mu, int col, float* z) {
    const v4u p = *(const v4u*)(prow + col); v4u q = (v4u){0u, 0u, 0u, 0u}; if (!first) q = *(const v4u*)(prow - NIN + col);
    const f32x4 m0 = *(const f32x4*)(mu + col), m1 = *(const f32x4*)(mu + col + 4);
    float pf[8], qf[8]; unpack8(p, pf); unpack8(q, qf);
#pragma unroll
    for (int j = 0; j < 4; ++j) { z[j] = pf[j] + m0[j] * (qf[j] - pf[j]); z[4 + j] = pf[4 + j] + m1[j] * (qf[4 + j] - pf[4 + j]); }
}
DI void loadz8L(const bf16* prow, bool first, const LAS float* mu, int col, float* z) {
    const v4u p = *(const v4u*)(prow + col); v4u q = (v4u){0u, 0u, 0u, 0u}; if (!first) q = *(const v4u*)(prow - NIN + col);
    const f32x4 m0 = *(const LAS f32x4*)(mu + col), m1 = *(const LAS f32x4*)(mu + col + 4);
    float pf[8], qf[8]; unpack8(p, pf); unpack8(q, qf);
#pragma unroll
    for (int j = 0; j < 4; ++j) { z[j] = pf[j] + m0[j] * (qf[j] - pf[j]); z[4 + j] = pf[4 + j] + m1[j] * (qf[4 + j] - pf[4 + j]); }
}
DI float loadz1(const bf16* prow, bool first, float mu, int col) { const float p = bf1(prow + col); const float q = first ? 0.f : bf1(prow - NIN + col); return p + mu * (q - p); }

DI void prep_phase(const Frame& F0, int l) { Frame F = refresh(F0);
    LAS float* PT = (LAS float*)(F.lds + MISC_OFF + 256);
    {   const float* srcs[6] = {INP(F, 10) + l * RW, INP(F, 12) + l * RW, INP(F, 15) + l * RW, INP(F, 16) + l * RW, INP(F, 17) + l * RW, INP(F, 9) + l * RCOLS};
        for (int i = F.tid; i < 5 * RW + RCOLS; i += NWAVES * 64) { const int a = i < 5 * RW ? i / RW : 5; PT[i] = srcs[a][i - a * RW]; }
        __syncthreads(); }
    const LAS float* w0 = PT; const LAS float* a0 = PT + RW; const LAS float* kkw = PT + 2 * RW; const LAS float* kaw = PT + 3 * RW; const LAS float* rkp = PT + 4 * RW; const LAS float* mu = PT + 5 * RW;
    const bf16* WUT = F_LORA + (size_t)l * LORA_L; const bf16* AUT = WUT + RW * 64; const bf16* GUT = AUT + RW * 64;
    const int row = F.lane & 15, kq = F.lane >> 4, tok = F.lane >> 2, cq = (F.lane & 3) * 16;
    LAS float* LW = (LAS float*)(F.lds + F.wave * 16384);
    for (int tile = F.gw; tile < M / 16; tile += F.NGW) {
        const int t0 = tile * 16;
        bf16x8 Aw[2], Aa[2], Ag[4];
        { const int t = t0 + row; const bool first = (t % SEQ) == 0; const bf16* prow = F_PROJ + (size_t)t * NIN + ROFF; float z[8];
#pragma unroll
          for (int ks = 0; ks < 2; ++ks) { loadz8L(prow, first, mu, 1152 + ks * 32 + kq * 8, z);
#pragma unroll
              for (int j = 0; j < 8; ++j) z[j] = tanhf_(z[j]);
              Aw[ks] = __builtin_bit_cast(bf16x8, pack8(z)); }
#pragma unroll
          for (int ks = 0; ks < 2; ++ks) { loadz8L(prow, first, mu, 1216 + ks * 32 + kq * 8, z); Aa[ks] = __builtin_bit_cast(bf16x8, pack8(z)); }
#pragma unroll
          for (int ks = 0; ks < 4; ++ks) { loadz8L(prow, first, mu, 1280 + ks * 32 + kq * 8, z);
#pragma unroll
              for (int j = 0; j < 8; ++j) z[j] = sigmoidf_(z[j]);
              Ag[ks] = __builtin_bit_cast(bf16x8, pack8(z)); } }
#pragma unroll 1
        for (int hq = 0; hq < 6; ++hq) { const int hd_ = hq + F.wave + (int)(blockIdx.x >> 3); const int hd = hd_ % 6;
            const int t = t0 + tok; const bool first = (t % SEQ) == 0; const bf16* prow = F_PROJ + (size_t)t * NIN + ROFF; const int ch0 = hd * 64 + cq;
            float zr2[2][8], zk2[2][8], zv2[2][8];
#pragma unroll
            for (int sub = 0; sub < 2; ++sub) { loadz8L(prow, first, mu, ch0 + sub * 8, zr2[sub]); loadz8L(prow, first, mu, RW + ch0 + sub * 8, zk2[sub]); loadz8L(prow, first, mu, 2 * RW + ch0 + sub * 8, zv2[sub]); }
#pragma unroll
            for (int cgi = 0; cgi < 4; ++cgi) {
                const int ch = hd * 64 + cgi * 16 + row;
                f32x4 cw = (f32x4){0.f, 0.f, 0.f, 0.f}, ca = cw, cgt = cw;
#pragma unroll
                for (int ks = 0; ks < 2; ++ks) {
                    const bf16x8 bw = *(const bf16x8*)(WUT + (size_t)ch * 64 + ks * 32 + kq * 8); cw = __builtin_amdgcn_mfma_f32_16x16x32_bf16(Aw[ks], bw, cw, 0, 0, 0);
                    const bf16x8 ba = *(const bf16x8*)(AUT + (size_t)ch * 64 + ks * 32 + kq * 8); ca = __builtin_amdgcn_mfma_f32_16x16x32_bf16(Aa[ks], ba, ca, 0, 0, 0); }
#pragma unroll
                for (int ks = 0; ks < 4; ++ks) { const bf16x8 bg = *(const bf16x8*)(GUT + (size_t)ch * 128 + ks * 32 + kq * 8); cgt = __builtin_amdgcn_mfma_f32_16x16x32_bf16(Ag[ks], bg, cgt, 0, 0, 0); }
#pragma unroll
                for (int j = 0; j < 4; ++j) { LAS float* d = LW + (kq * 4 + j) * 68 + cgi * 16 + row; d[0] = cw[j]; d[16 * 68] = ca[j]; d[32 * 68] = cgt[j]; }
            }
            asm volatile("s_waitcnt lgkmcnt(0)" ::: "memory");
            float kkq[16], aq[16]; float ss = 0.f, dotp = 0.f;
#pragma unroll
            for (int sub = 0; sub < 2; ++sub) {
                const int ch = ch0 + sub * 8; const size_t idx = (size_t)t * RW + ch;
                float (&zr)[8] = zr2[sub]; float (&zk)[8] = zk2[sub]; float (&zv)[8] = zv2[sub];
                float gl[8], ldv[8], kpv[8];
                const LAS float* lw = LW + tok * 68 + cq + sub * 8;
#pragma unroll
                for (int hh = 0; hh < 2; ++hh) { const f32x4 x0 = *(const LAS f32x4*)(lw + 4 * hh), x1 = *(const LAS f32x4*)(lw + 16 * 68 + 4 * hh), x2 = *(const LAS f32x4*)(lw + 32 * 68 + 4 * hh);
                    const f32x4 p0 = *(const LAS f32x4*)(w0 + ch + 4 * hh), p1 = *(const LAS f32x4*)(a0 + ch + 4 * hh), p2 = *(const LAS f32x4*)(kkw + ch + 4 * hh), p3 = *(const LAS f32x4*)(kaw + ch + 4 * hh), p4 = *(const LAS f32x4*)(rkp + ch + 4 * hh);
#pragma unroll
                    for (int e = 0; e < 4; ++e) { const int j = 4 * hh + e;
                        gl[j] = x2[e];
                        const float xs = -(p0[e] + x0[e]); const float sp = fmaxf(xs, 0.f) + __logf(1.f + __expf(-fabsf(xs)));
                        ldv[j] = -__expf(-sp - 0.5f);
                        const float a = sigmoidf_(p1[e] + x1[e]);
                        const float kk = zk[j] * p2[e]; kpv[j] = zk[j] * (1.f + (a - 1.f) * p3[e]);
                        kkq[sub * 8 + j] = kk; aq[sub * 8 + j] = a; ss += kk * kk; dotp += zr[j] * kpv[j] * p4[e];
                    } }
                *(v4u*)(F_S_ld + idx) = pack8(ldv); *(v4u*)(F_S_k + idx) = pack8(kpv); *(v4u*)(F_S_g + idx) = pack8(gl);
            }
            ss += __shfl_xor(ss, 1); ss += __shfl_xor(ss, 2);
            dotp += __shfl_xor(dotp, 1); dotp += __shfl_xor(dotp, 2);
            if ((F.lane & 3) == 0) ((float*)((unsigned char*)F.out + WS_DOTS))[(size_t)t * 6 + hd] = dotp;
            const float inv = __builtin_amdgcn_rsqf(fmaxf(ss, 1e-24f));
#pragma unroll
            for (int sub = 0; sub < 2; ++sub) { float nn[8], bbv[8];
#pragma unroll
                for (int j = 0; j < 8; ++j) { const float kn = kkq[sub * 8 + j] * inv; nn[j] = -kn; bbv[j] = kn * aq[sub * 8 + j]; }
                const size_t idx = (size_t)t * RW + ch0 + sub * 8; *(v4u*)(F_S_n + idx) = pack8(nn); *(v4u*)(F_S_b + idx) = pack8(bbv); }
            asm volatile("s_waitcnt lgkmcnt(0)" ::: "memory");
        }
    }
}

DI void conv_phase(const Frame& F0, int l, int w0, int nw) { Frame F = refresh(F0);
    const float* cw_ = INP(F, 8) + l * 3 * 256;
    for (int it = w0; it < M / 2; it += nw) {
        const int t = it * 2 + (F.lane >> 5), c8 = (F.lane & 31) * 8, pos = t % SEQ;
        const bf16* base = F_PROJ + (size_t)t * NIN + COFF + c8;
        float b8[8], g8[8], u8[8], acc[8], w8[8];
        unpack8(*(const v4u*)base, b8);
#pragma unroll
        for (int j = 0; j < 8; ++j) acc[j] = 0.f;
#pragma unroll
        for (int d = 0; d < 3; ++d) {
            const int back = 2 - d;
            if (pos >= back) {
                const bf16* pb = base - (size_t)back * NIN;
                unpack8(*(const v4u*)(pb + 256), g8); unpack8(*(const v4u*)(pb + 512), u8);
                const f32x4 wa = *(const f32x4*)(cw_ + d * 256 + c8), wb = *(const f32x4*)(cw_ + d * 256 + c8 + 4);
                w8[0] = wa.x; w8[1] = wa.y; w8[2] = wa.z; w8[3] = wa.w; w8[4] = wb.x; w8[5] = wb.y; w8[6] = wb.z; w8[7] = wb.w;
#pragma unroll
                for (int j = 0; j < 8; ++j) acc[j] += w8[j] * (g8[j] * u8[j]);
            }
        }
#pragma unroll
        for (int j = 0; j < 8; ++j) acc[j] *= b8[j];
        __builtin_nontemporal_store(pack8(acc), (v4u*)(F_MIX + (size_t)t * DMODEL + 384 + c8));
    }
}

DI void post_phase(const Frame& F0, int l) { Frame F = refresh(F0);
    const float* lg = INP(F, 18) + l * RW; const float* lb = INP(F, 19) + l * RW; const float* mu = INP(F, 9) + l * RCOLS;
    for (int it = F.gw; it < M * 6 / 8; it += F.NGW) {
        const int pair = it * 8 + (F.lane >> 3), t = pair / 6, hd = pair % 6, ch = hd * 64 + (F.lane & 7) * 8;
        bf16* yp = F_MIX + (size_t)t * DMODEL + 640 + ch; const size_t idx = (size_t)t * RW + ch;
        float y[8], v[8], g[8], o[8];
        unpack8(*(const v4u*)yp, y); unpack8(*(const v4u*)(F_S_g + idx), g);
        loadz8(F_PROJ + (size_t)t * NIN + ROFF, (t % SEQ) == 0, mu, 2 * RW + ch, v);
        const float dot = ((const float*)((unsigned char*)F.out + WS_DOTS))[(size_t)t * 6 + hd];
        float s = 0.f;
#pragma unroll
        for (int j = 0; j < 8; ++j) s += y[j];
        s += __shfl_xor(s, 1); s += __shfl_xor(s, 2); s += __shfl_xor(s, 4);
        const float mean = s * (1.f / 64.f); float q = 0.f;
#pragma unroll
        for (int j = 0; j < 8; ++j) { const float d = y[j] - mean; q += d * d; }
        q += __shfl_xor(q, 1); q += __shfl_xor(q, 2); q += __shfl_xor(q, 4);
        const float rstd = 1.f / sqrtf(q * (1.f / 64.f) + GN_EPS);
#pragma unroll
        for (int j = 0; j < 8; ++j) o[j] = ((y[j] - mean) * rstd * lg[ch + j] + lb[ch + j] + dot * v[j]) * g[j];
        *(v4u*)yp = pack8(o);
    }
}


DI void scan_wg(const Frame& F0, int sw) { Frame F = refresh(F0);
    const int bh = sw >> 1, half = sw & 1, b = bh / 6, hd = bh % 6;
    const size_t tb = (size_t)b * SEQ; const int cb = hd * 64;
    LAS unsigned char* const lds = F.lds;
    constexpr int BUFB = 6 * 8192, YOFF = 2 * BUFB;
    const bool loader = F.wave >= 4; const int ltid = F.tid - 256;
#define SCAN_STAGE(c, bufsel, P0, NP, STRIDE) do { _Pragma("unroll") for (int i = 0; i < (NP); ++i) { const int p = (P0) + (STRIDE) * i, a = p >> 8, tt = (p & 255) >> 3, c8 = (p & 7) * 8; \
        const bf16* src = (a == 0 ? F_S_r : a == 1 ? F_S_ld : a == 2 ? F_S_k : a == 3 ? F_S_v : a == 4 ? F_S_n : F_S_b); \
        const v4u raw = *(const v4u*)(src + (tb + (size_t)(c) * 32 + tt) * RW + cb + c8); \
        float f[8]; unpack8(raw, f); if (a == 1) { _Pragma("unroll") for (int j = 0; j < 8; ++j) f[j] = __expf(f[j]); } \
        LAS f32x4* d = (LAS f32x4*)(lds + (bufsel) * BUFB + a * 8192 + tt * 256 + c8 * 4); d[0] = (f32x4){f[0], f[1], f[2], f[3]}; d[1] = (f32x4){f[4], f[5], f[6], f[7]}; } } while (0)
#define SCAN_YOUT(c, bufsel) do { _Pragma("unroll") for (int i = 0; i < 2; ++i) { const int e = ltid + 256 * i, tt = e >> 4, r2 = (e & 15) * 2; \
        const LAS float* ys = (const LAS float*)(lds + YOFF + (bufsel) * 4096) + tt * 32 + r2; \
        *(unsigned*)(F_MIX + (tb + (size_t)(c) * 32 + tt) * DMODEL + 640 + cb + half * 32 + r2) = pk2(ys[0], ys[1]); } } while (0)
    SCAN_STAGE(0, 0, F.tid, 3, 512);
    __syncthreads();
    typedef float f32x2v __attribute__((ext_vector_type(2)));
    const int rp = F.wave * 8 + (F.lane >> 4) * 2, kp = F.lane & 15;
    f32x4 s0 = (f32x4){0.f, 0.f, 0.f, 0.f}, s1 = s0;
#pragma unroll 1
    for (int c = 0; c < SEQ / 32; ++c) {
        const int cur = c & 1;
        if (loader) {
            if (c + 1 < SEQ / 32) SCAN_STAGE(c + 1, cur ^ 1, ltid, 6, 256);
            if (c > 0) SCAN_YOUT(c - 1, cur ^ 1);
        } else {
            const LAS unsigned char* bb = lds + cur * BUFB + kp * 16;
            const LAS unsigned char* vb = lds + cur * BUFB + 3 * 8192 + (half * 32 + rp) * 4;
            LAS f32x2v* yb = (LAS f32x2v*)(lds + YOFF + cur * 4096 + rp * 4);
            f32x4 rv = *(const LAS f32x4*)(bb + 0 * 8192), wv = *(const LAS f32x4*)(bb + 1 * 8192), kv = *(const LAS f32x4*)(bb + 2 * 8192);
            f32x4 nv = *(const LAS f32x4*)(bb + 4 * 8192), bv = *(const LAS f32x4*)(bb + 5 * 8192);
            f32x2v vv = *(const LAS f32x2v*)(vb);
#pragma unroll 8
            for (int tt = 0; tt < 32; ++tt) {
                const int tn = (tt + 1) & 31;
                const f32x4 rv2 = *(const LAS f32x4*)(bb + 0 * 8192 + tn * 256), wv2 = *(const LAS f32x4*)(bb + 1 * 8192 + tn * 256), kv2 = *(const LAS f32x4*)(bb + 2 * 8192 + tn * 256);
                const f32x4 nv2 = *(const LAS f32x4*)(bb + 4 * 8192 + tn * 256), bv2 = *(const LAS f32x4*)(bb + 5 * 8192 + tn * 256);
                const f32x2v vv2 = *(const LAS f32x2v*)(vb + tn * 256);
                f32x2v d0 = (f32x2v){s0.x, s0.y} * (f32x2v){nv.x, nv.y}; d0 = (f32x2v){s0.z, s0.w} * (f32x2v){nv.z, nv.w} + d0;
                f32x2v d1 = (f32x2v){s1.x, s1.y} * (f32x2v){nv.x, nv.y}; d1 = (f32x2v){s1.z, s1.w} * (f32x2v){nv.z, nv.w} + d1;
                const float sa0 = red16(d0.x + d0.y), sa1 = red16(d1.x + d1.y);
                const f32x4 q0 = s0 * wv + kv * vv.x, q1 = s1 * wv + kv * vv.y;
                s0 = bv * sa0 + q0; s1 = bv * sa1 + q1;
                f32x2v y0 = (f32x2v){s0.x, s0.y} * (f32x2v){rv.x, rv.y}; y0 = (f32x2v){s0.z, s0.w} * (f32x2v){rv.z, rv.w} + y0;
                f32x2v y1 = (f32x2v){s1.x, s1.y} * (f32x2v){rv.x, rv.y}; y1 = (f32x2v){s1.z, s1.w} * (f32x2v){rv.z, rv.w} + y1;
                const float ya = red16(y0.x + y0.y), yc = red16(y1.x + y1.y);
                yb[tt * 16] = (f32x2v){ya, yc};
                rv = rv2; wv = wv2; kv = kv2; nv = nv2; bv = bv2; vv = vv2;
            }
        }
        __syncthreads();
    }
    if (loader) SCAN_YOUT(SEQ / 32 - 1, (SEQ / 32 - 1) & 1);
#undef SCAN_STAGE
#undef SCAN_YOUT
    __syncthreads();
}

typedef float f32x16 __attribute__((ext_vector_type(16)));
typedef short s16x4 __attribute__((ext_vector_type(4)));
DI int crow_(int r, int h) { return (r & 3) + 8 * (r >> 2) + 4 * h; }
typedef float f32x2c __attribute__((ext_vector_type(2))); typedef __bf16 bf16x2c __attribute__((ext_vector_type(2)));
DI unsigned cvtpk(float lo, float hi) { f32x2c v = {lo, hi}; bf16x2c b = __builtin_convertvector(v, bf16x2c); return __builtin_bit_cast(unsigned, b); }
DI bf16x8 packregs(const f32x16& x, int s) {
    v4u p; p.x = cvtpk(x[8 * s + 0], x[8 * s + 1]); p.y = cvtpk(x[8 * s + 2], x[8 * s + 3]); p.z = cvtpk(x[8 * s + 4], x[8 * s + 5]); p.w = cvtpk(x[8 * s + 6], x[8 * s + 7]);
    return __builtin_bit_cast(bf16x8, p);
}
DI bf16x8 cat44(s16x4 lo, s16x4 hi) { return __builtin_shufflevector(lo, hi, 0, 1, 2, 3, 4, 5, 6, 7); }
#define MFMA32(a, b, c) __builtin_amdgcn_mfma_f32_32x32x16_bf16((a), (b), (c), 0, 0, 0)

DI void cprep_phase(const Frame& F0, int l) { Frame F = refresh(F0);
    const float* mu_ = INP(F, 9) + l * RCOLS;
    LAS unsigned char* const W = F.lds + F.wave * 16384;
    const int lane = F.lane, r32 = lane & 31, h = lane >> 5;
    const bool local = (F.NGW == M / 16);
    for (int it_ = 0; it_ < (local ? 3 : (NITEMS + F.NGW - 1) / F.NGW); ++it_) {
        int item;
        if (local) { const int li = F.wave * 3 + it_, cg_ = 4 * (int)blockIdx.x + li / 6; item = ((cg_ >> 7) * 6 + li % 6) * 128 + (cg_ & 127); }
        else { item = F.gw + it_ * F.NGW; if (item >= NITEMS) break; }
        const int bh = item >> 7, c = item & 127, b = bh / 6, hd = bh % 6;
        const size_t row0 = (size_t)b * SEQ + (size_t)c * 32;
        const size_t sbase = row0 * RW + hd * 64;
        {
            float lp = 0.f, Pcur = 1.f; unsigned btp[16], ktp[16], vtp[16]; float bprev = 0.f, kprev = 0.f, vprev = 0.f;
            const bf16* pj = F_PROJ + row0 * NIN + ROFF + hd * 64 + lane;
            const float mur = mu_[hd * 64 + lane], muv = mu_[2 * RW + hd * 64 + lane];
            float pr_prev = 0.f, pv_prev = 0.f; if (c != 0) { pr_prev = bf1(pj - NIN); pv_prev = bf1(pj - NIN + 2 * RW); }
#pragma unroll
            for (int hf = 0; hf < 4; ++hf) {
                unsigned short raw[8][6];
#pragma unroll
                for (int tq = 0; tq < 8; ++tq) { const size_t e = sbase + (size_t)(8 * hf + tq) * RW + lane; raw[tq][0] = F_S_ld[e]; raw[tq][1] = pj[(size_t)(8 * hf + tq) * NIN]; raw[tq][2] = F_S_n[e]; raw[tq][3] = F_S_b[e]; raw[tq][4] = F_S_k[e]; raw[tq][5] = pj[(size_t)(8 * hf + tq) * NIN + 2 * RW]; }
#pragma unroll
                for (int tq = 0; tq < 8; ++tq) { const int t = 8 * hf + tq;
                    const float ldv = __uint_as_float((unsigned)raw[tq][0] << 16), prw = __uint_as_float((unsigned)raw[tq][1] << 16), nn = __uint_as_float((unsigned)raw[tq][2] << 16), bb = __uint_as_float((unsigned)raw[tq][3] << 16), kk = __uint_as_float((unsigned)raw[tq][4] << 16), pvw = __uint_as_float((unsigned)raw[tq][5] << 16);
                    const float rr = prw + mur * (pr_prev - prw), vv = pvw + muv * (pv_prev - pvw); pr_prev = prw; pv_prev = pvw;
                    lp += ldv;
                    const float Pp = Pcur; const float P = __expf(lp), iP = __builtin_amdgcn_rcpf(P); Pcur = P;
                    const float rt = rr * P, nt = nn * Pp, bt = bb * iP, kt = kk * iP;
                    const int sw = (((lane >> 3) ^ (t & 7)) << 4) + (lane & 7) * 2 + t * 128;
                    *(LAS bf16*)(W + sw) = (bf16)f2bf(rt); *(LAS bf16*)(W + 4096 + sw) = (bf16)f2bf(nt); *(LAS bf16*)(W + 8192 + sw) = (bf16)f2bf(bt); *(LAS bf16*)(W + 12288 + sw) = (bf16)f2bf(kt);
                    if (t & 1) { btp[t >> 1] = pk2(bprev, bt); ktp[t >> 1] = pk2(kprev, kt); vtp[t >> 1] = pk2(vprev, vv); } else { bprev = bt; kprev = kt; vprev = vv; }
                }
            }
            ((float*)((unsigned char*)F.out + WS_PT))[(size_t)item * 64 + lane] = Pcur;
            const size_t te = sbase + (size_t)(lane >> 1) * RW + (lane & 1) * 32;
#pragma unroll
            for (int q = 0; q < 4; ++q) {
                *(v4u*)(F_S_b + te + q * 8) = (v4u){btp[4 * q], btp[4 * q + 1], btp[4 * q + 2], btp[4 * q + 3]};
                *(v4u*)(F_S_k + te + q * 8) = (v4u){ktp[4 * q], ktp[4 * q + 1], ktp[4 * q + 2], ktp[4 * q + 3]};
                *(v4u*)(F_S_ld + te + q * 8) = (v4u){vtp[4 * q], vtp[4 * q + 1], vtp[4 * q + 2], vtp[4 * q + 3]};
            }
        }
        asm volatile("s_waitcnt lgkmcnt(0)" ::: "memory");
        f32x16 Cnb, Cnk, Crb, Crk;
#pragma unroll
        for (int i = 0; i < 16; ++i) { Cnb[i] = 0.f; Cnk[i] = 0.f; Crb[i] = 0.f; Crk[i] = 0.f; }
#pragma unroll
        for (int s4 = 0; s4 < 4; ++s4) {
            const int fo = r32 * 128 + (((2 * s4 + h) ^ (r32 & 7)) << 4);
            const bf16x8 aR = *(const LAS bf16x8*)(W + fo), aN = *(const LAS bf16x8*)(W + 4096 + fo), bB = *(const LAS bf16x8*)(W + 8192 + fo), bK = *(const LAS bf16x8*)(W + 12288 + fo);
            Cnb = MFMA32(aN, bB, Cnb); Cnk = MFMA32(aN, bK, Cnk); Crb = MFMA32(aR, bB, Crb); Crk = MFMA32(aR, bK, Crk);
        }
#pragma unroll
        for (int i = 0; i < 16; ++i) { const int t = crow_(i, h); if (!(r32 < t)) { Cnb[i] = 0.f; Cnk[i] = 0.f; } if (!(r32 <= t)) { Crb[i] = 0.f; Crk[i] = 0.f; } }
        asm volatile("s_waitcnt lgkmcnt(0)" ::: "memory");
#pragma unroll
        for (int q = 0; q < 4; ++q) { const int p = lane + 64 * q, rr_ = p >> 3, cc = p & 7;
            *(v4u*)(F_S_r + sbase + (size_t)rr_ * RW + cc * 8) = *(const LAS v4u*)(W + rr_ * 128 + ((cc ^ (rr_ & 7)) << 4)); }
#pragma unroll
        for (int i = 0; i < 16; ++i) *(LAS float*)(W + 8192 + crow_(i, h) * 144 + r32 * 4) = Cnb[i];
        asm volatile("s_waitcnt lgkmcnt(0)" ::: "memory");
        {
            float X[32];
#pragma unroll
            for (int t = 0; t < 32; ++t) {
                float a0 = (t == r32) ? 1.f : 0.f, a1 = 0.f;
#pragma unroll
                for (int i4 = 0; i4 < (t + 3) / 4; ++i4) {
                    const f32x4 Lr = *(const LAS f32x4*)(W + 8192 + t * 144 + i4 * 16);
#pragma unroll
                    for (int e = 0; e < 4; ++e) { const int i = 4 * i4 + e; if (i < t) { if (e & 1) a1 += Lr[e] * X[i]; else a0 += Lr[e] * X[i]; } }
                }
                X[t] = a0 + a1;
            }
            asm volatile("s_waitcnt lgkmcnt(0)" ::: "memory");
#pragma unroll
            for (int t = 0; t < 32; ++t) *(LAS bf16*)(W + 12800 + t * 64 + r32 * 2) = (bf16)f2bf(X[t]);
        }
        asm volatile("s_waitcnt lgkmcnt(0)" ::: "memory");
        f32x16 Cw[2];
#pragma unroll
        for (int nt = 0; nt < 2; ++nt) {
#pragma unroll
            for (int i = 0; i < 16; ++i) Cw[nt][i] = 0.f;
#pragma unroll
            for (int s = 0; s < 2; ++s) {
                const bf16x8 a = *(const LAS bf16x8*)(W + 12800 + r32 * 64 + (2 * s + h) * 16);
                const int ch = 32 * nt + r32; unsigned short e[8];
#pragma unroll
                for (int j = 0; j < 8; ++j) { const int i = 16 * s + 8 * h + j; e[j] = *(const LAS bf16*)(W + 4096 + i * 128 + (((ch >> 3) ^ (i & 7)) << 4) + (ch & 7) * 2); }
                v4u bw; bw.x = e[0] | ((unsigned)e[1] << 16); bw.y = e[2] | ((unsigned)e[3] << 16); bw.z = e[4] | ((unsigned)e[5] << 16); bw.w = e[6] | ((unsigned)e[7] << 16);
                Cw[nt] = MFMA32(a, __builtin_bit_cast(bf16x8, bw), Cw[nt]);
            }
        }
        f32x16 Cm;
#pragma unroll
        for (int i = 0; i < 16; ++i) Cm[i] = 0.f;
#pragma unroll
        for (int s = 0; s < 2; ++s) {
            const s16x4 lo = *(const LAS s16x4*)(W + 12800 + r32 * 64 + (16 * s + 4 * h) * 2), hi = *(const LAS s16x4*)(W + 12800 + r32 * 64 + (16 * s + 8 + 4 * h) * 2);
            Cm = MFMA32(cat44(lo, hi), packregs(Cnk, s), Cm);
        }
        asm volatile("s_waitcnt lgkmcnt(0)" ::: "memory");
#pragma unroll
        for (int nt = 0; nt < 2; ++nt)
#pragma unroll
            for (int i = 0; i < 16; ++i) *(LAS bf16*)(W + crow_(i, h) * 128 + (32 * nt + r32) * 2) = (bf16)f2bf(Cw[nt][i]);
#pragma unroll
        for (int i = 0; i < 16; ++i) { const int o = crow_(i, h) * 64 + r32 * 2;
            *(LAS bf16*)(W + 4096 + o) = (bf16)f2bf(Crb[i]); *(LAS bf16*)(W + 6144 + o) = (bf16)f2bf(Cm[i]); *(LAS bf16*)(W + 8192 + o) = (bf16)f2bf(Crk[i]); }
        asm volatile("s_waitcnt lgkmcnt(0)" ::: "memory");
#pragma unroll
        for (int q = 0; q < 4; ++q) { const int p = lane + 64 * q, rr = p >> 3, cc = p & 7;
            *(v4u*)(F_S_n + sbase + (size_t)rr * RW + cc * 8) = *(const LAS v4u*)(W + rr * 128 + cc * 16); }
#pragma unroll
        for (int q = 0; q < 2; ++q) { const int p = lane + 64 * q, mr = p >> 2, cc = p & 3;
            *(v4u*)(F_S_v + sbase + (size_t)(mr >> 1) * RW + (mr & 1) * 32 + cc * 8) = *(const LAS v4u*)(W + 4096 + mr * 64 + cc * 16);
            *(v4u*)(F_S_v + sbase + (size_t)(16 + (mr >> 1)) * RW + (mr & 1) * 32 + cc * 8) = *(const LAS v4u*)(W + 6144 + mr * 64 + cc * 16);
            *(v4u*)((bf16*)((unsigned char*)F.out + WS_AUX) + (size_t)item * 1024 + mr * 32 + cc * 8) = *(const LAS v4u*)(W + 8192 + mr * 64 + cc * 16); }
        asm volatile("s_waitcnt vmcnt(0) lgkmcnt(0)" ::: "memory");
    }
}

DI void cs_consume(const LAS unsigned char* B, LAS unsigned char* ybuf, f32x16 (&Hacc)[2], bf16x8 (&Hpk)[2][2], int r32, int h, int vh) {
    bf16x8 Vf[2];
#pragma unroll
    for (int s = 0; s < 2; ++s) Vf[s] = *(const LAS bf16x8*)(B + 19456 + (32 * vh + r32) * 80 + (2 * s + h) * 16);
    f32x16 U;
#pragma unroll
    for (int i = 0; i < 16; ++i) U[i] = 0.f;
#pragma unroll
    for (int kt = 0; kt < 2; ++kt)
#pragma unroll
        for (int s = 0; s < 2; ++s) { const LAS unsigned char* ap = B + r32 * 144 + (32 * kt + 16 * s + 4 * h) * 2;
            U = MFMA32(cat44(*(const LAS s16x4*)ap, *(const LAS s16x4*)(ap + 16)), Hpk[kt][s], U); }
#pragma unroll
    for (int s = 0; s < 2; ++s) U = MFMA32(*(const LAS bf16x8*)(B + 27136 + r32 * 80 + (2 * s + h) * 16), Vf[s], U);
    bf16x8 Upk[2]; Upk[0] = packregs(U, 0); Upk[1] = packregs(U, 1);
    f32x16 Y;
#pragma unroll
    for (int i = 0; i < 16; ++i) Y[i] = 0.f;
#pragma unroll
    for (int kt = 0; kt < 2; ++kt)
#pragma unroll
        for (int s = 0; s < 2; ++s) { const LAS unsigned char* ap = B + 4608 + r32 * 144 + (32 * kt + 16 * s + 4 * h) * 2;
            Y = MFMA32(cat44(*(const LAS s16x4*)ap, *(const LAS s16x4*)(ap + 16)), Hpk[kt][s], Y); }
#pragma unroll
    for (int s = 0; s < 2; ++s) { const LAS unsigned char* ap = B + 24576 + r32 * 80 + (16 * s + 4 * h) * 2;
        Y = MFMA32(cat44(*(const LAS s16x4*)ap, *(const LAS s16x4*)(ap + 16)), Upk[s], Y);
        Y = MFMA32(*(const LAS bf16x8*)(B + 29696 + r32 * 80 + (2 * s + h) * 16), Vf[s], Y); }
    {   LAS float* yb = (LAS float*)ybuf + 32 * vh + r32;
#pragma unroll
        for (int i = 0; i < 16; ++i) yb[crow_(i, h) * 64] = Y[i]; }
#pragma unroll
    for (int kt = 0; kt < 2; ++kt) {
        f32x16 acc = Hacc[kt];
#pragma unroll
        for (int s = 0; s < 2; ++s) { const LAS unsigned char* ap = B + 9216 + (32 * kt + r32) * 80 + (16 * s + 4 * h) * 2;
            acc = MFMA32(cat44(*(const LAS s16x4*)ap, *(const LAS s16x4*)(ap + 16)), Upk[s], acc);
            acc = MFMA32(*(const LAS bf16x8*)(B + 14336 + (32 * kt + r32) * 80 + (2 * s + h) * 16), Vf[s], acc); }
#pragma unroll
        for (int g = 0; g < 4; ++g) { const f32x4 pt = *(const LAS f32x4*)(B + 32256 + (32 * kt + 8 * g + 4 * h) * 4);
            acc[4 * g] *= pt.x; acc[4 * g + 1] *= pt.y; acc[4 * g + 2] *= pt.z; acc[4 * g + 3] *= pt.w; }
        Hacc[kt] = acc; Hpk[kt][0] = packregs(acc, 0); Hpk[kt][1] = packregs(acc, 1);
    }
}

DI void cscan_wg(const Frame& F0, int bh, int l) { Frame F = refresh(F0);
    const int b = bh / 6, hd = bh % 6; const size_t tb = (size_t)b * SEQ; const int cb = hd * 64;
    LAS unsigned char* const lds = F.lds;
    constexpr int BUFB = 32512, YOFF = 3 * BUFB, YB = 8192, NCH = SEQ / 32;
    const int ltid = F.tid - 128;
    const bool loader = F.wave >= 2;
    v4u st0[5], st1[5], st2[5], st3[5];
#define CS_LOAD(c, ST) do { const size_t sb_ = (tb + (size_t)(c) * 32) * RW + cb; const int item_ = bh * 128 + (c); \
        _Pragma("unroll") for (int i = 0; i < 5; ++i) { const int p = ltid + 384 * i; \
            if (p < 1536) { const int a = p >> 8, sr = (p >> 3) & 31, cc = p & 7;              \
                const bf16* src = (a == 0 ? F_S_n : a == 1 ? F_S_r : a == 2 ? F_S_b : a == 3 ? F_S_k : a == 4 ? F_S_ld : F_S_v); \
                ST[i] = __builtin_nontemporal_load((const v4u*)(src + sb_ + (size_t)sr * RW + cc * 8)); } \
            else if (p < 1664) { const int q = p - 1536, mr = q >> 2, cc = q & 3; ST[i] = __builtin_nontemporal_load((const v4u*)((const bf16*)((unsigned char*)F.out + WS_AUX) + (size_t)item_ * 1024 + mr * 32 + cc * 8)); } \
            else if (p < 1680) { const int q = p - 1664; ST[i] = __builtin_nontemporal_load((const v4u*)((const float*)((unsigned char*)F.out + WS_PT) + (size_t)item_ * 64 + q * 4)); } } } while (0)
#define CS_WRITE(bufsel, ST) do { LAS unsigned char* B_ = lds + (bufsel) * BUFB; \
        _Pragma("unroll") for (int i = 0; i < 5; ++i) { const int p = ltid + 384 * i; \
            if (p < 1536) { const int a = p >> 8, sr = (p >> 3) & 31, cc = p & 7; \
                int dst; if (a < 2) dst = a * 4608 + sr * 144 + cc * 16; else if (a < 5) dst = 9216 + (a - 2) * 5120 + (2 * sr + (cc >> 2)) * 80 + (cc & 3) * 16; \
                else dst = 24576 + (sr >> 4) * 2560 + ((2 * sr + (cc >> 2)) & 31) * 80 + (cc & 3) * 16; \
                *(LAS v4u*)(B_ + dst) = ST[i]; } \
            else if (p < 1664) { const int q = p - 1536, mr = q >> 2, cc = q & 3; *(LAS v4u*)(B_ + 29696 + mr * 80 + cc * 16) = ST[i]; } \
            else if (p < 1680) { const int q = p - 1664; *(LAS v4u*)(B_ + 32256 + q * 16) = ST[i]; } } } while (0)
    const int pt_ = (ltid >> 3) & 31, v8 = (ltid & 7) * 8;
    float lgv[8], lbv[8]; v4u gq = (v4u){0u, 0u, 0u, 0u}; float dq = 0.f;
    if (loader) { const float* lg = INP(F, 18) + l * RW + cb + v8; const float* lb = INP(F, 19) + l * RW + cb + v8;
#pragma unroll
        for (int j = 0; j < 8; ++j) { lgv[j] = lg[j]; lbv[j] = lb[j]; } }
#define CS_GLOAD(c) do { if (ltid < 256) { const size_t row_ = tb + (size_t)(c) * 32 + pt_; gq = *(const v4u*)(F_S_g + row_ * RW + cb + v8); dq = ((const float*)((unsigned char*)F.out + WS_DOTS))[row_ * 6 + hd]; } } while (0)
#define CS_POST(c, ybsel, bufsel) do { if (ltid < 256) { const LAS float* ys = (const LAS float*)(lds + YOFF + (ybsel) * YB) + pt_ * 64 + v8; \
        float y[8], g[8], o[8]; const f32x4 y0 = *(const LAS f32x4*)ys, y1 = *(const LAS f32x4*)(ys + 4); y[0] = y0.x; y[1] = y0.y; y[2] = y0.z; y[3] = y0.w; y[4] = y1.x; y[5] = y1.y; y[6] = y1.z; y[7] = y1.w; \
        unpack8(gq, g); float s = 0.f; _Pragma("unroll") for (int j = 0; j < 8; ++j) s += y[j]; \
        s += __shfl_xor(s, 1); s += __shfl_xor(s, 2); s += __shfl_xor(s, 4); const float mean = s * (1.f / 64.f); float q = 0.f; \
        _Pragma("unroll") for (int j = 0; j < 8; ++j) { const float d = y[j] - mean; q += d * d; } \
        q += __shfl_xor(q, 1); q += __shfl_xor(q, 2); q += __shfl_xor(q, 4); const float rstd = __builtin_amdgcn_rsqf(q * (1.f / 64.f) + GN_EPS); \
        const LAS unsigned char* vt = lds + (bufsel) * BUFB + 19456 + v8 * 80 + pt_ * 2; \
        _Pragma("unroll") for (int j = 0; j < 8; ++j) { const float vv = __uint_as_float(((unsigned)*(const LAS bf16*)(vt + j * 80)) << 16); o[j] = ((y[j] - mean) * rstd * lgv[j] + lbv[j] + dq * vv) * g[j]; } \
        __builtin_nontemporal_store(pack8(o), (v4u*)(F_MIX + (tb + (size_t)(c) * 32 + pt_) * DMODEL + 640 + cb + v8)); } } while (0)
    if (loader) {
        CS_LOAD(0, st0); CS_WRITE(0, st0); CS_LOAD(1, st1); CS_LOAD(2, st2);
        __syncthreads();
        int bn = 1, bp = 2, bc = 0;
#define CS_LITER(c, STW, LDN) do { const int cur = (c) & 1; \
            if ((c) + 3 < NCH) CS_LOAD((c) + 3, LDN); \
            if ((c) > 0) CS_POST((c) - 1, cur ^ 1, bp); \
            CS_GLOAD(c); \
            if ((c) + 1 < NCH) CS_WRITE(bn, STW); \
            __syncthreads(); { const int t_ = bp; bp = bc; bc = bn; bn = t_; } } while (0)
#pragma unroll 1
        for (int c4 = 0; c4 < NCH; c4 += 4) { CS_LITER(c4, st1, st3); CS_LITER(c4 + 1, st2, st0); CS_LITER(c4 + 2, st3, st1); CS_LITER(c4 + 3, st0, st2); }
        CS_POST(NCH - 1, (NCH - 1) & 1, bp);
#undef CS_LITER
    } else {
        const int lane = F.lane, r32 = lane & 31, h = lane >> 5, vh = F.wave;
        f32x16 Hacc[2]; bf16x8 Hpk[2][2];
#pragma unroll
        for (int kt = 0; kt < 2; ++kt) {
#pragma unroll
            for (int i = 0; i < 16; ++i) Hacc[kt][i] = 0.f;
            Hpk[kt][0] = bf16x8{0, 0, 0, 0, 0, 0, 0, 0}; Hpk[kt][1] = bf16x8{0, 0, 0, 0, 0, 0, 0, 0}; }
        __syncthreads();
        int bc = 0;
#pragma unroll 1
        for (int c = 0; c < NCH; ++c) { cs_consume(lds + bc * BUFB, lds + YOFF + (c & 1) * YB, Hacc, Hpk, r32, h, vh); __syncthreads(); bc = (bc == 2) ? 0 : bc + 1; }
    }
#undef CS_LOAD
#undef CS_WRITE
#undef CS_GLOAD
#undef CS_POST
    __syncthreads();
}

DI void mix_phase(const Frame& F0, int l, char* ldsg) { Frame F = refresh(F0);
#ifndef SKIP_SCAN
    if ((int)blockIdx.x < SCAN_WGS) { cscan_wg(F, (int)blockIdx.x, l); }
    else { const int nw_ = (F.G - SCAN_WGS) * NWAVES, w0_ = ((int)blockIdx.x - SCAN_WGS) * NWAVES + F.wave;
        conv_phase(F, l, w0_, nw_); if (l == 0) prologue<true>(F, 1, w0_, nw_); __syncthreads(); }
#endif
    const float* lq1 = INP(F, 3) + l * 32; const float* lk1 = INP(F, 4) + l * 32; const float* lq2 = INP(F, 5) + l * 32; const float* lk2 = INP(F, 6) + l * 32;
    float d1 = 0.f, d2 = 0.f;
    for (int i = 0; i < 32; ++i) { d1 += lq1[i] * lk1[i]; d2 += lq2[i] * lk2[i]; }
    const float lambda_init = (l == 0) ? 0.2f : 0.35550906759f;
    const float lam = __expf(d1) - __expf(d2) + lambda_init;
    const float* sg = INP(F, 7) + l * 64;
    volatile LAS unsigned* qslot = (volatile LAS unsigned*)(F.lds + MISC_OFF + 64);
    const int myx = (int)(xb_xcc_id() & 7u);
    int qk = 0;
    for (;;) {
        if (F.tid == 0) { unsigned got = 0xffffffffu; int k = qk;
            for (; k < 8; ++k) { const int x = (myx + k) & 7; const unsigned v = atomicAdd(F_ctl + 64 * (1 + 8 * l + x), 1u); if (v < 96u) { got = (unsigned)x * 96u + v; break; } }
            qslot[0] = got; qslot[1] = (unsigned)k; }
        __syncthreads();
        const unsigned idx = (unsigned)__builtin_amdgcn_readfirstlane((int)qslot[0]); qk = __builtin_amdgcn_readfirstlane((int)qslot[1]);
        __syncthreads();
        if (idx == 0xffffffffu) break;
        const int xq = (int)(idx / 96u), iq = (int)(idx % 96u), qb = 15 - (iq & 15), bh = xq * 6 + (iq >> 4), b = bh / 6, h = bh % 6;
        const attn_body::bf16* P = (const attn_body::bf16*)F_PROJ;
#ifndef SKIP_ATT
#pragma unroll 1
        for (int ns = 0; ns < 2; ++ns)
            attn_body::attn_unit<8>(b, h, qb, ns, lam, sg, 1.f - lambda_init, P, P + 384, P + 768, (attn_body::bf16*)F_MIX, ldsg);
#endif
    }
}

__global__ void __launch_bounds__(NWAVES * 64, 2) mega_fwd(Args args) {
    extern __shared__ __attribute__((aligned(16))) unsigned char lds[];
    cg::grid_group grid = cg::this_grid();
    Frame F;
    F.lds = (LAS unsigned char*)lds;
    F.tid = threadIdx.x; F.lane = F.tid & 63; F.wave = __builtin_amdgcn_readfirstlane(F.tid >> 6);
    F.G = gridDim.x; F.gw = (int)blockIdx.x * NWAVES + F.wave; F.NGW = F.G * NWAVES;
    F.in = args.in; F.out = args.out; F.ws = args.ws;
    const int G = F.G;
    if (F.tid < 32) ((LAS unsigned*)(F.lds + MISC_OFF))[F.tid] = 0u;
    __syncthreads();
    XcdBarrier bar = xcd_barrier_post((unsigned*)(args.ws + WS_CTL) + CW_BAR, (volatile LAS unsigned*)(F.lds + MISC_OFF) + 8);

    prologue<false>(F, 0, F.gw, F.NGW);
    x_to_bf16(F, INP(F, 0), F_XB, SSP(4));
    if (args.i0 != 0) grid.sync();
    xcd_barrier(bar);
#pragma unroll 1
    for (int l = 0; l < 2; ++l) {
        {
            pg8::Gemm g{F_XB, F_WIN + (size_t)l * NIN * DMODEL, M, NIN, DMODEL}; pg8::StaticOrder S; int bx = blockIdx.x; asm volatile("" : "+s"(bx)); S.init(M, NIN, G, bx);
            pg8::EpiBf16S<0> E{F_PROJ, NIN, (const float*)SSP(l == 0 ? 4 : 1)};
            GEMMCALL0 pg8::gemm_phase<pg8::EpiBf16S<0>, pg8::StaticOrder, true, true>(F.lds, g, S, E);
            if (PROBE & 1) { __syncthreads(); pg8::gemm_phase<pg8::EpiBf16S<0>, pg8::StaticOrder, true, true>(F.lds, g, S, E); }
        }
        xcd_barrier(bar);
#ifndef SKIP_PREP
        prep_phase(F, l);
#endif
        if (F.NGW == M / 16) {
            asm volatile("s_waitcnt vmcnt(0)" ::: "memory"); __syncthreads(); __builtin_amdgcn_fence(__ATOMIC_ACQUIRE, "agent"); asm volatile("s_waitcnt vmcnt(0)" ::: "memory");
        } else xcd_barrier(bar);
        cprep_phase(F, l);
        seam_arrive((unsigned*)(args.ws + WS_CTL) + 64 * (20 + l));
        if ((int)blockIdx.x < SCAN_WGS) seam_wait((unsigned*)(args.ws + WS_CTL) + 64 * (20 + l), gridDim.x);
        mix_phase(F, l, (char*)lds);
        xcd_barrier(bar);
        {
            pg8::Gemm g{F_MIX, F_WOUT + (size_t)l * DMODEL * DMODEL, M, DMODEL, DMODEL}; pg8::StaticOrder S; int bx = blockIdx.x; asm volatile("" : "+s"(bx)); S.init(M, DMODEL, G, bx);
            float* ssp = SSP(2 * l);
            pg8::EpiResBf16<false> E{nullptr, F_XB, DMODEL, ssp};
            pg8::gemm_phase<pg8::EpiResBf16<false>, pg8::StaticOrder, true, true>(F.lds, g, S, E);
        }
        xcd_barrier(bar);
        {
            pg8::Gemm g{F_XB, F_WUP + (size_t)l * FF * DMODEL, M, FF, DMODEL}; pg8::StaticOrder S; int bx = blockIdx.x; asm volatile("" : "+s"(bx)); S.init(M, FF, G, bx);
            pg8::EpiBf16S<2> E{F_HID, FF, (const float*)SSP(2 * l)};
            GEMMCALL2 pg8::gemm_phase<pg8::EpiBf16S<2>, pg8::StaticOrder, true, true>(F.lds, g, S, E);
            if (PROBE & 1) { __syncthreads(); pg8::gemm_phase<pg8::EpiBf16S<2>, pg8::StaticOrder, true, true>(F.lds, g, S, E); }
        }
        xcd_barrier(bar);
        {
            pg8::Gemm g{F_HID, F_WDN + (size_t)l * DMODEL * FF, M, DMODEL, FF}; pg8::StaticOrder S; int bx = blockIdx.x; asm volatile("" : "+s"(bx)); S.init(M, DMODEL, G, bx);
            pg8::EpiResBf16<false> E{nullptr, F_XB, DMODEL, SSP(2 * l + 1)};
            pg8::gemm_phase<pg8::EpiResBf16<false>, pg8::StaticOrder, true, true>(F.lds, g, S, E);
        }
        xcd_barrier(bar);
    }
    final_norm(F, F_XB, F.out, INP(F, 24));
}

extern "C" void kernel_launch(void* const* d_in, const int* in_sizes, int n_in, void* d_out, int out_size, void* d_ws, size_t ws_size, hipStream_t stream) {
    static int grid = 0;
    if (grid == 0) {
        if (n_in != 25 || in_sizes[0] != M * DMODEL || out_size != M * DMODEL || ws_size < WS_END) {
            fprintf(stderr, "kernel_launch: unexpected problem geometry (n_in %d, in0 %d, out %d, ws %zu)\n", n_in, n_in > 0 ? in_sizes[0] : -1, out_size, ws_size); grid = -1; return; }
        int dev = 0, cus = 0, per_cu = 0;
        if (hipGetDevice(&dev) != hipSuccess || hipDeviceGetAttribute(&cus, hipDeviceAttributeMultiprocessorCount, dev) != hipSuccess) { grid = -1; return; }
        if (hipFuncSetAttribute((const void*)mega_fwd, hipFuncAttributeMaxDynamicSharedMemorySize, LDS_BYTES) != hipSuccess) { fprintf(stderr, "kernel_launch: hipFuncSetAttribute failed\n"); grid = -1; return; }
        if (hipOccupancyMaxActiveBlocksPerMultiprocessor(&per_cu, (const void*)mega_fwd, NWAVES * 64, LDS_BYTES) != hipSuccess || per_cu < 1) { fprintf(stderr, "kernel_launch: occupancy query gave %d\n", per_cu); (void)hipGetLastError(); per_cu = 1; }
        grid = cus * per_cu;
    }
    if (grid < 0) return;
    (void)hipMemsetAsync((char*)d_ws + WS_CTL, 0, CTL_ZERO_BYTES, stream);
    Args a{};
    for (int i = 0; i < 25; ++i) a.in[i] = (const float*)d_in[i];
    a.out = (float*)d_out; a.ws = (unsigned char*)d_ws; a.i0 = 0; a.i1 = 0;
    void* kargs[] = {&a};
    const hipError_t e = hipLaunchCooperativeKernel((const void*)mega_fwd, dim3(grid), dim3(NWAVES * 64), kargs, LDS_BYTES, stream);
    if (e != hipSuccess) fprintf(stderr, "kernel_launch: cooperative launch failed: %s (grid %d)\n", hipGetErrorString(e), grid);
}
```

```cpp
#include <hip/hip_runtime.h>
#include <hip/hip_cooperative_groups.h>
#include <hip/hip_bf16.h>
#include <cstdio>
#include <cstdint>
#include <cmath>
namespace pg8 {
#define PG8_LAS __attribute__((address_space(3)))
typedef unsigned short bf16_t;
typedef short bf16x8 __attribute__((ext_vector_type(8)));
typedef float f32x4 __attribute__((ext_vector_type(4)));
typedef unsigned u32x4 __attribute__((ext_vector_type(4)));
constexpr int BM = 256, BK = 64, HALF = 128, HTB = HALF * BK * 2  , STAGE_BYTES = 8 * HTB, NXCD = 8, WGM = 8;

__host__ __device__ __forceinline__ int lds_byte(int r, int c) { const int st = (r >> 4) * 2 + (c >> 5), rr = r & 15, cc = c & 31, ob = rr * 64 + cc * 2; return st * 1024 + (ob ^ (((ob >> 9) & 1) << 5)); }
__host__ __device__ __forceinline__ void stage_rc(int b, int& R, int& C) { const int st = b / 1024, sb = b % 1024, swz = sb ^ (((sb >> 9) & 1) << 5); R = (st >> 1) * 16 + swz / 64; C = (st & 1) * 32 + (swz % 64) / 2; }
__host__ __device__ __forceinline__ int perm32(int rho) { const int n = rho >> 4, i = rho & 15; return 8 * (i >> 2) + 4 * n + (i & 3); }

struct Unit { int pm, pn; };
struct Gemm { const bf16_t* A; const bf16_t* Bt; int M, N, K; };

struct StaticOrder {
    int nM, nN, nwg, G, c;
    __host__ __device__ void init(int M, int N, int G_, int c_) { nM = M / BM; nN = N / BM; nwg = nM * nN; G = G_; c = c_; }
    __host__ __device__ bool next(int i, Unit& u) const {
        const long L = (long)i * G + c; if (L >= nwg) return false;
        int wgid = (int)L; { const int q = nwg / NXCD, r = nwg % NXCD, xcd = wgid % NXCD, off = wgid / NXCD; wgid = (xcd < r ? xcd * (q + 1) : r * (q + 1) + (xcd - r) * q) + off; }
        const int nig = WGM * nN, gid = wgid / nig, fm = gid * WGM, gsz = (nM - fm) < WGM ? (nM - fm) : WGM;
        u.pm = fm + ((wgid % nig) % gsz); u.pn = (wgid % nig) / gsz; return true;
    }
    __device__ __forceinline__ void a_ready(const Unit&) const {}
    __device__ __forceinline__ void done(const Unit&) const {}
};

__device__ __forceinline__ unsigned cvt_pk_bf16(float lo, float hi) { unsigned r; asm volatile("v_cvt_pk_bf16_f32 %0, %1, %2" : "=v"(r) : "v"(lo), "v"(hi)); return r; }
typedef float f32x2 __attribute__((ext_vector_type(2)));
template <int ACT  > struct EpiBf16S {
    static constexpr bool PERM = true, AFTER_DRAIN = false;
    bf16_t* O; int ldc; const float* ss;
    __device__ __forceinline__ void operator()(const f32x4 (&acc)[2][2][4][2], const Unit& u, int wr, int wc, int fr, int fq) const {
        const int row0 = u.pm * BM + wr * 64 + fr; const int col0 = u.pn * BM + wc * 32 + 8 * fq;
        f32x4 sp[8]; float rs[8];
#pragma unroll
        for (int g = 0; g < 8; ++g) sp[g] = *(const f32x4*)(ss + (size_t)(row0 + (g >> 2) * HALF + (g & 3) * 16) * 16 + fq * 4);
#pragma unroll
        for (int g = 0; g < 8; ++g) { float t = (sp[g].x + sp[g].y) + (sp[g].z + sp[g].w); t += __shfl_xor(t, 16); t += __shfl_xor(t, 32); rs[g] = 1.0f / sqrtf(t * (1.0f / 1024.0f) + 1e-6f); }
#pragma unroll
        for (int ai = 0; ai < 2; ++ai)
#pragma unroll
            for (int m = 0; m < 4; ++m) { bf16_t* rowp = O + (size_t)(row0 + ai * HALF + m * 16) * ldc + col0; const float r_ = rs[ai * 4 + m];
#pragma unroll
                for (int bj = 0; bj < 2; ++bj) { f32x4 v0 = acc[ai][bj][m][0] * r_, v1 = acc[ai][bj][m][1] * r_;
                    if (ACT == 2) {
#pragma unroll
                        for (int e = 0; e < 4; ++e) { float a = v0[e] > 0.f ? v0[e] : 0.f; v0[e] = a * a; float b = v1[e] > 0.f ? v1[e] : 0.f; v1[e] = b * b; } }
                    u32x4 w; w.x = cvt_pk_bf16(v0[0], v0[1]); w.y = cvt_pk_bf16(v0[2], v0[3]); w.z = cvt_pk_bf16(v1[0], v1[1]); w.w = cvt_pk_bf16(v1[2], v1[3]);
                    __builtin_nontemporal_store(w, (u32x4*)(rowp + bj * HALF)); } }
    }
};
template <bool BASE_F32> struct EpiResBf16 {
    static constexpr bool PERM = true, AFTER_DRAIN = false;
    const float* basef; bf16_t* xb; int ldc; float* ss;
    __device__ __forceinline__ void operator()(const f32x4 (&acc)[2][2][4][2], const Unit& u, int wr, int wc, int fr, int fq) const {
        const int col0 = u.pn * BM + wc * 32 + 8 * fq;
        const size_t off0 = (size_t)(u.pm * BM + wr * 64 + fr) * ldc + col0;
        f32x4 cb[4], nb[4];
        auto ld = [&](size_t off, f32x4 (&d)[4]) {
            if (BASE_F32) {
#pragma unroll
                for (int q = 0; q < 4; ++q) d[q] = *(const f32x4*)(basef + off + (q >> 1) * HALF + (q & 1) * 4);
            } else {
#pragma unroll
                for (int bj = 0; bj < 2; ++bj) { const u32x4 w = *(const u32x4*)(xb + off + bj * HALF);
                    d[2 * bj] = (f32x4){__uint_as_float(w.x << 16), __uint_as_float(w.x & 0xffff0000u), __uint_as_float(w.y << 16), __uint_as_float(w.y & 0xffff0000u)};
                    d[2 * bj + 1] = (f32x4){__uint_as_float(w.z << 16), __uint_as_float(w.z & 0xffff0000u), __uint_as_float(w.w << 16), __uint_as_float(w.w & 0xffff0000u)}; }
            }
        };
        ld(off0, cb);
#pragma unroll
        for (int g = 0; g < 8; ++g) { const int ai = g >> 2, m = g & 3; const size_t off = off0 + (size_t)(ai * HALF + m * 16) * ldc; const int r = u.pm * BM + ai * HALF + wr * 64 + m * 16 + fr;
            if (g < 7) ld(off0 + (size_t)(((g + 1) >> 2) * HALF + ((g + 1) & 3) * 16) * ldc, nb);
            float sq = 0.f;
#pragma unroll
            for (int bj = 0; bj < 2; ++bj) { const size_t idx = off + bj * HALF;
                const f32x4 o0 = cb[2 * bj] + acc[ai][bj][m][0], o1 = cb[2 * bj + 1] + acc[ai][bj][m][1];
                sq += ((o0[0] * o0[0] + o0[1] * o0[1]) + (o0[2] * o0[2] + o0[3] * o0[3])) + ((o1[0] * o1[0] + o1[1] * o1[1]) + (o1[2] * o1[2] + o1[3] * o1[3]));
                u32x4 w; w.x = cvt_pk_bf16(o0[0], o0[1]); w.y = cvt_pk_bf16(o0[2], o0[3]); w.z = cvt_pk_bf16(o1[0], o1[1]); w.w = cvt_pk_bf16(o1[2], o1[3]);
                *(u32x4*)(xb + idx) = w; }
            sq += __shfl_xor(sq, 16); sq += __shfl_xor(sq, 32);
            if (fq == 0) ss[(size_t)r * 16 + u.pn * 4 + wc] = sq;
#pragma unroll
            for (int q = 0; q < 4; ++q) cb[q] = nb[q];
            asm volatile("" ::: "memory"); }
    }
};
template <class Epi, class Sched, bool ALIGN_EPI = false, bool SP2 = false>
__device__ __forceinline__ void gemm_phase(PG8_LAS unsigned char* lds, const Gemm g, const Sched& S, const Epi& E) {
    int tid_ = threadIdx.x; asm volatile("" : "+v"(tid_)); const int tid = tid_, wid = __builtin_amdgcn_readfirstlane(tid >> 6), lane = tid & 63, wr = wid >> 2, wc = wid & 3, fr = lane & 15, fq = lane >> 4;
    const int K = g.K, nt = K / BK;
    unsigned voffA[2], voffB[2];
#pragma unroll
    for (int i = 0; i < 2; ++i) { int R, C; stage_rc(tid * 16 + i * 8192, R, C); const int Rb = Epi::PERM ? ((R & ~31) + perm32(R & 31)) : R;
        voffA[i] = (unsigned)(R * K + C) * 2u; voffB[i] = (unsigned)(Rb * K + C) * 2u; }
    const size_t kstep = (size_t)(BK * 2);
    const size_t hstep = (size_t)HALF * K * 2;
    const size_t tstep = 2 * hstep;
    const unsigned ldsw = (unsigned)wid * 1024u;
    const int aoff = lds_byte(wr * 64 + fr, fq * 8), boff = lds_byte(wc * 32 + fr, fq * 8);
#define PG8_SA(b, h) (((b) * 2 + (h)) * HTB)
#define PG8_SB(b, h) ((4 + (b) * 2 + (h)) * HTB)
#define PG8_STAGE(bufoff, gbase, voff) do { _Pragma("unroll") for (int _i = 0; _i < 2; ++_i) \
        __builtin_amdgcn_global_load_lds((const unsigned*)((const char*)(gbase) + (voff)[_i]), (PG8_LAS unsigned*)(lds + (bufoff) + ldsw + _i * 8192), 16, 0, 0); } while (0)
#define PG8_LDA(dst, b, h) do { _Pragma("unroll") for (int m = 0; m < 4; ++m) _Pragma("unroll") for (int k = 0; k < 2; ++k) dst[m][k] = *(const PG8_LAS bf16x8*)(lds + PG8_SA(b, h) + aoff + m * 2048 + k * 1024); } while (0)
#define PG8_LDB(dst, b, h) do { _Pragma("unroll") for (int n = 0; n < 2; ++n) _Pragma("unroll") for (int k = 0; k < 2; ++k) dst[n][k] = *(const PG8_LAS bf16x8*)(lds + PG8_SB(b, h) + boff + n * 2048 + k * 1024); } while (0)
#define PG8_MMA(ai, bj, At, Bt) do { __builtin_amdgcn_s_setprio(1); _Pragma("unroll") for (int m = 0; m < 4; ++m) _Pragma("unroll") for (int n = 0; n < 2; ++n) _Pragma("unroll") for (int k = 0; k < 2; ++k) \
        acc[ai][bj][m][n] = __builtin_amdgcn_mfma_f32_16x16x32_bf16(Bt[n][k], At[m][k], acc[ai][bj][m][n], 0, 0, 0); __builtin_amdgcn_s_setprio(0); } while (0)
#define PG8_WAIT_V(n) asm volatile("s_waitcnt vmcnt(" #n ")" ::: "memory")
#define PG8_WAIT_L(n) asm volatile("s_waitcnt lgkmcnt(" #n ")" ::: "memory")
#define PG8_BAR __builtin_amdgcn_s_barrier()
#define PG8_SCHED __builtin_amdgcn_sched_barrier(0)
    Unit cur, nxt; int ui = 0;
    if (!S.next(0, cur)) return;
    f32x4 acc[2][2][4][2];
#pragma unroll
    for (int a = 0; a < 2; ++a)
#pragma unroll
        for (int b = 0; b < 2; ++b)
#pragma unroll
            for (int m = 0; m < 4; ++m)
#pragma unroll
                for (int n = 0; n < 2; ++n) acc[a][b][m][n] = (f32x4){0.f, 0.f, 0.f, 0.f};
    bf16x8 At[4][2], B0[2][2], B1[2][2];
    const char* cA = (const char*)g.A + (size_t)cur.pm * tstep; const char* cB = (const char*)g.Bt + (size_t)cur.pn * tstep;
    S.a_ready(cur);
    if constexpr (SP2) {
        PG8_STAGE(PG8_SB(0, 0), cB, voffB); PG8_STAGE(PG8_SB(0, 1), cB + hstep, voffB); PG8_STAGE(PG8_SA(0, 0), cA, voffA); PG8_STAGE(PG8_SA(0, 1), cA + hstep, voffA);
        if (wr == 1) PG8_BAR;
        PG8_WAIT_V(2); PG8_BAR;
        PG8_STAGE(PG8_SB(1, 0), cB + kstep, voffB); PG8_STAGE(PG8_SA(1, 0), cA + kstep, voffA); PG8_STAGE(PG8_SB(1, 1), cB + hstep + kstep, voffB);
        PG8_WAIT_V(6); PG8_BAR;
    } else {
        PG8_STAGE(PG8_SB(0, 0), cB, voffB); PG8_STAGE(PG8_SA(0, 0), cA, voffA); PG8_STAGE(PG8_SB(0, 1), cB + hstep, voffB); PG8_STAGE(PG8_SA(0, 1), cA + hstep, voffA);
        if (wr == 1) PG8_BAR;
        PG8_WAIT_V(4); PG8_BAR;
        PG8_STAGE(PG8_SB(1, 0), cB + kstep, voffB); PG8_STAGE(PG8_SA(1, 0), cA + kstep, voffA); PG8_STAGE(PG8_SB(1, 1), cB + hstep + kstep, voffB);
        PG8_WAIT_V(6); PG8_BAR;
    }
    for (;;) {
        const bool has_next = S.next(ui + 1, nxt);
        const char* nA = has_next ? (const char*)g.A + (size_t)nxt.pm * tstep : cA; const char* nB = has_next ? (const char*)g.Bt + (size_t)nxt.pn * tstep : cB;
        for (int t = 0; t < nt; t += 2) {
            const bool last = (t == nt - 2);
            const char* a1 = cA + (size_t)(t + 1) * kstep;
            const char* a2 = last ? nA : cA + (size_t)(t + 2) * kstep; const char* b2 = last ? nB : cB + (size_t)(t + 2) * kstep;
            const char* a3 = a2 + kstep; const char* b3 = b2 + kstep;
            if (last && has_next) S.a_ready(nxt);
            if constexpr (SP2) {
            PG8_LDB(B0, 0, 0); PG8_LDB(B1, 0, 1); PG8_SCHED; PG8_LDA(At, 0, 0); PG8_STAGE(PG8_SA(1, 1), a1 + hstep, voffA);
            PG8_WAIT_V(8); PG8_WAIT_L(0); PG8_BAR; PG8_MMA(0, 0, At, B0); PG8_MMA(0, 1, At, B1); PG8_BAR; PG8_SCHED;
            PG8_LDA(At, 0, 1); PG8_STAGE(PG8_SB(0, 0), b2, voffB); PG8_STAGE(PG8_SB(0, 1), b2 + hstep, voffB); PG8_STAGE(PG8_SA(0, 0), a2, voffA);
            PG8_WAIT_V(8); PG8_WAIT_L(0); PG8_BAR; PG8_MMA(1, 0, At, B0); PG8_MMA(1, 1, At, B1); PG8_BAR; PG8_SCHED;
            PG8_LDB(B0, 1, 0); PG8_LDB(B1, 1, 1); PG8_SCHED; PG8_LDA(At, 1, 0); PG8_STAGE(PG8_SA(0, 1), a2 + hstep, voffA);
            PG8_WAIT_V(8); PG8_WAIT_L(0); PG8_BAR; PG8_MMA(0, 0, At, B0); PG8_MMA(0, 1, At, B1); PG8_BAR; PG8_SCHED;
            PG8_LDA(At, 1, 1); PG8_STAGE(PG8_SB(1, 0), b3, voffB); PG8_STAGE(PG8_SB(1, 1), b3 + hstep, voffB); PG8_STAGE(PG8_SA(1, 0), a3, voffA);
            PG8_WAIT_V(8); PG8_WAIT_L(0); PG8_BAR; PG8_MMA(1, 0, At, B0); PG8_MMA(1, 1, At, B1); PG8_BAR; PG8_SCHED;
            } else {
            PG8_LDB(B0, 0, 0); PG8_SCHED; PG8_LDA(At, 0, 0); PG8_STAGE(PG8_SA(1, 1), a1 + hstep, voffA);
            PG8_WAIT_L(8); PG8_BAR; PG8_WAIT_L(0); PG8_MMA(0, 0, At, B0); PG8_BAR; PG8_SCHED;
            PG8_LDB(B1, 0, 1); PG8_STAGE(PG8_SB(0, 0), b2, voffB);
            PG8_BAR; PG8_WAIT_L(0); PG8_MMA(0, 1, At, B1); PG8_BAR;
            PG8_LDA(At, 0, 1); PG8_STAGE(PG8_SA(0, 0), a2, voffA);
            PG8_BAR; PG8_WAIT_L(0); PG8_MMA(1, 0, At, B0); PG8_BAR; PG8_SCHED;
            PG8_STAGE(PG8_SB(0, 1), b2 + hstep, voffB);
            PG8_WAIT_V(6); PG8_BAR; PG8_MMA(1, 1, At, B1); PG8_BAR;
            PG8_LDB(B0, 1, 0); PG8_SCHED; PG8_LDA(At, 1, 0); PG8_STAGE(PG8_SA(0, 1), a2 + hstep, voffA);
            PG8_WAIT_L(8); PG8_BAR; PG8_WAIT_L(0); PG8_MMA(0, 0, At, B0); PG8_BAR; PG8_SCHED;
            PG8_LDB(B1, 1, 1); PG8_STAGE(PG8_SB(1, 0), b3, voffB);
            PG8_BAR; PG8_WAIT_L(0); PG8_MMA(0, 1, At, B1); PG8_BAR;
            PG8_LDA(At, 1, 1); PG8_STAGE(PG8_SA(1, 0), a3, voffA);
            PG8_BAR; PG8_WAIT_L(0); PG8_MMA(1, 0, At, B0); PG8_BAR; PG8_SCHED;
            PG8_STAGE(PG8_SB(1, 1), b3 + hstep, voffB);
            PG8_WAIT_V(6); PG8_BAR; PG8_MMA(1, 1, At, B1); PG8_BAR;
            }
        }
        if constexpr (ALIGN_EPI) { if (wr == 0) PG8_BAR; }
        if constexpr (!Epi::AFTER_DRAIN) { E(acc, cur, wr, wc, fr, fq); S.done(cur); }
        if (!has_next) break;
#pragma unroll
        for (int a = 0; a < 2; ++a)
#pragma unroll
            for (int b = 0; b < 2; ++b)
#pragma unroll
                for (int m = 0; m < 4; ++m)
#pragma unroll
                    for (int n = 0; n < 2; ++n) acc[a][b][m][n] = (f32x4){0.f, 0.f, 0.f, 0.f};
        cur = nxt; cA = nA; cB = nB; ++ui;
        if constexpr (ALIGN_EPI) { if (wr == 1) PG8_BAR; }
    }
    PG8_WAIT_V(0);
    if constexpr (!ALIGN_EPI) { if (wr == 0) PG8_BAR; }
    PG8_BAR;
    if constexpr (Epi::AFTER_DRAIN) { E.fused(acc, cur, wr, wc, fr, fq, lds, wid, lane); S.done(cur); }
#undef PG8_SA
#undef PG8_SB
#undef PG8_STAGE
#undef PG8_LDA
#undef PG8_LDB
#undef PG8_MMA
#undef PG8_WAIT_V
#undef PG8_WAIT_L
#undef PG8_BAR
#undef PG8_SCHED
}
}

#define PG8_SP2 true
#define PG8_ALIGN true
namespace attn_body {
using bf16=__hip_bfloat16;
using bf16x8=__attribute__((ext_vector_type(8)))short;
using s16x4=__attribute__((ext_vector_type(4)))short;
using f32x16=__attribute__((ext_vector_type(16)))float;
using u32x4=__attribute__((ext_vector_type(4)))unsigned;
constexpr int BATCH=8,NHEAD=6,SEQ=4096,D=64,DM=3328,OPITCH=1024;
constexpr int NW=8,QBLK=32,QB=QBLK*NW,KVBLK=64,NQB=SEQ/QB;
constexpr int ATTN_PITCH=DM, ATTN_UNIT_ROWS=QB;
__device__ __forceinline__ int crow(int r,int hi){return (r&3)+8*(r>>2)+4*hi;}
#define SBAR() __builtin_amdgcn_sched_barrier(0)
__device__ __forceinline__ void cmask(f32x16&p0,f32x16&p1,int jb,int qrel,int hi){
  const float NEG=-INFINITY; int kb=64*jb+4*hi;
  #pragma unroll
  for(int r=0;r<16;++r){int kv=kb+(r&3)+8*(r>>2); if(kv>qrel)p0[r]=NEG; if(kv+32>qrel)p1[r]=NEG;}
}

constexpr int NSLOT=3, SLOTB=8192;
constexpr int LDS_K=0, LDS_V=NSLOT*SLOTB, LDS_WS=2*NSLOT*SLOTB, LDS_OST=LDS_WS+NW*64*4, LDS_OST1=LDS_OST+NW*4096, LDS_BYTES=LDS_OST1+NW*4096;
constexpr float C2=0.17677669529663687f*1.4426950408889634f;
__device__ __forceinline__ void glds16(const void*gsrc,unsigned lds_dst){unsigned keep;
  asm volatile("s_mov_b32 %0, m0\n\ts_mov_b32 m0, %2\n\ts_nop 0\n\tglobal_load_lds_dwordx4 %1, off\n\ts_mov_b32 m0, %0":"=&s"(keep):"v"(gsrc),"s"(lds_dst):"memory");}
__device__ __forceinline__ float max3f(float a,float b,float c){float r;asm("v_max3_f32 %0, %1, %2, %3":"=v"(r):"v"(a),"v"(b),"v"(c));return r;}
__device__ __forceinline__ float max2f(float a,float b){float r;asm("v_max_f32_e32 %0, %1, %2":"=v"(r):"v"(a),"v"(b));return r;}
__device__ __forceinline__ float fadd_s(float a,float b){float r;asm("v_add_f32_e32 %0, %1, %2":"=v"(r):"v"(a),"v"(b));return r;}
__device__ __forceinline__ float fsub_s(float a,float b){float r;asm("v_sub_f32_e32 %0, %1, %2":"=v"(r):"v"(a),"v"(b));return r;}
typedef float f32x2_t __attribute__((ext_vector_type(2))); typedef __bf16 bf16x2_t __attribute__((ext_vector_type(2)));
__device__ __forceinline__ unsigned cvtpk_s(float lo,float hi){f32x2_t v={lo,hi};bf16x2_t b=__builtin_convertvector(v,bf16x2_t);return __builtin_bit_cast(unsigned,b);}
#define WAIT_BAR(N) asm volatile("s_waitcnt vmcnt(" #N ") lgkmcnt(0)\n\ts_barrier":::"memory")

__device__ __forceinline__ void qkt(f32x16&p0,f32x16&p1,const char*Kslot,const bf16x8*qr,const f32x16&negm,int r32,int hi){
  const char*kb=Kslot+hi*1024+r32*16;
  #pragma unroll
  for(int d0=0;d0<4;++d0){
    const bf16x8 b0=*reinterpret_cast<const bf16x8*>(kb+d0*2048);
    const bf16x8 b1=*reinterpret_cast<const bf16x8*>(kb+d0*2048+512);
    if(d0==0){p0=__builtin_amdgcn_mfma_f32_32x32x16_bf16(b0,qr[0],negm,0,0,0);p1=__builtin_amdgcn_mfma_f32_32x32x16_bf16(b1,qr[0],negm,0,0,0);}
    else{p0=__builtin_amdgcn_mfma_f32_32x32x16_bf16(b0,qr[d0],p0,0,0,0);p1=__builtin_amdgcn_mfma_f32_32x32x16_bf16(b1,qr[d0],p1,0,0,0);}}
}
typedef __attribute__((address_space(3))) const char* lds_cptr;
typedef short v4i16_t __attribute__((ext_vector_type(4)));
__device__ __forceinline__ void kload8(bf16x8*kf,lds_cptr kp){
  kf[0]=*(const __attribute__((address_space(3))) bf16x8*)(kp);      kf[1]=*(const __attribute__((address_space(3))) bf16x8*)(kp+512);
  kf[2]=*(const __attribute__((address_space(3))) bf16x8*)(kp+2048); kf[3]=*(const __attribute__((address_space(3))) bf16x8*)(kp+2560);
  kf[4]=*(const __attribute__((address_space(3))) bf16x8*)(kp+4096); kf[5]=*(const __attribute__((address_space(3))) bf16x8*)(kp+4608);
  kf[6]=*(const __attribute__((address_space(3))) bf16x8*)(kp+6144); kf[7]=*(const __attribute__((address_space(3))) bf16x8*)(kp+6656);
}
__device__ __forceinline__ void kload2(bf16x8*kf,lds_cptr kp,int j){ kf[2*j]=*(const __attribute__((address_space(3))) bf16x8*)(kp+j*2048); kf[2*j+1]=*(const __attribute__((address_space(3))) bf16x8*)(kp+j*2048+512); }
__device__ __forceinline__ s16x4 vtr(lds_cptr p){ return __builtin_bit_cast(s16x4,__builtin_amdgcn_ds_read_tr16_b64_v4i16((__attribute__((address_space(3))) v4i16_t*)p)); }
__device__ __forceinline__ float rowmax(const f32x16&p0,const f32x16&p1){
  float a=max3f(p0[0],p0[1],p1[0]),b=max3f(p0[2],p0[3],p1[1]);a=max3f(a,p1[2],p1[3]);
  #pragma unroll
  for(int r=4;r<16;r+=4){a=max3f(a,p0[r],p0[r+1]);b=max3f(b,p0[r+2],p0[r+3]);a=max3f(a,p1[r],p1[r+1]);b=max3f(b,p1[r+2],p1[r+3]);}
  const float m=max2f(a,b);
  auto rr=__builtin_amdgcn_permlane32_swap(__float_as_uint(m),__float_as_uint(m),false,false);
  return max2f(__uint_as_float(rr[0]),__uint_as_float(rr[1]));
}
__device__ __forceinline__ void pv(f32x16*o,int vb,bf16x8 pa0,bf16x8 pa1,bf16x8 pa2,bf16x8 pa3){
  #pragma unroll
  for(int d0=0;d0<2;++d0){s16x4 lo[4],hi[4];
    #pragma unroll
    for(int ks=0;ks<4;++ks){
      asm volatile("ds_read_b64_tr_b16 %0,%1 offset:%c2":"=&v"(lo[ks]):"v"(vb),"i"(d0*4096+ks*1024):"memory");
      asm volatile("ds_read_b64_tr_b16 %0,%1 offset:%c2":"=&v"(hi[ks]):"v"(vb),"i"(d0*4096+ks*1024+512):"memory");}
    asm volatile("s_waitcnt lgkmcnt(0)":::"memory");SBAR();
    #define PK(k) (bf16x8){lo[k][0],lo[k][1],lo[k][2],lo[k][3],hi[k][0],hi[k][1],hi[k][2],hi[k][3]}
    o[d0]=__builtin_amdgcn_mfma_f32_32x32x16_bf16(pa0,PK(0),o[d0],0,0,0);
    o[d0]=__builtin_amdgcn_mfma_f32_32x32x16_bf16(pa1,PK(1),o[d0],0,0,0);
    o[d0]=__builtin_amdgcn_mfma_f32_32x32x16_bf16(pa2,PK(2),o[d0],0,0,0);
    o[d0]=__builtin_amdgcn_mfma_f32_32x32x16_bf16(pa3,PK(3),o[d0],0,0,0);
    #undef PK
  }
}

#ifndef ATTN_STORE16
#define ATTN_STORE16(p,v) __builtin_nontemporal_store((v),(u32x4*)(p))
#endif
template<int THRL> __device__ __forceinline__ void attn_unit(int b,int h,int qb,int nsel,float lam,const float*subg,float omli,const bf16*Q,const bf16*__restrict__ K,const bf16*__restrict__ V,bf16*O,char*shm){
  int tid_=threadIdx.x; asm volatile("":"+v"(tid_)); const int tid=tid_,lane=tid&63,r32=lane&31,hi=lane>>5; const int wid=__builtin_amdgcn_readfirstlane(tid>>6);
  const long rowbase=(long)b*SEQ; const int q0=qb*QB;
  const bf16*Qw=Q+(rowbase+q0+wid*QBLK)*DM+h*D;
  const bf16*Kh=K+rowbase*DM+h*D,*Vh=V+rowbase*DM+h*D;
  const unsigned lds0=(unsigned)(uintptr_t)shm;
  float*wsf=(float*)(shm+LDS_WS)+wid*64;
  const bf16*ksrc=Kh+(long)lane*DM+wid*8;
  const bf16*vsrc=Vh+(long)(16*(wid&3)+(lane>>2))*DM+(wid>>2)*32+(lane&3)*8;
  const unsigned kdst=lds0+LDS_K+wid*1024, vdst=lds0+LDS_V+wid*1024;
  #define DMA_K(t,slot) glds16(ksrc+(long)(t)*KVBLK*DM,(unsigned)__builtin_amdgcn_readfirstlane(kdst+(slot)))
  #define DMA_V(t,slot) glds16(vsrc+(long)(t)*KVBLK*DM,(unsigned)__builtin_amdgcn_readfirstlane(vdst+(slot)))
  const int vb0=(int)(lds0+LDS_V)+((lane>>4)&1)*32+(lane&3)*8+(4*hi+((lane&15)>>2))*64;
  const char*Kbase=shm+LDS_K; bf16x8 kf[8];
  const lds_cptr shm3=(lds_cptr)shm; const lds_cptr kp0=shm3+LDS_K+hi*1024+r32*16; const lds_cptr vp0=shm3+LDS_V+((lane>>4)&1)*32+(lane&3)*8+(4*hi+((lane&15)>>2))*64;
  const int NT=(q0+QB)/KVBLK;
  DMA_K(0,0);DMA_V(0,0);DMA_K(1,SLOTB);
  bf16x8 qr[4];
  #pragma unroll
  for(int d0=0;d0<4;++d0){qr[d0]=*reinterpret_cast<const bf16x8*>(&Qw[(long)r32*DM+d0*16+hi*8]); if((d0>>1)!=nsel)qr[d0]=bf16x8{0,0,0,0,0,0,0,0};}
  float mhat=0.f,l_reg=0.f;f32x16 o[2];o[0]=f32x16{};o[1]=f32x16{};f32x16 negm=f32x16{};asm volatile("":"+v"(negm));
  const int qrel=wid*QBLK+r32;
  #define CMASK(P0,P1,t) do{int jb_=(t)-(NT-4); if(jb_>=0)cmask(P0,P1,jb_,qrel,hi);}while(0)
  bool resc=false;
  #define START(P0,P1) do{ const float rm=rowmax(P0,P1); resc=false; \
    { const float dl=rm; mhat=fadd_s(mhat,dl); \
      _Pragma("unroll") for(int r=0;r<16;++r){P0[r]=fsub_s(P0[r],dl);P1[r]=fsub_s(P1[r],dl);} \
      _Pragma("unroll") for(int r=0;r<16;++r)negm[r]=-mhat; asm volatile("":"+v"(negm)); } \
    _Pragma("unroll") for(int r=0;r<16;++r)P0[r]=__builtin_amdgcn_exp2f(P0[r]); }while(0)
  #define RESC() do{ if(resc){ asm volatile("s_waitcnt lgkmcnt(0)":::"memory"); \
      _Pragma("unroll") for(int d_=0;d_<2;++d_) _Pragma("unroll") for(int r=0;r<16;++r)o[d_][r]*=wsf[crow(r,hi)]; } }while(0)
  f32x16 pA0,pA1,pB0,pB1;
  int sl_prev=0,sl_cur=0,sl_next=SLOTB;
  #define ROT() do{sl_prev=sl_cur;sl_cur=sl_next;sl_next=(sl_next==(NSLOT-1)*SLOTB)?0:sl_next+SLOTB;}while(0)
  DMA_K(2,2*SLOTB);
  WAIT_BAR(3);
  qkt(pA0,pA1,Kbase,qr,negm,r32,hi);asm volatile("s_nop 15\n\ts_nop 7":"+v"(pA0),"+v"(pA1));CMASK(pA0,pA1,0);
  START(pA0,pA1);
  _Pragma("unroll") for(int r=0;r<16;++r)pA1[r]=__builtin_amdgcn_exp2f(pA1[r]);
  WAIT_BAR(0);
  DMA_K(3,0);DMA_V(1,SLOTB);
  ROT();
  kload8(kf,kp0+sl_cur);
  WAIT_BAR(2);
  s16x4 vlo[8],vhi[8]; u32x4 pw0,pw1,pw2,pw3;
  #define PKW(P,B) cvtpk_s(P[B],P[B+1])
  #define PAF(k) __builtin_bit_cast(bf16x8,pw##k)
  #define VFR(i) (bf16x8){vlo[i][0],vlo[i][1],vlo[i][2],vlo[i][3],vhi[i][0],vhi[i][1],vhi[i][2],vhi[i][3]}
  #define PIN(x) asm volatile("":"+v"(x))
  #define MX3(a,b,c) __builtin_fmaxf(__builtin_fmaxf((a),(b)),(c))
  #define GAPA(MF,A0,A1,A2,A3,W0,W1,PW) do{ MF; sacc+=A0; sacc+=A1; sacc+=A2; sacc+=A3; PIN(sacc); W0; W1; PIN(PW); SBAR(); }while(0)
  #define EX(v) __builtin_amdgcn_exp2f(v)
  #define GAPB(MF,X,B) do{ MF; X[B]=EX(X[B]); X[B+1]=EX(X[B+1]); X[B+2]=EX(X[B+2]); X[B+3]=EX(X[B+3]); PIN(X); SBAR(); }while(0)
  #define VRD(i) do{ vlo[i]=vtr(vp_+(((i)>>2)*4096+((i)&3)*1024)); vhi[i]=vtr(vp_+(((i)>>2)*4096+((i)&3)*1024+512)); }while(0)
  #define KRD(G,j) do{ if(G){ kload2(kf,kp0+sl_next,j); SBAR(); } }while(0)
  #define STEP(C0,C1,P0,P1,t,GK,GV,GL) do{ SBAR(); \
    const lds_cptr vp_=vp0+sl_prev; \
    VRD(0); SBAR(); float sacc=(P0[0]+P0[1]); \
    GAPA(C0=__builtin_amdgcn_mfma_f32_32x32x16_bf16(kf[0],qr[0],negm,0,0,0), P0[2],P0[3],P0[4],P0[5],     pw0[0]=PKW(P0,0), pw0[1]=PKW(P0,2), pw0); \
    VRD(4); SBAR(); GAPA(C1=__builtin_amdgcn_mfma_f32_32x32x16_bf16(kf[1],qr[0],negm,0,0,0), P0[6],P0[7],P0[8],P0[9],     pw0[2]=PKW(P0,4), pw0[3]=PKW(P0,6), pw0); \
    VRD(1); SBAR(); GAPA(C0=__builtin_amdgcn_mfma_f32_32x32x16_bf16(kf[2],qr[1],C0,0,0,0),   P0[10],P0[11],P0[12],P0[13], pw1[0]=PKW(P0,8), pw1[1]=PKW(P0,10), pw1); \
    VRD(5); SBAR(); GAPA(C1=__builtin_amdgcn_mfma_f32_32x32x16_bf16(kf[3],qr[1],C1,0,0,0),   P0[14],P0[15],P1[0],P1[1],   pw1[2]=PKW(P0,12),pw1[3]=PKW(P0,14), pw1); \
    VRD(2); SBAR(); GAPA(C0=__builtin_amdgcn_mfma_f32_32x32x16_bf16(kf[4],qr[2],C0,0,0,0),   P1[2],P1[3],P1[4],P1[5],     pw2[0]=PKW(P1,0), pw2[1]=PKW(P1,2), pw2); \
    VRD(6); SBAR(); GAPA(C1=__builtin_amdgcn_mfma_f32_32x32x16_bf16(kf[5],qr[2],C1,0,0,0),   P1[6],P1[7],P1[8],P1[9],     pw2[2]=PKW(P1,4), pw2[3]=PKW(P1,6), pw2); \
    VRD(3); SBAR(); GAPA(C0=__builtin_amdgcn_mfma_f32_32x32x16_bf16(kf[6],qr[3],C0,0,0,0),   P1[10],P1[11],P1[12],P1[13], pw3[0]=PKW(P1,8), pw3[1]=PKW(P1,10), pw3); \
    VRD(7); SBAR(); GAPA(C1=__builtin_amdgcn_mfma_f32_32x32x16_bf16(kf[7],qr[3],C1,0,0,0),   P1[14],P1[15],0.f,0.f,       pw3[2]=PKW(P1,12),pw3[3]=PKW(P1,14), pw3); \
    l_reg+=sacc; \
    if(GK){DMA_K((t)+3,sl_cur);} if(GV){DMA_V((t)+1,sl_next);} \
    CMASK(C0,C1,t); \
    { float a=MX3(C0[0],C0[1],C1[0]),b=MX3(C0[2],C0[3],C1[1]); a=MX3(a,C1[2],C1[3]); \
      _Pragma("unroll") for(int r=4;r<16;r+=4){a=MX3(a,C0[r],C0[r+1]);b=MX3(b,C0[r+2],C0[r+3]);a=MX3(a,C1[r],C1[r+1]);b=MX3(b,C1[r+2],C1[r+3]);} \
      float rm=__builtin_fmaxf(a,b); { auto rr=__builtin_amdgcn_permlane32_swap(__float_as_uint(rm),__float_as_uint(rm),false,false); rm=__builtin_fmaxf(__uint_as_float(rr[0]),__uint_as_float(rr[1])); } \
      resc=false; \
      if(__builtin_expect(__any(rm>(float)THRL),0)){ const float dl=__builtin_fmaxf(rm,0.f); mhat+=dl; \
        _Pragma("unroll") for(int r=0;r<16;++r){C0[r]-=dl;C1[r]-=dl;} \
        _Pragma("unroll") for(int r=0;r<16;++r)negm[r]=-mhat; asm volatile("":"+v"(negm)); \
        const float f=__builtin_amdgcn_exp2f(-dl); l_reg*=f; if(hi==0)wsf[r32]=f; resc=true; } } \
    SBAR(); \
    GAPB(o[0]=__builtin_amdgcn_mfma_f32_32x32x16_bf16(PAF(0),VFR(0),o[0],0,0,0), C0,0); \
    GAPB(o[1]=__builtin_amdgcn_mfma_f32_32x32x16_bf16(PAF(0),VFR(4),o[1],0,0,0), C0,4); \
    KRD(GL,0); GAPB(o[0]=__builtin_amdgcn_mfma_f32_32x32x16_bf16(PAF(1),VFR(1),o[0],0,0,0), C0,8); \
    KRD(GL,1); GAPB(o[1]=__builtin_amdgcn_mfma_f32_32x32x16_bf16(PAF(1),VFR(5),o[1],0,0,0), C0,12); \
    KRD(GL,2); GAPB(o[0]=__builtin_amdgcn_mfma_f32_32x32x16_bf16(PAF(2),VFR(2),o[0],0,0,0), C1,0); \
    KRD(GL,3); GAPB(o[1]=__builtin_amdgcn_mfma_f32_32x32x16_bf16(PAF(2),VFR(6),o[1],0,0,0), C1,4); \
    GAPB(o[0]=__builtin_amdgcn_mfma_f32_32x32x16_bf16(PAF(3),VFR(3),o[0],0,0,0), C1,8); \
    GAPB(o[1]=__builtin_amdgcn_mfma_f32_32x32x16_bf16(PAF(3),VFR(7),o[1],0,0,0), C1,12); \
    }while(0)
  int t=1;
  #undef CMASK
  #define CMASK(P0,P1,t) do{}while(0)
  for(;t+5<NT;t+=2){
    STEP(pB0,pB1,pA0,pA1,t,true,true,true);     WAIT_BAR(2); RESC(); ROT();
    STEP(pA0,pA1,pB0,pB1,t+1,true,true,true);   WAIT_BAR(2); RESC(); ROT();
  }
  #undef CMASK
  #define CMASK(P0,P1,t) do{int jb_=(t)-(NT-4); if(jb_>=0)cmask(P0,P1,jb_,qrel,hi);}while(0)
  #define ENDW(tt) do{ if((tt)+3<NT){WAIT_BAR(2);} else if((tt)+2<NT){WAIT_BAR(1);} else {WAIT_BAR(0);} }while(0)
  for(;t+1<NT;t+=2){
    STEP(pB0,pB1,pA0,pA1,t,(t+3<NT),(t+1<NT),(t+1<NT));       ENDW(t);   RESC(); ROT();
    STEP(pA0,pA1,pB0,pB1,t+1,(t+4<NT),(t+2<NT),(t+2<NT));     ENDW(t+1); RESC(); ROT();
  }
  STEP(pB0,pB1,pA0,pA1,NT-1,false,false,false); RESC();
  { float sacc=pB0[0]+pB0[1]; _Pragma("unroll") for(int r=2;r<16;++r)sacc+=pB0[r]; _Pragma("unroll") for(int r=0;r<16;++r)sacc+=pB1[r]; l_reg+=sacc;
    pw0=(u32x4){PKW(pB0,0),PKW(pB0,2),PKW(pB0,4),PKW(pB0,6)};pw1=(u32x4){PKW(pB0,8),PKW(pB0,10),PKW(pB0,12),PKW(pB0,14)};pw2=(u32x4){PKW(pB1,0),PKW(pB1,2),PKW(pB1,4),PKW(pB1,6)};pw3=(u32x4){PKW(pB1,8),PKW(pB1,10),PKW(pB1,12),PKW(pB1,14)};
    SBAR(); pv(o,vb0+sl_cur,PAF(0),PAF(1),PAF(2),PAF(3)); }
  #undef PKW
  #undef PAF
  #undef VFR
  #undef PIN
  #undef MX3
  #undef GAPA
  #undef GAPB
  #undef EX
  #undef VRD
  #undef KRD
  #undef STEP
  #undef ENDW
  {auto rr=__builtin_amdgcn_permlane32_swap(__float_as_uint(l_reg),__float_as_uint(l_reg),false,false);l_reg=__uint_as_float(rr[0])+__uint_as_float(rr[1]);}
  if(hi==0)wsf[32+r32]=l_reg;asm volatile("s_waitcnt lgkmcnt(0)":::"memory");
  float rli[16];
  #pragma unroll
  for(int r=0;r<16;++r)rli[r]=__builtin_amdgcn_rcpf(wsf[32+crow(r,hi)]);
  bf16*Ow=O+(rowbase+q0+wid*QBLK)*OPITCH+h*D;
  { bf16*stg=(bf16*)(shm+(nsel==0?LDS_OST1:LDS_OST))+wid*2048;
    #pragma unroll
    for(int r=0;r<16;++r){const int orow=crow(r,hi);
      #pragma unroll
      for(int d0=0;d0<2;++d0)stg[orow*64+d0*32+r32]=__float2bfloat16(o[d0][r]*rli[r]);}
    asm volatile("s_waitcnt lgkmcnt(0)":::"memory");
    if(nsel==1){ const bf16*stg1=(const bf16*)(shm+LDS_OST1)+wid*2048;
      #pragma unroll
      for(int i=0;i<4;++i){const int row=i*8+(lane>>3),ch=lane&7; const u32x4 v2=*(const u32x4*)(stg+row*64+ch*8); const u32x4 v1=*(const u32x4*)(stg1+row*64+ch*8);
        float dd[8]; float ss=0.f;
        #pragma unroll
        for(int j=0;j<4;++j){ const float a0=__uint_as_float(v1[j]<<16),a1=__uint_as_float(v1[j]&0xffff0000u),b0=__uint_as_float(v2[j]<<16),b1=__uint_as_float(v2[j]&0xffff0000u);
          dd[2*j]=a0-lam*b0; dd[2*j+1]=a1-lam*b1; ss+=dd[2*j]*dd[2*j]+dd[2*j+1]*dd[2*j+1]; }
        ss+=__shfl_xor(ss,1); ss+=__shfl_xor(ss,2); ss+=__shfl_xor(ss,4);
        const float rs=omli/sqrtf(ss*(1.0f/64.0f)+1e-6f);
        u32x4 w;
        #pragma unroll
        for(int j=0;j<4;++j) w[j]=cvtpk_s(dd[2*j]*rs*subg[ch*8+2*j],dd[2*j+1]*rs*subg[ch*8+2*j+1]);
        ATTN_STORE16(Ow+(long)row*OPITCH+ch*8,w);} } }
  asm volatile("s_waitcnt lgkmcnt(0)\n\ts_barrier":::"memory");
  #undef DMA_K
  #undef DMA_V
  #undef CMASK
  #undef START
  #undef RESC
  #undef ROT

}
#undef SBAR
#undef WAIT_BAR
}
#ifndef GOFF
#define GOFF 0
#endif
#define GEMMCALL0 if (!((GOFF) & 1))
#define GEMMCALL1 if (!((GOFF) & 2))
#define GEMMCALL2 if (!((GOFF) & 4))
#define GEMMCALL3 if (!((GOFF) & 8))
namespace cg = cooperative_groups;
#define GAS __attribute__((address_space(1)))
#define LAS __attribute__((address_space(3)))
#define DI __device__ __forceinline__
typedef unsigned short bf16;
typedef unsigned v4u __attribute__((ext_vector_type(4)));
typedef unsigned v2u __attribute__((ext_vector_type(2)));
typedef float f32x4 __attribute__((ext_vector_type(4)));
typedef short bf16x8 __attribute__((ext_vector_type(8)));

constexpr int NWAVES = 8;
constexpr int DMODEL = 1024, SEQ = 4096, M = 32768, NIN = 3328, FF = 4096;
constexpr int RW = 384, RCOLS = 1408, ROFF = 1920, COFF = 1152;
constexpr float NORM_EPS = 1e-6f, GN_EPS = 64e-5f;
constexpr size_t MiB = 1u << 20;
constexpr size_t WS_CTL = 0, CTL_ZERO_BYTES = 65536;
constexpr int CW_BAR = 4096;
constexpr size_t WS_SS = 128 * 1024;
constexpr size_t WS_WIN = 1 * MiB, WS_WOUT = 14 * MiB, WS_WUP = 18 * MiB, WS_WDN = 34 * MiB, WS_LORA = 50 * MiB;
constexpr size_t WS_XB = 51 * MiB, WS_PROJ = 115 * MiB, WS_MIX = 323 * MiB, WS_S = 387 * MiB, WS_END = 507 * MiB;
constexpr size_t WS_HID = 115 * MiB;
constexpr size_t WS_AUX = 48 * MiB;
constexpr size_t WS_PT = WS_AUX + 12 * MiB, WS_DOTS = WS_PT + 2 * MiB;
constexpr int NITEMS = 48 * 128;
constexpr size_t SARR = (size_t)M * RW;
constexpr int LORA_L = 384 * 64 * 2 + 384 * 128;
constexpr int LDS_BYTES = 147456, MISC_OFF = 131072;
constexpr int SCAN_WGS = 48, ATT_ITEMS = 768;

#ifndef STAG1
#define STAG1 2000u
#endif
#ifndef STAG3
#define STAG3 3000u
#endif
#ifndef PROBE
#define PROBE 0
#endif
struct Args { const float* in[25]; float* out; unsigned char* ws; int i0, i1; };

DI float wave_sum(float v) {
#pragma unroll
    for (int o = 1; o < 64; o <<= 1) v += __shfl_xor(v, o);
    return v;
}
typedef float f32x2h __attribute__((ext_vector_type(2))); typedef __bf16 bf16x2h __attribute__((ext_vector_type(2)));
DI unsigned pk2(float lo, float hi) { f32x2h v = {lo, hi}; bf16x2h b = __builtin_convertvector(v, bf16x2h); return __builtin_bit_cast(unsigned, b); }
DI unsigned f2bf(float f) { return pk2(f, 0.f) & 0xffffu; }
DI float bflo(unsigned w) { return __uint_as_float(w << 16); }
DI float bfhi(unsigned w) { return __uint_as_float(w & 0xffff0000u); }
DI float bf1(const bf16* p) { return __uint_as_float(((unsigned)*p) << 16); }
DI void unpack8(v4u w, float* f) { f[0] = bflo(w.x); f[1] = bfhi(w.x); f[2] = bflo(w.y); f[3] = bfhi(w.y); f[4] = bflo(w.z); f[5] = bfhi(w.z); f[6] = bflo(w.w); f[7] = bfhi(w.w); }
DI v4u pack8(const float* f) { v4u o; o.x = pk2(f[0], f[1]); o.y = pk2(f[2], f[3]); o.z = pk2(f[4], f[5]); o.w = pk2(f[6], f[7]); return o; }
DI float sigmoidf_(float x) { return __builtin_amdgcn_rcpf(1.f + __expf(-x)); }
DI float tanhf_(float x) { const float e = __expf(2.f * x); return 1.f - 2.f * __builtin_amdgcn_rcpf(e + 1.f); }
template <int CTRL> DI float dpp_add(float x) { return x + __int_as_float(__builtin_amdgcn_update_dpp(0, __float_as_int(x), CTRL, 0xf, 0xf, true)); }
DI float red16(float x) { x = dpp_add<0xB1>(x); x = dpp_add<0x4E>(x); x = dpp_add<0x141>(x); x = dpp_add<0x140>(x); return x; }

#define XB_TMO      128
#define XB_XCNT(j)  (256  + 64 * (j))
#define XB_XSUB(j)  (1280 + 64 * (j))
#define XB_XGEN(j)  (2304 + 64 * (j))
#define XB_TOP      3328
#define XB_TOPGEN   3392
#define XCD_BAR_WORDS 3456
#define XB_SPIN_CAP (1u << 18)

__device__ __forceinline__ unsigned xb_ld(unsigned* p)              { return __hip_atomic_load(p, __ATOMIC_RELAXED, __HIP_MEMORY_SCOPE_AGENT); }
__device__ __forceinline__ unsigned xb_add(unsigned* p, unsigned v) { return __hip_atomic_fetch_add(p, v, __ATOMIC_RELAXED, __HIP_MEMORY_SCOPE_AGENT); }
__device__ __forceinline__ unsigned xb_xcc_id() { return (unsigned)__builtin_amdgcn_s_getreg((3 << 11) | 20) & 0xFu; }
#define XB_SPIN(cond, bar) do { unsigned _sp = 0; while (cond) { __builtin_amdgcn_s_sleep(1); \
    if ((++_sp & 255u) == 0u) { if (xb_ld(&(bar)[XB_TMO])) break; if (_sp > XB_SPIN_CAP) { atomicAdd(&(bar)[XB_TMO], 1u); break; } } } } while (0)

struct XcdBarrier {
    unsigned* bar; unsigned x;
    volatile LAS unsigned* st;
};

__device__ __forceinline__ XcdBarrier xcd_barrier_post(unsigned* bar, volatile LAS unsigned* st) {
    XcdBarrier b; b.bar = bar; b.x = xb_xcc_id(); b.st = st;
    if (threadIdx.x == 0) (void)xb_add(&bar[XB_XCNT(b.x)], 1u);
    return b;
}
__device__ __forceinline__ void xcd_barrier_complete(unsigned* bar, unsigned x, unsigned& nloc, unsigned& nx) {
    const unsigned G = gridDim.x * gridDim.y * gridDim.z;
    unsigned sum, cnt, mine, sp = 0u;
    for (;;) {
        sum = 0u; cnt = 0u; mine = 0u;
#pragma unroll
        for (unsigned j = 0; j < 16; ++j) { const unsigned c = xb_ld(&bar[XB_XCNT(j)]); sum += c; cnt += (c > 0u) ? 1u : 0u; mine = (j == x) ? c : mine; }
        if (sum == G) break;
        __builtin_amdgcn_s_sleep(1);
        if ((++sp & 255u) == 0u) { if (xb_ld(&bar[XB_TMO])) break; if (sp > XB_SPIN_CAP) { atomicAdd(&bar[XB_TMO], 1u); break; } }
    }
    nloc = mine > 0u ? mine : 1u; nx = cnt > 0u ? cnt : 1u;
}

__device__ __forceinline__ void xcd_barrier(const XcdBarrier& b) {
    asm volatile("s_waitcnt vmcnt(0)" ::: "memory");
    __syncthreads();
    if (threadIdx.x == 0) {
        unsigned* bar = b.bar; unsigned bx_ = xb_xcc_id(); asm volatile("" : "+s"(bx_));
        __builtin_amdgcn_s_waitcnt(0);
        unsigned nloc = b.st[0], nx = b.st[1];
        if (nloc == 0u) { xcd_barrier_complete(bar, bx_, nloc, nx); b.st[0] = nloc; b.st[1] = nx; }
        const unsigned old = xb_add(&bar[XB_XSUB(bx_)], 1u);
        const unsigned gen = old / nloc;
        if (old + 1u == (gen + 1u) * nloc) {
            __builtin_amdgcn_fence(__ATOMIC_RELEASE, "agent");
            asm volatile("s_waitcnt vmcnt(0)" ::: "memory");
            const unsigned og = xb_add(&bar[XB_TOP], 1u);
            const unsigned tg = og / nx;
            if (og + 1u == (tg + 1u) * nx) xb_add(&bar[XB_TOPGEN], 1u);
            else XB_SPIN(xb_ld(&bar[XB_TOPGEN]) == tg, bar);
            __builtin_amdgcn_fence(__ATOMIC_ACQUIRE, "agent");
            xb_add(&bar[XB_XGEN(bx_)], 1u);
            asm volatile("s_waitcnt vmcnt(0)" ::: "memory");
        } else {
            XB_SPIN(xb_ld(&bar[XB_XGEN(bx_)]) == gen, bar);
            __builtin_amdgcn_fence(__ATOMIC_ACQUIRE, "agent");
            asm volatile("s_waitcnt vmcnt(0)" ::: "memory");
        }
    }
    __syncthreads();
}


DI void seam_arrive(unsigned* w) { asm volatile("s_waitcnt vmcnt(0)" ::: "memory"); __syncthreads();
    if (threadIdx.x == 0) { __builtin_amdgcn_fence(__ATOMIC_RELEASE, "agent"); asm volatile("s_waitcnt vmcnt(0)" ::: "memory"); (void)__hip_atomic_fetch_add(w, 1u, __ATOMIC_RELAXED, __HIP_MEMORY_SCOPE_AGENT); } }
DI void seam_wait(unsigned* w, unsigned need) {
    if (threadIdx.x == 0) { unsigned sp = 0u; while (__hip_atomic_load(w, __ATOMIC_RELAXED, __HIP_MEMORY_SCOPE_AGENT) < need) { __builtin_amdgcn_s_sleep(1); if (++sp > (1u << 22)) break; }
        __builtin_amdgcn_fence(__ATOMIC_ACQUIRE, "agent"); asm volatile("s_waitcnt vmcnt(0)" ::: "memory"); }
    __syncthreads(); }
struct Frame {
    LAS unsigned char* lds;
    int tid, lane, wave, G, gw, NGW;
    const float* const* in;
    float* out; unsigned char* ws;
};
DI const float* INP(const Frame& F, int k) { asm volatile("" : "+s"(k)); return F.in[k]; }
#define SSP(k) ((float*)((unsigned char*)F.out + 64 * MiB) + (size_t)(k) * M * 16)
#define F_WIN  ((bf16*)(F.ws + WS_WIN))
#define F_WOUT ((bf16*)(F.ws + WS_WOUT))
#define F_WUP  ((bf16*)(F.ws + WS_WUP))
#define F_WDN  ((bf16*)(F.ws + WS_WDN))
#define F_LORA ((bf16*)(F.ws + WS_LORA))
#define F_XB   ((bf16*)(F.ws + WS_XB))
#define F_PROJ ((bf16*)(F.ws + WS_PROJ))
#define F_MIX  ((bf16*)(F.ws + WS_MIX))
#define F_HID  ((bf16*)(F.ws + WS_HID))
#define F_S_r  ((bf16*)F.out)
#define F_S_ld ((bf16*)F.out + SARR)
#define F_S_k  ((bf16*)(F.ws + WS_S))
#define F_S_v  ((bf16*)(F.ws + WS_S) + SARR)
#define F_S_n  ((bf16*)(F.ws + WS_S) + 2 * SARR)
#define F_S_b  ((bf16*)(F.ws + WS_S) + 3 * SARR)
#define F_S_g  ((bf16*)(F.ws + WS_S) + 4 * SARR)
#define F_ctl  ((unsigned*)(F.ws + WS_CTL))

template <bool STREAM> DI void transpose_item(const float* W, int K, int N, bf16* WT, LAS float* scr, int item, int lane, const float* gk, float cs, int csn) {
    const int nblk = N / 32, kb = item / nblk, nb = item % nblk, k0 = 64 * kb, n0 = 32 * nb;
    const float colscale = (n0 + (lane & 31) < csn) ? cs : 1.f;
#pragma unroll 8
    for (int i = 0; i < 32; ++i) { const int kk = 2 * i + (lane >> 5); float v = __builtin_nontemporal_load(&W[(size_t)(k0 + kk) * N + n0 + (lane & 31)]); if (gk) v *= gk[k0 + kk]; scr[kk * 33 + (lane & 31)] = v * colscale; }
    asm volatile("s_waitcnt lgkmcnt(0)" ::: "memory");
    const int c = lane & 7;
#pragma unroll
    for (int j = 0; j < 4; ++j) { const int n = (lane >> 3) + 8 * j; const LAS float* s = scr + (8 * c) * 33 + n;
        v4u o; o.x = pk2(s[0 * 33], s[1 * 33]); o.y = pk2(s[2 * 33], s[3 * 33]); o.z = pk2(s[4 * 33], s[5 * 33]); o.w = pk2(s[6 * 33], s[7 * 33]);
        if (STREAM) __builtin_nontemporal_store(o, (v4u*)(WT + (size_t)(n0 + n) * K + k0 + 8 * c)); else *(v4u*)(WT + (size_t)(n0 + n) * K + k0 + 8 * c) = o; }
    asm volatile("s_waitcnt lgkmcnt(0)" ::: "memory");
}
DI Frame refresh(const Frame& F0) { Frame F = F0; int t = threadIdx.x; asm volatile("" : "+v"(t)); int bxx = blockIdx.x; asm volatile("" : "+s"(bxx)); F.tid = t; F.lane = t & 63; F.wave = __builtin_amdgcn_readfirstlane(t >> 6); F.gw = bxx * NWAVES + F.wave; return F; }
DI void stagger(unsigned ticks) { if ((blockIdx.x >> 3) & 1) { const unsigned long long t0 = __builtin_amdgcn_s_memrealtime(); while (__builtin_amdgcn_s_memrealtime() - t0 < ticks) __builtin_amdgcn_s_sleep(8); } }
template <bool STREAM> DI void prologue(const Frame& F0, int l, int w0, int nw) { Frame F = refresh(F0);
    LAS float* scr = (LAS float*)(F.lds + F.wave * 16384);
    constexpr int I_IN = 16 * 104, I_OUT = 16 * 32, I_UP = 16 * 128, I_DN = 64 * 32, I_LW = 12, I_LG = 24;
    constexpr int PER = I_IN + I_OUT + I_UP + I_DN + 2 * I_LW + I_LG;
    constexpr float C2 = 0.17677669529663687f * 1.4426950408889634f;
    for (int it = w0; it < PER; it += nw) {
        int r = it;
        if (r < I_IN) { transpose_item<STREAM>(INP(F, 2) + (size_t)l * DMODEL * NIN, DMODEL, NIN, F_WIN + (size_t)l * NIN * DMODEL, scr, r, F.lane, INP(F, 1) + l * DMODEL, C2, 384); continue; } r -= I_IN;
        if (r < I_OUT) { transpose_item<STREAM>(INP(F, 20) + (size_t)l * DMODEL * DMODEL, DMODEL, DMODEL, F_WOUT + (size_t)l * DMODEL * DMODEL, scr, r, F.lane, nullptr, 1.f, 0); continue; } r -= I_OUT;
        if (r < I_UP) { transpose_item<STREAM>(INP(F, 22) + (size_t)l * DMODEL * FF, DMODEL, FF, F_WUP + (size_t)l * FF * DMODEL, scr, r, F.lane, INP(F, 21) + l * DMODEL, 1.f, 0); continue; } r -= I_UP;
        if (r < I_DN) { transpose_item<STREAM>(INP(F, 23) + (size_t)l * FF * DMODEL, FF, DMODEL, F_WDN + (size_t)l * DMODEL * FF, scr, r, F.lane, nullptr, 1.f, 0); continue; } r -= I_DN;
        bf16* L = F_LORA + (size_t)l * LORA_L;
        if (r < I_LW) { transpose_item<STREAM>(INP(F, 11) + (size_t)l * 64 * RW, 64, RW, L, scr, r, F.lane, nullptr, 1.f, 0); continue; } r -= I_LW;
        if (r < I_LW) { transpose_item<STREAM>(INP(F, 13) + (size_t)l * 64 * RW, 64, RW, L + RW * 64, scr, r, F.lane, nullptr, 1.f, 0); continue; } r -= I_LW;
        transpose_item<STREAM>(INP(F, 14) + (size_t)l * 128 * RW, 128, RW, L + 2 * RW * 64, scr, r, F.lane, nullptr, 1.f, 0);
    }
}
DI void x_to_bf16(const Frame& F0, const float* src, bf16* dst, float* ss) { Frame F = refresh(F0);
    for (int m0 = F.gw; m0 < M; m0 += 4 * F.NGW) {
        f32x4 v[4][4];
#pragma unroll
        for (int q = 0; q < 4; ++q) { const int m = m0 + q * F.NGW; if (m < M) { const f32x4* xr = (const f32x4*)(src + (size_t)m * DMODEL) + F.lane;
#pragma unroll
            for (int j = 0; j < 4; ++j) v[q][j] = __builtin_nontemporal_load(&xr[64 * j]); } }
#pragma unroll
        for (int q = 0; q < 4; ++q) { const int m = m0 + q * F.NGW; if (m < M) { float s2 = 0.f;
#pragma unroll
            for (int j = 0; j < 4; ++j) s2 += (v[q][j].x * v[q][j].x + v[q][j].y * v[q][j].y) + (v[q][j].z * v[q][j].z + v[q][j].w * v[q][j].w);
            s2 = wave_sum(s2); if (F.lane < 16) ss[(size_t)m * 16 + F.lane] = (F.lane == 0) ? s2 : 0.f;
            v2u* o8 = (v2u*)(dst + (size_t)m * DMODEL) + F.lane;
#pragma unroll
            for (int j = 0; j < 4; ++j) { v2u w; w.x = pk2(v[q][j].x, v[q][j].y); w.y = pk2(v[q][j].z, v[q][j].w); o8[64 * j] = w; } } }
    }
}
DI void final_norm(const Frame& F0, const bf16* xb, float* out, const float* g) { Frame F = refresh(F0);
    const f32x4* gr = (const f32x4*)g + F.lane; f32x4 gv[4];
#pragma unroll
    for (int j = 0; j < 4; ++j) gv[j] = gr[64 * j];
    for (int m0 = F.gw; m0 < M; m0 += 4 * F.NGW) {
        v2u w[4][4];
#pragma unroll
        for (int q = 0; q < 4; ++q) { const int m = m0 + q * F.NGW; if (m < M) { const v2u* xr = (const v2u*)(xb + (size_t)m * DMODEL) + F.lane;
#pragma unroll
            for (int j = 0; j < 4; ++j) w[q][j] = __builtin_nontemporal_load(&xr[64 * j]); } }
#pragma unroll
        for (int q = 0; q < 4; ++q) { const int m = m0 + q * F.NGW; if (m < M) { f32x4 v[4]; float s2 = 0.f;
#pragma unroll
            for (int j = 0; j < 4; ++j) { v[j] = (f32x4){bflo(w[q][j].x), bfhi(w[q][j].x), bflo(w[q][j].y), bfhi(w[q][j].y)}; s2 += (v[j].x * v[j].x + v[j].y * v[j].y) + (v[j].z * v[j].z + v[j].w * v[j].w); }
            const float rstd = 1.f / sqrtf(wave_sum(s2) * (1.f / DMODEL) + NORM_EPS);
            f32x4* orow = (f32x4*)(out + (size_t)m * DMODEL) + F.lane;
#pragma unroll
            for (int j = 0; j < 4; ++j) __builtin_nontemporal_store(v[j] * rstd * gv[j], &orow[64 * j]); } }
    }
}

DI void loadz8(const bf16* prow, bool first, const float* mu, int col, float* z) {
    const v4u p = *(const v4u*)(prow + col); v4u q = (v4u){0u, 0u, 0u, 0u}; if (!first) q = *(const v4u*)(prow - NIN + col);
    const f32x4 m0 = *(const f32x4*)(mu + col), m1 = *(const f32x4*)(mu + col + 4);
    float pf[8], qf[8]; unpack8(p, pf); unpack8(q, qf);
#pragma unroll
    for (int j = 0; j < 4; ++j) { z[j] = pf[j] + m0[j] * (qf[j] - pf[j]); z[4 + j] = pf[4 + j] + m1[j] * (qf[4 + j] - pf[4 + j]); }
}
DI void loadz8L(const bf16* prow, bool first, const LAS float* mu, int col, float* z) {
    const v4u p = *(const v4u*)(prow + col); v4u q = (v4u){0u, 0u, 0u, 0u}; if (!first) q = *(const v4u*)(prow - NIN + col);
    const f32x4 m0 = *(const LAS f32x4*)(mu + col), m1 = *(const LAS f32x4*)(mu + col + 4);
    float pf[8], qf[8]; unpack8(p, pf); unpack8(q, qf);
#pragma unroll
    for (int j = 0; j < 4; ++j) { z[j] = pf[j] + m0[j] * (qf[j] - pf[j]); z[4 + j] = pf[4 + j] + m1[j] * (qf[4 + j] - pf[4 + j]); }
}
DI float loadz1(const bf16* prow, bool first, float mu, int col) { const float p = bf1(prow + col); const float q = first ? 0.f : bf1(prow - NIN + col); return p + mu * (q - p); }

DI void prep_phase(const Frame& F0, int l) { Frame F = refresh(F0);
    LAS float* PT = (LAS float*)(F.lds + MISC_OFF + 256);
    {   const float* srcs[6] = {INP(F, 10) + l * RW, INP(F, 12) + l * RW, INP(F, 15) + l * RW, INP(F, 16) + l * RW, INP(F, 17) + l * RW, INP(F, 9) + l * RCOLS};
        for (int i = F.tid; i < 5 * RW + RCOLS; i += NWAVES * 64) { const int a = i < 5 * RW ? i / RW : 5; PT[i] = srcs[a][i - a * RW]; }
        __syncthreads(); }
    const LAS float* w0 = PT; const LAS float* a0 = PT + RW; const LAS float* kkw = PT + 2 * RW; const LAS float* kaw = PT + 3 * RW; const LAS float* rkp = PT + 4 * RW; const LAS float* mu = PT + 5 * RW;
    const bf16* WUT = F_LORA + (size_t)l * LORA_L; const bf16* AUT = WUT + RW * 64; const bf16* GUT = AUT + RW * 64;
    const int row = F.lane & 15, kq = F.lane >> 4, tok = F.lane >> 2, cq = (F.lane & 3) * 16;
    LAS float* LW = (LAS float*)(F.lds + F.wave * 16384);
    for (int tile = F.gw; tile < M / 16; tile += F.NGW) {
        const int t0 = tile * 16;
        bf16x8 Aw[2], Aa[2], Ag[4];
        { const int t = t0 + row; const bool first = (t % SEQ) == 0; const bf16* prow = F_PROJ + (size_t)t * NIN + ROFF; float z[8];
#pragma unroll
          for (int ks = 0; ks < 2; ++ks) { loadz8L(prow, first, mu, 1152 + ks * 32 + kq * 8, z);
#pragma unroll
              for (int j = 0; j < 8; ++j) z[j] = tanhf_(z[j]);
              Aw[ks] = __builtin_bit_cast(bf16x8, pack8(z)); }
#pragma unroll
          for (int ks = 0; ks < 2; ++ks) { loadz8L(prow, first, mu, 1216 + ks * 32 + kq * 8, z); Aa[ks] = __builtin_bit_cast(bf16x8, pack8(z)); }
#pragma unroll
          for (int ks = 0; ks < 4; ++ks) { loadz8L(prow, first, mu, 1280 + ks * 32 + kq * 8, z);
#pragma unroll
              for (int j = 0; j < 8; ++j) z[j] = sigmoidf_(z[j]);
              Ag[ks] = __builtin_bit_cast(bf16x8, pack8(z)); } }
#pragma unroll 1
        for (int hq = 0; hq < 6; ++hq) { const int hd_ = hq + F.wave + (int)(blockIdx.x >> 3); const int hd = hd_ % 6;
            const int t = t0 + tok; const bool first = (t % SEQ) == 0; const bf16* prow = F_PROJ + (size_t)t * NIN + ROFF; const int ch0 = hd * 64 + cq;
            float zr2[2][8], zk2[2][8], zv2[2][8];
#pragma unroll
            for (int sub = 0; sub < 2; ++sub) { loadz8L(prow, first, mu, ch0 + sub * 8, zr2[sub]); loadz8L(prow, first, mu, RW + ch0 + sub * 8, zk2[sub]); loadz8L(prow, first, mu, 2 * RW + ch0 + sub * 8, zv2[sub]); }
#pragma unroll
            for (int cgi = 0; cgi < 4; ++cgi) {
                const int ch = hd * 64 + cgi * 16 + row;
                f32x4 cw = (f32x4){0.f, 0.f, 0.f, 0.f}, ca = cw, cgt = cw;
#pragma unroll
                for (int ks = 0; ks < 2; ++ks) {
                    const bf16x8 bw = *(const bf16x8*)(WUT + (size_t)ch * 64 + ks * 32 + kq * 8); cw = __builtin_amdgcn_mfma_f32_16x16x32_bf16(Aw[ks], bw, cw, 0, 0, 0);
                    const bf16x8 ba = *(const bf16x8*)(AUT + (size_t)ch * 64 + ks * 32 + kq * 8); ca = __builtin_amdgcn_mfma_f32_16x16x32_bf16(Aa[ks], ba, ca, 0, 0, 0); }
#pragma unroll
                for (int ks = 0; ks < 4; ++ks) { const bf16x8 bg = *(const bf16x8*)(GUT + (size_t)ch * 128 + ks * 32 + kq * 8); cgt = __builtin_amdgcn_mfma_f32_16x16x32_bf16(Ag[ks], bg, cgt, 0, 0, 0); }
#pragma unroll
                for (int j = 0; j < 4; ++j) { LAS float* d = LW + (kq * 4 + j) * 68 + cgi * 16 + row; d[0] = cw[j]; d[16 * 68] = ca[j]; d[32 * 68] = cgt[j]; }
            }
            asm volatile("s_waitcnt lgkmcnt(0)" ::: "memory");
            float kkq[16], aq[16]; float ss = 0.f, dotp = 0.f;
#pragma unroll
            for (int sub = 0; sub < 2; ++sub) {
                const int ch = ch0 + sub * 8; const size_t idx = (size_t)t * RW + ch;
                float (&zr)[8] = zr2[sub]; float (&zk)[8] = zk2[sub]; float (&zv)[8] = zv2[sub];
                float gl[8], ldv[8], kpv[8];
                const LAS float* lw = LW + tok * 68 + cq + sub * 8;
#pragma unroll
                for (int hh = 0; hh < 2; ++hh) { const f32x4 x0 = *(const LAS f32x4*)(lw + 4 * hh), x1 = *(const LAS f32x4*)(lw + 16 * 68 + 4 * hh), x2 = *(const LAS f32x4*)(lw + 32 * 68 + 4 * hh);
                    const f32x4 p0 = *(const LAS f32x4*)(w0 + ch + 4 * hh), p1 = *(const LAS f32x4*)(a0 + ch + 4 * hh), p2 = *(const LAS f32x4*)(kkw + ch + 4 * hh), p3 = *(const LAS f32x4*)(kaw + ch + 4 * hh), p4 = *(const LAS f32x4*)(rkp + ch + 4 * hh);
#pragma unroll
                    for (int e = 0; e < 4; ++e) { const int j = 4 * hh + e;
                        gl[j] = x2[e];
                        const float xs = -(p0[e] + x0[e]); const float sp = fmaxf(xs, 0.f) + __logf(1.f + __expf(-fabsf(xs)));
                        ldv[j] = -__expf(-sp - 0.5f);
                        const float a = sigmoidf_(p1[e] + x1[e]);
                        const float kk = zk[j] * p2[e]; kpv[j] = zk[j] * (1.f + (a - 1.f) * p3[e]);
                        kkq[sub * 8 + j] = kk; aq[sub * 8 + j] = a; ss += kk * kk; dotp += zr[j] * kpv[j] * p4[e];
                    } }
                *(v4u*)(F_S_ld + idx) = pack8(ldv); *(v4u*)(F_S_k + idx) = pack8(kpv); *(v4u*)(F_S_g + idx) = pack8(gl);
            }
            ss += __shfl_xor(ss, 1); ss += __shfl_xor(ss, 2);
            dotp += __shfl_xor(dotp, 1); dotp += __shfl_xor(dotp, 2);
            if ((F.lane & 3) == 0) ((float*)((unsigned char*)F.out + WS_DOTS))[(size_t)t * 6 + hd] = dotp;
            const float inv = __builtin_amdgcn_rsqf(fmaxf(ss, 1e-24f));
#pragma unroll
            for (int sub = 0; sub < 2; ++sub) { float nn[8], bbv[8];
#pragma unroll
                for (int j = 0; j < 8; ++j) { const float kn = kkq[sub * 8 + j] * inv; nn[j] = -kn; bbv[j] = kn * aq[sub * 8 + j]; }
                const size_t idx = (size_t)t * RW + ch0 + sub * 8; *(v4u*)(F_S_n + idx) = pack8(nn); *(v4u*)(F_S_b + idx) = pack8(bbv); }
            asm volatile("s_waitcnt lgkmcnt(0)" ::: "memory");
        }
    }
}

DI void conv_phase(const Frame& F0, int l, int w0, int nw) { Frame F = refresh(F0);
    const float* cw_ = INP(F, 8) + l * 3 * 256;
    for (int it = w0; it < M / 2; it += nw) {
        const int t = it * 2 + (F.lane >> 5), c8 = (F.lane & 31) * 8, pos = t % SEQ;
        const bf16* base = F_PROJ + (size_t)t * NIN + COFF + c8;
        float b8[8], g8[8], u8[8], acc[8], w8[8];
        unpack8(*(const v4u*)base, b8);
#pragma unroll
        for (int j = 0; j < 8; ++j) acc[j] = 0.f;
#pragma unroll
        for (int d = 0; d < 3; ++d) {
            const int back = 2 - d;
            if (pos >= back) {
                const bf16* pb = base - (size_t)back * NIN;
                unpack8(*(const v4u*)(pb + 256), g8); unpack8(*(const v4u*)(pb + 512), u8);
                const f32x4 wa = *(const f32x4*)(cw_ + d * 256 + c8), wb = *(const f32x4*)(cw_ + d * 256 + c8 + 4);
                w8[0] = wa.x; w8[1] = wa.y; w8[2] = wa.z; w8[3] = wa.w; w8[4] = wb.x; w8[5] = wb.y; w8[6] = wb.z; w8[7] = wb.w;
#pragma unroll
                for (int j = 0; j < 8; ++j) acc[j] += w8[j] * (g8[j] * u8[j]);
            }
        }
#pragma unroll
        for (int j = 0; j < 8; ++j) acc[j] *= b8[j];
        __builtin_nontemporal_store(pack8(acc), (v4u*)(F_MIX + (size_t)t * DMODEL + 384 + c8));
    }
}

DI void post_phase(const Frame& F0, int l) { Frame F = refresh(F0);
    const float* lg = INP(F, 18) + l * RW; const float* lb = INP(F, 19) + l * RW; const float* mu = INP(F, 9) + l * RCOLS;
    for (int it = F.gw; it < M * 6 / 8; it += F.NGW) {
        const int pair = it * 8 + (F.lane >> 3), t = pair / 6, hd = pair % 6, ch = hd * 64 + (F.lane & 7) * 8;
        bf16* yp = F_MIX + (size_t)t * DMODEL + 640 + ch; const size_t idx = (size_t)t * RW + ch;
        float y[8], v[8], g[8], o[8];
        unpack8(*(const v4u*)yp, y); unpack8(*(const v4u*)(F_S_g + idx), g);
        loadz8(F_PROJ + (size_t)t * NIN + ROFF, (t % SEQ) == 0, mu, 2 * RW + ch, v);
        const float dot = ((const float*)((unsigned char*)F.out + WS_DOTS))[(size_t)t * 6 + hd];
        float s = 0.f;
#pragma unroll
        for (int j = 0; j < 8; ++j) s += y[j];
        s += __shfl_xor(s, 1); s += __shfl_xor(s, 2); s += __shfl_xor(s, 4);
        const float mean = s * (1.f / 64.f); float q = 0.f;
#pragma unroll
        for (int j = 0; j < 8; ++j) { const float d = y[j] - mean; q += d * d; }
        q += __shfl_xor(q, 1); q += __shfl_xor(q, 2); q += __shfl_xor(q, 4);
        const float rstd = 1.f / sqrtf(q * (1.f / 64.f) + GN_EPS);
#pragma unroll
        for (int j = 0; j < 8; ++j) o[j] = ((y[j] - mean) * rstd * lg[ch + j] + lb[ch + j] + dot * v[j]) * g[j];
        *(v4u*)yp = pack8(o);
    }
}


DI void scan_wg(const Frame& F0, int sw) { Frame F = refresh(F0);
    const int bh = sw >> 1, half = sw & 1, b = bh / 6, hd = bh % 6;
    const size_t tb = (size_t)b * SEQ; const int cb = hd * 64;
    LAS unsigned char* const lds = F.lds;
    constexpr int BUFB = 6 * 8192, YOFF = 2 * BUFB;
    const bool loader = F.wave >= 4; const int ltid = F.tid - 256;
#define SCAN_STAGE(c, bufsel, P0, NP, STRIDE) do { _Pragma("unroll") for (int i = 0; i < (NP); ++i) { const int p = (P0) + (STRIDE) * i, a = p >> 8, tt = (p & 255) >> 3, c8 = (p & 7) * 8; \
        const bf16* src = (a == 0 ? F_S_r : a == 1 ? F_S_ld : a == 2 ? F_S_k : a == 3 ? F_S_v : a == 4 ? F_S_n : F_S_b); \
        const v4u raw = *(const v4u*)(src + (tb + (size_t)(c) * 32 + tt) * RW + cb + c8); \
        float f[8]; unpack8(raw, f); if (a == 1) { _Pragma("unroll") for (int j = 0; j < 8; ++j) f[j] = __expf(f[j]); } \
        LAS f32x4* d = (LAS f32x4*)(lds + (bufsel) * BUFB + a * 8192 + tt * 256 + c8 * 4); d[0] = (f32x4){f[0], f[1], f[2], f[3]}; d[1] = (f32x4){f[4], f[5], f[6], f[7]}; } } while (0)
#define SCAN_YOUT(c, bufsel) do { _Pragma("unroll") for (int i = 0; i < 2; ++i) { const int e = ltid + 256 * i, tt = e >> 4, r2 = (e & 15) * 2; \
        const LAS float* ys = (const LAS float*)(lds + YOFF + (bufsel) * 4096) + tt * 32 + r2; \
        *(unsigned*)(F_MIX + (tb + (size_t)(c) * 32 + tt) * DMODEL + 640 + cb + half * 32 + r2) = pk2(ys[0], ys[1]); } } while (0)
    SCAN_STAGE(0, 0, F.tid, 3, 512);
    __syncthreads();
    typedef float f32x2v __attribute__((ext_vector_type(2)));
    const int rp = F.wave * 8 + (F.lane >> 4) * 2, kp = F.lane & 15;
    f32x4 s0 = (f32x4){0.f, 0.f, 0.f, 0.f}, s1 = s0;
#pragma unroll 1
    for (int c = 0; c < SEQ / 32; ++c) {
        const int cur = c & 1;
        if (loader) {
            if (c + 1 < SEQ / 32) SCAN_STAGE(c + 1, cur ^ 1, ltid, 6, 256);
            if (c > 0) SCAN_YOUT(c - 1, cur ^ 1);
        } else {
            const LAS unsigned char* bb = lds + cur * BUFB + kp * 16;
            const LAS unsigned char* vb = lds + cur * BUFB + 3 * 8192 + (half * 32 + rp) * 4;
            LAS f32x2v* yb = (LAS f32x2v*)(lds + YOFF + cur * 4096 + rp * 4);
            f32x4 rv = *(const LAS f32x4*)(bb + 0 * 8192), wv = *(const LAS f32x4*)(bb + 1 * 8192), kv = *(const LAS f32x4*)(bb + 2 * 8192);
            f32x4 nv = *(const LAS f32x4*)(bb + 4 * 8192), bv = *(const LAS f32x4*)(bb + 5 * 8192);
            f32x2v vv = *(const LAS f32x2v*)(vb);
#pragma unroll 8
            for (int tt = 0; tt < 32; ++tt) {
                const int tn = (tt + 1) & 31;
                const f32x4 rv2 = *(const LAS f32x4*)(bb + 0 * 8192 + tn * 256), wv2 = *(const LAS f32x4*)(bb + 1 * 8192 + tn * 256), kv2 = *(const LAS f32x4*)(bb + 2 * 8192 + tn * 256);
                const f32x4 nv2 = *(const LAS f32x4*)(bb + 4 * 8192 + tn * 256), bv2 = *(const LAS f32x4*)(bb + 5 * 8192 + tn * 256);
                const f32x2v vv2 = *(const LAS f32x2v*)(vb + tn * 256);
                f32x2v d0 = (f32x2v){s0.x, s0.y} * (f32x2v){nv.x, nv.y}; d0 = (f32x2v){s0.z, s0.w} * (f32x2v){nv.z, nv.w} + d0;
                f32x2v d1 = (f32x2v){s1.x, s1.y} * (f32x2v){nv.x, nv.y}; d1 = (f32x2v){s1.z, s1.w} * (f32x2v){nv.z, nv.w} + d1;
                const float sa0 = red16(d0.x + d0.y), sa1 = red16(d1.x + d1.y);
                const f32x4 q0 = s0 * wv + kv * vv.x, q1 = s1 * wv + kv * vv.y;
                s0 = bv * sa0 + q0; s1 = bv * sa1 + q1;
                f32x2v y0 = (f32x2v){s0.x, s0.y} * (f32x2v){rv.x, rv.y}; y0 = (f32x2v){s0.z, s0.w} * (f32x2v){rv.z, rv.w} + y0;
                f32x2v y1 = (f32x2v){s1.x, s1.y} * (f32x2v){rv.x, rv.y}; y1 = (f32x2v){s1.z, s1.w} * (f32x2v){rv.z, rv.w} + y1;
                const float ya = red16(y0.x + y0.y), yc = red16(y1.x + y1.y);
                yb[tt * 16] = (f32x2v){ya, yc};
                rv = rv2; wv = wv2; kv = kv2; nv = nv2; bv = bv2; vv = vv2;
            }
        }
        __syncthreads();
    }
    if (loader) SCAN_YOUT(SEQ / 32 - 1, (SEQ / 32 - 1) & 1);
#undef SCAN_STAGE
#undef SCAN_YOUT
    __syncthreads();
}

typedef float f32x16 __attribute__((ext_vector_type(16)));
typedef short s16x4 __attribute__((ext_vector_type(4)));
DI int crow_(int r, int h) { return (r & 3) + 8 * (r >> 2) + 4 * h; }
typedef float f32x2c __attribute__((ext_vector_type(2))); typedef __bf16 bf16x2c __attribute__((ext_vector_type(2)));
DI unsigned cvtpk(float lo, float hi) { f32x2c v = {lo, hi}; bf16x2c b = __builtin_convertvector(v, bf16x2c); return __builtin_bit_cast(unsigned, b); }
DI bf16x8 packregs(const f32x16& x, int s) {
    v4u p; p.x = cvtpk(x[8 * s + 0], x[8 * s + 1]); p.y = cvtpk(x[8 * s + 2], x[8 * s + 3]); p.z = cvtpk(x[8 * s + 4], x[8 * s + 5]); p.w = cvtpk(x[8 * s + 6], x[8 * s + 7]);
    return __builtin_bit_cast(bf16x8, p);
}
DI bf16x8 cat44(s16x4 lo, s16x4 hi) { return __builtin_shufflevector(lo, hi, 0, 1, 2, 3, 4, 5, 6, 7); }
#define MFMA32(a, b, c) __builtin_amdgcn_mfma_f32_32x32x16_bf16((a), (b), (c), 0, 0, 0)

DI void cprep_phase(const Frame& F0, int l) { Frame F = refresh(F0);
    const float* mu_ = INP(F, 9) + l * RCOLS;
    LAS unsigned char* const W = F.lds + F.wave * 16384;
    const int lane = F.lane, r32 = lane & 31, h = lane >> 5;
    const bool local = (F.NGW == M / 16);
    for (int it_ = 0; it_ < (local ? 3 : (NITEMS + F.NGW - 1) / F.NGW); ++it_) {
        int item;
        if (local) { const int li = F.wave * 3 + it_, cg_ = 4 * (int)blockIdx.x + li / 6; item = ((cg_ >> 7) * 6 + li % 6) * 128 + (cg_ & 127); }
        else { item = F.gw + it_ * F.NGW; if (item >= NITEMS) break; }
        const int bh = item >> 7, c = item & 127, b = bh / 6, hd = bh % 6;
        const size_t row0 = (size_t)b * SEQ + (size_t)c * 32;
        const size_t sbase = row0 * RW + hd * 64;
        {
            float lp = 0.f, Pcur = 1.f; unsigned btp[16], ktp[16], vtp[16]; float bprev = 0.f, kprev = 0.f, vprev = 0.f;
            const bf16* pj = F_PROJ + row0 * NIN + ROFF + hd * 64 + lane;
            const float mur = mu_[hd * 64 + lane], muv = mu_[2 * RW + hd * 64 + lane];
            float pr_prev = 0.f, pv_prev = 0.f; if (c != 0) { pr_prev = bf1(pj - NIN); pv_prev = bf1(pj - NIN + 2 * RW); }
#pragma unroll
            for (int hf = 0; hf < 4; ++hf) {
                unsigned short raw[8][6];
#pragma unroll
                for (int tq = 0; tq < 8; ++tq) { const size_t e = sbase + (size_t)(8 * hf + tq) * RW + lane; raw[tq][0] = F_S_ld[e]; raw[tq][1] = pj[(size_t)(8 * hf + tq) * NIN]; raw[tq][2] = F_S_n[e]; raw[tq][3] = F_S_b[e]; raw[tq][4] = F_S_k[e]; raw[tq][5] = pj[(size_t)(8 * hf + tq) * NIN + 2 * RW]; }
#pragma unroll
                for (int tq = 0; tq < 8; ++tq) { const int t = 8 * hf + tq;
                    const float ldv = __uint_as_float((unsigned)raw[tq][0] << 16), prw = __uint_as_float((unsigned)raw[tq][1] << 16), nn = __uint_as_float((unsigned)raw[tq][2] << 16), bb = __uint_as_float((unsigned)raw[tq][3] << 16), kk = __uint_as_float((unsigned)raw[tq][4] << 16), pvw = __uint_as_float((unsigned)raw[tq][5] << 16);
                    const float rr = prw + mur * (pr_prev - prw), vv = pvw + muv * (pv_prev - pvw); pr_prev = prw; pv_prev = pvw;
                    lp += ldv;
                    const float Pp = Pcur; const float P = __expf(lp), iP = __builtin_amdgcn_rcpf(P); Pcur = P;
                    const float rt = rr * P, nt = nn * Pp, bt = bb * iP, kt = kk * iP;
                    const int sw = (((lane >> 3) ^ (t & 7)) << 4) + (lane & 7) * 2 + t * 128;
                    *(LAS bf16*)(W + sw) = (bf16)f2bf(rt); *(LAS bf16*)(W + 4096 + sw) = (bf16)f2bf(nt); *(LAS bf16*)(W + 8192 + sw) = (bf16)f2bf(bt); *(LAS bf16*)(W + 12288 + sw) = (bf16)f2bf(kt);
                    if (t & 1) { btp[t >> 1] = pk2(bprev, bt); ktp[t >> 1] = pk2(kprev, kt); vtp[t >> 1] = pk2(vprev, vv); } else { bprev = bt; kprev = kt; vprev = vv; }
                }
            }
            ((float*)((unsigned char*)F.out + WS_PT))[(size_t)item * 64 + lane] = Pcur;
            const size_t te = sbase + (size_t)(lane >> 1) * RW + (lane & 1) * 32;
#pragma unroll
            for (int q = 0; q < 4; ++q) {
                *(v4u*)(F_S_b + te + q * 8) = (v4u){btp[4 * q], btp[4 * q + 1], btp[4 * q + 2], btp[4 * q + 3]};
                *(v4u*)(F_S_k + te + q * 8) = (v4u){ktp[4 * q], ktp[4 * q + 1], ktp[4 * q + 2], ktp[4 * q + 3]};
                *(v4u*)(F_S_ld + te + q * 8) = (v4u){vtp[4 * q], vtp[4 * q + 1], vtp[4 * q + 2], vtp[4 * q + 3]};
            }
        }
        asm volatile("s_waitcnt lgkmcnt(0)" ::: "memory");
        f32x16 Cnb, Cnk, Crb, Crk;
#pragma unroll
        for (int i = 0; i < 16; ++i) { Cnb[i] = 0.f; Cnk[i] = 0.f; Crb[i] = 0.f; Crk[i] = 0.f; }
#pragma unroll
        for (int s4 = 0; s4 < 4; ++s4) {
            const int fo = r32 * 128 + (((2 * s4 + h) ^ (r32 & 7)) << 4);
            const bf16x8 aR = *(const LAS bf16x8*)(W + fo), aN = *(const LAS bf16x8*)(W + 4096 + fo), bB = *(const LAS bf16x8*)(W + 8192 + fo), bK = *(const LAS bf16x8*)(W + 12288 + fo);
            Cnb = MFMA32(aN, bB, Cnb); Cnk = MFMA32(aN, bK, Cnk); Crb = MFMA32(aR, bB, Crb); Crk = MFMA32(aR, bK, Crk);
        }
#pragma unroll
        for (int i = 0; i < 16; ++i) { const int t = crow_(i, h); if (!(r32 < t)) { Cnb[i] = 0.f; Cnk[i] = 0.f; } if (!(r32 <= t)) { Crb[i] = 0.f; Crk[i] = 0.f; } }
        asm volatile("s_waitcnt lgkmcnt(0)" ::: "memory");
#pragma unroll
        for (int q = 0; q < 4; ++q) { const int p = lane + 64 * q, rr_ = p >> 3, cc = p & 7;
            *(v4u*)(F_S_r + sbase + (size_t)rr_ * RW + cc * 8) = *(const LAS v4u*)(W + rr_ * 128 + ((cc ^ (rr_ & 7)) << 4)); }
#pragma unroll
        for (int i = 0; i < 16; ++i) *(LAS float*)(W + 8192 + crow_(i, h) * 144 + r32 * 4) = Cnb[i];
        asm volatile("s_waitcnt lgkmcnt(0)" ::: "memory");
        {
            float X[32];
#pragma unroll
            for (int t = 0; t < 32; ++t) {
                float a0 = (t == r32) ? 1.f : 0.f, a1 = 0.f;
#pragma unroll
                for (int i4 = 0; i4 < (t + 3) / 4; ++i4) {
                    const f32x4 Lr = *(const LAS f32x4*)(W + 8192 + t * 144 + i4 * 16);
#pragma unroll
                    for (int e = 0; e < 4; ++e) { const int i = 4 * i4 + e; if (i < t) { if (e & 1) a1 += Lr[e] * X[i]; else a0 += Lr[e] * X[i]; } }
                }
                X[t] = a0 + a1;
            }
            asm volatile("s_waitcnt lgkmcnt(0)" ::: "memory");
#pragma unroll
            for (int t = 0; t < 32; ++t) *(LAS bf16*)(W + 12800 + t * 64 + r32 * 2) = (bf16)f2bf(X[t]);
        }
        asm volatile("s_waitcnt lgkmcnt(0)" ::: "memory");
        f32x16 Cw[2];
#pragma unroll
        for (int nt = 0; nt < 2; ++nt) {
#pragma unroll
            for (int i = 0; i < 16; ++i) Cw[nt][i] = 0.f;
#pragma unroll
            for (int s = 0; s < 2; ++s) {
                const bf16x8 a = *(const LAS bf16x8*)(W + 12800 + r32 * 64 + (2 * s + h) * 16);
                const int ch = 32 * nt + r32; unsigned short e[8];
#pragma unroll
                for (int j = 0; j < 8; ++j) { const int i = 16 * s + 8 * h + j; e[j] = *(const LAS bf16*)(W + 4096 + i * 128 + (((ch >> 3) ^ (i & 7)) << 4) + (ch & 7) * 2); }
                v4u bw; bw.x = e[0] | ((unsigned)e[1] << 16); bw.y = e[2] | ((unsigned)e[3] << 16); bw.z = e[4] | ((unsigned)e[5] << 16); bw.w = e[6] | ((unsigned)e[7] << 16);
                Cw[nt] = MFMA32(a, __builtin_bit_cast(bf16x8, bw), Cw[nt]);
            }
        }
        f32x16 Cm;
#pragma unroll
        for (int i = 0; i < 16; ++i) Cm[i] = 0.f;
#pragma unroll
        for (int s = 0; s < 2; ++s) {
            const s16x4 lo = *(const LAS s16x4*)(W + 12800 + r32 * 64 + (16 * s + 4 * h) * 2), hi = *(const LAS s16x4*)(W + 12800 + r32 * 64 + (16 * s + 8 + 4 * h) * 2);
            Cm = MFMA32(cat44(lo, hi), packregs(Cnk, s), Cm);
        }
        asm volatile("s_waitcnt lgkmcnt(0)" ::: "memory");
#pragma unroll
        for (int nt = 0; nt < 2; ++nt)
#pragma unroll
            for (int i = 0; i < 16; ++i) *(LAS bf16*)(W + crow_(i, h) * 128 + (32 * nt + r32) * 2) = (bf16)f2bf(Cw[nt][i]);
#pragma unroll
        for (int i = 0; i < 16; ++i) { const int o = crow_(i, h) * 64 + r32 * 2;
            *(LAS bf16*)(W + 4096 + o) = (bf16)f2bf(Crb[i]); *(LAS bf16*)(W + 6144 + o) = (bf16)f2bf(Cm[i]); *(LAS bf16*)(W + 8192 + o) = (bf16)f2bf(Crk[i]); }
        asm volatile("s_waitcnt lgkmcnt(0)" ::: "memory");
#pragma unroll
        for (int q = 0; q < 4; ++q) { const int p = lane + 64 * q, rr = p >> 3, cc = p & 7;
            *(v4u*)(F_S_n + sbase + (size_t)rr * RW + cc * 8) = *(const LAS v4u*)(W + rr * 128 + cc * 16); }
#pragma unroll
        for (int q = 0; q < 2; ++q) { const int p = lane + 64 * q, mr = p >> 2, cc = p & 3;
            *(v4u*)(F_S_v + sbase + (size_t)(mr >> 1) * RW + (mr & 1) * 32 + cc * 8) = *(const LAS v4u*)(W + 4096 + mr * 64 + cc * 16);
            *(v4u*)(F_S_v + sbase + (size_t)(16 + (mr >> 1)) * RW + (mr & 1) * 32 + cc * 8) = *(const LAS v4u*)(W + 6144 + mr * 64 + cc * 16);
            *(v4u*)((bf16*)((unsigned char*)F.out + WS_AUX) + (size_t)item * 1024 + mr * 32 + cc * 8) = *(const LAS v4u*)(W + 8192 + mr * 64 + cc * 16); }
        asm volatile("s_waitcnt vmcnt(0) lgkmcnt(0)" ::: "memory");
    }
}

DI void cs_consume(const LAS unsigned char* B, LAS unsigned char* ybuf, f32x16 (&Hacc)[2], bf16x8 (&Hpk)[2][2], int r32, int h, int vh) {
    bf16x8 Vf[2];
#pragma unroll
    for (int s = 0; s < 2; ++s) Vf[s] = *(const LAS bf16x8*)(B + 19456 + (32 * vh + r32) * 80 + (2 * s + h) * 16);
    f32x16 U;
#pragma unroll
    for (int i = 0; i < 16; ++i) U[i] = 0.f;
#pragma unroll
    for (int kt = 0; kt < 2; ++kt)
#pragma unroll
        for (int s = 0; s < 2; ++s) { const LAS unsigned char* ap = B + r32 * 144 + (32 * kt + 16 * s + 4 * h) * 2;
            U = MFMA32(cat44(*(const LAS s16x4*)ap, *(const LAS s16x4*)(ap + 16)), Hpk[kt][s], U); }
#pragma unroll
    for (int s = 0; s < 2; ++s) U = MFMA32(*(const LAS bf16x8*)(B + 27136 + r32 * 80 + (2 * s + h) * 16), Vf[s], U);
    bf16x8 Upk[2]; Upk[0] = packregs(U, 0); Upk[1] = packregs(U, 1);
    f32x16 Y;
#pragma unroll
    for (int i = 0; i < 16; ++i) Y[i] = 0.f;
#pragma unroll
    for (int kt = 0; kt < 2; ++kt)
#pragma unroll
        for (int s = 0; s < 2; ++s) { const LAS unsigned char* ap = B + 4608 + r32 * 144 + (32 * kt + 16 * s + 4 * h) * 2;
            Y = MFMA32(cat44(*(const LAS s16x4*)ap, *(const LAS s16x4*)(ap + 16)), Hpk[kt][s], Y); }
#pragma unroll
    for (int s = 0; s < 2; ++s) { const LAS unsigned char* ap = B + 24576 + r32 * 80 + (16 * s + 4 * h) * 2;
        Y = MFMA32(cat44(*(const LAS s16x4*)ap, *(const LAS s16x4*)(ap + 16)), Upk[s], Y);
        Y = MFMA32(*(const LAS bf16x8*)(B + 29696 + r32 * 80 + (2 * s + h) * 16), Vf[s], Y); }
    {   LAS float* yb = (LAS float*)ybuf + 32 * vh + r32;
#pragma unroll
        for (int i = 0; i < 16; ++i) yb[crow_(i, h) * 64] = Y[i]; }
#pragma unroll
    for (int kt = 0; kt < 2; ++kt) {
        f32x16 acc = Hacc[kt];
#pragma unroll
        for (int s = 0; s < 2; ++s) { const LAS unsigned char* ap = B + 9216 + (32 * kt + r32) * 80 + (16 * s + 4 * h) * 2;
            acc = MFMA32(cat44(*(const LAS s16x4*)ap, *(const LAS s16x4*)(ap + 16)), Upk[s], acc);
            acc = MFMA32(*(const LAS bf16x8*)(B + 14336 + (32 * kt + r32) * 80 + (2 * s + h) * 16), Vf[s], acc); }
#pragma unroll
        for (int g = 0; g < 4; ++g) { const f32x4 pt = *(const LAS f32x4*)(B + 32256 + (32 * kt + 8 * g + 4 * h) * 4);
            acc[4 * g] *= pt.x; acc[4 * g + 1] *= pt.y; acc[4 * g + 2] *= pt.z; acc[4 * g + 3] *= pt.w; }
        Hacc[kt] = acc; Hpk[kt][0] = packregs(acc, 0); Hpk[kt][1] = packregs(acc, 1);
    }
}

DI void cscan_wg(const Frame& F0, int bh, int l) { Frame F = refresh(F0);
    const int b = bh / 6, hd = bh % 6; const size_t tb = (size_t)b * SEQ; const int cb = hd * 64;
    LAS unsigned char* const lds = F.lds;
    constexpr int BUFB = 32512, YOFF = 3 * BUFB, YB = 8192, NCH = SEQ / 32;
    const int ltid = F.tid - 128;
    const bool loader = F.wave >= 2;
    v4u st0[5], st1[5], st2[5], st3[5];
#define CS_LOAD(c, ST) do { const size_t sb_ = (tb + (size_t)(c) * 32) * RW + cb; const int item_ = bh * 128 + (c); \
        _Pragma("unroll") for (int i = 0; i < 5; ++i) { const int p = ltid + 384 * i; \
            if (p < 1536) { const int a = p >> 8, sr = (p >> 3) & 31, cc = p & 7;              \
                const bf16* src = (a == 0 ? F_S_n : a == 1 ? F_S_r : a == 2 ? F_S_b : a == 3 ? F_S_k : a == 4 ? F_S_ld : F_S_v); \
                ST[i] = __builtin_nontemporal_load((const v4u*)(src + sb_ + (size_t)sr * RW + cc * 8)); } \
            else if (p < 1664) { const int q = p - 1536, mr = q >> 2, cc = q & 3; ST[i] = __builtin_nontemporal_load((const v4u*)((const bf16*)((unsigned char*)F.out + WS_AUX) + (size_t)item_ * 1024 + mr * 32 + cc * 8)); } \
            else if (p < 1680) { const int q = p - 1664; ST[i] = __builtin_nontemporal_load((const v4u*)((const float*)((unsigned char*)F.out + WS_PT) + (size_t)item_ * 64 + q * 4)); } } } while (0)
#define CS_WRITE(bufsel, ST) do { LAS unsigned char* B_ = lds + (bufsel) * BUFB; \
        _Pragma("unroll") for (int i = 0; i < 5; ++i) { const int p = ltid + 384 * i; \
            if (p < 1536) { const int a = p >> 8, sr = (p >> 3) & 31, cc = p & 7; \
                int dst; if (a < 2) dst = a * 4608 + sr * 144 + cc * 16; else if (a < 5) dst = 9216 + (a - 2) * 5120 + (2 * sr + (cc >> 2)) * 80 + (cc & 3) * 16; \
                else dst = 24576 + (sr >> 4) * 2560 + ((2 * sr + (cc >> 2)) & 31) * 80 + (cc & 3) * 16; \
                *(LAS v4u*)(B_ + dst) = ST[i]; } \
            else if (p < 1664) { const int q = p - 1536, mr = q >> 2, cc = q & 3; *(LAS v4u*)(B_ + 29696 + mr * 80 + cc * 16) = ST[i]; } \
            else if (p < 1680) { const int q = p - 1664; *(LAS v4u*)(B_ + 32256 + q * 16) = ST[i]; } } } while (0)
    const int pt_ = (ltid >> 3) & 31, v8 = (ltid & 7) * 8;
    float lgv[8], lbv[8]; v4u gq = (v4u){0u, 0u, 0u, 0u}; float dq = 0.f;
    if (loader) { const float* lg = INP(F, 18) + l * RW + cb + v8; const float* lb = INP(F, 19) + l * RW + cb + v8;
#pragma unroll
        for (int j = 0; j < 8; ++j) { lgv[j] = lg[j]; lbv[j] = lb[j]; } }
#define CS_GLOAD(c) do { if (ltid < 256) { const size_t row_ = tb + (size_t)(c) * 32 + pt_; gq = __builtin_nontemporal_load((const v4u*)(F_S_g + row_ * RW + cb + v8)); dq = __builtin_nontemporal_load(((const float*)((unsigned char*)F.out + WS_DOTS)) + row_ * 6 + hd); } } while (0)
#define CS_POST(c, ybsel, bufsel) do { if (ltid < 256) { const LAS float* ys = (const LAS float*)(lds + YOFF + (ybsel) * YB) + pt_ * 64 + v8; \
        float y[8], g[8], o[8]; const f32x4 y0 = *(const LAS f32x4*)ys, y1 = *(const LAS f32x4*)(ys + 4); y[0] = y0.x; y[1] = y0.y; y[2] = y0.z; y[3] = y0.w; y[4] = y1.x; y[5] = y1.y; y[6] = y1.z; y[7] = y1.w; \
        unpack8(gq, g); float s = 0.f; _Pragma("unroll") for (int j = 0; j < 8; ++j) s += y[j]; \
        s += __shfl_xor(s, 1); s += __shfl_xor(s, 2); s += __shfl_xor(s, 4); const float mean = s * (1.f / 64.f); float q = 0.f; \
        _Pragma("unroll") for (int j = 0; j < 8; ++j) { const float d = y[j] - mean; q += d * d; } \
        q += __shfl_xor(q, 1); q += __shfl_xor(q, 2); q += __shfl_xor(q, 4); const float rstd = __builtin_amdgcn_rsqf(q * (1.f / 64.f) + GN_EPS); \
        const LAS unsigned char* vt = lds + (bufsel) * BUFB + 19456 + v8 * 80 + pt_ * 2; \
        _Pragma("unroll") for (int j = 0; j < 8; ++j) { const float vv = __uint_as_float(((unsigned)*(const LAS bf16*)(vt + j * 80)) << 16); o[j] = ((y[j] - mean) * rstd * lgv[j] + lbv[j] + dq * vv) * g[j]; } \
        __builtin_nontemporal_store(pack8(o), (v4u*)(F_MIX + (tb + (size_t)(c) * 32 + pt_) * DMODEL + 640 + cb + v8)); } } while (0)
    if (loader) {
        CS_LOAD(0, st0); CS_WRITE(0, st0); CS_LOAD(1, st1); CS_LOAD(2, st2);
        __syncthreads();
        int bn = 1, bp = 2, bc = 0;
#define CS_LITER(c, STW, LDN) do { const int cur = (c) & 1; \
            if ((c) + 3 < NCH) CS_LOAD((c) + 3, LDN); \
            if ((c) > 0) CS_POST((c) - 1, cur ^ 1, bp); \
            CS_GLOAD(c); \
            if ((c) + 1 < NCH) CS_WRITE(bn, STW); \
            __syncthreads(); { const int t_ = bp; bp = bc; bc = bn; bn = t_; } } while (0)
#pragma unroll 1
        for (int c4 = 0; c4 < NCH; c4 += 4) { CS_LITER(c4, st1, st3); CS_LITER(c4 + 1, st2, st0); CS_LITER(c4 + 2, st3, st1); CS_LITER(c4 + 3, st0, st2); }
        CS_POST(NCH - 1, (NCH - 1) & 1, bp);
#undef CS_LITER
    } else {
        const int lane = F.lane, r32 = lane & 31, h = lane >> 5, vh = F.wave;
        f32x16 Hacc[2]; bf16x8 Hpk[2][2];
#pragma unroll
        for (int kt = 0; kt < 2; ++kt) {
#pragma unroll
            for (int i = 0; i < 16; ++i) Hacc[kt][i] = 0.f;
            Hpk[kt][0] = bf16x8{0, 0, 0, 0, 0, 0, 0, 0}; Hpk[kt][1] = bf16x8{0, 0, 0, 0, 0, 0, 0, 0}; }
        __syncthreads();
        int bc = 0;
#pragma unroll 1
        for (int c = 0; c < NCH; ++c) { cs_consume(lds + bc * BUFB, lds + YOFF + (c & 1) * YB, Hacc, Hpk, r32, h, vh); __syncthreads(); bc = (bc == 2) ? 0 : bc + 1; }
    }
#undef CS_LOAD
#undef CS_WRITE
#undef CS_GLOAD
#undef CS_POST
    __syncthreads();
}

DI void mix_phase(const Frame& F0, int l, char* ldsg) { Frame F = refresh(F0);
#ifndef SKIP_SCAN
    if ((int)blockIdx.x < SCAN_WGS) { cscan_wg(F, (int)blockIdx.x, l); }
    else { const int nw_ = (F.G - SCAN_WGS) * NWAVES, w0_ = ((int)blockIdx.x - SCAN_WGS) * NWAVES + F.wave;
        conv_phase(F, l, w0_, nw_); if (l == 0) prologue<true>(F, 1, w0_, nw_); __syncthreads(); }
#endif
    const float* lq1 = INP(F, 3) + l * 32; const float* lk1 = INP(F, 4) + l * 32; const float* lq2 = INP(F, 5) + l * 32; const float* lk2 = INP(F, 6) + l * 32;
    float d1 = 0.f, d2 = 0.f;
    for (int i = 0; i < 32; ++i) { d1 += lq1[i] * lk1[i]; d2 += lq2[i] * lk2[i]; }
    const float lambda_init = (l == 0) ? 0.2f : 0.35550906759f;
    const float lam = __expf(d1) - __expf(d2) + lambda_init;
    const float* sg = INP(F, 7) + l * 64;
    volatile LAS unsigned* qslot = (volatile LAS unsigned*)(F.lds + MISC_OFF + 64);
    const int myx = (int)(xb_xcc_id() & 7u);
    int qk = 0;
    for (;;) {
        if (F.tid == 0) { unsigned got = 0xffffffffu; int k = qk;
            for (; k < 8; ++k) { const int x = (myx + k) & 7; const unsigned v = atomicAdd(F_ctl + 64 * (1 + 8 * l + x), 1u); if (v < 96u) { got = (unsigned)x * 96u + v; break; } }
            qslot[0] = got; qslot[1] = (unsigned)k; }
        __syncthreads();
        const unsigned idx = (unsigned)__builtin_amdgcn_readfirstlane((int)qslot[0]); qk = __builtin_amdgcn_readfirstlane((int)qslot[1]);
        __syncthreads();
        if (idx == 0xffffffffu) break;
        const int xq = (int)(idx / 96u), iq = (int)(idx % 96u), qb = 15 - (iq & 15), bh = xq * 6 + (iq >> 4), b = bh / 6, h = bh % 6;
        const attn_body::bf16* P = (const attn_body::bf16*)F_PROJ;
#ifndef SKIP_ATT
#pragma unroll 1
        for (int ns = 0; ns < 2; ++ns)
            attn_body::attn_unit<8>(b, h, qb, ns, lam, sg, 1.f - lambda_init, P, P + 384, P + 768, (attn_body::bf16*)F_MIX, ldsg);
#endif
    }
}

__global__ void __launch_bounds__(NWAVES * 64, 2) mega_fwd(Args args) {
    extern __shared__ __attribute__((aligned(16))) unsigned char lds[];
    cg::grid_group grid = cg::this_grid();
    Frame F;
    F.lds = (LAS unsigned char*)lds;
    F.tid = threadIdx.x; F.lane = F.tid & 63; F.wave = __builtin_amdgcn_readfirstlane(F.tid >> 6);
    F.G = gridDim.x; F.gw = (int)blockIdx.x * NWAVES + F.wave; F.NGW = F.G * NWAVES;
    F.in = args.in; F.out = args.out; F.ws = args.ws;
    const int G = F.G;
    if (F.tid < 32) ((LAS unsigned*)(F.lds + MISC_OFF))[F.tid] = 0u;
    __syncthreads();
    XcdBarrier bar = xcd_barrier_post((unsigned*)(args.ws + WS_CTL) + CW_BAR, (volatile LAS unsigned*)(F.lds + MISC_OFF) + 8);

    prologue<false>(F, 0, F.gw, F.NGW);
    x_to_bf16(F, INP(F, 0), F_XB, SSP(4));
    if (args.i0 != 0) grid.sync();
    xcd_barrier(bar);
#pragma unroll 1
    for (int l = 0; l < 2; ++l) {
        {
            pg8::Gemm g{F_XB, F_WIN + (size_t)l * NIN * DMODEL, M, NIN, DMODEL}; pg8::StaticOrder S; int bx = blockIdx.x; asm volatile("" : "+s"(bx)); S.init(M, NIN, G, bx);
            pg8::EpiBf16S<0> E{F_PROJ, NIN, (const float*)SSP(l == 0 ? 4 : 1)};
            GEMMCALL0 pg8::gemm_phase<pg8::EpiBf16S<0>, pg8::StaticOrder, true, true>(F.lds, g, S, E);
            if (PROBE & 1) { __syncthreads(); pg8::gemm_phase<pg8::EpiBf16S<0>, pg8::StaticOrder, true, true>(F.lds, g, S, E); }
        }
        xcd_barrier(bar);
#ifndef SKIP_PREP
        prep_phase(F, l);
#endif
        if (F.NGW == M / 16) {
            asm volatile("s_waitcnt vmcnt(0)" ::: "memory"); __syncthreads(); __builtin_amdgcn_fence(__ATOMIC_ACQUIRE, "agent"); asm volatile("s_waitcnt vmcnt(0)" ::: "memory");
        } else xcd_barrier(bar);
        cprep_phase(F, l);
        seam_arrive((unsigned*)(args.ws + WS_CTL) + 64 * (20 + l));
        if ((int)blockIdx.x < SCAN_WGS) seam_wait((unsigned*)(args.ws + WS_CTL) + 64 * (20 + l), gridDim.x);
        mix_phase(F, l, (char*)lds);
        xcd_barrier(bar);
        {
            pg8::Gemm g{F_MIX, F_WOUT + (size_t)l * DMODEL * DMODEL, M, DMODEL, DMODEL}; pg8::StaticOrder S; int bx = blockIdx.x; asm volatile("" : "+s"(bx)); S.init(M, DMODEL, G, bx);
            float* ssp = SSP(2 * l);
            pg8::EpiResBf16<false> E{nullptr, F_XB, DMODEL, ssp};
            pg8::gemm_phase<pg8::EpiResBf16<false>, pg8::StaticOrder, true, true>(F.lds, g, S, E);
        }
        xcd_barrier(bar);
        {
            pg8::Gemm g{F_XB, F_WUP + (size_t)l * FF * DMODEL, M, FF, DMODEL}; pg8::StaticOrder S; int bx = blockIdx.x; asm volatile("" : "+s"(bx)); S.init(M, FF, G, bx);
            pg8::EpiBf16S<2> E{F_HID, FF, (const float*)SSP(2 * l)};
            GEMMCALL2 pg8::gemm_phase<pg8::EpiBf16S<2>, pg8::StaticOrder, true, true>(F.lds, g, S, E);
            if (PROBE & 1) { __syncthreads(); pg8::gemm_phase<pg8::EpiBf16S<2>, pg8::StaticOrder, true, true>(F.lds, g, S, E); }
        }
        xcd_barrier(bar);
        {
            pg8::Gemm g{F_HID, F_WDN + (size_t)l * DMODEL * FF, M, DMODEL, FF}; pg8::StaticOrder S; int bx = blockIdx.x; asm volatile("" : "+s"(bx)); S.init(M, DMODEL, G, bx);
            pg8::EpiResBf16<false> E{nullptr, F_XB, DMODEL, SSP(2 * l + 1)};
            pg8::gemm_phase<pg8::EpiResBf16<false>, pg8::StaticOrder, true, true>(F.lds, g, S, E);
        }
        xcd_barrier(bar);
    }
    final_norm(F, F_XB, F.out, INP(F, 24));
}

extern "C" void kernel_launch(void* const* d_in, const int* in_sizes, int n_in, void* d_out, int out_size, void* d_ws, size_t ws_size, hipStream_t stream) {
    static int grid = 0;
    if (grid == 0) {
        if (n_in != 25 || in_sizes[0] != M * DMODEL || out_size != M * DMODEL || ws_size < WS_END) {
            fprintf(stderr, "kernel_launch: unexpected problem geometry (n_in %d, in0 %d, out %d, ws %zu)\n", n_in, n_in > 0 ? in_sizes[0] : -1, out_size, ws_size); grid = -1; return; }
        int dev = 0, cus = 0, per_cu = 0;
        if (hipGetDevice(&dev) != hipSuccess || hipDeviceGetAttribute(&cus, hipDeviceAttributeMultiprocessorCount, dev) != hipSuccess) { grid = -1; return; }
        if (hipFuncSetAttribute((const void*)mega_fwd, hipFuncAttributeMaxDynamicSharedMemorySize, LDS_BYTES) != hipSuccess) { fprintf(stderr, "kernel_launch: hipFuncSetAttribute failed\n"); grid = -1; return; }
        if (hipOccupancyMaxActiveBlocksPerMultiprocessor(&per_cu, (const void*)mega_fwd, NWAVES * 64, LDS_BYTES) != hipSuccess || per_cu < 1) { fprintf(stderr, "kernel_launch: occupancy query gave %d\n", per_cu); (void)hipGetLastError(); per_cu = 1; }
        grid = cus * per_cu;
    }
    if (grid < 0) return;
    (void)hipMemsetAsync((char*)d_ws + WS_CTL, 0, CTL_ZERO_BYTES, stream);
    Args a{};
    for (int i = 0; i < 25; ++i) a.in[i] = (const float*)d_in[i];
    a.out = (float*)d_out; a.ws = (unsigned char*)d_ws; a.i0 = 0; a.i1 = 0;
    void* kargs[] = {&a};
    const hipError_t e = hipLaunchCooperativeKernel((const void*)mega_fwd, dim3(grid), dim3(NWAVES * 64), kargs, LDS_BYTES, stream);
    if (e != hipSuccess) fprintf(stderr, "kernel_launch: cooperative launch failed: %s (grid %d)\n", hipGetErrorString(e), grid);
}
```
